# Optimizing an MI355X kernel written in HIP

```python
import math
import jax
import jax.numpy as jnp
from jax import lax
import numpy as np

D_MODEL = 2048
BATCH = 4
SEQ = 4096
DEPTH = 1

D_SSM = D_MODEL // 2
D_ATT = D_MODEL - D_SSM
SSM_HEADDIM = 64
SSM_HEADS = D_SSM // SSM_HEADDIM
SSM_GROUPS = 2
SSM_HPG = SSM_HEADS // SSM_GROUPS
SSM_STATE = 128
CONV_WIDTH = 4
CHUNK = 128
D_CONV = D_SSM + 2 * SSM_GROUPS * SSM_STATE
ATT_HEADDIM = 64
ATT_HEADS = D_ATT // ATT_HEADDIM
ATT_KV_HEADS = 2
ATT_QPK = ATT_HEADS // ATT_KV_HEADS
WINDOW = 128
D_KV = ATT_KV_HEADS * ATT_HEADDIM
PEER_HEADS = 8
PEER_KEYS = 128
PEER_EXPERTS = PEER_KEYS * PEER_KEYS
PEER_TOPK = 16
PEER_QDIM = 256
PEER_HALF = PEER_QDIM // 2
PEER_TOKEN_BLOCK = 128
N_MOD = 6
ALPHA = (2.0 * DEPTH) ** 0.25
BETA = (8.0 * DEPTH) ** -0.25
EPS = 1e-5
SPLIT_IDX = (D_SSM,
             D_SSM + D_CONV,
             D_SSM + D_CONV + SSM_HEADS,
             D_SSM + D_CONV + SSM_HEADS + D_ATT,
             D_SSM + D_CONV + SSM_HEADS + D_ATT + D_KV)
D_IN = SPLIT_IDX[-1] + D_KV

kernel_name = "hybrid_ssd_swa_peer_deepnorm_adaln"


def layer_norm(x, g, b):
    xf = x.astype(jnp.float32)
    mu = jnp.mean(xf, axis=-1, keepdims=True)
    var = jnp.mean(jnp.square(xf - mu), axis=-1, keepdims=True)
    return ((xf - mu) * lax.rsqrt(var + EPS) * g.astype(jnp.float32) + b.astype(jnp.float32)).astype(x.dtype)


def rms_norm(x, g):
    xf = x.astype(jnp.float32)
    return xf * lax.rsqrt(jnp.mean(jnp.square(xf), axis=-1, keepdims=True) + EPS) * g.astype(jnp.float32)


def causal_dwconv(x, w, b):
    out = lax.conv_general_dilated(
        x, w[:, None, :].astype(x.dtype), window_strides=(1,), padding=[(CONV_WIDTH - 1, 0)],
        dimension_numbers=('NWC', 'WIO', 'NWC'), feature_group_count=x.shape[-1])
    return out + b.astype(x.dtype)


def ssd_chunked(xh, dt, A, Bm, Cm):
    b, s = xh.shape[:2]
    nc = s // CHUNK
    xh = xh.reshape(b, nc, CHUNK, SSM_GROUPS, SSM_HPG, SSM_HEADDIM)
    dt = dt.reshape(b, nc, CHUNK, SSM_GROUPS, SSM_HPG)
    Bm = Bm.reshape(b, nc, CHUNK, SSM_GROUPS, SSM_STATE)
    Cm = Cm.reshape(b, nc, CHUNK, SSM_GROUPS, SSM_STATE)
    a_cum = jnp.cumsum(dt * A, axis=2)
    a_t = jnp.moveaxis(a_cum, 2, -1)
    seg = a_t[..., :, None] - a_t[..., None, :]
    causal = jnp.tril(jnp.ones((CHUNK, CHUNK), dtype=bool))
    decay = jnp.exp(jnp.where(causal, seg, -jnp.inf))
    cb = jnp.einsum('bclgn,bcsgn->bcgls', Cm, Bm)
    w = cb[:, :, :, None] * decay * jnp.moveaxis(dt, 2, -1)[..., None, :]
    y_diag = jnp.einsum('bcgrls,bcsgrp->bclgrp', w, xh)
    decay_to_end = jnp.exp(a_cum[:, :, -1:] - a_cum)
    states = jnp.einsum('bclgn,bclgr,bclgrp->bcgrpn', Bm, decay_to_end * dt, xh)
    chunk_decay = jnp.exp(a_cum[:, :, -1])

    def step(h, inp):
        st, dec = inp
        return dec[..., None, None] * h + st, h

    h0 = jnp.zeros((b, SSM_GROUPS, SSM_HPG, SSM_HEADDIM, SSM_STATE), jnp.float32)
    _, prev = lax.scan(step, h0, (jnp.moveaxis(states, 1, 0), jnp.moveaxis(chunk_decay, 1, 0)))
    prev = jnp.moveaxis(prev, 0, 1)
    y_off = jnp.einsum('bclgn,bcgrpn,bclgr->bclgrp', Cm, prev, jnp.exp(a_cum))
    return (y_diag + y_off).reshape(b, s, SSM_GROUPS, SSM_HPG, SSM_HEADDIM)


def sliding_window_sink_attention(q, k, v, sinks):
    f32 = jnp.float32
    b, s, _ = q.shape
    nb = s // WINDOW
    qh = q.astype(f32).reshape(b, nb, WINDOW, ATT_KV_HEADS, ATT_QPK, ATT_HEADDIM) * (ATT_HEADDIM ** -0.5)
    kh = k.astype(f32).reshape(b, nb, WINDOW, ATT_KV_HEADS, ATT_HEADDIM)
    vh = v.astype(f32).reshape(b, nb, WINDOW, ATT_KV_HEADS, ATT_HEADDIM)

    def with_prev(t):
        prev = jnp.concatenate([jnp.zeros_like(t[:, :1]), t[:, :-1]], axis=1)
        return jnp.concatenate([prev, t], axis=2)

    kb, vb = with_prev(kh), with_prev(vh)
    scores = jnp.einsum('bnqhrd,bnshd->bnhrqs', qh, kb)
    qi = jnp.arange(WINDOW)[:, None]
    kj = jnp.arange(2 * WINDOW)[None, :]
    dist = qi + WINDOW - kj
    band = (dist >= 0) & (dist < WINDOW)
    block_ids = jnp.arange(nb)[:, None, None]
    mask = band[None] & ((block_ids > 0) | (kj >= WINDOW)[None])
    scores = jnp.where(mask[None, :, None, None], scores, -jnp.inf)
    sink = sinks.astype(f32).reshape(ATT_KV_HEADS, ATT_QPK)[None, None, :, :, None, None]
    m = jnp.maximum(jnp.max(scores, axis=-1, keepdims=True), sink)
    p = jnp.exp(scores - m)
    denom = jnp.sum(p, axis=-1, keepdims=True) + jnp.exp(sink - m)
    o = jnp.einsum('bnhrqs,bnshd->bnqhrd', p / denom, vb)
    return o.reshape(b, s, D_ATT)


def hybrid_mixer(h, w_in, conv_w, conv_b, dt_bias, a_log, d_skip, ssm_norm_g, sinks, att_norm_g, w_out):
    f32 = jnp.float32
    b, s, _ = h.shape
    proj = h @ w_in
    z, xbc, dt_raw, q, k, v = jnp.split(proj, list(SPLIT_IDX), axis=-1)
    xbc = jax.nn.silu(causal_dwconv(xbc, conv_w, conv_b))
    xs, Bm, Cm = jnp.split(xbc, [D_SSM, D_SSM + SSM_GROUPS * SSM_STATE], axis=-1)
    dt = jax.nn.softplus(dt_raw.astype(f32) + dt_bias.astype(f32))
    A = -jnp.exp(a_log.astype(f32))
    xh = xs.astype(f32).reshape(b, s, SSM_GROUPS, SSM_HPG, SSM_HEADDIM)
    y = ssd_chunked(xh, dt.reshape(b, s, SSM_GROUPS, SSM_HPG), A.reshape(SSM_GROUPS, SSM_HPG),
                    Bm.astype(f32).reshape(b, s, SSM_GROUPS, SSM_STATE),
                    Cm.astype(f32).reshape(b, s, SSM_GROUPS, SSM_STATE))
    y = y + d_skip.astype(f32).reshape(SSM_GROUPS, SSM_HPG)[..., None] * xh
    y_ssd = rms_norm(y.reshape(b, s, D_SSM) * jax.nn.silu(z.astype(f32)), ssm_norm_g)
    y_att = rms_norm(sliding_window_sink_attention(q, k, v, sinks), att_norm_g)
    return jnp.concatenate([y_ssd, y_att], axis=-1).astype(h.dtype) @ w_out


def peer(h, w_q, sub_keys, u_tab, v_tab):
    f32 = jnp.float32
    b, s, d = h.shape
    blocks = h.reshape(-1, PEER_TOKEN_BLOCK, d)
    keys = sub_keys.astype(f32)

    def block(hb):
        t = hb.shape[0]
        q = (hb @ w_q).astype(f32).reshape(t, PEER_HEADS, 2, PEER_HALF)
        sc = jnp.einsum('thcd,hcnd->thcn', q, keys)
        val, idx = lax.top_k(sc, PEER_TOPK)
        cand = val[..., 0, :, None] + val[..., 1, None, :]
        cand_idx = idx[..., 0, :, None] * PEER_KEYS + idx[..., 1, None, :]
        best, pos = lax.top_k(cand.reshape(t, PEER_HEADS, PEER_TOPK * PEER_TOPK), PEER_TOPK)
        expert = jnp.take_along_axis(cand_idx.reshape(t, PEER_HEADS, PEER_TOPK * PEER_TOPK), pos, axis=-1)
        g = jax.nn.softmax(best, axis=-1)
        u = u_tab[expert]
        a = jnp.einsum('td,thkd->thk', hb, u)
        wgt = (g * jax.nn.gelu(a.astype(f32), approximate=False)).astype(hb.dtype)
        return jnp.einsum('thk,thkd->td', wgt, v_tab[expert])

    return lax.map(block, blocks).reshape(b, s, d)


def setup_inputs(seed: int = 0) -> dict:
    key = jax.random.key(seed)
    ks = jax.random.split(key, 24)
    f32 = jnp.float32
    L = DEPTH

    def nrm(k, shape, scale):
        return jax.random.normal(k, shape, f32) * scale

    x = nrm(ks[0], (BATCH, SEQ, D_MODEL), 1.0)
    c = nrm(ks[1], (BATCH, D_MODEL), 1.0)
    w_ada = nrm(ks[2], (L, D_MODEL, N_MOD * D_MODEL), 0.5 * D_MODEL ** -0.5)
    b_ada = nrm(ks[3], (L, N_MOD * D_MODEL), 0.01)
    w_in = nrm(ks[4], (L, D_MODEL, D_IN), D_MODEL ** -0.5)
    w_in = w_in.at[:, :, SPLIT_IDX[-1]:].multiply(BETA)
    conv_w = nrm(ks[5], (L, CONV_WIDTH, D_CONV), CONV_WIDTH ** -0.5)
    conv_b = nrm(ks[6], (L, D_CONV), 0.02)
    dt0 = jnp.exp(jax.random.uniform(ks[7], (L, SSM_HEADS), f32, math.log(1e-3), math.log(1e-1)))
    dt_bias = dt0 + jnp.log(-jnp.expm1(-dt0))
    a_log = jnp.log(jax.random.uniform(ks[8], (L, SSM_HEADS), f32, 1.0, 16.0))
    d_skip = 1.0 + nrm(ks[9], (L, SSM_HEADS), 0.02)
    ssm_norm_g = 1.0 + nrm(ks[10], (L, D_SSM), 0.02)
    attn_sinks = nrm(ks[11], (L, ATT_HEADS), 0.5)
    attn_norm_g = 1.0 + nrm(ks[12], (L, D_ATT), 0.02)
    w_out = nrm(ks[13], (L, D_SSM + D_ATT, D_MODEL), BETA * (D_SSM + D_ATT) ** -0.5)
    ln1_g = 1.0 + nrm(ks[14], (L, D_MODEL), 0.02)
    ln1_b = nrm(ks[15], (L, D_MODEL), 0.02)
    peer_w_q = nrm(ks[16], (L, D_MODEL, PEER_HEADS * PEER_QDIM), D_MODEL ** -0.5)
    peer_sub_keys = nrm(ks[17], (L, PEER_HEADS, 2, PEER_KEYS, PEER_HALF), PEER_HALF ** -0.5)
    peer_u = nrm(ks[18], (L, PEER_EXPERTS, D_MODEL), D_MODEL ** -0.5)
    peer_v = nrm(ks[19], (L, PEER_EXPERTS, D_MODEL), BETA)
    ln2_g = 1.0 + nrm(ks[20], (L, D_MODEL), 0.02)
    ln2_b = nrm(ks[21], (L, D_MODEL), 0.02)
    return {'x': x, 'c': c, 'w_ada': w_ada, 'b_ada': b_ada, 'w_in': w_in, 'conv_w': conv_w,
            'conv_b': conv_b, 'dt_bias': dt_bias, 'a_log': a_log, 'd_skip': d_skip,
            'ssm_norm_g': ssm_norm_g, 'attn_sinks': attn_sinks, 'attn_norm_g': attn_norm_g,
            'w_out': w_out, 'ln1_g': ln1_g, 'ln1_b': ln1_b, 'peer_w_q': peer_w_q,
            'peer_sub_keys': peer_sub_keys, 'peer_u': peer_u, 'peer_v': peer_v,
            'ln2_g': ln2_g, 'ln2_b': ln2_b}


def reference(x, c, w_ada, b_ada, w_in, conv_w, conv_b, dt_bias, a_log, d_skip, ssm_norm_g,
              attn_sinks, attn_norm_g, w_out, ln1_g, ln1_b, peer_w_q, peer_sub_keys, peer_u,
              peer_v, ln2_g, ln2_b):
    for l in range(DEPTH):
        mod = jax.nn.silu(c) @ w_ada[l] + b_ada[l]
        shift1, scale1, gate1, shift2, scale2, gate2 = [m[:, None, :] for m in jnp.split(mod, N_MOD, axis=-1)]
        h = x * (1.0 + scale1) + shift1
        y = hybrid_mixer(h, w_in[l], conv_w[l], conv_b[l], dt_bias[l], a_log[l], d_skip[l],
                         ssm_norm_g[l], attn_sinks[l], attn_norm_g[l], w_out[l])
        x = layer_norm(ALPHA * x + gate1 * y, ln1_g[l], ln1_b[l])
        h = x * (1.0 + scale2) + shift2
        y = peer(h, peer_w_q[l], peer_sub_keys[l], peer_u[l], peer_v[l])
        x = layer_norm(ALPHA * x + gate2 * y, ln2_g[l], ln2_b[l])
    return x
```

```cpp
#include <hip/hip_runtime.h>
#include <cstdio>
#include <cstdint>

#ifndef ONE_LAUNCH
#define ONE_LAUNCH 0
#endif

#define LAS __attribute__((address_space(3)))
typedef unsigned short bf16_t;
typedef float f32x4 __attribute__((ext_vector_type(4)));
typedef unsigned u32x4 __attribute__((ext_vector_type(4)));
typedef unsigned u32x2 __attribute__((ext_vector_type(2)));

namespace {
constexpr int NB = 4, SEQ = 4096, T = NB * SEQ, D = 2048;
constexpr int NH = 16, NCH = SEQ / 128;
constexpr int DINP = 4096;
constexpr int Z_OFF = 0, XBC_OFF = 1024, Q_OFF = 2560, K_OFF = 3584, V_OFF = 3712, DT_OFF = 3840;
constexpr int NMOD = 6 * D;
constexpr float ALPHA = 1.189207115002721f;
constexpr float EPS = 1e-5f;
constexpr int NTHR = 512, NWAVES = 8;

constexpr size_t MiB = 1u << 20;
constexpr size_t WS_CTL = 0, CTL_ZERO_BYTES = 1 * MiB;
constexpr size_t WS_MOD = 512 * 1024;
constexpr size_t WS_KEYS = 1 * MiB;
constexpr size_t WS_DTRAW = 2 * MiB;
constexpr size_t WS_DT = 3 * MiB;
constexpr size_t WS_ACUM = 4 * MiB;
constexpr size_t WS_SSP = 5 * MiB;
constexpr size_t WS_RS = 7 * MiB;
constexpr size_t WS_EXP = 8 * MiB;
constexpr size_t WS_GATE = 16 * MiB;
constexpr size_t WS_WIN = 24 * MiB;
constexpr size_t WS_WOUT = 40 * MiB;
constexpr size_t WS_WQ = 48 * MiB;
constexpr size_t WS_UB = 56 * MiB;
constexpr size_t WS_VB = 120 * MiB;
constexpr size_t WS_ACT = 184 * MiB;
constexpr size_t WS_PROJ = 248 * MiB;
constexpr size_t WS_XBCC = 376 * MiB;
constexpr size_t WS_STATES = 424 * MiB;
constexpr size_t WS_PREVB = 488 * MiB;
constexpr size_t WS_END = 520 * MiB;

constexpr int RING_BYTES = 131072;
constexpr int LDSCTL_OFF = RING_BYTES, MISC_OFF = LDSCTL_OFF + 320;
constexpr int LDS_BYTES = 147456;

__device__ __forceinline__ float bf2f(unsigned v) { return __uint_as_float(v << 16); }
__device__ __forceinline__ float bflo(unsigned w) { return __uint_as_float(w << 16); }
__device__ __forceinline__ float bfhi(unsigned w) { return __uint_as_float(w & 0xffff0000u); }
__device__ __forceinline__ unsigned f2bf(float f) { unsigned u = __float_as_uint(f); return (u + 0x7fffu + ((u >> 16) & 1u)) >> 16; }
__device__ __forceinline__ unsigned pk2(float lo, float hi) { return f2bf(lo) | (f2bf(hi) << 16); }
__device__ __forceinline__ float silu_f(float x) { return x / (1.f + expf(-x)); }
__device__ __forceinline__ float softplus_f(float x) { return x > 20.f ? x : log1pf(expf(x)); }
__device__ __forceinline__ float gelu_f(float x) { return 0.5f * x * (1.f + erff(x * 0.70710678118654752f)); }
__device__ __forceinline__ float wave_sum(float v) {
#pragma unroll
    for (int o = 1; o < 64; o <<= 1) v += __shfl_xor(v, o);
    return v;
}
__device__ __forceinline__ float dot8(u32x4 a, u32x4 b) {
    float s = bflo(a.x) * bflo(b.x); s += bfhi(a.x) * bfhi(b.x);
    s += bflo(a.y) * bflo(b.y); s += bfhi(a.y) * bfhi(b.y);
    s += bflo(a.z) * bflo(b.z); s += bfhi(a.z) * bfhi(b.z);
    s += bflo(a.w) * bflo(b.w); s += bfhi(a.w) * bfhi(b.w);
    return s;
}
__device__ __forceinline__ int win_src_col(int n) { return n < 2560 ? n : (n < 3840 ? n + 16 : (n < 3856 ? n - 1280 : -1)); }

#define XB_TMO      128
#define XB_XCNT(j)  (256  + 64 * (j))
#define XB_XSUB(j)  (1280 + 64 * (j))
#define XB_XGEN(j)  (2304 + 64 * (j))
#define XB_TOP      3328
#define XB_TOPGEN   3392
#define XCD_BAR_WORDS 3456
#define XB_SPIN_CAP (1u << 18)
__device__ __forceinline__ unsigned xb_ld(unsigned* p)              { return __hip_atomic_load(p, __ATOMIC_RELAXED, __HIP_MEMORY_SCOPE_AGENT); }
__device__ __forceinline__ unsigned xb_add(unsigned* p, unsigned v) { return __hip_atomic_fetch_add(p, v, __ATOMIC_RELAXED, __HIP_MEMORY_SCOPE_AGENT); }
__device__ __forceinline__ unsigned xb_xcc_id() { return (unsigned)__builtin_amdgcn_s_getreg((3 << 11) | 20) & 0xFu; }
#define XB_SPIN(cond, bar) do { unsigned _sp = 0; while (cond) { __builtin_amdgcn_s_sleep(1); \
    if ((++_sp & 255u) == 0u) { if (xb_ld(&(bar)[XB_TMO])) break; if (_sp > XB_SPIN_CAP) { atomicAdd(&(bar)[XB_TMO], 1u); break; } } } } while (0)
struct XcdBarrier { unsigned* bar; unsigned x; volatile LAS unsigned* st; };
__device__ __forceinline__ XcdBarrier xcd_barrier_post(unsigned* bar, volatile LAS unsigned* st) {
    XcdBarrier b; b.bar = bar; b.x = xb_xcc_id(); b.st = st;
    if (threadIdx.x == 0) (void)xb_add(&bar[XB_XCNT(b.x)], 1u);
    return b;
}
__device__ __forceinline__ void xcd_barrier_complete(unsigned* bar, unsigned x, unsigned& nloc, unsigned& nx) {
    const unsigned G = gridDim.x * gridDim.y * gridDim.z;
    unsigned sum, cnt, mine, sp = 0u;
    for (;;) {
        sum = 0u; cnt = 0u; mine = 0u;
#pragma unroll
        for (unsigned j = 0; j < 16; ++j) { const unsigned c = xb_ld(&bar[XB_XCNT(j)]); sum += c; cnt += (c > 0u) ? 1u : 0u; mine = (j == x) ? c : mine; }
        if (sum == G) break;
        __builtin_amdgcn_s_sleep(1);
        if ((++sp & 255u) == 0u) { if (xb_ld(&bar[XB_TMO])) break; if (sp > XB_SPIN_CAP) { atomicAdd(&bar[XB_TMO], 1u); break; } }
    }
    nloc = mine > 0u ? mine : 1u; nx = cnt > 0u ? cnt : 1u;
}
__device__ __forceinline__ void xcd_barrier(const XcdBarrier& b) {
    asm volatile("s_waitcnt vmcnt(0)" ::: "memory");
    __syncthreads();
    if (threadIdx.x == 0) {
        unsigned* bar = b.bar;
        __builtin_amdgcn_s_waitcnt(0);
        unsigned nloc = b.st[0], nx = b.st[1];
        if (nloc == 0u) { xcd_barrier_complete(bar, b.x, nloc, nx); b.st[0] = nloc; b.st[1] = nx; }
        const unsigned old = xb_add(&bar[XB_XSUB(b.x)], 1u);
        const unsigned gen = old / nloc;
        if (old + 1u == (gen + 1u) * nloc) {
            __builtin_amdgcn_fence(__ATOMIC_RELEASE, "agent");
            asm volatile("s_waitcnt vmcnt(0)" ::: "memory");
            const unsigned og = xb_add(&bar[XB_TOP], 1u);
            const unsigned tg = og / nx;
            if (og + 1u == (tg + 1u) * nx) xb_add(&bar[XB_TOPGEN], 1u);
            else XB_SPIN(xb_ld(&bar[XB_TOPGEN]) == tg, bar);
            __builtin_amdgcn_fence(__ATOMIC_ACQUIRE, "agent");
            xb_add(&bar[XB_XGEN(b.x)], 1u);
            asm volatile("s_waitcnt vmcnt(0)" ::: "memory");
        } else {
            XB_SPIN(xb_ld(&bar[XB_XGEN(b.x)]) == gen, bar);
            __builtin_amdgcn_fence(__ATOMIC_ACQUIRE, "agent");
            asm volatile("s_waitcnt vmcnt(0)" ::: "memory");
        }
    }
    __syncthreads();
}

struct Args { const float* in[22]; float* out; unsigned char* ws; int lo, hi; };
struct Ctx {
    const float* in[22]; float* out; unsigned char* ws; LAS unsigned char* lds;
    int tid, lane, wave, gw, ngw, gt, ngt;
};
#define IN_X c.in[0]
#define IN_C c.in[1]
#define IN_WADA c.in[2]
#define IN_BADA c.in[3]
#define IN_WIN c.in[4]
#define IN_CONVW c.in[5]
#define IN_CONVB c.in[6]
#define IN_DTBIAS c.in[7]
#define IN_ALOG c.in[8]
#define IN_DSKIP c.in[9]
#define IN_SSMG c.in[10]
#define IN_SINKS c.in[11]
#define IN_ATTG c.in[12]
#define IN_WOUT c.in[13]
#define IN_LN1G c.in[14]
#define IN_LN1B c.in[15]
#define IN_WQ c.in[16]
#define IN_KEYS c.in[17]
#define IN_U c.in[18]
#define IN_V c.in[19]
#define IN_LN2G c.in[20]
#define IN_LN2B c.in[21]
#define WSP(type, off) ((type*)(c.ws + (off)))

template <int MODE>
__device__ __forceinline__ void transpose_item(const float* W, int K, int Nsrc, int ND, bf16_t* WT, LAS float* scr, int item, int lane, const float* g1, const float* g2) {
    const int nblk = ND / 32, kb = item / nblk, nb = item % nblk, k0 = 64 * kb, n0 = 32 * nb;
    const int n = n0 + (lane & 31), sc = MODE == 0 ? win_src_col(n) : n;
#pragma unroll 8
    for (int i = 0; i < 32; ++i) {
        const int kk = 2 * i + (lane >> 5);
        float v = sc >= 0 ? W[(size_t)(k0 + kk) * Nsrc + sc] : 0.f;
        if (MODE == 1) v *= (k0 + kk < 1024) ? g1[k0 + kk] : g2[k0 + kk - 1024];
        scr[kk * 33 + (lane & 31)] = v;
    }
    asm volatile("s_waitcnt lgkmcnt(0)" ::: "memory");
    const int cch = lane & 7;
#pragma unroll
    for (int j = 0; j < 4; ++j) {
        const int nn = (lane >> 3) + 8 * j; const LAS float* s = scr + (8 * cch) * 33 + nn;
        u32x4 o; o.x = pk2(s[0 * 33], s[1 * 33]); o.y = pk2(s[2 * 33], s[3 * 33]); o.z = pk2(s[4 * 33], s[5 * 33]); o.w = pk2(s[6 * 33], s[7 * 33]);
        *(u32x4*)(WT + (size_t)(n0 + nn) * K + k0 + 8 * cch) = o;
    }
    asm volatile("s_waitcnt lgkmcnt(0)" ::: "memory");
}
__device__ __forceinline__ void cvt_f32_bf16(const Ctx& c, const float* src, bf16_t* dst, size_t n8) {
    for (size_t i = (size_t)c.gt; i < n8; i += (size_t)c.ngt) {
        const f32x4 a = ((const f32x4*)src)[2 * i], b = ((const f32x4*)src)[2 * i + 1];
        u32x4 o; o.x = pk2(a.x, a.y); o.y = pk2(a.z, a.w); o.z = pk2(b.x, b.y); o.w = pk2(b.z, b.w);
        ((u32x4*)dst)[i] = o;
    }
}
__device__ __forceinline__ void step_pro(const Ctx& c) {
    float* MOD = WSP(float, WS_MOD);
    {
        LAS float* sl = (LAS float*)c.lds;
        for (int i = c.tid; i < 4 * D; i += NTHR) sl[i] = silu_f(IN_C[i]);
        __syncthreads();
        float* PART = WSP(float, WS_STATES);
        unsigned* CNT = WSP(unsigned, WS_CTL) + 8192;
        for (int it = c.gw; it < 192 * 32; it += c.ngw) {
            const int nb = it >> 5, kb = it & 31, col = nb * 64 + c.lane;
            float acc0 = 0.f, acc1 = 0.f, acc2 = 0.f, acc3 = 0.f;
            const float* wp = IN_WADA + (size_t)(kb * 64) * NMOD + col;
#pragma unroll 16
            for (int kk = 0; kk < 64; ++kk) {
                const float w = wp[(size_t)kk * NMOD]; const int k = kb * 64 + kk;
                acc0 += sl[k] * w; acc1 += sl[D + k] * w; acc2 += sl[2 * D + k] * w; acc3 += sl[3 * D + k] * w;
            }
            float* pp = PART + ((size_t)it * 4) * 64 + c.lane;
            pp[0] = acc0; pp[64] = acc1; pp[128] = acc2; pp[192] = acc3;
            asm volatile("s_waitcnt vmcnt(0)" ::: "memory");
            __builtin_amdgcn_fence(__ATOMIC_RELEASE, "agent");
            asm volatile("s_waitcnt vmcnt(0)" ::: "memory");
            unsigned ticket = 0u;
            if (c.lane == 0) ticket = __hip_atomic_fetch_add(CNT + nb, 1u, __ATOMIC_RELAXED, __HIP_MEMORY_SCOPE_AGENT);
            ticket = __builtin_amdgcn_readfirstlane(ticket);
            if (ticket == 31u) {
                __builtin_amdgcn_fence(__ATOMIC_ACQUIRE, "agent");
                asm volatile("s_waitcnt vmcnt(0)" ::: "memory");
                const float bb = IN_BADA[col]; float s0 = bb, s1 = bb, s2 = bb, s3 = bb;
                const float* rp = PART + ((size_t)nb * 32 * 4) * 64 + c.lane;
#pragma unroll 8
                for (int j = 0; j < 32; ++j) { s0 += rp[j * 256]; s1 += rp[j * 256 + 64]; s2 += rp[j * 256 + 128]; s3 += rp[j * 256 + 192]; }
                MOD[col] = s0; MOD[NMOD + col] = s1; MOD[2 * NMOD + col] = s2; MOD[3 * NMOD + col] = s3;
            }
        }
        __syncthreads();
    }
    LAS float* scr = (LAS float*)(c.lds + c.wave * 16384);
    constexpr int I_IN = (D / 64) * (DINP / 32), I_SQ = (D / 64) * (D / 32);
    for (int it = c.gw; it < I_IN + 2 * I_SQ; it += c.ngw) {
        int r = it;
        if (r < I_IN) { transpose_item<0>(IN_WIN, D, 3856, DINP, WSP(bf16_t, WS_WIN), scr, r, c.lane, nullptr, nullptr); continue; } r -= I_IN;
        if (r < I_SQ) { transpose_item<1>(IN_WOUT, D, D, D, WSP(bf16_t, WS_WOUT), scr, r, c.lane, IN_SSMG, IN_ATTG); continue; } r -= I_SQ;
        transpose_item<2>(IN_WQ, D, D, D, WSP(bf16_t, WS_WQ), scr, r, c.lane, nullptr, nullptr);
    }
    cvt_f32_bf16(c, IN_U, WSP(bf16_t, WS_UB), (size_t)16384 * D / 8);
    cvt_f32_bf16(c, IN_V, WSP(bf16_t, WS_VB), (size_t)16384 * D / 8);
    cvt_f32_bf16(c, IN_KEYS, WSP(bf16_t, WS_KEYS), (size_t)8 * 2 * 128 * 128 / 8);
}

__device__ __forceinline__ void step_h1(const Ctx& c) {
    const float* MOD = WSP(float, WS_MOD); bf16_t* H1 = WSP(bf16_t, WS_ACT);
    for (int t = c.gw; t < T; t += c.ngw) {
        const int b = t >> 12; const float* xr = IN_X + (size_t)t * D; const float* sh = MOD + b * NMOD; const float* sc = sh + D;
#pragma unroll
        for (int j = 0; j < 8; ++j) {
            const int col = j * 256 + c.lane * 4;
            const f32x4 xv = *(const f32x4*)(xr + col), s = *(const f32x4*)(sc + col), h = *(const f32x4*)(sh + col);
            u32x2 o; o.x = pk2(xv.x * (1.f + s.x) + h.x, xv.y * (1.f + s.y) + h.y); o.y = pk2(xv.z * (1.f + s.z) + h.z, xv.w * (1.f + s.w) + h.w);
            *(u32x2*)(H1 + (size_t)t * D + col) = o;
        }
    }
}

struct Epi1 {
    bf16_t* proj; float* dtraw;
    __device__ __forceinline__ float rho(int) const { return 1.f; }
    __device__ __forceinline__ void store8(int row, int col, const float (&v)[8]) const {
        u32x4 o; o.x = pk2(v[0], v[1]); o.y = pk2(v[2], v[3]); o.z = pk2(v[4], v[5]); o.w = pk2(v[6], v[7]);
        *(u32x4*)(proj + (size_t)row * DINP + col) = o;
        if (col >= DT_OFF && col < DT_OFF + 16) {
            float* d = dtraw + (size_t)row * 16 + (col - DT_OFF);
            *(f32x4*)d = (f32x4){v[0], v[1], v[2], v[3]}; *(f32x4*)(d + 4) = (f32x4){v[4], v[5], v[6], v[7]};
        }
    }
};
struct Epi2 {
    const float* x; const float* mod; const float* rs; float* r1;
    __device__ __forceinline__ float rho(int row) const { return rs[2 * row]; }
    __device__ __forceinline__ void store8(int row, int col, const float (&v)[8]) const {
        const float ra = rs[2 * row + 1]; const int b = row >> 12;
        const float* g = mod + b * NMOD + 2 * D + col; const float* xr = x + (size_t)row * D + col; float* o = r1 + (size_t)row * D + col;
        const f32x4 g0 = *(const f32x4*)g, g1 = *(const f32x4*)(g + 4), x0 = *(const f32x4*)xr, x1 = *(const f32x4*)(xr + 4);
        *(f32x4*)o = (f32x4){ALPHA * x0.x + g0.x * (ra * v[0]), ALPHA * x0.y + g0.y * (ra * v[1]), ALPHA * x0.z + g0.z * (ra * v[2]), ALPHA * x0.w + g0.w * (ra * v[3])};
        *(f32x4*)(o + 4) = (f32x4){ALPHA * x1.x + g1.x * (ra * v[4]), ALPHA * x1.y + g1.y * (ra * v[5]), ALPHA * x1.z + g1.z * (ra * v[6]), ALPHA * x1.w + g1.w * (ra * v[7])};
    }
};
struct Epi3 {
    bf16_t* q;
    __device__ __forceinline__ float rho(int) const { return 1.f; }
    __device__ __forceinline__ void store8(int row, int col, const float (&v)[8]) const {
        u32x4 o; o.x = pk2(v[0], v[1]); o.y = pk2(v[2], v[3]); o.z = pk2(v[4], v[5]); o.w = pk2(v[6], v[7]);
        *(u32x4*)(q + (size_t)row * D + col) = o;
    }
};

template <class Epi, bool MIDK>
__device__ __forceinline__ void gemm_simple(const Ctx& c, const bf16_t* A, const bf16_t* Bt, int M, int N, int K, const Epi& E) {
    LAS float* As = (LAS float*)c.lds;
    LAS float* Bs = As + 32 * 132;
    const int tid = c.tid, ty = tid >> 4, tx = tid & 15, lr = tid >> 2, lk = (tid & 3) * 8;
    const int nTn = N / 128, ntile = (M / 128) * nTn;
    for (int tile = blockIdx.x; tile < ntile; tile += gridDim.x) {
        const int tm = tile / nTn, tn = tile % nTn;
        float acc[4][8];
#pragma unroll
        for (int i = 0; i < 4; ++i)
#pragma unroll
            for (int j = 0; j < 8; ++j) acc[i][j] = 0.f;
        const bf16_t* Ap = A + (size_t)(tm * 128 + lr) * K + lk;
        const bf16_t* Bp = Bt + (size_t)(tn * 128 + lr) * K + lk;
        for (int k0 = 0; k0 < K; k0 += 32) {
            if (MIDK && k0 == K / 2) {
#pragma unroll
                for (int i = 0; i < 4; ++i) { const float r = E.rho(tm * 128 + ty * 4 + i);
#pragma unroll
                    for (int j = 0; j < 8; ++j) acc[i][j] *= r; }
            }
            const u32x4 av = *(const u32x4*)(Ap + k0), bv = *(const u32x4*)(Bp + k0);
            __syncthreads();
            As[(lk + 0) * 132 + lr] = bflo(av.x); As[(lk + 1) * 132 + lr] = bfhi(av.x); As[(lk + 2) * 132 + lr] = bflo(av.y); As[(lk + 3) * 132 + lr] = bfhi(av.y);
            As[(lk + 4) * 132 + lr] = bflo(av.z); As[(lk + 5) * 132 + lr] = bfhi(av.z); As[(lk + 6) * 132 + lr] = bflo(av.w); As[(lk + 7) * 132 + lr] = bfhi(av.w);
            Bs[(lk + 0) * 132 + lr] = bflo(bv.x); Bs[(lk + 1) * 132 + lr] = bfhi(bv.x); Bs[(lk + 2) * 132 + lr] = bflo(bv.y); Bs[(lk + 3) * 132 + lr] = bfhi(bv.y);
            Bs[(lk + 4) * 132 + lr] = bflo(bv.z); Bs[(lk + 5) * 132 + lr] = bfhi(bv.z); Bs[(lk + 6) * 132 + lr] = bflo(bv.w); Bs[(lk + 7) * 132 + lr] = bfhi(bv.w);
            __syncthreads();
#pragma unroll 8
            for (int k = 0; k < 32; ++k) {
                const f32x4 a = *(const LAS f32x4*)(As + k * 132 + ty * 4);
                const f32x4 b0 = *(const LAS f32x4*)(Bs + k * 132 + tx * 8), b1 = *(const LAS f32x4*)(Bs + k * 132 + tx * 8 + 4);
                const float aa[4] = {a.x, a.y, a.z, a.w}; const float bb[8] = {b0.x, b0.y, b0.z, b0.w, b1.x, b1.y, b1.z, b1.w};
#pragma unroll
                for (int i = 0; i < 4; ++i)
#pragma unroll
                    for (int j = 0; j < 8; ++j) acc[i][j] += aa[i] * bb[j];
            }
        }
#pragma unroll
        for (int i = 0; i < 4; ++i) E.store8(tm * 128 + ty * 4 + i, tn * 128 + tx * 8, acc[i]);
    }
    __syncthreads();
}

__device__ __forceinline__ void step_conv(const Ctx& c) {
    const bf16_t* PROJ = WSP(bf16_t, WS_PROJ); bf16_t* XBCC = WSP(bf16_t, WS_XBCC);
    for (int idx = c.gt; idx < T * 768; idx += c.ngt) {
        const int t = idx / 768, ch = (idx % 768) * 2, pos = t & (SEQ - 1);
        float a0 = IN_CONVB[ch], a1 = IN_CONVB[ch + 1];
#pragma unroll
        for (int j = 0; j < 4; ++j) {
            if (pos - 3 + j >= 0) {
                const unsigned v = *(const unsigned*)(PROJ + (size_t)(t - 3 + j) * DINP + XBC_OFF + ch);
                a0 += IN_CONVW[j * 1536 + ch] * bflo(v); a1 += IN_CONVW[j * 1536 + ch + 1] * bfhi(v);
            }
        }
        *(unsigned*)(XBCC + (size_t)t * 1536 + ch) = pk2(silu_f(a0), silu_f(a1));
    }
    const float* DTRAW = WSP(float, WS_DTRAW); float* DT = WSP(float, WS_DT); float* ACUM = WSP(float, WS_ACUM);
    for (int idx = c.gt; idx < NB * NCH * NH; idx += c.ngt) {
        const int h = idx % NH, bc = idx / NH, t0 = bc * 128;
        const float A = -expf(IN_ALOG[h]), bias = IN_DTBIAS[h]; float cum = 0.f;
        for (int l = 0; l < 128; ++l) {
            const float dtv = softplus_f(DTRAW[(size_t)(t0 + l) * 16 + h] + bias); cum += dtv * A;
            DT[(size_t)idx * 128 + l] = dtv; ACUM[(size_t)idx * 128 + l] = cum;
        }
    }
}

__device__ __forceinline__ void step_ssd1_simple(const Ctx& c) {
    const bf16_t* XBCC = WSP(bf16_t, WS_XBCC); const float* DT = WSP(float, WS_DT); const float* ACUM = WSP(float, WS_ACUM); float* STATES = WSP(float, WS_STATES);
    LAS float* wl = (LAS float*)c.lds;
    for (int item = blockIdx.x; item < NB * NCH * NH; item += gridDim.x) {
        const int bc = item / NH, h = item % NH, g = h >> 3, t0 = bc * 128;
        __syncthreads();
        if (c.tid < 128) { const float aend = ACUM[(size_t)item * 128 + 127]; wl[c.tid] = expf(aend - ACUM[(size_t)item * 128 + c.tid]) * DT[(size_t)item * 128 + c.tid]; }
        __syncthreads();
        const int p = c.tid >> 3, n0 = (c.tid & 7) * 16;
        float acc[16];
#pragma unroll
        for (int j = 0; j < 16; ++j) acc[j] = 0.f;
        for (int l = 0; l < 128; ++l) {
            const bf16_t* row = XBCC + (size_t)(t0 + l) * 1536;
            const float xv = bf2f(row[h * 64 + p]) * wl[l];
            const u32x4 b0 = *(const u32x4*)(row + 1024 + g * 128 + n0), b1 = *(const u32x4*)(row + 1024 + g * 128 + n0 + 8);
            acc[0] += xv * bflo(b0.x); acc[1] += xv * bfhi(b0.x); acc[2] += xv * bflo(b0.y); acc[3] += xv * bfhi(b0.y);
            acc[4] += xv * bflo(b0.z); acc[5] += xv * bfhi(b0.z); acc[6] += xv * bflo(b0.w); acc[7] += xv * bfhi(b0.w);
            acc[8] += xv * bflo(b1.x); acc[9] += xv * bfhi(b1.x); acc[10] += xv * bflo(b1.y); acc[11] += xv * bfhi(b1.y);
            acc[12] += xv * bflo(b1.z); acc[13] += xv * bfhi(b1.z); acc[14] += xv * bflo(b1.w); acc[15] += xv * bfhi(b1.w);
        }
        float* o = STATES + ((size_t)item * 64 + p) * 128 + n0;
#pragma unroll
        for (int j = 0; j < 4; ++j) *(f32x4*)(o + 4 * j) = (f32x4){acc[4 * j], acc[4 * j + 1], acc[4 * j + 2], acc[4 * j + 3]};
    }
    __syncthreads();
}

__device__ __forceinline__ void step_scan(const Ctx& c) {
    const float* STATES = WSP(float, WS_STATES); const float* ACUM = WSP(float, WS_ACUM); bf16_t* PREVB = WSP(bf16_t, WS_PREVB);
    for (int idx = c.gt; idx < NB * NH * 64 * 32; idx += c.ngt) {
        const int n4 = idx & 31, p = (idx >> 5) & 63, h = (idx >> 11) & 15, b = idx >> 15;
        f32x4 hs = {0.f, 0.f, 0.f, 0.f};
        for (int ch = 0; ch < NCH; ++ch) {
            const size_t it = (size_t)(b * NCH + ch) * NH + h, off = (it * 64 + p) * 128 + n4 * 4;
            u32x2 o; o.x = pk2(hs.x, hs.y); o.y = pk2(hs.z, hs.w); *(u32x2*)(PREVB + off) = o;
            const f32x4 st = *(const f32x4*)(STATES + off); const float dec = expf(ACUM[it * 128 + 127]);
            hs = hs * dec + st;
        }
    }
}

__device__ __forceinline__ void step_cb_simple(const Ctx& c) {
    const bf16_t* XBCC = WSP(bf16_t, WS_XBCC); float* G = WSP(float, WS_STATES);
    for (int idx = c.gt; idx < NB * NCH * 2 * 128 * 128; idx += c.ngt) {
        const int s = idx & 127, l = (idx >> 7) & 127, g = (idx >> 14) & 1, bc = idx >> 15, t0 = bc * 128;
        const bf16_t* Cr = XBCC + (size_t)(t0 + l) * 1536 + 1280 + g * 128; const bf16_t* Br = XBCC + (size_t)(t0 + s) * 1536 + 1024 + g * 128;
        float sum = 0.f;
#pragma unroll 4
        for (int n = 0; n < 128; n += 8) sum += dot8(*(const u32x4*)(Cr + n), *(const u32x4*)(Br + n));
        G[idx] = sum;
    }
}

__device__ __forceinline__ void step_ssd2_simple(const Ctx& c) {
    const bf16_t* XBCC = WSP(bf16_t, WS_XBCC); const bf16_t* PROJ = WSP(bf16_t, WS_PROJ); const bf16_t* PREVB = WSP(bf16_t, WS_PREVB);
    const float* DT = WSP(float, WS_DT); const float* ACUM = WSP(float, WS_ACUM); const float* G = WSP(float, WS_STATES);
    bf16_t* YCAT = WSP(bf16_t, WS_ACT); float* SSP = WSP(float, WS_SSP);
    LAS float* ac = (LAS float*)c.lds; LAS float* dl = ac + 128;
    for (int item = blockIdx.x; item < NB * NCH * NH; item += gridDim.x) {
        const int bc = item / NH, h = item % NH, g = h >> 3, t0 = bc * 128;
        __syncthreads();
        if (c.tid < 128) { ac[c.tid] = ACUM[(size_t)item * 128 + c.tid]; dl[c.tid] = DT[(size_t)item * 128 + c.tid]; }
        __syncthreads();
        const int l = c.tid >> 2, p0 = (c.tid & 3) * 16, t = t0 + l;
        float acc[16];
#pragma unroll
        for (int j = 0; j < 16; ++j) acc[j] = 0.f;
        {
            const bf16_t* Cr = XBCC + (size_t)t * 1536 + 1280 + g * 128; const bf16_t* Pr = PREVB + ((size_t)item * 64 + p0) * 128;
            for (int n = 0; n < 128; n += 8) {
                const u32x4 cv = *(const u32x4*)(Cr + n);
#pragma unroll
                for (int j = 0; j < 16; ++j) acc[j] += dot8(cv, *(const u32x4*)(Pr + j * 128 + n));
            }
            const float el = expf(ac[l]);
#pragma unroll
            for (int j = 0; j < 16; ++j) acc[j] *= el;
        }
        const float al = ac[l]; const float* Gr = G + ((size_t)(bc * 2 + g) * 128 + l) * 128;
        for (int s = 0; s <= l; ++s) {
            const float coef = Gr[s] * expf(al - ac[s]) * dl[s];
            const bf16_t* xr = XBCC + (size_t)(t0 + s) * 1536 + h * 64 + p0;
            const u32x4 x0 = *(const u32x4*)xr, x1 = *(const u32x4*)(xr + 8);
            acc[0] += coef * bflo(x0.x); acc[1] += coef * bfhi(x0.x); acc[2] += coef * bflo(x0.y); acc[3] += coef * bfhi(x0.y);
            acc[4] += coef * bflo(x0.z); acc[5] += coef * bfhi(x0.z); acc[6] += coef * bflo(x0.w); acc[7] += coef * bfhi(x0.w);
            acc[8] += coef * bflo(x1.x); acc[9] += coef * bfhi(x1.x); acc[10] += coef * bflo(x1.y); acc[11] += coef * bfhi(x1.y);
            acc[12] += coef * bflo(x1.z); acc[13] += coef * bfhi(x1.z); acc[14] += coef * bflo(x1.w); acc[15] += coef * bfhi(x1.w);
        }
        {
            const bf16_t* xr = XBCC + (size_t)t * 1536 + h * 64 + p0; const bf16_t* zr = PROJ + (size_t)t * DINP + Z_OFF + h * 64 + p0;
            const float dsk = IN_DSKIP[h]; float ss = 0.f; unsigned ow[8];
#pragma unroll
            for (int j = 0; j < 16; j += 2) {
                const unsigned xw = *(const unsigned*)(xr + j), zw = *(const unsigned*)(zr + j);
                const float y0 = (acc[j] + dsk * bflo(xw)) * silu_f(bflo(zw)), y1 = (acc[j + 1] + dsk * bfhi(xw)) * silu_f(bfhi(zw));
                ss += y0 * y0 + y1 * y1; ow[j >> 1] = pk2(y0, y1);
            }
            bf16_t* o = YCAT + (size_t)t * D + h * 64 + p0;
            *(u32x4*)o = (u32x4){ow[0], ow[1], ow[2], ow[3]}; *(u32x4*)(o + 8) = (u32x4){ow[4], ow[5], ow[6], ow[7]};
            ss += __shfl_xor(ss, 1); ss += __shfl_xor(ss, 2);
            if ((c.tid & 3) == 0) SSP[(size_t)t * 32 + h] = ss;
        }
    }
    __syncthreads();
}

__device__ __forceinline__ void step_att_simple(const Ctx& c) {
    const bf16_t* PROJ = WSP(bf16_t, WS_PROJ); bf16_t* YCAT = WSP(bf16_t, WS_ACT); float* SSP = WSP(float, WS_SSP);
    for (int idx = c.gt; idx < T * 16; idx += c.ngt) {
        const int t = idx >> 4, hd = idx & 15, kvh = hd >> 3, pos = t & (SEQ - 1);
        float q[64], o[64];
        {
            const bf16_t* qr = PROJ + (size_t)t * DINP + Q_OFF + hd * 64;
#pragma unroll
            for (int d = 0; d < 64; d += 8) { const u32x4 v = *(const u32x4*)(qr + d);
                q[d] = 0.125f * bflo(v.x); q[d + 1] = 0.125f * bfhi(v.x); q[d + 2] = 0.125f * bflo(v.y); q[d + 3] = 0.125f * bfhi(v.y);
                q[d + 4] = 0.125f * bflo(v.z); q[d + 5] = 0.125f * bfhi(v.z); q[d + 6] = 0.125f * bflo(v.w); q[d + 7] = 0.125f * bfhi(v.w); }
        }
#pragma unroll
        for (int d = 0; d < 64; ++d) o[d] = 0.f;
        float m = IN_SINKS[hd], den = 1.f;
        const int j0 = pos - 127 > 0 ? pos - 127 : 0;
        for (int kp = j0; kp <= pos; ++kp) {
            const size_t tk = (size_t)(t - pos + kp);
            const bf16_t* kr = PROJ + tk * DINP + K_OFF + kvh * 64; const bf16_t* vr = PROJ + tk * DINP + V_OFF + kvh * 64;
            float s = 0.f;
#pragma unroll
            for (int d = 0; d < 64; d += 8) { const u32x4 v = *(const u32x4*)(kr + d);
                s += q[d] * bflo(v.x) + q[d + 1] * bfhi(v.x) + q[d + 2] * bflo(v.y) + q[d + 3] * bfhi(v.y) + q[d + 4] * bflo(v.z) + q[d + 5] * bfhi(v.z) + q[d + 6] * bflo(v.w) + q[d + 7] * bfhi(v.w); }
            if (s > m) { const float sc = expf(m - s); den *= sc;
#pragma unroll
                for (int d = 0; d < 64; ++d) o[d] *= sc;
                m = s; }
            const float p = expf(s - m); den += p;
#pragma unroll
            for (int d = 0; d < 64; d += 8) { const u32x4 v = *(const u32x4*)(vr + d);
                o[d] += p * bflo(v.x); o[d + 1] += p * bfhi(v.x); o[d + 2] += p * bflo(v.y); o[d + 3] += p * bfhi(v.y);
                o[d + 4] += p * bflo(v.z); o[d + 5] += p * bfhi(v.z); o[d + 6] += p * bflo(v.w); o[d + 7] += p * bfhi(v.w); }
        }
        const float inv = 1.f / den; float ss = 0.f;
        bf16_t* orow = YCAT + (size_t)t * D + 1024 + hd * 64;
#pragma unroll
        for (int d = 0; d < 64; d += 8) {
            float r[8];
#pragma unroll
            for (int e = 0; e < 8; ++e) { r[e] = o[d + e] * inv; ss += r[e] * r[e]; }
            *(u32x4*)(orow + d) = (u32x4){pk2(r[0], r[1]), pk2(r[2], r[3]), pk2(r[4], r[5]), pk2(r[6], r[7])};
        }
        SSP[(size_t)t * 32 + 16 + hd] = ss;
    }
}

__device__ __forceinline__ void step_rs(const Ctx& c) {
    const float* SSP = WSP(float, WS_SSP); float* RS = WSP(float, WS_RS);
    for (int t = c.gt; t < T; t += c.ngt) {
        float s1 = 0.f, s2 = 0.f;
#pragma unroll
        for (int j = 0; j < 4; ++j) { const f32x4 a = *(const f32x4*)(SSP + (size_t)t * 32 + 4 * j), b = *(const f32x4*)(SSP + (size_t)t * 32 + 16 + 4 * j);
            s1 += (a.x + a.y) + (a.z + a.w); s2 += (b.x + b.y) + (b.z + b.w); }
        const float r1 = rsqrtf(s1 * (1.f / 1024.f) + EPS), r2 = rsqrtf(s2 * (1.f / 1024.f) + EPS);
        RS[2 * t] = r1 / r2; RS[2 * t + 1] = r2;
    }
}

__device__ __forceinline__ void step_ln1(const Ctx& c) {
    const float* MOD = WSP(float, WS_MOD); bf16_t* H2 = WSP(bf16_t, WS_ACT);
    for (int t = c.gw; t < T; t += c.ngw) {
        const int b = t >> 12; float* row = c.out + (size_t)t * D;
        f32x4 v[8]; float s = 0.f;
#pragma unroll
        for (int j = 0; j < 8; ++j) { v[j] = *(const f32x4*)(row + j * 256 + c.lane * 4); s += (v[j].x + v[j].y) + (v[j].z + v[j].w); }
        const float mean = wave_sum(s) * (1.f / D); float s2 = 0.f;
#pragma unroll
        for (int j = 0; j < 8; ++j) { v[j] = v[j] - mean; s2 += (v[j].x * v[j].x + v[j].y * v[j].y) + (v[j].z * v[j].z + v[j].w * v[j].w); }
        const float rstd = rsqrtf(wave_sum(s2) * (1.f / D) + EPS);
        const float* sh = MOD + b * NMOD + 3 * D; const float* sc = MOD + b * NMOD + 4 * D;
#pragma unroll
        for (int j = 0; j < 8; ++j) {
            const int col = j * 256 + c.lane * 4;
            const f32x4 g = *(const f32x4*)(IN_LN1G + col), bb = *(const f32x4*)(IN_LN1B + col), s_ = *(const f32x4*)(sc + col), h_ = *(const f32x4*)(sh + col);
            const f32x4 x1 = v[j] * rstd * g + bb;
            *(f32x4*)(row + col) = x1;
            u32x2 o; o.x = pk2(x1.x * (1.f + s_.x) + h_.x, x1.y * (1.f + s_.y) + h_.y); o.y = pk2(x1.z * (1.f + s_.z) + h_.z, x1.w * (1.f + s_.w) + h_.w);
            *(u32x2*)(H2 + (size_t)t * D + col) = o;
        }
    }
}

__device__ __forceinline__ void argmax_bfly(float& bv, int& bi) {
#pragma unroll
    for (int off = 32; off >= 1; off >>= 1) {
        const float ov = __shfl_xor(bv, off); const int oi = __shfl_xor(bi, off);
        if (ov > bv || (ov == bv && oi < bi)) { bv = ov; bi = oi; }
    }
}
__device__ __forceinline__ void step_topk_simple(const Ctx& c) {
    const bf16_t* Q = WSP(bf16_t, WS_PROJ); const bf16_t* KEYS = WSP(bf16_t, WS_KEYS); int* EXPERT = WSP(int, WS_EXP); float* GATE = WSP(float, WS_GATE);
    const int lane = c.lane; const float NEG = -__builtin_huge_valf();
    for (int item = c.gw; item < T * 8; item += c.ngw) {
        const int t = item >> 3, h = item & 7;
        const bf16_t* qrow = Q + (size_t)t * D + h * 256;
        float tv[2] = {0.f, 0.f}; int ti[2] = {0, 0};
#pragma unroll
        for (int cc = 0; cc < 2; ++cc) {
            float v0 = 0.f, v1 = 0.f;
            const bf16_t* k0 = KEYS + ((size_t)(h * 2 + cc) * 128 + lane) * 128; const bf16_t* k1 = k0 + 64 * 128;
            for (int d = 0; d < 128; d += 8) { const u32x4 qv = *(const u32x4*)(qrow + cc * 128 + d); v0 += dot8(qv, *(const u32x4*)(k0 + d)); v1 += dot8(qv, *(const u32x4*)(k1 + d)); }
            for (int r = 0; r < 16; ++r) {
                float bv = v0; int bi = lane; if (v1 > bv) { bv = v1; bi = lane + 64; }
                argmax_bfly(bv, bi);
                if (lane == r) { tv[cc] = bv; ti[cc] = bi; }
                if (bi == lane) v0 = NEG; if (bi == lane + 64) v1 = NEG;
            }
        }
        float cv[4]; const int ci0 = lane * 4;
#pragma unroll
        for (int q = 0; q < 4; ++q) { const int ci = ci0 + q; cv[q] = __shfl(tv[0], ci >> 4) + __shfl(tv[1], ci & 15); }
        float bestv = 0.f; int bestp = 0;
        for (int r = 0; r < 16; ++r) {
            float bv = cv[0]; int bi = ci0;
#pragma unroll
            for (int q = 1; q < 4; ++q) if (cv[q] > bv) { bv = cv[q]; bi = ci0 + q; }
            argmax_bfly(bv, bi);
            if (lane == r) { bestv = bv; bestp = bi; }
#pragma unroll
            for (int q = 0; q < 4; ++q) if (bi == ci0 + q) cv[q] = NEG;
        }
        const float mx = __shfl(bestv, 0);
        const float e = lane < 16 ? expf(bestv - mx) : 0.f; const float ssum = wave_sum(e);
        const int e0 = __shfl(ti[0], bestp >> 4), e1 = __shfl(ti[1], bestp & 15);
        if (lane < 16) { EXPERT[(size_t)item * 16 + lane] = e0 * 128 + e1; GATE[(size_t)item * 16 + lane] = e / ssum; }
    }
}

__device__ __forceinline__ void step_peer(const Ctx& c) {
    const bf16_t* H2 = WSP(bf16_t, WS_ACT); const bf16_t* UB = WSP(bf16_t, WS_UB); const bf16_t* VB = WSP(bf16_t, WS_VB);
    const int* EXPERT = WSP(int, WS_EXP); const float* GATE = WSP(float, WS_GATE); const float* MOD = WSP(float, WS_MOD);
    const int lane = c.lane;
    for (int t = c.gw; t < T; t += c.ngw) {
        u32x4 hq[4];
#pragma unroll
        for (int j = 0; j < 4; ++j) hq[j] = *(const u32x4*)(H2 + (size_t)t * D + j * 512 + lane * 8);
        int er[2]; float gr[2], ar[2] = {0.f, 0.f};
        er[0] = EXPERT[(size_t)t * 128 + lane]; er[1] = EXPERT[(size_t)t * 128 + 64 + lane];
        gr[0] = GATE[(size_t)t * 128 + lane]; gr[1] = GATE[(size_t)t * 128 + 64 + lane];
#pragma unroll
        for (int hf = 0; hf < 2; ++hf) {
            for (int kb = 0; kb < 64; kb += 4) {
                u32x4 r[4][4];
#pragma unroll
                for (int u = 0; u < 4; ++u) { const int e = __builtin_amdgcn_readlane(er[hf], kb + u); const bf16_t* ur = UB + (size_t)e * D + lane * 8;
#pragma unroll
                    for (int j = 0; j < 4; ++j) r[u][j] = *(const u32x4*)(ur + j * 512); }
#pragma unroll
                for (int u = 0; u < 4; ++u) {
                    float p = dot8(r[u][0], hq[0]) + dot8(r[u][1], hq[1]) + dot8(r[u][2], hq[2]) + dot8(r[u][3], hq[3]);
                    p = wave_sum(p);
                    if (lane == kb + u) ar[hf] = p;
                }
            }
        }
        float wr[2]; wr[0] = gr[0] * gelu_f(ar[0]); wr[1] = gr[1] * gelu_f(ar[1]);
        float y[32];
#pragma unroll
        for (int i = 0; i < 32; ++i) y[i] = 0.f;
#pragma unroll
        for (int hf = 0; hf < 2; ++hf) {
            for (int kb = 0; kb < 64; kb += 4) {
                u32x4 r[4][4]; float w[4];
#pragma unroll
                for (int u = 0; u < 4; ++u) { const int e = __builtin_amdgcn_readlane(er[hf], kb + u); w[u] = __uint_as_float(__builtin_amdgcn_readlane(__float_as_uint(wr[hf]), kb + u));
                    const bf16_t* vr = VB + (size_t)e * D + lane * 8;
#pragma unroll
                    for (int j = 0; j < 4; ++j) r[u][j] = *(const u32x4*)(vr + j * 512); }
#pragma unroll
                for (int u = 0; u < 4; ++u)
#pragma unroll
                    for (int j = 0; j < 4; ++j) {
                        y[j * 8 + 0] += w[u] * bflo(r[u][j].x); y[j * 8 + 1] += w[u] * bfhi(r[u][j].x); y[j * 8 + 2] += w[u] * bflo(r[u][j].y); y[j * 8 + 3] += w[u] * bfhi(r[u][j].y);
                        y[j * 8 + 4] += w[u] * bflo(r[u][j].z); y[j * 8 + 5] += w[u] * bfhi(r[u][j].z); y[j * 8 + 6] += w[u] * bflo(r[u][j].w); y[j * 8 + 7] += w[u] * bfhi(r[u][j].w);
                    }
            }
        }
        const int b = t >> 12; float* row = c.out + (size_t)t * D; const float* g2 = MOD + b * NMOD + 5 * D;
        float s = 0.f;
#pragma unroll
        for (int j = 0; j < 4; ++j)
#pragma unroll
            for (int q = 0; q < 2; ++q) {
                const int col = j * 512 + lane * 8 + q * 4; const f32x4 xv = *(const f32x4*)(row + col), gv = *(const f32x4*)(g2 + col);
                float* yy = y + j * 8 + q * 4;
                yy[0] = ALPHA * xv.x + gv.x * yy[0]; yy[1] = ALPHA * xv.y + gv.y * yy[1]; yy[2] = ALPHA * xv.z + gv.z * yy[2]; yy[3] = ALPHA * xv.w + gv.w * yy[3];
                s += (yy[0] + yy[1]) + (yy[2] + yy[3]);
            }
        const float mean = wave_sum(s) * (1.f / D); float s2 = 0.f;
#pragma unroll
        for (int i = 0; i < 32; ++i) { y[i] -= mean; s2 += y[i] * y[i]; }
        const float rstd = rsqrtf(wave_sum(s2) * (1.f / D) + EPS);
#pragma unroll
        for (int j = 0; j < 4; ++j)
#pragma unroll
            for (int q = 0; q < 2; ++q) {
                const int col = j * 512 + lane * 8 + q * 4; const f32x4 g = *(const f32x4*)(IN_LN2G + col), bb = *(const f32x4*)(IN_LN2B + col);
                const float* yy = y + j * 8 + q * 4;
                *(f32x4*)(row + col) = (f32x4){yy[0] * rstd * g.x + bb.x, yy[1] * rstd * g.y + bb.y, yy[2] * rstd * g.z + bb.z, yy[3] * rstd * g.w + bb.w};
            }
    }
}

constexpr int NSTEPS = 15;
__global__ void __launch_bounds__(NTHR, 2) fwd_kernel(Args a) {
    extern __shared__ __attribute__((aligned(16))) unsigned char lds_raw[];
    Ctx c;
#pragma unroll
    for (int i = 0; i < 22; ++i) c.in[i] = a.in[i];
    c.out = a.out; c.ws = a.ws; c.lds = (LAS unsigned char*)lds_raw;
    c.tid = threadIdx.x; c.lane = c.tid & 63; c.wave = __builtin_amdgcn_readfirstlane(c.tid >> 6);
    c.gw = blockIdx.x * NWAVES + c.wave; c.ngw = gridDim.x * NWAVES; c.gt = blockIdx.x * NTHR + c.tid; c.ngt = gridDim.x * NTHR;
    for (int u = c.tid; u < (LDS_BYTES - LDSCTL_OFF) / 4; u += NTHR) ((LAS unsigned*)(c.lds + LDSCTL_OFF))[u] = 0u;
    __syncthreads();
    const bool multi = (a.hi - a.lo) > 1;
    XcdBarrier bar; bar.bar = (unsigned*)(c.ws + WS_CTL); bar.x = 0; bar.st = (volatile LAS unsigned*)(c.lds + MISC_OFF);
    if (multi) bar = xcd_barrier_post((unsigned*)(c.ws + WS_CTL), (volatile LAS unsigned*)(c.lds + MISC_OFF));
#define STEP(i, ...) if (a.lo <= (i) && (i) < a.hi) { __VA_ARGS__; if ((i) + 1 < a.hi) xcd_barrier(bar); }
    STEP(0, step_pro(c));
    STEP(1, step_h1(c));
    STEP(2, { Epi1 e{WSP(bf16_t, WS_PROJ), WSP(float, WS_DTRAW)}; gemm_simple<Epi1, false>(c, WSP(bf16_t, WS_ACT), WSP(bf16_t, WS_WIN), T, DINP, D, e); });
    STEP(3, step_conv(c));
    STEP(4, step_ssd1_simple(c));
    STEP(5, step_att_simple(c));
    STEP(6, step_scan(c));
    STEP(7, step_cb_simple(c));
    STEP(8, step_ssd2_simple(c));
    STEP(9, step_rs(c));
    STEP(10, { Epi2 e{IN_X, WSP(float, WS_MOD), WSP(float, WS_RS), c.out}; gemm_simple<Epi2, true>(c, WSP(bf16_t, WS_ACT), WSP(bf16_t, WS_WOUT), T, D, D, e); });
    STEP(11, step_ln1(c));
    STEP(12, { Epi3 e{WSP(bf16_t, WS_PROJ)}; gemm_simple<Epi3, false>(c, WSP(bf16_t, WS_ACT), WSP(bf16_t, WS_WQ), T, D, D, e); });
    STEP(13, step_topk_simple(c));
    STEP(14, step_peer(c));
#undef STEP
}
}

extern "C" void kernel_launch(void* const* d_in, const int* in_sizes, int n_in, void* d_out, int out_size, void* d_ws, size_t ws_size, hipStream_t stream) {
    static int grid = 0;
    if (grid == 0) {
        if (n_in != 22 || in_sizes[0] != T * D || out_size != T * D || ws_size < WS_END) {
            fprintf(stderr, "kernel_launch: unexpected problem (n_in %d, in0 %d, out %d, ws %zu < %zu); nothing launched\n", n_in, n_in > 0 ? in_sizes[0] : -1, out_size, ws_size, (size_t)WS_END);
            grid = -1; return;
        }
        int dev = 0, cus = 0;
        if (hipGetDevice(&dev) != hipSuccess || hipDeviceGetAttribute(&cus, hipDeviceAttributeMultiprocessorCount, dev) != hipSuccess) { grid = -1; return; }
        if (hipFuncSetAttribute((const void*)fwd_kernel, hipFuncAttributeMaxDynamicSharedMemorySize, LDS_BYTES) != hipSuccess) { fprintf(stderr, "kernel_launch: hipFuncSetAttribute failed\n"); grid = -1; return; }
        int per_cu = 0;
        if (hipOccupancyMaxActiveBlocksPerMultiprocessor(&per_cu, (const void*)fwd_kernel, NTHR, LDS_BYTES) != hipSuccess || per_cu < 1) fprintf(stderr, "kernel_launch: occupancy query reports %d blocks per CU\n", per_cu);
        (void)hipGetLastError();
        grid = cus > 0 ? cus : 256;
    }
    if (grid < 0) return;
    (void)hipMemsetAsync((char*)d_ws + WS_CTL, 0, CTL_ZERO_BYTES, stream);
    Args a{};
    for (int i = 0; i < 22; ++i) a.in[i] = (const float*)d_in[i];
    a.out = (float*)d_out; a.ws = (unsigned char*)d_ws;
#if ONE_LAUNCH
    a.lo = 0; a.hi = NSTEPS;
    hipLaunchKernelGGL(fwd_kernel, dim3(grid), dim3(NTHR), LDS_BYTES, stream, a);
#else
    for (int i = 0; i < NSTEPS; ++i) { a.lo = i; a.hi = i + 1; hipLaunchKernelGGL(fwd_kernel, dim3(grid), dim3(NTHR), LDS_BYTES, stream, a); }
#endif
}
```

```cpp
#include <hip/hip_runtime.h>
#include <cstdio>
#include <cstdint>

#ifndef ONE_LAUNCH
#define ONE_LAUNCH 1
#endif
#ifndef FAST_GEMM
#define FAST_GEMM 1
#endif
#ifndef FAST_TOPK
#define FAST_TOPK 1
#endif
#ifndef FAST_MIX
#define FAST_MIX 15
#endif
#ifndef SLICED_PEER
#define SLICED_PEER 1
#endif
#ifndef PRO_REPEAT
#define PRO_REPEAT 0
#endif
#ifndef V_INT8
#define V_INT8 1
#endif
#ifndef HIDE_TABLES
#define HIDE_TABLES 1
#endif
#ifndef I8_GEMM3
#define I8_GEMM3 1
#endif
#ifndef I8_GEMM1
#define I8_GEMM1 1
#endif
#ifndef I8_GEMM2
#define I8_GEMM2 1
#endif
#ifndef PART16
#define PART16 1
#endif
#ifndef FUSE_TOPK
#define FUSE_TOPK 1
#endif
#ifndef WQ_ONEPASS
#define WQ_ONEPASS 1
#endif
#ifndef FUSE_SSD1
#define FUSE_SSD1 1
#endif
#ifndef REPEAT_MASK
#define REPEAT_MASK 0
#endif

#define LAS __attribute__((address_space(3)))
typedef unsigned short bf16_t;
typedef float f32x4 __attribute__((ext_vector_type(4)));
typedef unsigned u32x4 __attribute__((ext_vector_type(4)));
typedef unsigned u32x2 __attribute__((ext_vector_type(2)));

namespace {
constexpr int NB = 4, SEQ = 4096, T = NB * SEQ, D = 2048;
constexpr int NH = 16, NCH = SEQ / 128;
constexpr int DINP = 4096;
constexpr int Z_OFF = 0, XBC_OFF = 1024, Q_OFF = 2560, K_OFF = 3584, V_OFF = 3712, DT_OFF = 3840;
constexpr int NMOD = 6 * D;
constexpr float ALPHA = 1.189207115002721f;
constexpr float EPS = 1e-5f;
constexpr int NTHR = 512, NWAVES = 8;

constexpr size_t MiB = 1u << 20;
constexpr size_t WS_CTL = 0, CTL_ZERO_BYTES = 1 * MiB;
constexpr size_t WS_MOD = 512 * 1024;
constexpr size_t WS_KEYS = 1 * MiB;
constexpr size_t WS_DTRAW = 2 * MiB;
constexpr size_t WS_DT = 3 * MiB;
constexpr size_t WS_ACUM = 4 * MiB;
constexpr size_t WS_SSP = 5 * MiB;
constexpr size_t WS_RS = 7 * MiB;
constexpr size_t WS_SCU = 7 * MiB + 256 * 1024, WS_SCV = 7 * MiB + 512 * 1024;
constexpr size_t WS_EXP = 8 * MiB;
constexpr size_t WS_GATE = 16 * MiB;
constexpr size_t WS_WIN = 24 * MiB;
constexpr size_t WS_WOUT = 40 * MiB;
constexpr size_t WS_WQ = 48 * MiB;
constexpr size_t WS_UB = 56 * MiB;
constexpr size_t WS_VB = 120 * MiB;
constexpr size_t WS_ACT = 184 * MiB;
constexpr size_t WS_PROJ = 248 * MiB;
constexpr size_t WS_XBCC = 376 * MiB;
constexpr size_t WS_STATES = 424 * MiB;
constexpr size_t WS_PREVB = 488 * MiB;
constexpr size_t WS_H2Q = 504 * MiB;
constexpr size_t WS_W8 = 5 * MiB;
constexpr size_t WS_WS = 7 * MiB + 128 * 1024;
constexpr size_t WS_SWQ = 7 * MiB + 64 * 1024, WS_SWIN = 7 * MiB + 80 * 1024, WS_SA1 = 7 * MiB + 320 * 1024;
constexpr int CW_AMXQ = 32768, CW_AMXIN = 36864;
constexpr size_t WS_A8 = WS_XBCC;
constexpr size_t WS_SA2 = 7 * MiB + 384 * 1024, WS_SWOUT = 7 * MiB + 96 * 1024;
constexpr int CW_AMXOUT = 40960;
constexpr size_t WS_HS = 7 * MiB;
constexpr size_t WS_END = 536 * MiB;
constexpr size_t WS_R1B = WS_PROJ, WS_X1B = WS_PROJ + 64 * MiB, WS_Q = WS_PROJ, WS_PARTA = WS_XBCC, WS_Y = WS_ACT;

constexpr int RING_BYTES = 131072;
constexpr int LDSCTL_OFF = 147456 - 64, MISC_OFF = LDSCTL_OFF;
constexpr int LDS_BYTES = 147456;

__device__ __forceinline__ float bf2f(unsigned v) { return __uint_as_float(v << 16); }
__device__ __forceinline__ float bflo(unsigned w) { return __uint_as_float(w << 16); }
__device__ __forceinline__ float bfhi(unsigned w) { return __uint_as_float(w & 0xffff0000u); }
__device__ __forceinline__ unsigned f2bf(float f) { unsigned u = __float_as_uint(f); return (u + 0x7fffu + ((u >> 16) & 1u)) >> 16; }
__device__ __forceinline__ unsigned pk2(float lo, float hi) { return f2bf(lo) | (f2bf(hi) << 16); }
typedef __bf16 bf16x2n __attribute__((ext_vector_type(2)));
typedef float f32x2n __attribute__((ext_vector_type(2)));
__device__ __forceinline__ unsigned cvtpk(float lo, float hi) { const bf16x2n r = __builtin_convertvector((f32x2n){lo, hi}, bf16x2n); return __builtin_bit_cast(unsigned, r); }
__device__ __forceinline__ float silu_f(float x) { return x / (1.f + expf(-x)); }
__device__ __forceinline__ float softplus_f(float x) { return x > 20.f ? x : log1pf(expf(x)); }
__device__ __forceinline__ float gelu_f(float x) { return 0.5f * x * (1.f + erff(x * 0.70710678118654752f)); }
__device__ __forceinline__ float wave_sum(float v) {
#pragma unroll
    for (int o = 1; o < 64; o <<= 1) v += __shfl_xor(v, o);
    return v;
}
__device__ __forceinline__ float dot8(u32x4 a, u32x4 b) {
    float s = bflo(a.x) * bflo(b.x); s += bfhi(a.x) * bfhi(b.x);
    s += bflo(a.y) * bflo(b.y); s += bfhi(a.y) * bfhi(b.y);
    s += bflo(a.z) * bflo(b.z); s += bfhi(a.z) * bfhi(b.z);
    s += bflo(a.w) * bflo(b.w); s += bfhi(a.w) * bfhi(b.w);
    return s;
}
__device__ __forceinline__ int win_src_col(int n) { return n < 2560 ? n : (n < 3840 ? n + 16 : (n < 3856 ? n - 1280 : -1)); }

#define XB_TMO      128
#define XB_XCNT(j)  (256  + 64 * (j))
#define XB_XSUB(j)  (1280 + 64 * (j))
#define XB_XGEN(j)  (2304 + 64 * (j))
#define XB_TOP      3328
#define XB_TOPGEN   3392
#define XCD_BAR_WORDS 3456
#define XB_SPIN_CAP (1u << 18)
__device__ __forceinline__ unsigned xb_ld(unsigned* p)              { return __hip_atomic_load(p, __ATOMIC_RELAXED, __HIP_MEMORY_SCOPE_AGENT); }
__device__ __forceinline__ unsigned xb_add(unsigned* p, unsigned v) { return __hip_atomic_fetch_add(p, v, __ATOMIC_RELAXED, __HIP_MEMORY_SCOPE_AGENT); }
__device__ __forceinline__ unsigned xb_xcc_id() { return (unsigned)__builtin_amdgcn_s_getreg((3 << 11) | 20) & 0xFu; }
#define XB_SPIN(cond, bar) do { unsigned _sp = 0; while (cond) { __builtin_amdgcn_s_sleep(1); \
    if ((++_sp & 255u) == 0u) { if (xb_ld(&(bar)[XB_TMO])) break; if (_sp > XB_SPIN_CAP) { atomicAdd(&(bar)[XB_TMO], 1u); break; } } } } while (0)
struct XcdBarrier { unsigned* bar; unsigned x; volatile LAS unsigned* st; };
__device__ __forceinline__ XcdBarrier xcd_barrier_post(unsigned* bar, volatile LAS unsigned* st) {
    XcdBarrier b; b.bar = bar; b.x = xb_xcc_id(); b.st = st;
    if (threadIdx.x == 0) (void)xb_add(&bar[XB_XCNT(b.x)], 1u);
    return b;
}
__device__ __forceinline__ void xcd_barrier_complete(unsigned* bar, unsigned x, unsigned& nloc, unsigned& nx) {
    const unsigned G = gridDim.x * gridDim.y * gridDim.z;
    unsigned sum, cnt, mine, sp = 0u;
    for (;;) {
        sum = 0u; cnt = 0u; mine = 0u;
#pragma unroll
        for (unsigned j = 0; j < 16; ++j) { const unsigned c = xb_ld(&bar[XB_XCNT(j)]); sum += c; cnt += (c > 0u) ? 1u : 0u; mine = (j == x) ? c : mine; }
        if (sum == G) break;
        __builtin_amdgcn_s_sleep(1);
        if ((++sp & 255u) == 0u) { if (xb_ld(&bar[XB_TMO])) break; if (sp > XB_SPIN_CAP) { atomicAdd(&bar[XB_TMO], 1u); break; } }
    }
    nloc = mine > 0u ? mine : 1u; nx = cnt > 0u ? cnt : 1u;
}
__device__ __forceinline__ void xcd_barrier(const XcdBarrier& b) {
    asm volatile("s_waitcnt vmcnt(0)" ::: "memory");
    __syncthreads();
    if (threadIdx.x == 0) {
        unsigned* bar = b.bar;
        __builtin_amdgcn_s_waitcnt(0);
        unsigned nloc = b.st[0], nx = b.st[1];
        if (nloc == 0u) { xcd_barrier_complete(bar, b.x, nloc, nx); b.st[0] = nloc; b.st[1] = nx; }
        const unsigned old = xb_add(&bar[XB_XSUB(b.x)], 1u);
        const unsigned gen = old / nloc;
        if (old + 1u == (gen + 1u) * nloc) {
            __builtin_amdgcn_fence(__ATOMIC_RELEASE, "agent");
            asm volatile("s_waitcnt vmcnt(0)" ::: "memory");
            const unsigned og = xb_add(&bar[XB_TOP], 1u);
            const unsigned tg = og / nx;
            if (og + 1u == (tg + 1u) * nx) xb_add(&bar[XB_TOPGEN], 1u);
            else XB_SPIN(xb_ld(&bar[XB_TOPGEN]) == tg, bar);
            __builtin_amdgcn_fence(__ATOMIC_ACQUIRE, "agent");
            xb_add(&bar[XB_XGEN(b.x)], 1u);
            asm volatile("s_waitcnt vmcnt(0)" ::: "memory");
        } else {
            XB_SPIN(xb_ld(&bar[XB_XGEN(b.x)]) == gen, bar);
            __builtin_amdgcn_fence(__ATOMIC_ACQUIRE, "agent");
            asm volatile("s_waitcnt vmcnt(0)" ::: "memory");
        }
    }
    __syncthreads();
}

struct Args { const float* in[22]; float* out; unsigned char* ws; int lo, hi; };
struct Ctx {
    const float* in[22]; float* out; unsigned char* ws; LAS unsigned char* lds;
    int tid, lane, wave, gw, ngw, gt, ngt;
};
#define IN_X c.in[0]
#define IN_C c.in[1]
#define IN_WADA c.in[2]
#define IN_BADA c.in[3]
#define IN_WIN c.in[4]
#define IN_CONVW c.in[5]
#define IN_CONVB c.in[6]
#define IN_DTBIAS c.in[7]
#define IN_ALOG c.in[8]
#define IN_DSKIP c.in[9]
#define IN_SSMG c.in[10]
#define IN_SINKS c.in[11]
#define IN_ATTG c.in[12]
#define IN_WOUT c.in[13]
#define IN_LN1G c.in[14]
#define IN_LN1B c.in[15]
#define IN_WQ c.in[16]
#define IN_KEYS c.in[17]
#define IN_U c.in[18]
#define IN_V c.in[19]
#define IN_LN2G c.in[20]
#define IN_LN2B c.in[21]
#define WSP(type, off) ((type*)(c.ws + (off)))


typedef float f32x2 __attribute__((ext_vector_type(2)));
typedef short bf16x8v __attribute__((ext_vector_type(8)));
typedef float f32x16 __attribute__((ext_vector_type(16)));
#define DPPF(v, ctrl) __int_as_float(__builtin_amdgcn_update_dpp(0, __float_as_int(v), (ctrl), 0xF, 0xF, true))
__device__ __forceinline__ float row_sum16(float v) {
    v += DPPF(v, 0xB1); v += DPPF(v, 0x4E); v += DPPF(v, 0x141); v += DPPF(v, 0x140); return v;
}
__device__ __forceinline__ float wave_sum63(float v) {
    v = row_sum16(v);
    v += __int_as_float(__builtin_amdgcn_update_dpp(0, __float_as_int(v), 0x142, 0xA, 0xF, false));
    v += __int_as_float(__builtin_amdgcn_update_dpp(0, __float_as_int(v), 0x143, 0xC, 0xF, false));
    return v;
}
__device__ __forceinline__ float lane63(float v) { return __int_as_float(__builtin_amdgcn_readlane(__float_as_int(v), 63)); }
__device__ __forceinline__ float wave_sum_all(float v) { return lane63(wave_sum63(v)); }
__device__ __forceinline__ void fp8_row_load(f32x4 (&v)[8], const float* src, int lane) {
#pragma unroll
    for (int j = 0; j < 2; ++j)
#pragma unroll
        for (int q = 0; q < 4; ++q) v[j * 4 + q] = *(const f32x4*)(src + j * 1024 + lane * 16 + q * 4);
}
#define DPPMAX(v, ctrl) fmaxf(v, __int_as_float(__builtin_amdgcn_update_dpp(0, __float_as_int(v), (ctrl), 0xF, 0xF, true)))
__device__ __forceinline__ unsigned pack_i8x4(f32x4 x) {
    const int q0 = (int)__builtin_rintf(x.x), q1 = (int)__builtin_rintf(x.y), q2 = (int)__builtin_rintf(x.z), q3 = (int)__builtin_rintf(x.w);
    return (unsigned)(q0 & 0xff) | ((unsigned)(q1 & 0xff) << 8) | ((unsigned)(q2 & 0xff) << 16) | ((unsigned)q3 << 24);
}
template <bool INT8>
__device__ __forceinline__ void fp8_row_finish(const f32x4 (&v)[8], unsigned char* tab, int row, float* scale, int lane) {
    float am = 0.f;
#pragma unroll
    for (int i = 0; i < 8; ++i) am = fmaxf(am, fmaxf(fmaxf(fabsf(v[i].x), fabsf(v[i].y)), fmaxf(fabsf(v[i].z), fabsf(v[i].w))));
    am = DPPMAX(am, 0xB1); am = DPPMAX(am, 0x4E); am = DPPMAX(am, 0x141); am = DPPMAX(am, 0x140);
    {
        const unsigned a0 = __builtin_amdgcn_readlane(__float_as_uint(am), 0), a1 = __builtin_amdgcn_readlane(__float_as_uint(am), 16);
        const unsigned a2 = __builtin_amdgcn_readlane(__float_as_uint(am), 32), a3 = __builtin_amdgcn_readlane(__float_as_uint(am), 48);
        const unsigned m01 = a0 > a1 ? a0 : a1, m23 = a2 > a3 ? a2 : a3; am = __uint_as_float(m01 > m23 ? m01 : m23);
    }
    const float top = INT8 ? 127.f : 448.f;
    const float inv = am > 0.f ? top / am : 0.f;
#pragma unroll
    for (int j = 0; j < 2; ++j) {
        u32x4 o;
#pragma unroll
        for (int q = 0; q < 4; ++q) { const f32x4 x = v[j * 4 + q] * inv;
            if (INT8) o[q] = pack_i8x4(x);
            else { int w = 0; w = __builtin_amdgcn_cvt_pk_fp8_f32(x.x, x.y, w, false); w = __builtin_amdgcn_cvt_pk_fp8_f32(x.z, x.w, w, true); o[q] = (unsigned)w; } }
#if SLICED_PEER
        *(u32x4*)(tab + ((size_t)(8 * j + (lane >> 3)) * 16384 + row) * 128 + (lane & 7) * 16) = o;
#else
        *(u32x4*)(tab + (size_t)row * D + j * 1024 + lane * 16) = o;
#endif
    }
    if (lane == 0) *scale = am / top;
}

template <bool WIN_MAP, bool GAINS = false>
__device__ __forceinline__ void colamax_items(const Ctx& c, const float* W, int Nsrc, unsigned* AMX, const float* g1 = nullptr, const float* g2 = nullptr) {
    const int nblk = (Nsrc + 255) / 256;
    for (int it = c.gw; it < 32 * nblk; it += c.ngw) {
        const int kb = it / nblk, nb = it % nblk, col = nb * 256 + c.lane * 4;
        if (col < Nsrc) {
            f32x4 m = {0.f, 0.f, 0.f, 0.f};
            const float* wp = W + (size_t)(kb * 64) * Nsrc + col;
#pragma unroll 16
            for (int kk = 0; kk < 64; ++kk) { f32x4 v = *(const f32x4*)(wp + (size_t)kk * Nsrc); if (GAINS) { const int k = kb * 64 + kk; v = v * (k < 1024 ? g1[k] : g2[k - 1024]); } m.x = fmaxf(m.x, fabsf(v.x)); m.y = fmaxf(m.y, fabsf(v.y)); m.z = fmaxf(m.z, fabsf(v.z)); m.w = fmaxf(m.w, fabsf(v.w)); }
#pragma unroll
            for (int j = 0; j < 4; ++j) { const int sc = col + j; const int dn = WIN_MAP ? (sc < 2560 ? sc : (sc < 2576 ? sc + 1280 : sc - 16)) : sc;
                atomicMax(AMX + dn, __float_as_uint(m[j])); }
        }
    }
}
template <bool WIN_MAP, bool GAINS = false>
__device__ __forceinline__ void transpose_item_i8(const float* W, int K, int Nsrc, int ND, unsigned char* WT, const unsigned* AMX, float* SW, LAS float* scr, int item, int lane, const float* g1 = nullptr, const float* g2 = nullptr) {
    const int nblk = ND / 32, kb = item / nblk, nb = item % nblk, k0 = 64 * kb, n0 = 32 * nb;
    const int n = n0 + (lane & 31), sc = WIN_MAP ? win_src_col(n) : n;
    const float am = __uint_as_float(AMX[n]), inv = am > 0.f ? 127.f / am : 0.f;
    float tv[32];
    const float* wp = W + (size_t)(k0 + (lane >> 5)) * Nsrc + (sc >= 0 ? sc : 0);
#pragma unroll
    for (int i = 0; i < 32; ++i) tv[i] = wp[(size_t)(2 * i) * Nsrc];
#pragma unroll
    for (int i = 0; i < 32; ++i) { const int kk = k0 + 2 * i + (lane >> 5); float v = sc >= 0 ? tv[i] * inv : 0.f; if (GAINS) v *= (kk < 1024 ? g1[kk] : g2[kk - 1024]); scr[(2 * i + (lane >> 5)) * 33 + (lane & 31)] = v; }
    asm volatile("s_waitcnt lgkmcnt(0)" ::: "memory");
#pragma unroll
    for (int j = 0; j < 2; ++j) {
        const int ch = lane + 64 * j, nn = ch >> 2, kc = ch & 3; const LAS float* sp = scr + (16 * kc) * 33 + nn;
        u32x4 o;
#pragma unroll
        for (int q = 0; q < 4; ++q) o[q] = pack_i8x4((f32x4){sp[(4 * q) * 33], sp[(4 * q + 1) * 33], sp[(4 * q + 2) * 33], sp[(4 * q + 3) * 33]});
        *(u32x4*)(WT + (size_t)(n0 + nn) * K + k0 + 16 * kc) = o;
    }
    if (kb == 0 && lane < 32) SW[n] = am * (1.f / 127.f);
    asm volatile("s_waitcnt lgkmcnt(0)" ::: "memory");
}
template <int MODE>
__device__ __forceinline__ void wquant_block(const Ctx& c, const float* W, int Nsrc, int nb, unsigned char* WT, float* SW, const float* g1, const float* g2) {
    constexpr int PITCH = 4112;
    LAS unsigned char* Lb = c.lds;
    LAS float* red = (LAS float*)(c.lds + 32 * PITCH);
    const int n = c.lane & 31, half = c.lane >> 5, n0 = nb * 32, dn = n0 + n, sc = MODE == 0 ? win_src_col(dn) : dn;
    const float* wp = W + (size_t)(c.wave * 256 + 2 * half) * Nsrc + (sc >= 0 ? sc : 0);
    float am = 0.f;
#pragma unroll 1
    for (int it0 = 0; it0 < 64; it0 += 8) {
        float v0[8], v1[8];
#pragma unroll
        for (int u = 0; u < 8; ++u) { const float* p = wp + (size_t)(4 * (it0 + u)) * Nsrc; v0[u] = p[0]; v1[u] = p[Nsrc]; }
#pragma unroll
        for (int u = 0; u < 8; ++u) {
            const int k = c.wave * 256 + 4 * (it0 + u) + 2 * half;
            float a = sc >= 0 ? v0[u] : 0.f, b = sc >= 0 ? v1[u] : 0.f;
            if (MODE == 1) { a *= (k < 1024 ? g1[k] : g2[k - 1024]); b *= (k + 1 < 1024 ? g1[k + 1] : g2[k + 1 - 1024]); }
            am = fmaxf(am, fmaxf(fabsf(a), fabsf(b)));
            *(LAS unsigned*)(Lb + n * PITCH + k * 2) = cvtpk(a, b);
        }
    }
    red[(c.wave * 2 + half) * 32 + n] = am;
    __syncthreads();
    if (c.tid < 32) {
        float m = 0.f;
#pragma unroll
        for (int j = 0; j < 16; ++j) m = fmaxf(m, red[j * 32 + c.tid]);
        red[512 + c.tid] = m > 0.f ? 127.f / m : 0.f; SW[n0 + c.tid] = m * (1.f / 127.f);
    }
    __syncthreads();
#pragma unroll 2
    for (int i = 0; i < 8; ++i) {
        const int id = i * NTHR + c.tid, nn = id >> 7, kc = id & 127; const float inv = red[512 + nn];
        const u32x4 r0 = *(const LAS u32x4*)(Lb + nn * PITCH + kc * 32), r1 = *(const LAS u32x4*)(Lb + nn * PITCH + kc * 32 + 16);
        u32x4 o;
        o.x = pack_i8x4((f32x4){bflo(r0.x), bfhi(r0.x), bflo(r0.y), bfhi(r0.y)} * inv); o.y = pack_i8x4((f32x4){bflo(r0.z), bfhi(r0.z), bflo(r0.w), bfhi(r0.w)} * inv);
        o.z = pack_i8x4((f32x4){bflo(r1.x), bfhi(r1.x), bflo(r1.y), bfhi(r1.y)} * inv); o.w = pack_i8x4((f32x4){bflo(r1.z), bfhi(r1.z), bflo(r1.w), bfhi(r1.w)} * inv);
        *(u32x4*)(WT + (size_t)(n0 + nn) * D + kc * 16) = o;
    }
    __syncthreads();
}
template <int MODE>
__device__ __forceinline__ void transpose_item(const float* W, int K, int Nsrc, int ND, bf16_t* WT, LAS float* scr, int item, int lane, const float* g1, const float* g2) {
    const int nblk = ND / 32, kb = item / nblk, nb = item % nblk, k0 = 64 * kb, n0 = 32 * nb;
    const int n = n0 + (lane & 31), sc = MODE == 0 ? win_src_col(n) : n;
    float tv[32];
    const float* wp = W + (size_t)(k0 + (lane >> 5)) * Nsrc + (sc >= 0 ? sc : 0);
#pragma unroll
    for (int i = 0; i < 32; ++i) tv[i] = wp[(size_t)(2 * i) * Nsrc];
#pragma unroll
    for (int i = 0; i < 32; ++i) {
        const int kk = 2 * i + (lane >> 5);
        float v = sc >= 0 ? tv[i] : 0.f;
        if (MODE == 1) v *= (k0 + kk < 1024) ? g1[k0 + kk] : g2[k0 + kk - 1024];
        scr[kk * 33 + (lane & 31)] = v;
    }
    asm volatile("s_waitcnt lgkmcnt(0)" ::: "memory");
    const int cch = lane & 7;
#pragma unroll
    for (int j = 0; j < 4; ++j) {
        const int nn = (lane >> 3) + 8 * j; const LAS float* s = scr + (8 * cch) * 33 + nn;
        u32x4 o; o.x = pk2(s[0 * 33], s[1 * 33]); o.y = pk2(s[2 * 33], s[3 * 33]); o.z = pk2(s[4 * 33], s[5 * 33]); o.w = pk2(s[6 * 33], s[7 * 33]);
        *(u32x4*)(WT + (size_t)(n0 + nn) * K + k0 + 8 * cch) = o;
    }
    asm volatile("s_waitcnt lgkmcnt(0)" ::: "memory");
}
__device__ __forceinline__ void cvt_f32_bf16(const Ctx& c, const float* src, bf16_t* dst, size_t n8) {
    for (size_t i = (size_t)c.gt; i < n8; i += (size_t)c.ngt) {
        const f32x4 a = ((const f32x4*)src)[2 * i], b = ((const f32x4*)src)[2 * i + 1];
        u32x4 o; o.x = pk2(a.x, a.y); o.y = pk2(a.z, a.w); o.z = pk2(b.x, b.y); o.w = pk2(b.z, b.w);
        ((u32x4*)dst)[i] = o;
    }
}
__device__ __forceinline__ void step_pro(const Ctx& c) {
    float* MOD = WSP(float, WS_MOD);
    for (int rep_ = 0; rep_ < 1 + ((PRO_REPEAT >> 0) & 1); ++rep_) {
    {
        LAS float* sl = (LAS float*)c.lds;
        LAS float* red = (LAS float*)(c.lds + 32768);
        for (int i = c.tid; i < 4 * D; i += NTHR) sl[i] = silu_f(IN_C[i]);
        __syncthreads();
        for (int cb = blockIdx.x; cb < NMOD / 48; cb += gridDim.x) {
            const int rsub = c.lane / 12, cq = c.lane % 12; const bool act = c.lane < 60;
            const float* wp = IN_WADA + (size_t)(c.wave * 256) * NMOD + cb * 48 + cq * 4;
            f32x4 a0 = {0.f, 0.f, 0.f, 0.f}, a1 = a0, a2 = a0, a3 = a0;
#pragma unroll 1
            for (int it0 = 0; it0 < 56; it0 += 8) {
                f32x4 wv[8];
#pragma unroll
                for (int u = 0; u < 8; ++u) { const int r = (it0 + u) * 5 + rsub; wv[u] = (act && r < 256) ? *(const f32x4*)(wp + (size_t)r * NMOD) : (f32x4){0.f, 0.f, 0.f, 0.f}; }
#pragma unroll
                for (int u = 0; u < 8; ++u) { const int r = (it0 + u) * 5 + rsub, k = c.wave * 256 + (r < 256 ? r : 255);
                    a0 += wv[u] * sl[k]; a1 += wv[u] * sl[D + k]; a2 += wv[u] * sl[2 * D + k]; a3 += wv[u] * sl[3 * D + k]; }
            }
            if (act) { LAS f32x4* o = (LAS f32x4*)(red + (c.wave * 60 + c.lane) * 16); o[0] = a0; o[1] = a1; o[2] = a2; o[3] = a3; }
            __syncthreads();
            if (c.tid < 192) {
                const int bb = c.tid / 48, j = c.tid % 48, q = j >> 2, e = j & 3;
                float sum = IN_BADA[cb * 48 + j];
#pragma unroll
                for (int w = 0; w < 8; ++w)
#pragma unroll
                    for (int rs = 0; rs < 5; ++rs) sum += red[(w * 60 + rs * 12 + q) * 16 + bb * 4 + e];
                MOD[bb * NMOD + cb * 48 + j] = sum;
            }
            __syncthreads();
        }
    }
    }
    for (int rep_ = 0; rep_ < 1 + ((PRO_REPEAT >> 1) & 1); ++rep_) {
    LAS float* scr = (LAS float*)(c.lds + c.wave * 16384);
    constexpr int I_IN = (D / 64) * (DINP / 32), I_SQ = (D / 64) * (D / 32);
    for (int it = c.gw; it < I_IN + 2 * I_SQ; it += c.ngw) {
        int r = it;
        if (r < I_IN) { if (!(I8_GEMM1 && FAST_GEMM)) transpose_item<0>(IN_WIN, D, 3856, DINP, WSP(bf16_t, WS_WIN), scr, r, c.lane, nullptr, nullptr); continue; } r -= I_IN;
        if (r < I_SQ) { if (!(I8_GEMM2 && FAST_GEMM)) transpose_item<1>(IN_WOUT, D, D, D, WSP(bf16_t, WS_WOUT), scr, r, c.lane, IN_SSMG, IN_ATTG); continue; } r -= I_SQ;
        if (!I8_GEMM3) transpose_item<2>(IN_WQ, D, D, D, WSP(bf16_t, WS_WQ), scr, r, c.lane, nullptr, nullptr);
    }
#if WQ_ONEPASS && I8_GEMM1 && I8_GEMM2 && I8_GEMM3 && FAST_GEMM
    __syncthreads();
    for (int it = blockIdx.x; it < 256; it += gridDim.x) {
        if (it < 128) wquant_block<0>(c, IN_WIN, 3856, it, WSP(unsigned char, WS_WIN), WSP(float, WS_SWIN), nullptr, nullptr);
        else if (it < 192) wquant_block<1>(c, IN_WOUT, D, it - 128, WSP(unsigned char, WS_WOUT), WSP(float, WS_SWOUT), IN_SSMG, IN_ATTG);
        else wquant_block<2>(c, IN_WQ, D, it - 192, WSP(unsigned char, WS_WQ), WSP(float, WS_SWQ), nullptr, nullptr);
    }
#else
    if (I8_GEMM3) colamax_items<false>(c, IN_WQ, D, WSP(unsigned, WS_CTL) + CW_AMXQ);
    if (I8_GEMM1 && FAST_GEMM) colamax_items<true>(c, IN_WIN, 3856, WSP(unsigned, WS_CTL) + CW_AMXIN);
    if (I8_GEMM2 && FAST_GEMM) colamax_items<false, true>(c, IN_WOUT, D, WSP(unsigned, WS_CTL) + CW_AMXOUT, IN_SSMG, IN_ATTG);
#endif
    }
    for (int rep_ = 0; rep_ < (HIDE_TABLES ? 0 : 1) + ((PRO_REPEAT >> 2) & 1); ++rep_) {
    {
#define TAB_SRC(r_) ((r_) < 16384 ? IN_U + (size_t)(r_) * D : IN_V + (size_t)((r_) - 16384) * D)
        f32x4 cur[8], nxt[8];
        int r = c.gw;
        if (r < 2 * 16384) fp8_row_load(cur, TAB_SRC(r), c.lane);
        for (; r < 2 * 16384; r += c.ngw) {
            const int rn = r + c.ngw;
            if (rn < 2 * 16384) fp8_row_load(nxt, TAB_SRC(rn), c.lane);
            if (r < 16384) fp8_row_finish<SLICED_PEER != 0>(cur, WSP(unsigned char, WS_UB), r, WSP(float, WS_SCU) + r, c.lane);
            else fp8_row_finish<(SLICED_PEER != 0) && (V_INT8 != 0)>(cur, WSP(unsigned char, WS_VB), r - 16384, WSP(float, WS_SCV) + (r - 16384), c.lane);
#pragma unroll
            for (int i = 0; i < 8; ++i) cur[i] = nxt[i];
        }
#undef TAB_SRC
    }
    }
    cvt_f32_bf16(c, IN_KEYS, WSP(bf16_t, WS_KEYS), (size_t)8 * 2 * 128 * 128 / 8);
}

__device__ __forceinline__ void step_h1(const Ctx& c) {
    const float* MOD = WSP(float, WS_MOD); bf16_t* H1 = WSP(bf16_t, WS_ACT);
    for (int t = c.gw; t < T; t += c.ngw) {
        const int b = t >> 12; const float* xr = IN_X + (size_t)t * D; const float* sh = MOD + b * NMOD; const float* sc = sh + D;
#if I8_GEMM1 && FAST_GEMM
        f32x4 hv[8]; float hmax = 0.f;
#pragma unroll
        for (int j = 0; j < 8; ++j) {
            const int col = j * 256 + c.lane * 4;
            const f32x4 xv = *(const f32x4*)(xr + col), s = *(const f32x4*)(sc + col), h = *(const f32x4*)(sh + col);
            hv[j] = xv * (s + 1.f) + h; hmax = fmaxf(hmax, fmaxf(fmaxf(fabsf(hv[j].x), fabsf(hv[j].y)), fmaxf(fabsf(hv[j].z), fabsf(hv[j].w))));
        }
        hmax = DPPMAX(hmax, 0xB1); hmax = DPPMAX(hmax, 0x4E); hmax = DPPMAX(hmax, 0x141); hmax = DPPMAX(hmax, 0x140);
        const unsigned a0 = __builtin_amdgcn_readlane(__float_as_uint(hmax), 0), a1 = __builtin_amdgcn_readlane(__float_as_uint(hmax), 16), a2 = __builtin_amdgcn_readlane(__float_as_uint(hmax), 32), a3 = __builtin_amdgcn_readlane(__float_as_uint(hmax), 48);
        const unsigned m01 = a0 > a1 ? a0 : a1, m23 = a2 > a3 ? a2 : a3; const float am = __uint_as_float(m01 > m23 ? m01 : m23), inv = am > 0.f ? 127.f / am : 0.f;
#pragma unroll
        for (int j = 0; j < 8; ++j) *(unsigned*)((unsigned char*)H1 + (size_t)t * D + j * 256 + c.lane * 4) = pack_i8x4(hv[j] * inv);
        if (c.lane == 0) WSP(float, WS_SA1)[t] = am * (1.f / 127.f);
#else
#pragma unroll
        for (int j = 0; j < 8; ++j) {
            const int col = j * 256 + c.lane * 4;
            const f32x4 xv = *(const f32x4*)(xr + col), s = *(const f32x4*)(sc + col), h = *(const f32x4*)(sh + col);
            u32x2 o; o.x = pk2(xv.x * (1.f + s.x) + h.x, xv.y * (1.f + s.y) + h.y); o.y = pk2(xv.z * (1.f + s.z) + h.z, xv.w * (1.f + s.w) + h.w);
            *(u32x2*)(H1 + (size_t)t * D + col) = o;
        }
#endif
    }
}

struct Epi1 {
    bf16_t* proj; float* dtraw;
    __device__ __forceinline__ float rho(int) const { return 1.f; }
    __device__ __forceinline__ float rowscale(int) const { return 1.f; }
    __device__ __forceinline__ void store8s(int row, int col, const float (&v)[8], float) const { store8(row, col, v); }
    __device__ __forceinline__ void store8(int row, int col, const float (&v)[8]) const {
        u32x4 o; o.x = pk2(v[0], v[1]); o.y = pk2(v[2], v[3]); o.z = pk2(v[4], v[5]); o.w = pk2(v[6], v[7]);
        *(u32x4*)(proj + (size_t)row * DINP + col) = o;
        if (col >= DT_OFF && col < DT_OFF + 16) {
            float* d = dtraw + (size_t)row * 16 + (col - DT_OFF);
            *(f32x4*)d = (f32x4){v[0], v[1], v[2], v[3]}; *(f32x4*)(d + 4) = (f32x4){v[4], v[5], v[6], v[7]};
        }
    }
};
struct Epi2 {
    const float* x; const float* mod; const float* ssp; bf16_t* r1;
    __device__ __forceinline__ void rs_pair(int row, float& r_ssd, float& r_att) const {
        float s1 = 0.f, s2 = 0.f;
#pragma unroll
        for (int j = 0; j < 4; ++j) { const f32x4 a = *(const f32x4*)(ssp + (size_t)row * 32 + 4 * j), b = *(const f32x4*)(ssp + (size_t)row * 32 + 16 + 4 * j);
            s1 += (a.x + a.y) + (a.z + a.w); s2 += (b.x + b.y) + (b.z + b.w); }
        r_ssd = rsqrtf(s1 * (1.f / 1024.f) + EPS); r_att = rsqrtf(s2 * (1.f / 1024.f) + EPS);
    }
    __device__ __forceinline__ float rho(int row) const { float a, b; rs_pair(row, a, b); return a / b; }
    __device__ __forceinline__ float rowscale(int row) const { float a, b; rs_pair(row, a, b); return b; }
    __device__ __forceinline__ void store8s(int row, int col, const float (&v)[8], float ra) const {
        const int b = row >> 12;
        const float* g = mod + b * NMOD + 2 * D + col;
        const f32x4 g0 = *(const f32x4*)g, g1 = *(const f32x4*)(g + 4);
        u32x4 o;
        o.x = cvtpk(g0.x * (ra * v[0]), g0.y * (ra * v[1])); o.y = cvtpk(g0.z * (ra * v[2]), g0.w * (ra * v[3]));
        o.z = cvtpk(g1.x * (ra * v[4]), g1.y * (ra * v[5])); o.w = cvtpk(g1.z * (ra * v[6]), g1.w * (ra * v[7]));
        *(u32x4*)(r1 + (size_t)row * D + col) = o;
    }
    __device__ __forceinline__ void store8(int row, int col, const float (&v)[8]) const { store8s(row, col, v, rowscale(row)); }
};
struct Epi3 {
    bf16_t* q;
    __device__ __forceinline__ float rho(int) const { return 1.f; }
    __device__ __forceinline__ float rowscale(int) const { return 1.f; }
    __device__ __forceinline__ void store8s(int row, int col, const float (&v)[8], float) const { store8(row, col, v); }
    __device__ __forceinline__ void store8(int row, int col, const float (&v)[8]) const {
        u32x4 o; o.x = pk2(v[0], v[1]); o.y = pk2(v[2], v[3]); o.z = pk2(v[4], v[5]); o.w = pk2(v[6], v[7]);
        *(u32x4*)(q + (size_t)row * D + col) = o;
    }
};

struct Epi1Q {
    bf16_t* proj; float* dtraw; const float* sa; const float* sw;
    __device__ __forceinline__ float rho(int) const { return 1.f; }
    __device__ __forceinline__ float rowscale(int row) const { return sa[row]; }
    __device__ __forceinline__ void store8s(int row, int col, const float (&v)[8], float rsc) const {
        const f32x4 s0 = *(const f32x4*)(sw + col) * rsc, s1 = *(const f32x4*)(sw + col + 4) * rsc;
        const float r0 = v[0] * s0.x, r1 = v[1] * s0.y, r2 = v[2] * s0.z, r3 = v[3] * s0.w, r4 = v[4] * s1.x, r5 = v[5] * s1.y, r6 = v[6] * s1.z, r7 = v[7] * s1.w;
        u32x4 o; o.x = cvtpk(r0, r1); o.y = cvtpk(r2, r3); o.z = cvtpk(r4, r5); o.w = cvtpk(r6, r7);
        *(u32x4*)(proj + (size_t)row * DINP + col) = o;
        if (col >= DT_OFF && col < DT_OFF + 16) { float* d = dtraw + (size_t)row * 16 + (col - DT_OFF); *(f32x4*)d = (f32x4){r0, r1, r2, r3}; *(f32x4*)(d + 4) = (f32x4){r4, r5, r6, r7}; }
    }
    __device__ __forceinline__ void store8(int row, int col, const float (&v)[8]) const { store8s(row, col, v, rowscale(row)); }
};
struct Epi2Q {
    const float* mod; const float* sa; const float* sw; bf16_t* r1;
    __device__ __forceinline__ float rho(int) const { return 1.f; }
    __device__ __forceinline__ float rowscale(int row) const { return sa[row]; }
    __device__ __forceinline__ void store8s(int row, int col, const float (&v)[8], float rsc) const {
        const int b = row >> 12; const float* g = mod + b * NMOD + 2 * D + col;
        const f32x4 s0 = *(const f32x4*)(sw + col) * *(const f32x4*)g * rsc, s1 = *(const f32x4*)(sw + col + 4) * *(const f32x4*)(g + 4) * rsc;
        u32x4 o; o.x = cvtpk(v[0] * s0.x, v[1] * s0.y); o.y = cvtpk(v[2] * s0.z, v[3] * s0.w); o.z = cvtpk(v[4] * s1.x, v[5] * s1.y); o.w = cvtpk(v[6] * s1.z, v[7] * s1.w);
        *(u32x4*)(r1 + (size_t)row * D + col) = o;
    }
    __device__ __forceinline__ void store8(int row, int col, const float (&v)[8]) const { store8s(row, col, v, rowscale(row)); }
};
struct Epi3Q {
    bf16_t* q; const float* hs; const float* swq;
    __device__ __forceinline__ float rho(int) const { return 1.f; }
    __device__ __forceinline__ float rowscale(int row) const { return hs[row]; }
    __device__ __forceinline__ void store8s(int row, int col, const float (&v)[8], float rsc) const {
        const f32x4 s0 = *(const f32x4*)(swq + col) * rsc, s1 = *(const f32x4*)(swq + col + 4) * rsc;
        u32x4 o; o.x = cvtpk(v[0] * s0.x, v[1] * s0.y); o.y = cvtpk(v[2] * s0.z, v[3] * s0.w); o.z = cvtpk(v[4] * s1.x, v[5] * s1.y); o.w = cvtpk(v[6] * s1.z, v[7] * s1.w);
        *(u32x4*)(q + (size_t)row * D + col) = o;
    }
    __device__ __forceinline__ void store8(int row, int col, const float (&v)[8]) const { store8s(row, col, v, rowscale(row)); }
};
template <class Epi, bool MIDK>
__device__ __forceinline__ void gemm_simple(const Ctx& c, const bf16_t* A, const bf16_t* Bt, int M, int N, int K, const Epi& E) {
    LAS float* As = (LAS float*)c.lds;
    LAS float* Bs = As + 32 * 132;
    const int tid = c.tid, ty = tid >> 4, tx = tid & 15, lr = tid >> 2, lk = (tid & 3) * 8;
    const int nTn = N / 128, ntile = (M / 128) * nTn;
    for (int tile = blockIdx.x; tile < ntile; tile += gridDim.x) {
        const int tm = tile / nTn, tn = tile % nTn;
        float acc[4][8];
#pragma unroll
        for (int i = 0; i < 4; ++i)
#pragma unroll
            for (int j = 0; j < 8; ++j) acc[i][j] = 0.f;
        const bf16_t* Ap = A + (size_t)(tm * 128 + lr) * K + lk;
        const bf16_t* Bp = Bt + (size_t)(tn * 128 + lr) * K + lk;
        for (int k0 = 0; k0 < K; k0 += 32) {
            if (MIDK && k0 == K / 2) {
#pragma unroll
                for (int i = 0; i < 4; ++i) { const float r = E.rho(tm * 128 + ty * 4 + i);
#pragma unroll
                    for (int j = 0; j < 8; ++j) acc[i][j] *= r; }
            }
            const u32x4 av = *(const u32x4*)(Ap + k0), bv = *(const u32x4*)(Bp + k0);
            __syncthreads();
            As[(lk + 0) * 132 + lr] = bflo(av.x); As[(lk + 1) * 132 + lr] = bfhi(av.x); As[(lk + 2) * 132 + lr] = bflo(av.y); As[(lk + 3) * 132 + lr] = bfhi(av.y);
            As[(lk + 4) * 132 + lr] = bflo(av.z); As[(lk + 5) * 132 + lr] = bfhi(av.z); As[(lk + 6) * 132 + lr] = bflo(av.w); As[(lk + 7) * 132 + lr] = bfhi(av.w);
            Bs[(lk + 0) * 132 + lr] = bflo(bv.x); Bs[(lk + 1) * 132 + lr] = bfhi(bv.x); Bs[(lk + 2) * 132 + lr] = bflo(bv.y); Bs[(lk + 3) * 132 + lr] = bfhi(bv.y);
            Bs[(lk + 4) * 132 + lr] = bflo(bv.z); Bs[(lk + 5) * 132 + lr] = bfhi(bv.z); Bs[(lk + 6) * 132 + lr] = bflo(bv.w); Bs[(lk + 7) * 132 + lr] = bfhi(bv.w);
            __syncthreads();
#pragma unroll 8
            for (int k = 0; k < 32; ++k) {
                const f32x4 a = *(const LAS f32x4*)(As + k * 132 + ty * 4);
                const f32x4 b0 = *(const LAS f32x4*)(Bs + k * 132 + tx * 8), b1 = *(const LAS f32x4*)(Bs + k * 132 + tx * 8 + 4);
                const float aa[4] = {a.x, a.y, a.z, a.w}; const float bb[8] = {b0.x, b0.y, b0.z, b0.w, b1.x, b1.y, b1.z, b1.w};
#pragma unroll
                for (int i = 0; i < 4; ++i)
#pragma unroll
                    for (int j = 0; j < 8; ++j) acc[i][j] += aa[i] * bb[j];
            }
        }
#pragma unroll
        for (int i = 0; i < 4; ++i) E.store8(tm * 128 + ty * 4 + i, tn * 128 + tx * 8, acc[i]);
    }
    __syncthreads();
}

namespace pg8 {
#define PG8_LAS __attribute__((address_space(3)))
typedef unsigned short bf16_t;
typedef short bf16x8 __attribute__((ext_vector_type(8)));
typedef float f32x4 __attribute__((ext_vector_type(4)));
typedef unsigned u32x4 __attribute__((ext_vector_type(4)));
constexpr int BM = 256, BK = 64, HALF = 128, HTB = HALF * BK * 2  , STAGE_BYTES = 8 * HTB, NXCD = 8, WGM = 8;

__host__ __device__ __forceinline__ int lds_byte(int r, int c) { const int st = (r >> 4) * 2 + (c >> 5), rr = r & 15, cc = c & 31, ob = rr * 64 + cc * 2; return st * 1024 + (ob ^ (((ob >> 9) & 1) << 5)); }
__host__ __device__ __forceinline__ void stage_rc(int b, int& R, int& C) { const int st = b / 1024, sb = b % 1024, swz = sb ^ (((sb >> 9) & 1) << 5); R = (st >> 1) * 16 + swz / 64; C = (st & 1) * 32 + (swz % 64) / 2; }
__host__ __device__ __forceinline__ int perm32(int rho) { const int n = rho >> 4, i = rho & 15; return 8 * (i >> 2) + 4 * n + (i & 3); }

struct Unit { int pm, pn; };
struct Gemm { const bf16_t* A; const bf16_t* Bt; int M, N, K; };

struct StaticOrder {
    int nM, nN, nwg, G, c;
    __host__ __device__ void init(int M, int N, int G_, int c_) { nM = M / BM; nN = N / BM; nwg = nM * nN; G = G_; c = c_; }
    __host__ __device__ bool next(int i, Unit& u) const {
        const long L = (long)i * G + c; if (L >= nwg) return false;
        int wgid = (int)L; { const int q = nwg / NXCD, r = nwg % NXCD, xcd = wgid % NXCD, off = wgid / NXCD; wgid = (xcd < r ? xcd * (q + 1) : r * (q + 1) + (xcd - r) * q) + off; }
        const int nig = WGM * nN, gid = wgid / nig, fm = gid * WGM, gsz = (nM - fm) < WGM ? (nM - fm) : WGM;
        u.pm = fm + ((wgid % nig) % gsz); u.pn = (wgid % nig) / gsz; return true;
    }
    __device__ __forceinline__ void a_ready(const Unit&) const {}
    __device__ __forceinline__ void done(const Unit&) const {}
};


template <class E, bool I8 = false> struct EpiA {
    static constexpr bool PERM = true, AFTER_DRAIN = false; E e;
    __device__ __forceinline__ void operator()(const f32x4 (&acc)[2][2][4][2], const Unit& u, int wr, int wc, int fr, int fq) const {
#pragma unroll
        for (int ai = 0; ai < 2; ++ai)
#pragma unroll
            for (int m = 0; m < 4; ++m) {
                const int row = u.pm * BM + ai * HALF + wr * 64 + m * 16 + fr; const float rsc = e.rowscale(row);
#pragma unroll
                for (int bj = 0; bj < 2; ++bj) {
                    const f32x4 v0 = acc[ai][bj][m][0], v1 = acc[ai][bj][m][1];
                    float v[8];
                    if constexpr (I8) {
#pragma unroll
                        for (int j = 0; j < 4; ++j) { v[j] = (float)__float_as_int(v0[j]); v[4 + j] = (float)__float_as_int(v1[j]); }
                    } else {
#pragma unroll
                        for (int j = 0; j < 4; ++j) { v[j] = v0[j]; v[4 + j] = v1[j]; }
                    }
                    e.store8s(row, u.pn * BM + bj * HALF + wc * 32 + 8 * fq, v, rsc);
                }
                if (m & 1) asm volatile("" ::: "memory");
            }
    }
    __device__ __forceinline__ void midk(f32x4 (&acc)[2][2][4][2], const Unit& u, int wr, int fr) const {
#pragma unroll
        for (int ai = 0; ai < 2; ++ai)
#pragma unroll
            for (int m = 0; m < 4; ++m) {
                const float r = e.rho(u.pm * BM + ai * HALF + wr * 64 + m * 16 + fr);
#pragma unroll
                for (int bj = 0; bj < 2; ++bj)
#pragma unroll
                    for (int n = 0; n < 2; ++n) acc[ai][bj][m][n] = acc[ai][bj][m][n] * r;
            }
    }
};
typedef int i32x4 __attribute__((ext_vector_type(4)));
template <class Epi, class Sched, bool ALIGN_EPI = false, bool SP2 = false, bool MIDK = false, bool I8 = false>
__device__ __forceinline__ void gemm_phase(PG8_LAS unsigned char* lds, const Gemm g, const Sched& S, const Epi& E) {
    const int tid = threadIdx.x, wid = __builtin_amdgcn_readfirstlane(tid >> 6), lane = tid & 63, wr = wid >> 2, wc = wid & 3, fr = lane & 15, fq = lane >> 4;
    const int K = g.K, nt = K / BK;
    unsigned voffA[2], voffB[2];
#pragma unroll
    for (int i = 0; i < 2; ++i) { int R, C; stage_rc(tid * 16 + i * 8192, R, C); const int Rb = Epi::PERM ? ((R & ~31) + perm32(R & 31)) : R;
        voffA[i] = (unsigned)(R * K + C) * 2u; voffB[i] = (unsigned)(Rb * K + C) * 2u; }
    const size_t kstep = (size_t)(BK * 2);
    const size_t hstep = (size_t)HALF * K * 2;
    const size_t tstep = 2 * hstep;
    const unsigned ldsw = (unsigned)wid * 1024u;
    const int aoff = lds_byte(wr * 64 + fr, fq * 8), boff = lds_byte(wc * 32 + fr, fq * 8);
#define PG8_SA(b, h) (((b) * 2 + (h)) * HTB)
#define PG8_SB(b, h) ((4 + (b) * 2 + (h)) * HTB)
#define PG8_STAGE(bufoff, gbase, voff) do { _Pragma("unroll") for (int _i = 0; _i < 2; ++_i) \
        __builtin_amdgcn_global_load_lds((const unsigned*)((const char*)(gbase) + (voff)[_i]), (PG8_LAS unsigned*)(lds + (bufoff) + ldsw + _i * 8192), 16, 0, 0); } while (0)
#define PG8_LDA(dst, b, h) do { _Pragma("unroll") for (int m = 0; m < 4; ++m) _Pragma("unroll") for (int k = 0; k < 2; ++k) dst[m][k] = *(const PG8_LAS bf16x8*)(lds + PG8_SA(b, h) + aoff + m * 2048 + k * 1024); } while (0)
#define PG8_LDB(dst, b, h) do { _Pragma("unroll") for (int n = 0; n < 2; ++n) _Pragma("unroll") for (int k = 0; k < 2; ++k) dst[n][k] = *(const PG8_LAS bf16x8*)(lds + PG8_SB(b, h) + boff + n * 2048 + k * 1024); } while (0)
#define PG8_MMA(ai, bj, At, Bt) do { __builtin_amdgcn_s_setprio(1); _Pragma("unroll") for (int m = 0; m < 4; ++m) _Pragma("unroll") for (int n = 0; n < 2; ++n) _Pragma("unroll") for (int k = 0; k < 2; ++k) { \
        if constexpr (I8) acc[ai][bj][m][n] = __builtin_bit_cast(f32x4, __builtin_amdgcn_mfma_i32_16x16x64_i8(__builtin_bit_cast(i32x4, Bt[n][k]), __builtin_bit_cast(i32x4, At[m][k]), __builtin_bit_cast(i32x4, acc[ai][bj][m][n]), 0, 0, 0)); \
        else acc[ai][bj][m][n] = __builtin_amdgcn_mfma_f32_16x16x32_bf16(Bt[n][k], At[m][k], acc[ai][bj][m][n], 0, 0, 0); } __builtin_amdgcn_s_setprio(0); } while (0)
#define PG8_WAIT_V(n) asm volatile("s_waitcnt vmcnt(" #n ")" ::: "memory")
#define PG8_WAIT_L(n) asm volatile("s_waitcnt lgkmcnt(" #n ")" ::: "memory")
#define PG8_BAR __builtin_amdgcn_s_barrier()
#define PG8_SCHED __builtin_amdgcn_sched_barrier(0)
    Unit cur, nxt; int ui = 0;
    if (!S.next(0, cur)) return;
    f32x4 acc[2][2][4][2];
#pragma unroll
    for (int a = 0; a < 2; ++a)
#pragma unroll
        for (int b = 0; b < 2; ++b)
#pragma unroll
            for (int m = 0; m < 4; ++m)
#pragma unroll
                for (int n = 0; n < 2; ++n) acc[a][b][m][n] = (f32x4){0.f, 0.f, 0.f, 0.f};
    bf16x8 At[4][2], B0[2][2], B1[2][2];
    const char* cA = (const char*)g.A + (size_t)cur.pm * tstep; const char* cB = (const char*)g.Bt + (size_t)cur.pn * tstep;
    S.a_ready(cur);
    if constexpr (SP2) {
        PG8_STAGE(PG8_SB(0, 0), cB, voffB); PG8_STAGE(PG8_SB(0, 1), cB + hstep, voffB); PG8_STAGE(PG8_SA(0, 0), cA, voffA); PG8_STAGE(PG8_SA(0, 1), cA + hstep, voffA);
        if (wr == 1) PG8_BAR;
        PG8_WAIT_V(2); PG8_BAR;
        PG8_STAGE(PG8_SB(1, 0), cB + kstep, voffB); PG8_STAGE(PG8_SA(1, 0), cA + kstep, voffA); PG8_STAGE(PG8_SB(1, 1), cB + hstep + kstep, voffB);
        PG8_WAIT_V(6); PG8_BAR;
    } else {
        PG8_STAGE(PG8_SB(0, 0), cB, voffB); PG8_STAGE(PG8_SA(0, 0), cA, voffA); PG8_STAGE(PG8_SB(0, 1), cB + hstep, voffB); PG8_STAGE(PG8_SA(0, 1), cA + hstep, voffA);
        if (wr == 1) PG8_BAR;
        PG8_WAIT_V(4); PG8_BAR;
        PG8_STAGE(PG8_SB(1, 0), cB + kstep, voffB); PG8_STAGE(PG8_SA(1, 0), cA + kstep, voffA); PG8_STAGE(PG8_SB(1, 1), cB + hstep + kstep, voffB);
        PG8_WAIT_V(6); PG8_BAR;
    }
    for (;;) {
        const bool has_next = S.next(ui + 1, nxt);
        const char* nA = has_next ? (const char*)g.A + (size_t)nxt.pm * tstep : cA; const char* nB = has_next ? (const char*)g.Bt + (size_t)nxt.pn * tstep : cB;
        for (int t = 0; t < nt; t += 2) {
            const bool last = (t == nt - 2);
            if constexpr (MIDK) { if (t == nt / 2) E.midk(acc, cur, wr, fr); }
            const char* a1 = cA + (size_t)(t + 1) * kstep;
            const char* a2 = last ? nA : cA + (size_t)(t + 2) * kstep; const char* b2 = last ? nB : cB + (size_t)(t + 2) * kstep;
            const char* a3 = a2 + kstep; const char* b3 = b2 + kstep;
            if (last && has_next) S.a_ready(nxt);
            if constexpr (SP2) {
            PG8_LDB(B0, 0, 0); PG8_LDB(B1, 0, 1); PG8_SCHED; PG8_LDA(At, 0, 0); PG8_STAGE(PG8_SA(1, 1), a1 + hstep, voffA);
            PG8_WAIT_V(8); PG8_WAIT_L(0); PG8_BAR; PG8_MMA(0, 0, At, B0); PG8_MMA(0, 1, At, B1); PG8_BAR; PG8_SCHED;
            PG8_LDA(At, 0, 1); PG8_STAGE(PG8_SB(0, 0), b2, voffB); PG8_STAGE(PG8_SB(0, 1), b2 + hstep, voffB); PG8_STAGE(PG8_SA(0, 0), a2, voffA);
            PG8_WAIT_V(8); PG8_WAIT_L(0); PG8_BAR; PG8_MMA(1, 0, At, B0); PG8_MMA(1, 1, At, B1); PG8_BAR; PG8_SCHED;
            PG8_LDB(B0, 1, 0); PG8_LDB(B1, 1, 1); PG8_SCHED; PG8_LDA(At, 1, 0); PG8_STAGE(PG8_SA(0, 1), a2 + hstep, voffA);
            PG8_WAIT_V(8); PG8_WAIT_L(0); PG8_BAR; PG8_MMA(0, 0, At, B0); PG8_MMA(0, 1, At, B1); PG8_BAR; PG8_SCHED;
            PG8_LDA(At, 1, 1); PG8_STAGE(PG8_SB(1, 0), b3, voffB); PG8_STAGE(PG8_SB(1, 1), b3 + hstep, voffB); PG8_STAGE(PG8_SA(1, 0), a3, voffA);
            PG8_WAIT_V(8); PG8_WAIT_L(0); PG8_BAR; PG8_MMA(1, 0, At, B0); PG8_MMA(1, 1, At, B1); PG8_BAR; PG8_SCHED;
            } else {
            PG8_LDB(B0, 0, 0); PG8_SCHED; PG8_LDA(At, 0, 0); PG8_STAGE(PG8_SA(1, 1), a1 + hstep, voffA);
            PG8_WAIT_L(8); PG8_BAR; PG8_WAIT_L(0); PG8_MMA(0, 0, At, B0); PG8_BAR; PG8_SCHED;
            PG8_LDB(B1, 0, 1); PG8_STAGE(PG8_SB(0, 0), b2, voffB);
            PG8_BAR; PG8_WAIT_L(0); PG8_MMA(0, 1, At, B1); PG8_BAR;
            PG8_LDA(At, 0, 1); PG8_STAGE(PG8_SA(0, 0), a2, voffA);
            PG8_BAR; PG8_WAIT_L(0); PG8_MMA(1, 0, At, B0); PG8_BAR; PG8_SCHED;
            PG8_STAGE(PG8_SB(0, 1), b2 + hstep, voffB);
            PG8_WAIT_V(6); PG8_BAR; PG8_MMA(1, 1, At, B1); PG8_BAR;
            PG8_LDB(B0, 1, 0); PG8_SCHED; PG8_LDA(At, 1, 0); PG8_STAGE(PG8_SA(0, 1), a2 + hstep, voffA);
            PG8_WAIT_L(8); PG8_BAR; PG8_WAIT_L(0); PG8_MMA(0, 0, At, B0); PG8_BAR; PG8_SCHED;
            PG8_LDB(B1, 1, 1); PG8_STAGE(PG8_SB(1, 0), b3, voffB);
            PG8_BAR; PG8_WAIT_L(0); PG8_MMA(0, 1, At, B1); PG8_BAR;
            PG8_LDA(At, 1, 1); PG8_STAGE(PG8_SA(1, 0), a3, voffA);
            PG8_BAR; PG8_WAIT_L(0); PG8_MMA(1, 0, At, B0); PG8_BAR; PG8_SCHED;
            PG8_STAGE(PG8_SB(1, 1), b3 + hstep, voffB);
            PG8_WAIT_V(6); PG8_BAR; PG8_MMA(1, 1, At, B1); PG8_BAR;
            }
        }
        if constexpr (ALIGN_EPI) { if (wr == 0) PG8_BAR; }
        if constexpr (!Epi::AFTER_DRAIN) { E(acc, cur, wr, wc, fr, fq); S.done(cur); }
        if (!has_next) break;
#pragma unroll
        for (int a = 0; a < 2; ++a)
#pragma unroll
            for (int b = 0; b < 2; ++b)
#pragma unroll
                for (int m = 0; m < 4; ++m)
#pragma unroll
                    for (int n = 0; n < 2; ++n) acc[a][b][m][n] = (f32x4){0.f, 0.f, 0.f, 0.f};
        cur = nxt; cA = nA; cB = nB; ++ui;
        if constexpr (ALIGN_EPI) { if (wr == 1) PG8_BAR; }
    }
    PG8_WAIT_V(0);
    if constexpr (!ALIGN_EPI) { if (wr == 0) PG8_BAR; }
    PG8_BAR;
    if constexpr (Epi::AFTER_DRAIN) { E.fused(acc, cur, wr, wc, fr, fq, lds, wid, lane); S.done(cur); }
#undef PG8_SA
#undef PG8_SB
#undef PG8_STAGE
#undef PG8_LDA
#undef PG8_LDB
#undef PG8_MMA
#undef PG8_WAIT_V
#undef PG8_WAIT_L
#undef PG8_BAR
#undef PG8_SCHED
}
}

__device__ __forceinline__ void step_conv(const Ctx& c) {
    const bf16_t* PROJ = WSP(bf16_t, WS_PROJ); bf16_t* XBCC = WSP(bf16_t, WS_XBCC);
    for (int idx = c.gt; idx < T * 768; idx += c.ngt) {
        const int t = idx / 768, ch = (idx % 768) * 2, pos = t & (SEQ - 1);
        float a0 = IN_CONVB[ch], a1 = IN_CONVB[ch + 1];
#pragma unroll
        for (int j = 0; j < 4; ++j) {
            if (pos - 3 + j >= 0) {
                const unsigned v = *(const unsigned*)(PROJ + (size_t)(t - 3 + j) * DINP + XBC_OFF + ch);
                a0 += IN_CONVW[j * 1536 + ch] * bflo(v); a1 += IN_CONVW[j * 1536 + ch + 1] * bfhi(v);
            }
        }
        *(unsigned*)(XBCC + (size_t)t * 1536 + ch) = pk2(silu_f(a0), silu_f(a1));
    }
    const float* DTRAW = WSP(float, WS_DTRAW); float* DT = WSP(float, WS_DT); float* ACUM = WSP(float, WS_ACUM);
    for (int idx = c.gt; idx < NB * NCH * NH; idx += c.ngt) {
        const int h = idx % NH, bc = idx / NH, t0 = bc * 128;
        const float A = -expf(IN_ALOG[h]), bias = IN_DTBIAS[h]; float cum = 0.f;
        for (int l = 0; l < 128; ++l) {
            const float dtv = softplus_f(DTRAW[(size_t)(t0 + l) * 16 + h] + bias); cum += dtv * A;
            DT[(size_t)idx * 128 + l] = dtv; ACUM[(size_t)idx * 128 + l] = cum;
        }
    }
}

__device__ __forceinline__ void step_ssd1_simple(const Ctx& c) {
    const bf16_t* XBCC = WSP(bf16_t, WS_XBCC); const float* DT = WSP(float, WS_DT); const float* ACUM = WSP(float, WS_ACUM); float* STATES = WSP(float, WS_STATES);
    LAS float* wl = (LAS float*)c.lds;
    for (int item = blockIdx.x; item < NB * NCH * NH; item += gridDim.x) {
        const int bc = item / NH, h = item % NH, g = h >> 3, t0 = bc * 128;
        __syncthreads();
        if (c.tid < 128) { const float aend = ACUM[(size_t)item * 128 + 127]; wl[c.tid] = expf(aend - ACUM[(size_t)item * 128 + c.tid]) * DT[(size_t)item * 128 + c.tid]; }
        __syncthreads();
        const int p = c.tid >> 3, n0 = (c.tid & 7) * 16;
        float acc[16];
#pragma unroll
        for (int j = 0; j < 16; ++j) acc[j] = 0.f;
        for (int l = 0; l < 128; ++l) {
            const bf16_t* row = XBCC + (size_t)(t0 + l) * 1536;
            const float xv = bf2f(row[h * 64 + p]) * wl[l];
            const u32x4 b0 = *(const u32x4*)(row + 1024 + g * 128 + n0), b1 = *(const u32x4*)(row + 1024 + g * 128 + n0 + 8);
            acc[0] += xv * bflo(b0.x); acc[1] += xv * bfhi(b0.x); acc[2] += xv * bflo(b0.y); acc[3] += xv * bfhi(b0.y);
            acc[4] += xv * bflo(b0.z); acc[5] += xv * bfhi(b0.z); acc[6] += xv * bflo(b0.w); acc[7] += xv * bfhi(b0.w);
            acc[8] += xv * bflo(b1.x); acc[9] += xv * bfhi(b1.x); acc[10] += xv * bflo(b1.y); acc[11] += xv * bfhi(b1.y);
            acc[12] += xv * bflo(b1.z); acc[13] += xv * bfhi(b1.z); acc[14] += xv * bflo(b1.w); acc[15] += xv * bfhi(b1.w);
        }
        float* o = STATES + ((size_t)item * 64 + p) * 128 + n0;
#pragma unroll
        for (int j = 0; j < 4; ++j) *(f32x4*)(o + 4 * j) = (f32x4){acc[4 * j], acc[4 * j + 1], acc[4 * j + 2], acc[4 * j + 3]};
    }
    __syncthreads();
}

__device__ __forceinline__ void step_scan(const Ctx& c) {
    const float* STATES = WSP(float, WS_STATES); const float* ACUM = WSP(float, WS_ACUM); bf16_t* PREVB = WSP(bf16_t, WS_PREVB);
    static_assert(NCH == 32, "four quarters of 8 chunks");
    for (int idx = c.gt; idx < NB * NH * 64 * 32; idx += c.ngt) {
        const int n4 = idx & 31, p = (idx >> 5) & 63, h = (idx >> 11) & 15, b = idx >> 15;
        f32x4 hs = {0.f, 0.f, 0.f, 0.f};
#pragma unroll 1
        for (int q = 0; q < 4; ++q) {
            f32x4 st[8]; float dec[8];
            const size_t it0 = (size_t)(b * NCH + q * 8) * NH + h;
            const float* sp = STATES + (it0 * 64 + p) * 128 + n4 * 4; const float* ap = ACUM + it0 * 128 + 127; bf16_t* pp = PREVB + (it0 * 64 + p) * 128 + n4 * 4;
#pragma unroll
            for (int j = 0; j < 8; ++j) { st[j] = *(const f32x4*)(sp + (size_t)j * (NH * 64 * 128)); dec[j] = ap[(size_t)j * (NH * 128)]; }
#pragma unroll
            for (int j = 0; j < 8; ++j) {
                *(u32x2*)(pp + (size_t)j * (NH * 64 * 128)) = (u32x2){pk2(hs.x, hs.y), pk2(hs.z, hs.w)};
                hs = hs * expf(dec[j]) + st[j]; }
        }
    }
}

__device__ __forceinline__ void step_cb_simple(const Ctx& c) {
    const bf16_t* XBCC = WSP(bf16_t, WS_XBCC); float* G = WSP(float, WS_STATES);
    for (int idx = c.gt; idx < NB * NCH * 2 * 128 * 128; idx += c.ngt) {
        const int s = idx & 127, l = (idx >> 7) & 127, g = (idx >> 14) & 1, bc = idx >> 15, t0 = bc * 128;
        const bf16_t* Cr = XBCC + (size_t)(t0 + l) * 1536 + 1280 + g * 128; const bf16_t* Br = XBCC + (size_t)(t0 + s) * 1536 + 1024 + g * 128;
        float sum = 0.f;
#pragma unroll 4
        for (int n = 0; n < 128; n += 8) sum += dot8(*(const u32x4*)(Cr + n), *(const u32x4*)(Br + n));
        G[idx] = sum;
    }
}

__device__ __forceinline__ void step_ssd2_simple(const Ctx& c) {
    const bf16_t* XBCC = WSP(bf16_t, WS_XBCC); const bf16_t* PROJ = WSP(bf16_t, WS_PROJ); const bf16_t* PREVB = WSP(bf16_t, WS_PREVB);
    const float* DT = WSP(float, WS_DT); const float* ACUM = WSP(float, WS_ACUM); const float* G = WSP(float, WS_STATES);
    bf16_t* YCAT = WSP(bf16_t, WS_ACT); float* SSP = WSP(float, WS_SSP);
    LAS float* ac = (LAS float*)c.lds; LAS float* dl = ac + 128;
    for (int item = blockIdx.x; item < NB * NCH * NH; item += gridDim.x) {
        const int bc = item / NH, h = item % NH, g = h >> 3, t0 = bc * 128;
        __syncthreads();
        if (c.tid < 128) { ac[c.tid] = ACUM[(size_t)item * 128 + c.tid]; dl[c.tid] = DT[(size_t)item * 128 + c.tid]; }
        __syncthreads();
        const int l = c.tid >> 2, p0 = (c.tid & 3) * 16, t = t0 + l;
        float acc[16];
#pragma unroll
        for (int j = 0; j < 16; ++j) acc[j] = 0.f;
        {
            const bf16_t* Cr = XBCC + (size_t)t * 1536 + 1280 + g * 128; const bf16_t* Pr = PREVB + ((size_t)item * 64 + p0) * 128;
            for (int n = 0; n < 128; n += 8) {
                const u32x4 cv = *(const u32x4*)(Cr + n);
#pragma unroll
                for (int j = 0; j < 16; ++j) acc[j] += dot8(cv, *(const u32x4*)(Pr + j * 128 + n));
            }
            const float el = expf(ac[l]);
#pragma unroll
            for (int j = 0; j < 16; ++j) acc[j] *= el;
        }
        const float al = ac[l]; const float* Gr = G + ((size_t)(bc * 2 + g) * 128 + l) * 128;
        for (int s = 0; s <= l; ++s) {
            const float coef = Gr[s] * expf(al - ac[s]) * dl[s];
            const bf16_t* xr = XBCC + (size_t)(t0 + s) * 1536 + h * 64 + p0;
            const u32x4 x0 = *(const u32x4*)xr, x1 = *(const u32x4*)(xr + 8);
            acc[0] += coef * bflo(x0.x); acc[1] += coef * bfhi(x0.x); acc[2] += coef * bflo(x0.y); acc[3] += coef * bfhi(x0.y);
            acc[4] += coef * bflo(x0.z); acc[5] += coef * bfhi(x0.z); acc[6] += coef * bflo(x0.w); acc[7] += coef * bfhi(x0.w);
            acc[8] += coef * bflo(x1.x); acc[9] += coef * bfhi(x1.x); acc[10] += coef * bflo(x1.y); acc[11] += coef * bfhi(x1.y);
            acc[12] += coef * bflo(x1.z); acc[13] += coef * bfhi(x1.z); acc[14] += coef * bflo(x1.w); acc[15] += coef * bfhi(x1.w);
        }
        {
            const bf16_t* xr = XBCC + (size_t)t * 1536 + h * 64 + p0; const bf16_t* zr = PROJ + (size_t)t * DINP + Z_OFF + h * 64 + p0;
            const float dsk = IN_DSKIP[h]; float ss = 0.f; unsigned ow[8];
#pragma unroll
            for (int j = 0; j < 16; j += 2) {
                const unsigned xw = *(const unsigned*)(xr + j), zw = *(const unsigned*)(zr + j);
                const float y0 = (acc[j] + dsk * bflo(xw)) * silu_f(bflo(zw)), y1 = (acc[j + 1] + dsk * bfhi(xw)) * silu_f(bfhi(zw));
                ss += y0 * y0 + y1 * y1; ow[j >> 1] = pk2(y0, y1);
            }
            bf16_t* o = YCAT + (size_t)t * D + h * 64 + p0;
            *(u32x4*)o = (u32x4){ow[0], ow[1], ow[2], ow[3]}; *(u32x4*)(o + 8) = (u32x4){ow[4], ow[5], ow[6], ow[7]};
            ss += __shfl_xor(ss, 1); ss += __shfl_xor(ss, 2);
            if ((c.tid & 3) == 0) SSP[(size_t)t * 32 + h] = ss;
        }
    }
    __syncthreads();
}

__device__ __forceinline__ void step_att_simple(const Ctx& c) {
    const bf16_t* PROJ = WSP(bf16_t, WS_PROJ); bf16_t* YCAT = WSP(bf16_t, WS_ACT); float* SSP = WSP(float, WS_SSP);
    for (int idx = c.gt; idx < T * 16; idx += c.ngt) {
        const int t = idx >> 4, hd = idx & 15, kvh = hd >> 3, pos = t & (SEQ - 1);
        float q[64], o[64];
        {
            const bf16_t* qr = PROJ + (size_t)t * DINP + Q_OFF + hd * 64;
#pragma unroll
            for (int d = 0; d < 64; d += 8) { const u32x4 v = *(const u32x4*)(qr + d);
                q[d] = 0.125f * bflo(v.x); q[d + 1] = 0.125f * bfhi(v.x); q[d + 2] = 0.125f * bflo(v.y); q[d + 3] = 0.125f * bfhi(v.y);
                q[d + 4] = 0.125f * bflo(v.z); q[d + 5] = 0.125f * bfhi(v.z); q[d + 6] = 0.125f * bflo(v.w); q[d + 7] = 0.125f * bfhi(v.w); }
        }
#pragma unroll
        for (int d = 0; d < 64; ++d) o[d] = 0.f;
        float m = IN_SINKS[hd], den = 1.f;
        const int j0 = pos - 127 > 0 ? pos - 127 : 0;
        for (int kp = j0; kp <= pos; ++kp) {
            const size_t tk = (size_t)(t - pos + kp);
            const bf16_t* kr = PROJ + tk * DINP + K_OFF + kvh * 64; const bf16_t* vr = PROJ + tk * DINP + V_OFF + kvh * 64;
            float s = 0.f;
#pragma unroll
            for (int d = 0; d < 64; d += 8) { const u32x4 v = *(const u32x4*)(kr + d);
                s += q[d] * bflo(v.x) + q[d + 1] * bfhi(v.x) + q[d + 2] * bflo(v.y) + q[d + 3] * bfhi(v.y) + q[d + 4] * bflo(v.z) + q[d + 5] * bfhi(v.z) + q[d + 6] * bflo(v.w) + q[d + 7] * bfhi(v.w); }
            if (s > m) { const float sc = expf(m - s); den *= sc;
#pragma unroll
                for (int d = 0; d < 64; ++d) o[d] *= sc;
                m = s; }
            const float p = expf(s - m); den += p;
#pragma unroll
            for (int d = 0; d < 64; d += 8) { const u32x4 v = *(const u32x4*)(vr + d);
                o[d] += p * bflo(v.x); o[d + 1] += p * bfhi(v.x); o[d + 2] += p * bflo(v.y); o[d + 3] += p * bfhi(v.y);
                o[d + 4] += p * bflo(v.z); o[d + 5] += p * bfhi(v.z); o[d + 6] += p * bflo(v.w); o[d + 7] += p * bfhi(v.w); }
        }
        const float inv = 1.f / den; float ss = 0.f;
        bf16_t* orow = YCAT + (size_t)t * D + 1024 + hd * 64;
#pragma unroll
        for (int d = 0; d < 64; d += 8) {
            float r[8];
#pragma unroll
            for (int e = 0; e < 8; ++e) { r[e] = o[d + e] * inv; ss += r[e] * r[e]; }
            *(u32x4*)(orow + d) = (u32x4){pk2(r[0], r[1]), pk2(r[2], r[3]), pk2(r[4], r[5]), pk2(r[6], r[7])};
        }
        SSP[(size_t)t * 32 + 16 + hd] = ss;
    }
}

__device__ __forceinline__ bf16x8v ld_frag16(const void* p) { return __builtin_bit_cast(bf16x8v, *(const u32x4*)p); }
__device__ __forceinline__ bf16x8v lds_frag16(const LAS unsigned char* p) { return __builtin_bit_cast(bf16x8v, *(const LAS u32x4*)p); }
__device__ __forceinline__ f32x16 zero16() { f32x16 z;
#pragma unroll
    for (int r = 0; r < 16; ++r) z[r] = 0.f;
    return z; }
#define MFMA32(a, b, c) __builtin_amdgcn_mfma_f32_32x32x16_bf16((a), (b), (c), 0, 0, 0)
__device__ __forceinline__ bf16x8v acc_frag(const f32x16& x, int ks2) {
    u32x4 w; w.x = cvtpk(x[8 * ks2 + 0], x[8 * ks2 + 1]); w.y = cvtpk(x[8 * ks2 + 2], x[8 * ks2 + 3]); w.z = cvtpk(x[8 * ks2 + 4], x[8 * ks2 + 5]); w.w = cvtpk(x[8 * ks2 + 6], x[8 * ks2 + 7]);
    return __builtin_bit_cast(bf16x8v, w);
}

__device__ __forceinline__ void step_dta(const Ctx& c) {
    const float* DTRAW = WSP(float, WS_DTRAW); float* DT = WSP(float, WS_DT); float* ACUM = WSP(float, WS_ACUM);
    for (int idx = c.gw; idx < NB * NCH * NH; idx += c.ngw) {
        const int h = idx % NH, bc = idx / NH, t0 = bc * 128, l0 = 2 * c.lane;
        const float A = -expf(IN_ALOG[h]), bias = IN_DTBIAS[h];
        const float d0 = softplus_f(DTRAW[(size_t)(t0 + l0) * 16 + h] + bias), d1 = softplus_f(DTRAW[(size_t)(t0 + l0 + 1) * 16 + h] + bias);
        const float a0 = d0 * A, a1 = d1 * A; float x = a0 + a1;
#pragma unroll
        for (int o = 1; o < 64; o <<= 1) { const float v = __shfl_up(x, o); if (c.lane >= o) x += v; }
        const float ex = x - (a0 + a1);
        *(f32x2*)(DT + (size_t)idx * 128 + l0) = (f32x2){d0, d1};
        *(f32x2*)(ACUM + (size_t)idx * 128 + l0) = (f32x2){ex + a0, ex + a0 + a1};
    }
}
__device__ __forceinline__ void conv_unit(const Ctx& c, int t0, int ch) {
    const bf16_t* PROJ = WSP(bf16_t, WS_PROJ); bf16_t* XBCC = WSP(bf16_t, WS_XBCC);
    const int pos0 = t0 & (SEQ - 1);
    f32x4 w[4];
#pragma unroll
    for (int j = 0; j < 4; ++j) w[j] = *(const f32x4*)(IN_CONVW + j * 1536 + ch);
    const f32x4 bias = *(const f32x4*)(IN_CONVB + ch);
    f32x4 xr[11];
#pragma unroll
    for (int i = 0; i < 11; ++i) {
        if (pos0 - 3 + i >= 0) { const u32x2 v = *(const u32x2*)(PROJ + (size_t)(t0 - 3 + i) * DINP + XBC_OFF + ch); xr[i] = (f32x4){bflo(v.x), bfhi(v.x), bflo(v.y), bfhi(v.y)}; }
        else xr[i] = (f32x4){0.f, 0.f, 0.f, 0.f};
    }
#pragma unroll
    for (int r = 0; r < 8; ++r) {
        const f32x4 a = bias + w[0] * xr[r] + w[1] * xr[r + 1] + w[2] * xr[r + 2] + w[3] * xr[r + 3];
        *(u32x2*)(XBCC + (size_t)(t0 + r) * 1536 + ch) = (u32x2){cvtpk(silu_f(a.x), silu_f(a.y)), cvtpk(silu_f(a.z), silu_f(a.w))};
    }
}
__device__ __forceinline__ void conv_unit4(const Ctx& c, int t0, int ch) {
    const bf16_t* PROJ = WSP(bf16_t, WS_PROJ); bf16_t* XBCC = WSP(bf16_t, WS_XBCC);
    const int pos0 = t0 & (SEQ - 1);
    f32x4 w[4];
#pragma unroll
    for (int j = 0; j < 4; ++j) w[j] = *(const f32x4*)(IN_CONVW + j * 1536 + ch);
    const f32x4 bias = *(const f32x4*)(IN_CONVB + ch);
    f32x4 xr[7];
#pragma unroll
    for (int i = 0; i < 7; ++i) {
        if (pos0 - 3 + i >= 0) { const u32x2 v = *(const u32x2*)(PROJ + (size_t)(t0 - 3 + i) * DINP + XBC_OFF + ch); xr[i] = (f32x4){bflo(v.x), bfhi(v.x), bflo(v.y), bfhi(v.y)}; }
        else xr[i] = (f32x4){0.f, 0.f, 0.f, 0.f};
    }
#pragma unroll
    for (int r = 0; r < 4; ++r) {
        const f32x4 a = bias + w[0] * xr[r] + w[1] * xr[r + 1] + w[2] * xr[r + 2] + w[3] * xr[r + 3];
        *(u32x2*)(XBCC + (size_t)(t0 + r) * 1536 + ch) = (u32x2){cvtpk(silu_f(a.x), silu_f(a.y)), cvtpk(silu_f(a.z), silu_f(a.w))};
    }
}
__device__ __forceinline__ void dta_item(const Ctx& c, int idx) {
    const float* DTRAW = WSP(float, WS_DTRAW); float* DT = WSP(float, WS_DT); float* ACUM = WSP(float, WS_ACUM);
    const int h = idx % NH, bc = idx / NH, t0 = bc * 128, l0 = 2 * c.lane;
    const float A = -expf(IN_ALOG[h]), bias = IN_DTBIAS[h];
    const float d0 = softplus_f(DTRAW[(size_t)(t0 + l0) * 16 + h] + bias), d1 = softplus_f(DTRAW[(size_t)(t0 + l0 + 1) * 16 + h] + bias);
    const float a0 = d0 * A, a1 = d1 * A; float x = a0 + a1;
#pragma unroll
    for (int o = 1; o < 64; o <<= 1) { const float v = __shfl_up(x, o); if (c.lane >= o) x += v; }
    const float ex = x - (a0 + a1);
    *(f32x2*)(DT + (size_t)idx * 128 + l0) = (f32x2){d0, d1};
    *(f32x2*)(ACUM + (size_t)idx * 128 + l0) = (f32x2){ex + a0, ex + a0 + a1};
}
__device__ __forceinline__ void step_conv_only(const Ctx& c) {
    const bf16_t* PROJ = WSP(bf16_t, WS_PROJ); bf16_t* XBCC = WSP(bf16_t, WS_XBCC);
    for (int idx = c.gt; idx < (T / 8) * 384; idx += c.ngt) {
        const int rb = idx / 384, ch = (idx % 384) * 4, t0 = rb * 8, pos0 = t0 & (SEQ - 1);
        f32x4 w[4];
#pragma unroll
        for (int j = 0; j < 4; ++j) w[j] = *(const f32x4*)(IN_CONVW + j * 1536 + ch);
        const f32x4 bias = *(const f32x4*)(IN_CONVB + ch);
        f32x4 xr[11];
#pragma unroll
        for (int i = 0; i < 11; ++i) {
            if (pos0 - 3 + i >= 0) { const u32x2 v = *(const u32x2*)(PROJ + (size_t)(t0 - 3 + i) * DINP + XBC_OFF + ch); xr[i] = (f32x4){bflo(v.x), bfhi(v.x), bflo(v.y), bfhi(v.y)}; }
            else xr[i] = (f32x4){0.f, 0.f, 0.f, 0.f};
        }
#pragma unroll
        for (int r = 0; r < 8; ++r) {
            const f32x4 a = bias + w[0] * xr[r] + w[1] * xr[r + 1] + w[2] * xr[r + 2] + w[3] * xr[r + 3];
            *(u32x2*)(XBCC + (size_t)(t0 + r) * 1536 + ch) = (u32x2){cvtpk(silu_f(a.x), silu_f(a.y)), cvtpk(silu_f(a.z), silu_f(a.w))};
        }
    }
}

__device__ __forceinline__ void step_conv_local(const Ctx& c) {
    for (int item = blockIdx.x; item < NB * NCH * 2; item += gridDim.x) {
        const int bc = item >> 1, g = item & 1, t0 = bc * 128;
#pragma unroll 1
        for (int u = c.tid; u < 16 * 192; u += NTHR) {
            const int rbk = u / 192, q = u % 192;
            const int ch = q < 128 ? 512 * g + 4 * q : (q < 160 ? 1024 + 128 * g + 4 * (q - 128) : 1280 + 128 * g + 4 * (q - 160));
            conv_unit(c, t0 + rbk * 8, ch);
        }
    }
}
__device__ __forceinline__ void step_dta_local(const Ctx& c) {
    for (int item = blockIdx.x; item < NB * NCH * 2; item += gridDim.x) dta_item(c, (item >> 1) * NH + (item & 1) * 8 + c.wave);
}
__device__ __forceinline__ void step_ssd1_fast(const Ctx& c) {
    const bf16_t* XBCC = WSP(bf16_t, WS_XBCC); const float* DT = WSP(float, WS_DT); const float* ACUM = WSP(float, WS_ACUM); float* STATES = WSP(float, WS_STATES);
    LAS unsigned char* Bl = c.lds;
    LAS unsigned char* Xl = c.lds + 32768;
    LAS float* wl = (LAS float*)(c.lds + 65536);
    const int lane = c.lane, col = lane & 31, hh = lane >> 5, pt = c.wave >> 2, nt = c.wave & 3;
    for (int item = blockIdx.x; item < NB * NCH * 2; item += gridDim.x) {
        const int bc = item >> 1, g = item & 1, t0 = bc * 128;
        __syncthreads();
        for (int i = c.tid; i < 128 * 16; i += NTHR) { const int l = i >> 4, ch = i & 15;
            *(LAS u32x4*)(Bl + l * 256 + ch * 16) = *(const u32x4*)(XBCC + (size_t)(t0 + l) * 1536 + 1024 + g * 128 + ch * 8); }
        for (int i = c.tid; i < 8 * 128; i += NTHR) { const int r = i >> 7, l = i & 127; const size_t o = ((size_t)bc * 16 + g * 8 + r) * 128;
            wl[i] = expf(ACUM[o + 127] - ACUM[o + l]) * DT[o + l]; }
        __syncthreads();
#define SSD1_STAGE(r_) { _Pragma("unroll") for (int q_ = 0; q_ < 2; ++q_) { const int i_ = c.tid + q_ * NTHR, l_ = i_ >> 3, ch_ = i_ & 7; \
            const u32x4 v_ = *(const u32x4*)(XBCC + (size_t)(t0 + l_) * 1536 + (g * 8 + (r_)) * 64 + ch_ * 8); const float w_ = wl[(r_) * 128 + l_]; \
            u32x4 o_; o_.x = cvtpk(bflo(v_.x) * w_, bfhi(v_.x) * w_); o_.y = cvtpk(bflo(v_.y) * w_, bfhi(v_.y) * w_); o_.z = cvtpk(bflo(v_.z) * w_, bfhi(v_.z) * w_); o_.w = cvtpk(bflo(v_.w) * w_, bfhi(v_.w) * w_); \
            *(LAS u32x4*)(Xl + ((r_) & 1) * 16384 + l_ * 128 + ch_ * 16) = o_; } }
        SSD1_STAGE(0);
        __syncthreads();
        for (int r = 0; r < 8; ++r) {
            if (r + 1 < 8) SSD1_STAGE(r + 1);
            const LAS unsigned char* xb = Xl + (r & 1) * 16384 + (pt * 32 + col) * 2; const LAS unsigned char* bb = Bl + (nt * 32 + col) * 2;
            f32x16 acc = zero16();
#pragma unroll
            for (int ks = 0; ks < 8; ++ks) {
                bf16x8v af, bf;
#pragma unroll
                for (int j = 0; j < 8; ++j) { const int l = 16 * ks + 8 * hh + j; af[j] = *(const LAS short*)(xb + l * 128); bf[j] = *(const LAS short*)(bb + l * 256); }
                acc = MFMA32(af, bf, acc);
            }
            float* o = STATES + (((size_t)bc * 16 + g * 8 + r) * 64 + pt * 32) * 128 + nt * 32 + col;
#pragma unroll
            for (int rr = 0; rr < 16; ++rr) o[(size_t)((rr & 3) + 8 * (rr >> 2) + 4 * hh) * 128] = acc[rr];
            __syncthreads();
        }
#undef SSD1_STAGE
    }
    __syncthreads();
}

#define TABH_SRC(r_) ((r_) < 16384 ? IN_U + (size_t)(r_) * D : IN_V + (size_t)((r_) - 16384) * D)
#define TABH_FINISH(rowv, r_) { if ((r_) < 16384) fp8_row_finish<SLICED_PEER != 0>(rowv, WSP(unsigned char, WS_UB), (r_), WSP(float, WS_SCU) + (r_), c.lane); \
        else fp8_row_finish<(SLICED_PEER != 0) && (V_INT8 != 0)>(rowv, WSP(unsigned char, WS_VB), (r_) - 16384, WSP(float, WS_SCV) + ((r_) - 16384), c.lane); }
#define TABH_TICK() { if (HIDE_TABLES) { if (tabr < 2 * 16384) { TABH_FINISH(tabv, tabr); } tabr += c.ngw; if (tabr < 2 * 16384) fp8_row_load(tabv, TABH_SRC(tabr), c.lane); } }
__device__ __forceinline__ void step_ssd2_fast(const Ctx& c) {
    const bf16_t* XBCC = WSP(bf16_t, WS_XBCC); const bf16_t* PROJ = WSP(bf16_t, WS_PROJ); const bf16_t* PREVB = WSP(bf16_t, WS_PREVB);
    const float* DT = WSP(float, WS_DT); const float* ACUM = WSP(float, WS_ACUM); bf16_t* YCAT = WSP(bf16_t, WS_ACT); float* SSP = WSP(float, WS_SSP);
    const int lane = c.lane, col = lane & 31, hh = lane >> 5;
    LAS unsigned char* Xw = c.lds + c.wave * 16384;
    LAS float* ac = (LAS float*)(c.lds + 131072 + c.wave * 1024); LAS float* dl = ac + 128;
    f32x4 tabv[8]; int tabr = c.gw;
    if (HIDE_TABLES && tabr < 2 * 16384) fp8_row_load(tabv, TABH_SRC(tabr), c.lane);
    for (int item = blockIdx.x; item < NB * NCH * 2; item += gridDim.x) {
        const int bc = item >> 1, g = item & 1, t0 = bc * 128, hd = g * 8 + c.wave; const size_t ih = (size_t)bc * 16 + hd;
        asm volatile("s_waitcnt lgkmcnt(0)" ::: "memory");
#pragma unroll 4
        for (int i = lane; i < 128 * 8; i += 64) { const int srow = i >> 3, ch = i & 7;
            *(LAS u32x4*)(Xw + srow * 128 + ch * 16) = *(const u32x4*)(XBCC + (size_t)(t0 + srow) * 1536 + hd * 64 + ch * 8); }
        ac[lane] = ACUM[ih * 128 + lane]; ac[lane + 64] = ACUM[ih * 128 + 64 + lane]; dl[lane] = DT[ih * 128 + lane]; dl[lane + 64] = DT[ih * 128 + 64 + lane];
        asm volatile("s_waitcnt vmcnt(0) lgkmcnt(0)" ::: "memory");
        const float dsk = IN_DSKIP[hd];
#pragma unroll 1
        for (int lt = 0; lt < 4; ++lt) {
            const int l = lt * 32 + col, t = t0 + l;
            bf16x8v cf[8], pf0[8], pf1[8];
            const bf16_t* cp = XBCC + (size_t)t * 1536 + 1280 + g * 128 + hh * 8;
            const bf16_t* pp0 = PREVB + (ih * 64 + col) * 128 + hh * 8; const bf16_t* pp1 = pp0 + 32 * 128;
#pragma unroll
            for (int ks = 0; ks < 8; ++ks) { cf[ks] = ld_frag16(cp + ks * 16); pf0[ks] = ld_frag16(pp0 + ks * 16); pf1[ks] = ld_frag16(pp1 + ks * 16); }
            TABH_TICK();
            f32x16 acc[2]; acc[0] = zero16(); acc[1] = zero16();
#pragma unroll
            for (int ks = 0; ks < 8; ++ks) { acc[0] = MFMA32(pf0[ks], cf[ks], acc[0]); acc[1] = MFMA32(pf1[ks], cf[ks], acc[1]); }
            const float al = ac[l], el = expf(al);
#pragma unroll
            for (int p2 = 0; p2 < 2; ++p2)
#pragma unroll
                for (int r = 0; r < 16; ++r) acc[p2][r] *= el;
#pragma unroll 1
            for (int st = 0; st <= lt; ++st) {
                bf16x8v bfr[8];
                const bf16_t* bp = XBCC + (size_t)(t0 + st * 32 + col) * 1536 + 1024 + g * 128 + hh * 8;
#pragma unroll
                for (int ks = 0; ks < 8; ++ks) bfr[ks] = ld_frag16(bp + ks * 16);
                if (st == 0 || st == lt || (lt == 3 && st == 1)) { TABH_TICK(); }
                f32x16 gt = zero16();
#pragma unroll
                for (int ks = 0; ks < 8; ++ks) gt = MFMA32(bfr[ks], cf[ks], gt);
#pragma unroll
                for (int g4 = 0; g4 < 4; ++g4) {
                    const int sl0 = 8 * g4 + 4 * hh;
                    const f32x4 as = *(const LAS f32x4*)(ac + st * 32 + sl0), ds = *(const LAS f32x4*)(dl + st * 32 + sl0);
#pragma unroll
                    for (int e = 0; e < 4; ++e) {
                        const bool ok = (st < lt) || (sl0 + e <= col);
                        gt[4 * g4 + e] = ok ? gt[4 * g4 + e] * expf(al - as[e]) * ds[e] : 0.f;
                    }
                }
                const bf16x8v w0 = acc_frag(gt, 0), w1 = acc_frag(gt, 1);
#pragma unroll
                for (int p2 = 0; p2 < 2; ++p2) {
                    const LAS unsigned char* xb = Xw + (p2 * 32 + col) * 2 + (st * 32 + 4 * hh) * 128;
                    bf16x8v x0, x1;
#pragma unroll
                    for (int j = 0; j < 8; ++j) { const int srow = 8 * (j >> 2) + (j & 3); x0[j] = *(const LAS short*)(xb + srow * 128); x1[j] = *(const LAS short*)(xb + (16 + srow) * 128); }
                    acc[p2] = MFMA32(x0, w0, acc[p2]); acc[p2] = MFMA32(x1, w1, acc[p2]);
                }
            }
            u32x2 zw[2][4];
#pragma unroll
            for (int p2 = 0; p2 < 2; ++p2)
#pragma unroll
                for (int g4 = 0; g4 < 4; ++g4) zw[p2][g4] = *(const u32x2*)(PROJ + (size_t)t * DINP + Z_OFF + hd * 64 + p2 * 32 + 8 * g4 + 4 * hh);
            TABH_TICK();
            float ss = 0.f;
#pragma unroll
            for (int p2 = 0; p2 < 2; ++p2)
#pragma unroll
                for (int g4 = 0; g4 < 4; ++g4) {
                    const int p0 = p2 * 32 + 8 * g4 + 4 * hh;
                    const u32x2 xw = *(const LAS u32x2*)(Xw + l * 128 + p0 * 2), z2 = zw[p2][g4];
                    const float y0 = (acc[p2][4 * g4 + 0] + dsk * bflo(xw.x)) * silu_f(bflo(z2.x)), y1 = (acc[p2][4 * g4 + 1] + dsk * bfhi(xw.x)) * silu_f(bfhi(z2.x));
                    const float y2 = (acc[p2][4 * g4 + 2] + dsk * bflo(xw.y)) * silu_f(bflo(z2.y)), y3 = (acc[p2][4 * g4 + 3] + dsk * bfhi(xw.y)) * silu_f(bfhi(z2.y));
                    ss += (y0 * y0 + y1 * y1) + (y2 * y2 + y3 * y3);
                    *(u32x2*)(YCAT + (size_t)t * D + hd * 64 + p0) = (u32x2){cvtpk(y0, y1), cvtpk(y2, y3)};
                }
            ss += __shfl_xor(ss, 32);
            if (hh == 0) SSP[(size_t)t * 32 + hd] = ss;
        }
    }
    if (HIDE_TABLES) { while (tabr < 2 * 16384) { TABH_TICK(); } }
    __syncthreads();
}

__device__ __forceinline__ void step_att_fast(const Ctx& c) {
    const bf16_t* PROJ = WSP(bf16_t, WS_PROJ); bf16_t* YCAT = WSP(bf16_t, WS_ACT); float* SSP = WSP(float, WS_SSP);
    const int lane = c.lane, col = lane & 31, hh = lane >> 5;
    LAS unsigned char* Kl = c.lds;
    LAS unsigned char* Vt = c.lds + 256 * 144;
    const float NEG = -__builtin_huge_valf();
    for (int item = blockIdx.x; item < NB * NCH * 2; item += gridDim.x) {
        const int kvh = item & 1, nblk = (item >> 1) & 31, b = item >> 6, tq0 = b * SEQ + nblk * 128, tk0 = tq0 - 128;
        __syncthreads();
        for (int i = c.tid; i < 256 * 8; i += NTHR) {
            const int kj = i >> 3, ch = i & 7;
            if (nblk > 0 || kj >= 128) {
                const bf16_t* src = PROJ + (size_t)(tk0 + kj) * DINP + kvh * 64 + ch * 8;
                *(LAS u32x4*)(Kl + kj * 144 + ch * 16) = *(const u32x4*)(src + K_OFF);
                const u32x4 v = *(const u32x4*)(src + V_OFF);
                LAS unsigned char* vp = Vt + (ch * 8) * 520 + kj * 2;
                *(LAS unsigned short*)(vp + 0 * 520) = (unsigned short)(v.x & 0xffff); *(LAS unsigned short*)(vp + 1 * 520) = (unsigned short)(v.x >> 16);
                *(LAS unsigned short*)(vp + 2 * 520) = (unsigned short)(v.y & 0xffff); *(LAS unsigned short*)(vp + 3 * 520) = (unsigned short)(v.y >> 16);
                *(LAS unsigned short*)(vp + 4 * 520) = (unsigned short)(v.z & 0xffff); *(LAS unsigned short*)(vp + 5 * 520) = (unsigned short)(v.z >> 16);
                *(LAS unsigned short*)(vp + 6 * 520) = (unsigned short)(v.w & 0xffff); *(LAS unsigned short*)(vp + 7 * 520) = (unsigned short)(v.w >> 16);
            }
        }
        __syncthreads();
        const int hd = kvh * 8 + c.wave; const float sink = IN_SINKS[hd];
        for (int qt = 0; qt < 4; ++qt) {
            const int tq = tq0 + qt * 32 + col;
            bf16x8v qf[4];
#pragma unroll
            for (int ks = 0; ks < 4; ++ks) qf[ks] = ld_frag16(PROJ + (size_t)tq * DINP + Q_OFF + hd * 64 + ks * 16 + hh * 8);
            f32x16 S[5]; float m = sink;
#pragma unroll
            for (int jj = 0; jj < 5; ++jj) {
                const int j = qt + jj;
                if (nblk == 0 && j < 4) {
#pragma unroll
                    for (int r = 0; r < 16; ++r) S[jj][r] = NEG;
                } else {
                    f32x16 a = zero16();
#pragma unroll
                    for (int ks = 0; ks < 4; ++ks) a = MFMA32(lds_frag16(Kl + (j * 32 + col) * 144 + ks * 32 + hh * 16), qf[ks], a);
#pragma unroll
                    for (int r = 0; r < 16; ++r) {
                        const int kl = (r & 3) + 8 * (r >> 2) + 4 * hh;
                        float sv = a[r] * 0.125f;
                        if (jj == 0) sv = (kl > col) ? sv : NEG;
                        if (jj == 4) sv = (kl <= col) ? sv : NEG;
                        S[jj][r] = sv; m = fmaxf(m, sv);
                    }
                }
            }
            m = fmaxf(m, __shfl_xor(m, 32));
            float lsum = 0.f;
#pragma unroll
            for (int jj = 0; jj < 5; ++jj)
#pragma unroll
                for (int r = 0; r < 16; ++r) { const float p = expf(S[jj][r] - m); S[jj][r] = p; lsum += p; }
            lsum += __shfl_xor(lsum, 32); lsum += expf(sink - m);
            f32x16 O[2]; O[0] = zero16(); O[1] = zero16();
#pragma unroll
            for (int jj = 0; jj < 5; ++jj) {
                const int j = qt + jj;
                if (!(nblk == 0 && j < 4)) {
#pragma unroll
                    for (int ks2 = 0; ks2 < 2; ++ks2) {
                        const bf16x8v pf = acc_frag(S[jj], ks2);
#pragma unroll
                        for (int d2 = 0; d2 < 2; ++d2) {
                            const LAS unsigned char* vp = Vt + (d2 * 32 + col) * 520 + (j * 32 + 16 * ks2 + 4 * hh) * 2;
                            const u32x2 v0 = *(const LAS u32x2*)vp, v1 = *(const LAS u32x2*)(vp + 16);
                            O[d2] = MFMA32(__builtin_bit_cast(bf16x8v, ((u32x4){v0.x, v0.y, v1.x, v1.y})), pf, O[d2]);
                        }
                    }
                }
            }
            const float inv = 1.f / lsum; float ss = 0.f;
#pragma unroll
            for (int d2 = 0; d2 < 2; ++d2)
#pragma unroll
                for (int g4 = 0; g4 < 4; ++g4) {
                    const float o0 = O[d2][4 * g4] * inv, o1 = O[d2][4 * g4 + 1] * inv, o2 = O[d2][4 * g4 + 2] * inv, o3 = O[d2][4 * g4 + 3] * inv;
                    ss += (o0 * o0 + o1 * o1) + (o2 * o2 + o3 * o3);
                    *(u32x2*)(YCAT + (size_t)tq * D + 1024 + hd * 64 + d2 * 32 + 8 * g4 + 4 * hh) = (u32x2){cvtpk(o0, o1), cvtpk(o2, o3)};
                }
            ss += __shfl_xor(ss, 32);
            if (hh == 0) SSP[(size_t)tq * 32 + 16 + hd] = ss;
        }
    }
    __syncthreads();
}

__device__ __forceinline__ void step_rs(const Ctx& c) {
    const float* SSP = WSP(float, WS_SSP); float* RS = WSP(float, WS_RS);
    for (int t = c.gt; t < T; t += c.ngt) {
        float s1 = 0.f, s2 = 0.f;
#pragma unroll
        for (int j = 0; j < 4; ++j) { const f32x4 a = *(const f32x4*)(SSP + (size_t)t * 32 + 4 * j), b = *(const f32x4*)(SSP + (size_t)t * 32 + 16 + 4 * j);
            s1 += (a.x + a.y) + (a.z + a.w); s2 += (b.x + b.y) + (b.z + b.w); }
        const float r1 = rsqrtf(s1 * (1.f / 1024.f) + EPS), r2 = rsqrtf(s2 * (1.f / 1024.f) + EPS);
        RS[2 * t] = r1 / r2; RS[2 * t + 1] = r2;
    }
}

__device__ __forceinline__ void step_ln1(const Ctx& c) {
    const float* MOD = WSP(float, WS_MOD); bf16_t* H2 = WSP(bf16_t, WS_ACT); const bf16_t* GB = WSP(bf16_t, WS_R1B); bf16_t* X1B = WSP(bf16_t, WS_X1B); unsigned char* H2Q = WSP(unsigned char, WS_H2Q); float* HS = WSP(float, WS_HS);
    f32x4 xc[8], xn[8]; u32x2 gc[8], gn[8];
    int t = c.gw;
#define LN1_LOAD(xa, ga, tok) { _Pragma("unroll") for (int j_ = 0; j_ < 8; ++j_) { xa[j_] = *(const f32x4*)(IN_X + (size_t)(tok) * D + j_ * 256 + c.lane * 4); ga[j_] = *(const u32x2*)(GB + (size_t)(tok) * D + j_ * 256 + c.lane * 4); } }
    if (t < T) LN1_LOAD(xc, gc, t);
    for (; t < T; t += c.ngw) {
        const int tn = t + c.ngw;
        if (tn < T) LN1_LOAD(xn, gn, tn);
        const int b = t >> 12;
        f32x4 v[8]; float s = 0.f;
#pragma unroll
        for (int j = 0; j < 8; ++j) { v[j] = xc[j] * ALPHA + (f32x4){bflo(gc[j].x), bfhi(gc[j].x), bflo(gc[j].y), bfhi(gc[j].y)}; s += (v[j].x + v[j].y) + (v[j].z + v[j].w); }
        const float mean = wave_sum_all(s) * (1.f / D); float s2 = 0.f;
#pragma unroll
        for (int j = 0; j < 8; ++j) { v[j] = v[j] - mean; s2 += (v[j].x * v[j].x + v[j].y * v[j].y) + (v[j].z * v[j].z + v[j].w * v[j].w); }
        const float rstd = rsqrtf(wave_sum_all(s2) * (1.f / D) + EPS);
        const float* sh = MOD + b * NMOD + 3 * D; const float* sc = MOD + b * NMOD + 4 * D; float hmax = 0.f;
#pragma unroll
        for (int j = 0; j < 8; ++j) {
            const int col = j * 256 + c.lane * 4;
            const f32x4 g = *(const f32x4*)(IN_LN1G + col), bb = *(const f32x4*)(IN_LN1B + col), s_ = *(const f32x4*)(sc + col), h_ = *(const f32x4*)(sh + col);
            const f32x4 x1 = v[j] * rstd * g + bb;
            *(u32x2*)(X1B + (size_t)t * D + col) = (u32x2){cvtpk(x1.x, x1.y), cvtpk(x1.z, x1.w)};
            const f32x4 h2v = x1 * (s_ + 1.f) + h_;
            if (!(I8_GEMM3 && FAST_GEMM)) *(u32x2*)(H2 + (size_t)t * D + col) = (u32x2){cvtpk(h2v.x, h2v.y), cvtpk(h2v.z, h2v.w)};
            v[j] = h2v; hmax = fmaxf(hmax, fmaxf(fmaxf(fabsf(h2v.x), fabsf(h2v.y)), fmaxf(fabsf(h2v.z), fabsf(h2v.w))));
        }
        {
            hmax = DPPMAX(hmax, 0xB1); hmax = DPPMAX(hmax, 0x4E); hmax = DPPMAX(hmax, 0x141); hmax = DPPMAX(hmax, 0x140);
            const unsigned a0 = __builtin_amdgcn_readlane(__float_as_uint(hmax), 0), a1 = __builtin_amdgcn_readlane(__float_as_uint(hmax), 16);
            const unsigned a2 = __builtin_amdgcn_readlane(__float_as_uint(hmax), 32), a3 = __builtin_amdgcn_readlane(__float_as_uint(hmax), 48);
            const unsigned m01 = a0 > a1 ? a0 : a1, m23 = a2 > a3 ? a2 : a3; const float am = __uint_as_float(m01 > m23 ? m01 : m23);
            const float inv = am > 0.f ? 127.f / am : 0.f;
#pragma unroll
            for (int j = 0; j < 8; ++j) *(unsigned*)(H2Q + (size_t)t * D + j * 256 + c.lane * 4) = pack_i8x4(v[j] * inv);
            if (c.lane == 0) HS[t] = am * (1.f / 127.f);
        }
#pragma unroll
        for (int j = 0; j < 8; ++j) { xc[j] = xn[j]; gc[j] = gn[j]; }
    }
#undef LN1_LOAD
}

__device__ __forceinline__ void argmax_bfly(float& bv, int& bi) {
#pragma unroll
    for (int off = 32; off >= 1; off >>= 1) {
        const float ov = __shfl_xor(bv, off); const int oi = __shfl_xor(bi, off);
        if (ov > bv || (ov == bv && oi < bi)) { bv = ov; bi = oi; }
    }
}
__device__ __forceinline__ void step_topk_simple(const Ctx& c) {
    const bf16_t* Q = WSP(bf16_t, WS_PROJ); const bf16_t* KEYS = WSP(bf16_t, WS_KEYS); int* EXPERT = WSP(int, WS_EXP); float* GATE = WSP(float, WS_GATE);
    const int lane = c.lane; const float NEG = -__builtin_huge_valf();
    for (int item = c.gw; item < T * 8; item += c.ngw) {
        const int t = item >> 3, h = item & 7;
        const bf16_t* qrow = Q + (size_t)t * D + h * 256;
        float tv[2] = {0.f, 0.f}; int ti[2] = {0, 0};
#pragma unroll
        for (int cc = 0; cc < 2; ++cc) {
            float v0 = 0.f, v1 = 0.f;
            const bf16_t* k0 = KEYS + ((size_t)(h * 2 + cc) * 128 + lane) * 128; const bf16_t* k1 = k0 + 64 * 128;
            for (int d = 0; d < 128; d += 8) { const u32x4 qv = *(const u32x4*)(qrow + cc * 128 + d); v0 += dot8(qv, *(const u32x4*)(k0 + d)); v1 += dot8(qv, *(const u32x4*)(k1 + d)); }
            for (int r = 0; r < 16; ++r) {
                float bv = v0; int bi = lane; if (v1 > bv) { bv = v1; bi = lane + 64; }
                argmax_bfly(bv, bi);
                if (lane == r) { tv[cc] = bv; ti[cc] = bi; }
                if (bi == lane) v0 = NEG; if (bi == lane + 64) v1 = NEG;
            }
        }
        float cv[4]; const int ci0 = lane * 4;
#pragma unroll
        for (int q = 0; q < 4; ++q) { const int ci = ci0 + q; cv[q] = __shfl(tv[0], ci >> 4) + __shfl(tv[1], ci & 15); }
        float bestv = 0.f; int bestp = 0;
        for (int r = 0; r < 16; ++r) {
            float bv = cv[0]; int bi = ci0;
#pragma unroll
            for (int q = 1; q < 4; ++q) if (cv[q] > bv) { bv = cv[q]; bi = ci0 + q; }
            argmax_bfly(bv, bi);
            if (lane == r) { bestv = bv; bestp = bi; }
#pragma unroll
            for (int q = 0; q < 4; ++q) if (bi == ci0 + q) cv[q] = NEG;
        }
        const float mx = __shfl(bestv, 0);
        const float e = lane < 16 ? expf(bestv - mx) : 0.f; const float ssum = wave_sum(e);
        const int e0 = __shfl(ti[0], bestp >> 4), e1 = __shfl(ti[1], bestp & 15);
        if (lane < 16) { EXPERT[(size_t)item * 16 + lane] = e0 * 128 + e1; GATE[(size_t)item * 16 + lane] = e / ssum; }
    }
}

#define TK_CE(a, b) { const int t_ = max(a, b); b = min(a, b); a = t_; }
__device__ __forceinline__ int tk_mono(float x) { int b = __float_as_int(x); return b ^ ((b >> 31) & 0x7fffffff); }
__device__ __forceinline__ float tk_val(int key, int mask) { int b = key & ~mask; b ^= (b >> 31) & 0x7fffffff; return __int_as_float(b); }
__device__ __forceinline__ void tk_sort16(int (&k)[16]) {
#pragma unroll
    for (int size = 2; size <= 16; size <<= 1)
#pragma unroll
        for (int stride = size >> 1; stride > 0; stride >>= 1)
#pragma unroll
            for (int i = 0; i < 16; ++i) { const int j = i ^ stride; if (j > i) { if ((i & size) == 0) TK_CE(k[i], k[j]) else TK_CE(k[j], k[i]) } }
}
__device__ __forceinline__ void tk_clean16(int (&k)[16]) {
#pragma unroll
    for (int stride = 8; stride > 0; stride >>= 1)
#pragma unroll
        for (int i = 0; i < 16; ++i) { const int j = i ^ stride; if (j > i) TK_CE(k[i], k[j]) }
}
__device__ __forceinline__ void tk_merge16(int (&a)[16], const int (&b)[16]) {
#pragma unroll
    for (int i = 0; i < 16; ++i) a[i] = max(a[i], b[15 - i]);
    tk_clean16(a);
}
__device__ __forceinline__ void topk_groups(const Ctx& c, const int h, const int grp_first, const int grp_end, const int grp_step) {
    const bf16_t* Q = WSP(bf16_t, WS_PROJ); const bf16_t* KEYS = WSP(bf16_t, WS_KEYS); int* EXPERT = WSP(int, WS_EXP); float* GATE = WSP(float, WS_GATE);
    const int lane = c.lane, col = lane & 31, hh = lane >> 5;
    constexpr int KP = 272;
    LAS unsigned char* kl = c.lds;
    LAS int* tab = (LAS int*)(c.lds + 256 * KP) + c.wave * (32 * 33);
    __syncthreads();
    for (int i = c.tid; i < 256 * 16; i += NTHR) { const int r = i >> 4, ch = i & 15;
        *(LAS u32x4*)(kl + r * KP + ch * 16) = *(const u32x4*)(KEYS + ((size_t)h * 256 + r) * 128 + ch * 8); }
    __syncthreads();
    const int INTMIN = (int)0x80000000;
    for (int grp = grp_first; grp < grp_end; grp += grp_step) {
        const int t0 = grp * 32;
        int top[2][16];
#pragma unroll
        for (int cc = 0; cc < 2; ++cc) {
            bf16x8v qf[8];
            const bf16_t* qp = Q + (size_t)(t0 + col) * D + h * 256 + cc * 128 + hh * 8;
#pragma unroll
            for (int ks = 0; ks < 8; ++ks) qf[ks] = __builtin_bit_cast(bf16x8v, *(const u32x4*)(qp + ks * 16));
            int k[4][16];
#pragma unroll
            for (int nt = 0; nt < 4; ++nt) {
                f32x16 acc;
#pragma unroll
                for (int r = 0; r < 16; ++r) acc[r] = 0.f;
#pragma unroll
                for (int ks = 0; ks < 8; ++ks) {
                    const bf16x8v af = __builtin_bit_cast(bf16x8v, *(const LAS u32x4*)(kl + (cc * 128 + nt * 32 + col) * KP + ks * 32 + hh * 16));
                    acc = __builtin_amdgcn_mfma_f32_32x32x16_bf16(af, qf[ks], acc, 0, 0, 0);
                }
#pragma unroll
                for (int r = 0; r < 16; ++r) k[nt][r] = (tk_mono(acc[r]) & ~127) | (nt * 32 + (r & 3) + 8 * (r >> 2) + 4 * hh);
                tk_sort16(k[nt]);
            }
            tk_merge16(k[0], k[1]); tk_merge16(k[2], k[3]); tk_merge16(k[0], k[2]);
            int p[16];
#pragma unroll
            for (int i = 0; i < 16; ++i) p[i] = __shfl_xor(k[0][15 - i], 32);
#pragma unroll
            for (int i = 0; i < 16; ++i) k[0][i] = max(k[0][i], p[i]);
            tk_clean16(k[0]);
#pragma unroll
            for (int i = 0; i < 16; ++i) top[cc][i] = k[0][i];
        }
        if (hh == 0) {
#pragma unroll
            for (int i = 0; i < 16; ++i) { tab[col * 33 + i] = top[0][i] & 127; tab[col * 33 + 16 + i] = top[1][i] & 127; }
        }
        float va[16], vb[16];
#pragma unroll
        for (int i = 0; i < 16; ++i) { va[i] = tk_val(top[0][i], 127); vb[i] = tk_val(top[1][i], 127); }
#define TK_CAND(i, j) ((tk_mono(va[i] + vb[j]) & ~255) | ((i) * 16 + (j)))
        int m[16], l1[16], l3[16], l4[16];
#pragma unroll
        for (int j = 0; j < 16; ++j) m[j] = TK_CAND(0, j);
#pragma unroll
        for (int j = 0; j < 8; ++j) l1[j] = TK_CAND(1, j);
#pragma unroll
        for (int j = 8; j < 16; ++j) l1[j] = INTMIN;
        tk_merge16(m, l1);
        l3[0] = TK_CAND(2, 0); l3[1] = TK_CAND(2, 1); l3[2] = TK_CAND(2, 2); l3[3] = TK_CAND(2, 3); l3[4] = TK_CAND(2, 4);
        l3[5] = TK_CAND(3, 0); l3[6] = TK_CAND(3, 1); l3[7] = TK_CAND(3, 2); l3[8] = TK_CAND(3, 3);
        l3[9] = TK_CAND(4, 0); l3[10] = TK_CAND(4, 1); l3[11] = TK_CAND(4, 2);
        l3[12] = TK_CAND(5, 0); l3[13] = TK_CAND(5, 1); l3[14] = TK_CAND(6, 0); l3[15] = TK_CAND(6, 1);
        tk_sort16(l3); tk_merge16(m, l3);
        l4[0] = TK_CAND(7, 0); l4[1] = TK_CAND(7, 1);
#pragma unroll
        for (int i = 8; i < 16; ++i) l4[i - 6] = TK_CAND(i, 0);
#pragma unroll
        for (int i = 10; i < 16; ++i) l4[i] = INTMIN;
        tk_sort16(l4); tk_merge16(m, l4);
#undef TK_CAND
        float ev[16]; float ssum = 0.f; const float mx = tk_val(m[0], 255);
#pragma unroll
        for (int r = 0; r < 16; ++r) { ev[r] = expf(tk_val(m[r], 255) - mx); ssum += ev[r]; }
        const float inv = 1.f / ssum;
#if SLICED_PEER
        const size_t ob = (size_t)(t0 + col) * 128 + 2 * h;
        if (hh == 0) {
            int eo[16];
#pragma unroll
            for (int r = 0; r < 16; ++r) { const int code = m[r] & 255; eo[r] = tab[col * 33 + (code >> 4)] * 128 + tab[col * 33 + 16 + (code & 15)]; }
#pragma unroll
            for (int g = 0; g < 8; ++g) *(u32x2*)(EXPERT + ob + g * 16) = (u32x2){(unsigned)eo[g], (unsigned)eo[g + 8]};
        } else {
#pragma unroll
            for (int g = 0; g < 8; ++g) *(f32x2*)(GATE + ob + g * 16) = (f32x2){ev[g] * inv, ev[g + 8] * inv};
        }
#else
        const size_t ob = ((size_t)(t0 + col) * 8 + h) * 16;
        if (hh == 0) {
            int eo[16];
#pragma unroll
            for (int r = 0; r < 16; ++r) { const int code = m[r] & 255; eo[r] = tab[col * 33 + (code >> 4)] * 128 + tab[col * 33 + 16 + (code & 15)]; }
#pragma unroll
            for (int q = 0; q < 4; ++q) *(u32x4*)(EXPERT + ob + 4 * q) = (u32x4){(unsigned)eo[4 * q], (unsigned)eo[4 * q + 1], (unsigned)eo[4 * q + 2], (unsigned)eo[4 * q + 3]};
        } else {
#pragma unroll
            for (int q = 0; q < 4; ++q) *(f32x4*)(GATE + ob + 4 * q) = (f32x4){ev[4 * q] * inv, ev[4 * q + 1] * inv, ev[4 * q + 2] * inv, ev[4 * q + 3] * inv};
        }
#endif
    }
    __syncthreads();
}

__device__ __forceinline__ void step_topk_fast(const Ctx& c) {
    const int nper = (int)gridDim.x >> 3;
    topk_groups(c, (int)blockIdx.x & 7, (int)(blockIdx.x >> 3) + nper * c.wave, T / 32, nper * NWAVES);
}

#define PEER_LOAD(buf, TAB, kbase) { _Pragma("unroll") for (int u_ = 0; u_ < 4; ++u_) { const int k_ = (kbase) + u_; \
        const int e_ = __builtin_amdgcn_readlane(k_ < 64 ? er0 : er1, k_ & 63); const unsigned char* rp_ = (TAB) + (size_t)e_ * D + lane * 16; \
        buf[u_][0] = *(const u32x4*)rp_; buf[u_][1] = *(const u32x4*)(rp_ + 1024); } }
#define PEER_DOT(buf, kbase) { _Pragma("unroll") for (int u_ = 0; u_ < 4; ++u_) { f32x2 a2_ = {0.f, 0.f}; \
        _Pragma("unroll") for (int j_ = 0; j_ < 2; ++j_) _Pragma("unroll") for (int q_ = 0; q_ < 4; ++q_) { const int w_ = (int)buf[u_][j_][q_]; \
            a2_ += __builtin_amdgcn_cvt_pk_f32_fp8(w_, false) * hh[j_ * 8 + q_ * 2]; a2_ += __builtin_amdgcn_cvt_pk_f32_fp8(w_, true) * hh[j_ * 8 + q_ * 2 + 1]; } \
        const float tot_ = lane63(wave_sum63(a2_.x + a2_.y)); const int k_ = (kbase) + u_; \
        if (k_ < 64) ar0 = (lane == k_) ? tot_ : ar0; else ar1 = (lane == k_ - 64) ? tot_ : ar1; } }
#define PEER_AXPY(buf, kbase) { _Pragma("unroll") for (int u_ = 0; u_ < 4; ++u_) { const int k_ = (kbase) + u_; \
        const float w1_ = __int_as_float(__builtin_amdgcn_readlane(__float_as_int(k_ < 64 ? wr0 : wr1), k_ & 63)); const f32x2 ww_ = {w1_, w1_}; \
        _Pragma("unroll") for (int j_ = 0; j_ < 2; ++j_) _Pragma("unroll") for (int q_ = 0; q_ < 4; ++q_) { const int w_ = (int)buf[u_][j_][q_]; \
            yy[j_ * 8 + q_ * 2] += __builtin_amdgcn_cvt_pk_f32_fp8(w_, false) * ww_; yy[j_ * 8 + q_ * 2 + 1] += __builtin_amdgcn_cvt_pk_f32_fp8(w_, true) * ww_; } } }
__device__ __forceinline__ void step_peer(const Ctx& c) {
    const bf16_t* H2 = WSP(bf16_t, WS_ACT); const unsigned char* U8 = WSP(unsigned char, WS_UB); const unsigned char* V8 = WSP(unsigned char, WS_VB);
    const float* SCU = WSP(float, WS_SCU); const float* SCV = WSP(float, WS_SCV);
    const int* EXPERT = WSP(int, WS_EXP); const float* GATE = WSP(float, WS_GATE); const float* MOD = WSP(float, WS_MOD);
    const int lane = c.lane;
    for (int t = c.gw; t < T; t += c.ngw) {
        const int er0 = EXPERT[(size_t)t * 128 + lane], er1 = EXPERT[(size_t)t * 128 + 64 + lane];
        const float gr0 = GATE[(size_t)t * 128 + lane], gr1 = GATE[(size_t)t * 128 + 64 + lane];
        const float su0 = SCU[er0], su1 = SCU[er1], sv0 = SCV[er0], sv1 = SCV[er1];
        f32x2 hh[16];
#pragma unroll
        for (int j = 0; j < 2; ++j)
#pragma unroll
            for (int q = 0; q < 2; ++q) { const u32x4 v = *(const u32x4*)(H2 + (size_t)t * D + j * 1024 + lane * 16 + q * 8);
                hh[j * 8 + q * 4 + 0] = (f32x2){bflo(v.x), bfhi(v.x)}; hh[j * 8 + q * 4 + 1] = (f32x2){bflo(v.y), bfhi(v.y)};
                hh[j * 8 + q * 4 + 2] = (f32x2){bflo(v.z), bfhi(v.z)}; hh[j * 8 + q * 4 + 3] = (f32x2){bflo(v.w), bfhi(v.w)}; }
        float ar0 = 0.f, ar1 = 0.f;
        u32x4 A[4][2], B[4][2];
        PEER_LOAD(A, U8, 0);
        for (int kb = 0; kb < 128; kb += 8) {
            PEER_LOAD(B, U8, kb + 4);
            PEER_DOT(A, kb);
            if (kb + 8 < 128) PEER_LOAD(A, U8, kb + 8) else PEER_LOAD(A, V8, 0);
            PEER_DOT(B, kb + 4);
        }
        const float wr0 = gr0 * gelu_f(ar0 * su0) * sv0, wr1 = gr1 * gelu_f(ar1 * su1) * sv1;
        f32x2 yy[16];
#pragma unroll
        for (int i = 0; i < 16; ++i) yy[i] = (f32x2){0.f, 0.f};
        for (int kb = 0; kb < 128; kb += 8) {
            PEER_LOAD(B, V8, kb + 4);
            PEER_AXPY(A, kb);
            if (kb + 8 < 128) PEER_LOAD(A, V8, kb + 8);
            PEER_AXPY(B, kb + 4);
        }
        const int b = t >> 12; float* row = c.out + (size_t)t * D; const float* g2 = MOD + b * NMOD + 5 * D;
        float s = 0.f;
#pragma unroll
        for (int j = 0; j < 2; ++j)
#pragma unroll
            for (int q = 0; q < 4; ++q) {
                const int col = j * 1024 + lane * 16 + q * 4; const f32x4 xv = *(const f32x4*)(row + col), gv = *(const f32x4*)(g2 + col);
                f32x2& y0 = yy[j * 8 + q * 2]; f32x2& y1 = yy[j * 8 + q * 2 + 1];
                y0.x = ALPHA * xv.x + gv.x * y0.x; y0.y = ALPHA * xv.y + gv.y * y0.y; y1.x = ALPHA * xv.z + gv.z * y1.x; y1.y = ALPHA * xv.w + gv.w * y1.y;
                s += (y0.x + y0.y) + (y1.x + y1.y);
            }
        const float mean = wave_sum(s) * (1.f / D); float s2 = 0.f;
#pragma unroll
        for (int i = 0; i < 16; ++i) { yy[i] = yy[i] - mean; s2 += yy[i].x * yy[i].x + yy[i].y * yy[i].y; }
        const float rstd = rsqrtf(wave_sum(s2) * (1.f / D) + EPS);
#pragma unroll
        for (int j = 0; j < 2; ++j)
#pragma unroll
            for (int q = 0; q < 4; ++q) {
                const int col = j * 1024 + lane * 16 + q * 4; const f32x4 g = *(const f32x4*)(IN_LN2G + col), bb = *(const f32x4*)(IN_LN2B + col);
                const f32x2 y0 = yy[j * 8 + q * 2], y1 = yy[j * 8 + q * 2 + 1];
                *(f32x4*)(row + col) = (f32x4){y0.x * rstd * g.x + bb.x, y0.y * rstd * g.y + bb.y, y1.x * rstd * g.z + bb.z, y1.y * rstd * g.w + bb.w};
            }
    }
}

struct XcdPlace { int nloc, nx, xrank, rank; };
__device__ __forceinline__ float reduce8(float v) { v += DPPF(v, 0xB1); v += DPPF(v, 0x4E); v += DPPF(v, 0x141); return v; }
struct Sel8 { unsigned long long m1, m2, m4; };
__device__ __forceinline__ float cnd(float a, float b, unsigned long long m) { float r; asm("v_cndmask_b32 %0, %1, %2, %3" : "=v"(r) : "v"(a), "v"(b), "s"(m)); return r; }
__device__ __forceinline__ float sel8(const Sel8& S, float p0, float p1, float p2, float p3, float p4, float p5, float p6, float p7) {
    const float a0 = cnd(p0, p1, S.m1), a1 = cnd(p2, p3, S.m1), a2 = cnd(p4, p5, S.m1), a3 = cnd(p6, p7, S.m1);
    return cnd(cnd(a0, a1, S.m2), cnd(a2, a3, S.m2), S.m4);
}
#define PS_GATHER(buf, ids, tabp) { _Pragma("unroll") for (int q_ = 0; q_ < 4; ++q_) { \
        buf[4 * q_ + 0] = *(const u32x4*)((tabp) + (ids[q_].x * 128u + c16)); buf[4 * q_ + 1] = *(const u32x4*)((tabp) + (ids[q_].y * 128u + c16)); \
        buf[4 * q_ + 2] = *(const u32x4*)((tabp) + (ids[q_].z * 128u + c16)); buf[4 * q_ + 3] = *(const u32x4*)((tabp) + (ids[q_].w * 128u + c16)); } }
#define PS_IDS(ids, tok) { _Pragma("unroll") for (int q_ = 0; q_ < 4; ++q_) ids[q_] = *(const u32x4*)(EP + (size_t)(tok) * 128 + g * 16 + q_ * 4); }
__device__ __forceinline__ int cndi(int a, int b, unsigned long long m) { int r; asm("v_cndmask_b32 %0, %1, %2, %3" : "=v"(r) : "v"(a), "v"(b), "s"(m)); return r; }
__device__ __forceinline__ int sel8i(const Sel8& S, int p0, int p1, int p2, int p3, int p4, int p5, int p6, int p7) {
    const int a0 = cndi(p0, p1, S.m1), a1 = cndi(p2, p3, S.m1), a2 = cndi(p4, p5, S.m1), a3 = cndi(p6, p7, S.m1);
    return cndi(cndi(a0, a1, S.m2), cndi(a2, a3, S.m2), S.m4);
}
#define DPPI(v, ctrl) __builtin_amdgcn_update_dpp(0, (v), (ctrl), 0xF, 0xF, true)
__device__ __forceinline__ int reduce8i(int v) { v += DPPI(v, 0xB1); v += DPPI(v, 0x4E); v += DPPI(v, 0x141); return v; }
#define PU_PROCESS(buf, tok) { \
        const u32x4 hq_ = *(const u32x4*)(H2Q + (size_t)(tok) * D + slice * 128 + c16); \
        int p_[16]; \
        _Pragma("unroll") for (int i_ = 0; i_ < 16; ++i_) { int a_ = __builtin_amdgcn_sdot4((int)buf[i_].x, (int)hq_.x, 0, false); \
            a_ = __builtin_amdgcn_sdot4((int)buf[i_].y, (int)hq_.y, a_, false); a_ = __builtin_amdgcn_sdot4((int)buf[i_].z, (int)hq_.z, a_, false); a_ = __builtin_amdgcn_sdot4((int)buf[i_].w, (int)hq_.w, a_, false); \
            p_[i_] = reduce8i(a_); } \
        const int lo_ = sel8i(SL, p_[0], p_[1], p_[2], p_[3], p_[4], p_[5], p_[6], p_[7]), hi_ = sel8i(SL, p_[8], p_[9], p_[10], p_[11], p_[12], p_[13], p_[14], p_[15]); \
        if (PART16) {   \
            PARTA[((size_t)slice * T + (tok)) * 64 + lane] = (int)((((unsigned)(lo_ + 32) >> 6) & 0xffffu) | ((unsigned)((hi_ + 32) >> 6) << 16)); \
        } else { int* o_ = PARTA + ((size_t)slice * T + (tok)) * 128 + g * 16 + c8; o_[0] = lo_; o_[8] = hi_; } }
__device__ __forceinline__ void step_peer_u(const Ctx& c, const XcdPlace& P) {
    const unsigned char* H2Q = WSP(unsigned char, WS_H2Q); const unsigned char* U8 = WSP(unsigned char, WS_UB); const int* EP = WSP(int, WS_EXP); int* PARTA = WSP(int, WS_PARTA);
    const int lane = c.lane, g = lane >> 3, c8 = lane & 7, wid = P.rank * NWAVES + c.wave, nw = P.nloc * NWAVES;
    const Sel8 SL{__ballot((c8 & 1) != 0), __ballot((c8 & 2) != 0), __ballot((c8 & 4) != 0)};
    const unsigned c16 = (unsigned)c8 * 16u;
    for (int slice = P.xrank; slice < 16; slice += P.nx) {
        const unsigned char* ub = U8 + (size_t)slice * 16384 * 128;
        u32x4 idn[4]; u32x4 A[16], B[16];
        int t = wid;
        if (t < T) { PS_IDS(idn, t); PS_GATHER(A, idn, ub); }
        if (t + nw < T) { PS_IDS(idn, t + nw); PS_GATHER(B, idn, ub); }
        for (; t < T; t += 2 * nw) {
            if (t + 2 * nw < T) PS_IDS(idn, t + 2 * nw);
            PU_PROCESS(A, t);
            if (t + 2 * nw < T) { PS_GATHER(A, idn, ub); }
            if (t + nw < T) {
                if (t + 3 * nw < T) PS_IDS(idn, t + 3 * nw);
                PU_PROCESS(B, t + nw);
                if (t + 3 * nw < T) { PS_GATHER(B, idn, ub); }
            }
        }
    }
}
#if V_INT8
__device__ __forceinline__ void step_peer_w(const Ctx& c) {
    const int* PARTA = WSP(int, WS_PARTA); const int* EP = WSP(int, WS_EXP); const float* G = WSP(float, WS_GATE); unsigned* W8 = WSP(unsigned, WS_W8);
    const float* SCU = WSP(float, WS_SCU); const float* SCV = WSP(float, WS_SCV); const float* HS = WSP(float, WS_HS); float* WSC = WSP(float, WS_WS);
    const int g = c.lane >> 3, c8 = c.lane & 7, i0 = g * 16 + c8, i1 = i0 + 8;
    for (int t = c.gw; t < T; t += c.ngw) {
        int a0 = 0, a1 = 0;
#if PART16
#pragma unroll
        for (int sl = 0; sl < 16; ++sl) { const int p = PARTA[((size_t)sl * T + t) * 64 + c.lane]; a0 += (int)(short)(p & 0xffff); a1 += p >> 16; }
        const float descale = 64.f;
#else
#pragma unroll
        for (int sl = 0; sl < 16; ++sl) { a0 += PARTA[((size_t)sl * T + t) * 128 + i0]; a1 += PARTA[((size_t)sl * T + t) * 128 + i1]; }
        const float descale = 1.f;
#endif
        const size_t base = (size_t)t * 128;
        const int e0 = EP[base + i0], e1 = EP[base + i1]; const float g0 = G[base + i0], g1 = G[base + i1], hs = HS[t] * descale;
        const float w0 = g0 * gelu_f((float)a0 * (SCU[e0] * hs)) * SCV[e0], w1 = g1 * gelu_f((float)a1 * (SCU[e1] * hs)) * SCV[e1];
        float am = fmaxf(fabsf(w0), fabsf(w1));
        am = DPPMAX(am, 0xB1); am = DPPMAX(am, 0x4E); am = DPPMAX(am, 0x141); am = DPPMAX(am, 0x140);
        const unsigned m0 = __builtin_amdgcn_readlane(__float_as_uint(am), 0), m1 = __builtin_amdgcn_readlane(__float_as_uint(am), 16), m2 = __builtin_amdgcn_readlane(__float_as_uint(am), 32), m3 = __builtin_amdgcn_readlane(__float_as_uint(am), 48);
        const unsigned m01 = m0 > m1 ? m0 : m1, m23 = m2 > m3 ? m2 : m3; am = __uint_as_float(m01 > m23 ? m01 : m23);
        const float inv = am > 0.f ? 127.f / am : 0.f;
        const int q0 = (int)__builtin_rintf(w0 * inv) & 0xff, q1 = (int)__builtin_rintf(w1 * inv) & 0xff;
        const int pk = q0 | (q1 << 8);
        const int b0 = DPPI(pk, 0x00), b1 = DPPI(pk, 0x55), b2 = DPPI(pk, 0xAA), b3 = DPPI(pk, 0xFF);
        const unsigned dlo = (unsigned)(b0 & 0xff) | ((unsigned)(b1 & 0xff) << 8) | ((unsigned)(b2 & 0xff) << 16) | ((unsigned)(b3 & 0xff) << 24);
        const unsigned dhi = ((unsigned)(b0 >> 8) & 0xff) | (((unsigned)(b1 >> 8) & 0xff) << 8) | (((unsigned)(b2 >> 8) & 0xff) << 16) | (((unsigned)(b3 >> 8) & 0xff) << 24);
        if ((c.lane & 3) == 0) { W8[(size_t)t * 32 + g * 4 + (c8 >> 2)] = dlo; W8[(size_t)t * 32 + g * 4 + 2 + (c8 >> 2)] = dhi; }
        if (c.lane == 0) WSC[t] = am * (1.f / 127.f);
    }
}
#else
__device__ __forceinline__ void step_peer_w(const Ctx& c) {
    const int* PARTA = WSP(int, WS_PARTA); const int* EP = WSP(int, WS_EXP); float* GW = WSP(float, WS_GATE); const float* SCU = WSP(float, WS_SCU); const float* SCV = WSP(float, WS_SCV); const float* HS = WSP(float, WS_HS);
    for (int idx = c.gt; idx < T * 128; idx += c.ngt) {
        int a = 0;
#pragma unroll
        for (int sl = 0; sl < 16; ++sl) a += PARTA[(size_t)sl * T * 128 + idx];
        const int e = EP[idx];
        GW[idx] = GW[idx] * gelu_f((float)a * (SCU[e] * HS[idx >> 7])) * SCV[e];
    }
}
#endif
#if V_INT8
#define PV_PROCESS(buf, tok) { \
        const u32x4 wq_ = *(const u32x4*)(W8 + (size_t)(tok) * 32 + g * 4); const float wsc_ = WSC[tok]; \
        int acc_[16]; _Pragma("unroll") for (int q_ = 0; q_ < 16; ++q_) acc_[q_] = 0; \
        _Pragma("unroll") for (int j_ = 0; j_ < 4; ++j_) { const int w4_ = (int)wq_[j_]; \
            _Pragma("unroll") for (int q_ = 0; q_ < 4; ++q_) { \
                const unsigned a_ = buf[4 * j_][q_], b_ = buf[4 * j_ + 1][q_], c_ = buf[4 * j_ + 2][q_], d_ = buf[4 * j_ + 3][q_]; \
                const unsigned tl_ = __builtin_amdgcn_perm(b_, a_, 0x05010400u), th_ = __builtin_amdgcn_perm(b_, a_, 0x07030602u); \
                const unsigned ul_ = __builtin_amdgcn_perm(d_, c_, 0x05010400u), uh_ = __builtin_amdgcn_perm(d_, c_, 0x07030602u); \
                acc_[4 * q_ + 0] = __builtin_amdgcn_sdot4((int)__builtin_amdgcn_perm(ul_, tl_, 0x05040100u), w4_, acc_[4 * q_ + 0], false); \
                acc_[4 * q_ + 1] = __builtin_amdgcn_sdot4((int)__builtin_amdgcn_perm(ul_, tl_, 0x07060302u), w4_, acc_[4 * q_ + 1], false); \
                acc_[4 * q_ + 2] = __builtin_amdgcn_sdot4((int)__builtin_amdgcn_perm(uh_, th_, 0x05040100u), w4_, acc_[4 * q_ + 2], false); \
                acc_[4 * q_ + 3] = __builtin_amdgcn_sdot4((int)__builtin_amdgcn_perm(uh_, th_, 0x07060302u), w4_, acc_[4 * q_ + 3], false); } } \
        int p_[16]; \
        _Pragma("unroll") for (int q_ = 0; q_ < 16; ++q_) p_[q_] = acc_[q_] + DPPI(acc_[q_], 0x128); \
        int q8_[8]; \
        _Pragma("unroll") for (int k_ = 0; k_ < 8; ++k_) { const auto r_ = __builtin_amdgcn_permlane16_swap((unsigned)p_[k_], (unsigned)p_[k_ + 8], false, false); q8_[k_] = (int)r_[0] + (int)r_[1]; } \
        int r4_[4]; \
        _Pragma("unroll") for (int k_ = 0; k_ < 4; ++k_) { const auto r_ = __builtin_amdgcn_permlane32_swap((unsigned)q8_[k_], (unsigned)q8_[k_ + 4], false, false); r4_[k_] = (int)r_[0] + (int)r_[1]; } \
        if ((lane & 8) == 0) *(u32x2*)(Y + (size_t)(tok) * D + slice * 128 + ocol) = (u32x2){cvtpk((float)r4_[0] * wsc_, (float)r4_[1] * wsc_), cvtpk((float)r4_[2] * wsc_, (float)r4_[3] * wsc_)}; }
#else
#define PV_PROCESS(buf, tok) { \
        f32x4 wv_[4]; _Pragma("unroll") for (int q_ = 0; q_ < 4; ++q_) wv_[q_] = *(const f32x4*)(GW + (size_t)(tok) * 128 + g * 16 + q_ * 4); \
        f32x2 acc_[8]; _Pragma("unroll") for (int q_ = 0; q_ < 8; ++q_) acc_[q_] = (f32x2){0.f, 0.f}; \
        _Pragma("unroll") for (int i_ = 0; i_ < 16; ++i_) { const float w1_ = wv_[i_ >> 2][i_ & 3]; const f32x2 ww_ = {w1_, w1_}; \
            _Pragma("unroll") for (int q_ = 0; q_ < 4; ++q_) { const int w_ = (int)buf[i_][q_]; acc_[2 * q_] += __builtin_amdgcn_cvt_pk_f32_fp8(w_, false) * ww_; acc_[2 * q_ + 1] += __builtin_amdgcn_cvt_pk_f32_fp8(w_, true) * ww_; } } \
        float p_[16]; \
        _Pragma("unroll") for (int q_ = 0; q_ < 8; ++q_) { p_[2 * q_] = acc_[q_].x + DPPF(acc_[q_].x, 0x128); p_[2 * q_ + 1] = acc_[q_].y + DPPF(acc_[q_].y, 0x128); } \
        float q8_[8]; \
        _Pragma("unroll") for (int k_ = 0; k_ < 8; ++k_) { const auto r_ = __builtin_amdgcn_permlane16_swap(__float_as_uint(p_[k_]), __float_as_uint(p_[k_ + 8]), false, false); q8_[k_] = __uint_as_float(r_[0]) + __uint_as_float(r_[1]); } \
        float r4_[4]; \
        _Pragma("unroll") for (int k_ = 0; k_ < 4; ++k_) { const auto r_ = __builtin_amdgcn_permlane32_swap(__float_as_uint(q8_[k_]), __float_as_uint(q8_[k_ + 4]), false, false); r4_[k_] = __uint_as_float(r_[0]) + __uint_as_float(r_[1]); } \
        if ((lane & 8) == 0) *(u32x2*)(Y + (size_t)(tok) * D + slice * 128 + ocol) = (u32x2){cvtpk(r4_[0], r4_[1]), cvtpk(r4_[2], r4_[3])}; }
#endif
__device__ __forceinline__ void step_peer_v(const Ctx& c, const XcdPlace& P) {
    const unsigned char* V8 = WSP(unsigned char, WS_VB); const int* EP = WSP(int, WS_EXP); const float* GW = WSP(float, WS_GATE); bf16_t* Y = WSP(bf16_t, WS_Y);
    const unsigned* W8 = WSP(unsigned, WS_W8); const float* WSC = WSP(float, WS_WS); (void)GW; (void)W8; (void)WSC;
    const int lane = c.lane, g = lane >> 3, c8 = lane & 7, wid = P.rank * NWAVES + c.wave, nw = P.nloc * NWAVES;
    const int ocol = c8 * 16 + 8 * ((lane >> 4) & 1) + 4 * (lane >> 5);
    const unsigned c16 = (unsigned)c8 * 16u;
    for (int slice = P.xrank; slice < 16; slice += P.nx) {
        const unsigned char* vb = V8 + (size_t)slice * 16384 * 128;
        u32x4 idn[4]; u32x4 A[16], B[16];
        int t = wid;
        if (t < T) { PS_IDS(idn, t); PS_GATHER(A, idn, vb); }
        if (t + nw < T) { PS_IDS(idn, t + nw); PS_GATHER(B, idn, vb); }
        for (; t < T; t += 2 * nw) {
            if (t + 2 * nw < T) PS_IDS(idn, t + 2 * nw);
            PV_PROCESS(A, t);
            if (t + 2 * nw < T) { PS_GATHER(A, idn, vb); }
            if (t + nw < T) {
                if (t + 3 * nw < T) PS_IDS(idn, t + 3 * nw);
                PV_PROCESS(B, t + nw);
                if (t + 3 * nw < T) { PS_GATHER(B, idn, vb); }
            }
        }
    }
}
__device__ __forceinline__ void step_ln2(const Ctx& c) {
    const float* MOD = WSP(float, WS_MOD); const bf16_t* Y = WSP(bf16_t, WS_Y); const bf16_t* X1B = WSP(bf16_t, WS_X1B);
    u32x2 xc[8], xn[8], yc[8], yn[8];
    int t = c.gw;
#define LN2_LOAD(xa, ya, tok) { _Pragma("unroll") for (int j_ = 0; j_ < 8; ++j_) { xa[j_] = *(const u32x2*)(X1B + (size_t)(tok) * D + j_ * 256 + c.lane * 4); ya[j_] = *(const u32x2*)(Y + (size_t)(tok) * D + j_ * 256 + c.lane * 4); } }
    if (t < T) LN2_LOAD(xc, yc, t);
    for (; t < T; t += c.ngw) {
        const int tn = t + c.ngw;
        if (tn < T) LN2_LOAD(xn, yn, tn);
        const int b = t >> 12; float* row = c.out + (size_t)t * D; const float* g2 = MOD + b * NMOD + 5 * D;
        f32x4 v[8]; float s = 0.f;
#pragma unroll
        for (int j = 0; j < 8; ++j) { const int col = j * 256 + c.lane * 4; const f32x4 gv = *(const f32x4*)(g2 + col); const u32x2 xw = xc[j], yw = yc[j];
            v[j] = (f32x4){ALPHA * bflo(xw.x) + gv.x * bflo(yw.x), ALPHA * bfhi(xw.x) + gv.y * bfhi(yw.x), ALPHA * bflo(xw.y) + gv.z * bflo(yw.y), ALPHA * bfhi(xw.y) + gv.w * bfhi(yw.y)};
            s += (v[j].x + v[j].y) + (v[j].z + v[j].w); }
        const float mean = wave_sum_all(s) * (1.f / D); float s2 = 0.f;
#pragma unroll
        for (int j = 0; j < 8; ++j) { v[j] = v[j] - mean; s2 += (v[j].x * v[j].x + v[j].y * v[j].y) + (v[j].z * v[j].z + v[j].w * v[j].w); }
        const float rstd = rsqrtf(wave_sum_all(s2) * (1.f / D) + EPS);
#pragma unroll
        for (int j = 0; j < 8; ++j) { const int col = j * 256 + c.lane * 4; const f32x4 gg = *(const f32x4*)(IN_LN2G + col), bb = *(const f32x4*)(IN_LN2B + col);
            *(f32x4*)(row + col) = v[j] * rstd * gg + bb; }
#pragma unroll
        for (int j = 0; j < 8; ++j) { xc[j] = xn[j]; yc[j] = yn[j]; }
    }
#undef LN2_LOAD
}

__device__ __forceinline__ void step_requant(const Ctx& c) {
    const bf16_t* YCAT = WSP(bf16_t, WS_ACT); const float* SSP = WSP(float, WS_SSP); unsigned char* A8 = WSP(unsigned char, WS_A8); float* SA2 = WSP(float, WS_SA2);
    for (int t = c.gw; t < T; t += c.ngw) {
        float s1 = 0.f, s2 = 0.f;
#pragma unroll
        for (int j = 0; j < 4; ++j) { const f32x4 a = *(const f32x4*)(SSP + (size_t)t * 32 + 4 * j), b = *(const f32x4*)(SSP + (size_t)t * 32 + 16 + 4 * j); s1 += (a.x + a.y) + (a.z + a.w); s2 += (b.x + b.y) + (b.z + b.w); }
        const float r1 = rsqrtf(s1 * (1.f / 1024.f) + EPS), r2 = rsqrtf(s2 * (1.f / 1024.f) + EPS);
        f32x4 v[8]; float am = 0.f;
#pragma unroll
        for (int j = 0; j < 8; ++j) { const u32x2 w = *(const u32x2*)(YCAT + (size_t)t * D + j * 256 + c.lane * 4); const float r = j < 4 ? r1 : r2;
            v[j] = (f32x4){bflo(w.x), bfhi(w.x), bflo(w.y), bfhi(w.y)} * r; am = fmaxf(am, fmaxf(fmaxf(fabsf(v[j].x), fabsf(v[j].y)), fmaxf(fabsf(v[j].z), fabsf(v[j].w)))); }
        am = DPPMAX(am, 0xB1); am = DPPMAX(am, 0x4E); am = DPPMAX(am, 0x141); am = DPPMAX(am, 0x140);
        const unsigned a0 = __builtin_amdgcn_readlane(__float_as_uint(am), 0), a1 = __builtin_amdgcn_readlane(__float_as_uint(am), 16), a2 = __builtin_amdgcn_readlane(__float_as_uint(am), 32), a3 = __builtin_amdgcn_readlane(__float_as_uint(am), 48);
        const unsigned m01 = a0 > a1 ? a0 : a1, m23 = a2 > a3 ? a2 : a3; am = __uint_as_float(m01 > m23 ? m01 : m23);
        const float inv = am > 0.f ? 127.f / am : 0.f;
#pragma unroll
        for (int j = 0; j < 8; ++j) *(unsigned*)(A8 + (size_t)t * D + j * 256 + c.lane * 4) = pack_i8x4(v[j] * inv);
        if (c.lane == 0) SA2[t] = am * (1.f / 127.f);
    }
}
__device__ __forceinline__ void step_wq8(const Ctx& c) {
    LAS float* scr = (LAS float*)(c.lds + c.wave * 16384);
    if (I8_GEMM3 && FAST_GEMM) { for (int it = c.gw; it < (D / 64) * (D / 32); it += c.ngw) transpose_item_i8<false>(IN_WQ, D, D, D, WSP(unsigned char, WS_WQ), WSP(unsigned, WS_CTL) + CW_AMXQ, WSP(float, WS_SWQ), scr, it, c.lane); }
    if (I8_GEMM2 && FAST_GEMM) { for (int it = c.gw; it < (D / 64) * (D / 32); it += c.ngw) transpose_item_i8<false, true>(IN_WOUT, D, D, D, WSP(unsigned char, WS_WOUT), WSP(unsigned, WS_CTL) + CW_AMXOUT, WSP(float, WS_SWOUT), scr, it, c.lane, IN_SSMG, IN_ATTG); }
    if (I8_GEMM1 && FAST_GEMM) { for (int it = c.gw; it < (D / 64) * (DINP / 32); it += c.ngw) transpose_item_i8<true>(IN_WIN, D, 3856, DINP, WSP(unsigned char, WS_WIN), WSP(unsigned, WS_CTL) + CW_AMXIN, WSP(float, WS_SWIN), scr, it, c.lane); }
}

constexpr int NSTEPS = 18;
__global__ void __launch_bounds__(NTHR, 2) fwd_kernel(Args a) {
    extern __shared__ __attribute__((aligned(16))) unsigned char lds_raw[];
    Ctx c;
#pragma unroll
    for (int i = 0; i < 22; ++i) c.in[i] = a.in[i];
    c.out = a.out; c.ws = a.ws; c.lds = (LAS unsigned char*)lds_raw;
    c.tid = threadIdx.x; c.lane = c.tid & 63; c.wave = __builtin_amdgcn_readfirstlane(c.tid >> 6);
    c.gw = blockIdx.x * NWAVES + c.wave; c.ngw = gridDim.x * NWAVES; c.gt = blockIdx.x * NTHR + c.tid; c.ngt = gridDim.x * NTHR;
    for (int u = c.tid; u < (LDS_BYTES - LDSCTL_OFF) / 4; u += NTHR) ((LAS unsigned*)(c.lds + LDSCTL_OFF))[u] = 0u;
    __syncthreads();
    const bool multi = (a.hi - a.lo) > 1;
    XcdBarrier bar; bar.bar = (unsigned*)(c.ws + WS_CTL); bar.x = 0; bar.st = (volatile LAS unsigned*)(c.lds + MISC_OFF);
    if (multi) bar = xcd_barrier_post((unsigned*)(c.ws + WS_CTL), (volatile LAS unsigned*)(c.lds + MISC_OFF));
#define STEP_IDS() { int tid_ = (int)threadIdx.x; asm volatile("" : "+v"(tid_)); c.tid = tid_; c.lane = tid_ & 63; c.gt = (int)blockIdx.x * NTHR + tid_; }
#define STEP(i, ...) if (a.lo <= (i) && (i) < a.hi) { STEP_IDS(); __VA_ARGS__; if ((REPEAT_MASK >> (i)) & 1) { xcd_barrier(bar); __VA_ARGS__; } if ((i) + 1 < a.hi) xcd_barrier(bar); }
    STEP(0, step_pro(c));
#if WQ_ONEPASS && I8_GEMM1 && I8_GEMM2 && I8_GEMM3 && FAST_GEMM
    STEP(1, step_h1(c));
#else
    STEP(1, { step_h1(c); step_wq8(c); });
#endif
#if FAST_GEMM
#define RUN_GEMM(EPI, MIDK, Aoff, Boff, N_, ...) { pg8::Gemm g{WSP(bf16_t, Aoff), WSP(bf16_t, Boff), T, N_, D}; pg8::StaticOrder S; S.init(T, N_, (int)gridDim.x, (int)blockIdx.x); \
        pg8::EpiA<EPI> E{EPI{__VA_ARGS__}}; pg8::gemm_phase<pg8::EpiA<EPI>, pg8::StaticOrder, false, true, MIDK>(c.lds, g, S, E); }
#else
#define RUN_GEMM(EPI, MIDK, Aoff, Boff, N_, ...) { EPI e{__VA_ARGS__}; gemm_simple<EPI, MIDK>(c, WSP(bf16_t, Aoff), WSP(bf16_t, Boff), T, N_, D, e); }
#endif
#if I8_GEMM1 && FAST_GEMM
    STEP(2, { pg8::Gemm g{WSP(bf16_t, WS_ACT), WSP(bf16_t, WS_WIN), T, DINP, D / 2}; pg8::StaticOrder S; S.init(T, DINP, (int)gridDim.x, (int)blockIdx.x);
        pg8::EpiA<Epi1Q, true> E{Epi1Q{WSP(bf16_t, WS_PROJ), WSP(float, WS_DTRAW), WSP(float, WS_SA1), WSP(float, WS_SWIN)}}; pg8::gemm_phase<pg8::EpiA<Epi1Q, true>, pg8::StaticOrder, false, true, false, true>(c.lds, g, S, E); });
#else
    STEP(2, RUN_GEMM(Epi1, false, WS_ACT, WS_WIN, DINP, WSP(bf16_t, WS_PROJ), WSP(float, WS_DTRAW)));
#endif
#if (FAST_MIX & 5) == 5
#if FUSE_SSD1 && (FAST_MIX & 2)
    STEP(3, { step_att_fast(c); step_conv_local(c); step_dta_local(c); asm volatile("s_waitcnt vmcnt(0)" ::: "memory"); __syncthreads(); step_ssd1_fast(c); });
#else
    STEP(3, { step_att_fast(c); step_conv_only(c); step_dta(c); });
#endif
#elif FAST_MIX & 1
    STEP(3, { step_conv_only(c); step_dta(c); });
#else
    STEP(3, step_conv(c));
#endif
#if FUSE_SSD1 && (FAST_MIX & 2) && ((FAST_MIX & 5) == 5)
#elif FAST_MIX & 2
    STEP(4, step_ssd1_fast(c));
#else
    STEP(4, step_ssd1_simple(c));
#endif
#if (FAST_MIX & 5) == 5
#elif FAST_MIX & 4
    STEP(5, step_att_fast(c));
#else
    STEP(5, step_att_simple(c));
#endif
    STEP(6, step_scan(c));
#if FAST_MIX & 8
    STEP(8, step_ssd2_fast(c));
#else
    STEP(7, step_cb_simple(c));
    STEP(8, step_ssd2_simple(c));
#endif
#if I8_GEMM2 && FAST_GEMM
    STEP(9, step_requant(c));
    STEP(10, { pg8::Gemm g{WSP(bf16_t, WS_A8), WSP(bf16_t, WS_WOUT), T, D, D / 2}; pg8::StaticOrder S; S.init(T, D, (int)gridDim.x, (int)blockIdx.x);
        pg8::EpiA<Epi2Q, true> E{Epi2Q{WSP(float, WS_MOD), WSP(float, WS_SA2), WSP(float, WS_SWOUT), WSP(bf16_t, WS_R1B)}}; pg8::gemm_phase<pg8::EpiA<Epi2Q, true>, pg8::StaticOrder, false, true, false, true>(c.lds, g, S, E); });
#else
    STEP(10, RUN_GEMM(Epi2, true, WS_ACT, WS_WOUT, D, IN_X, WSP(float, WS_MOD), WSP(float, WS_SSP), WSP(bf16_t, WS_R1B)));
#endif
    STEP(11, step_ln1(c));
#if I8_GEMM3 && FAST_GEMM && FUSE_TOPK && FAST_TOPK
    STEP(12, { pg8::Gemm g{WSP(bf16_t, WS_H2Q), WSP(bf16_t, WS_WQ), T, D, D / 2}; pg8::StaticOrder S; S.init(T, D, (int)gridDim.x, (int)blockIdx.x);
        pg8::EpiA<Epi3Q, true> E{Epi3Q{WSP(bf16_t, WS_PROJ), WSP(float, WS_HS), WSP(float, WS_SWQ)}}; pg8::gemm_phase<pg8::EpiA<Epi3Q, true>, pg8::StaticOrder, false, true, false, true>(c.lds, g, S, E);
        asm volatile("s_waitcnt vmcnt(0)" ::: "memory"); __syncthreads();
        pg8::Unit u; for (int i = 0; S.next(i, u); ++i) topk_groups(c, u.pn, u.pm * 8 + c.wave, u.pm * 8 + c.wave + 1, 1); });
#else
#if I8_GEMM3 && FAST_GEMM
    STEP(12, { pg8::Gemm g{WSP(bf16_t, WS_H2Q), WSP(bf16_t, WS_WQ), T, D, D / 2}; pg8::StaticOrder S; S.init(T, D, (int)gridDim.x, (int)blockIdx.x);
        pg8::EpiA<Epi3Q, true> E{Epi3Q{WSP(bf16_t, WS_PROJ), WSP(float, WS_HS), WSP(float, WS_SWQ)}}; pg8::gemm_phase<pg8::EpiA<Epi3Q, true>, pg8::StaticOrder, false, true, false, true>(c.lds, g, S, E); });
#else
    STEP(12, RUN_GEMM(Epi3, false, WS_ACT, WS_WQ, D, WSP(bf16_t, WS_PROJ)));
#endif
#if FAST_TOPK
    STEP(13, step_topk_fast(c));
#else
    STEP(13, step_topk_simple(c));
#endif
#endif
#if SLICED_PEER
    XcdPlace P; P.nloc = (int)gridDim.x; P.nx = 1; P.xrank = 0; P.rank = (int)blockIdx.x;
    if (multi && a.lo <= 14 && 14 < a.hi) {
        unsigned* bw = (unsigned*)(c.ws + WS_CTL); const unsigned myx = xb_xcc_id();
        LAS unsigned* pl = (LAS unsigned*)(c.lds + LDSCTL_OFF + 16);
        if (c.tid == 0) pl[0] = xb_add(bw + 16384 + 64 * myx, 1u);
        __syncthreads();
        int nx = 0, xr = 0, nl = 0;
#pragma unroll
        for (int j = 0; j < 16; ++j) { const int cj = (int)xb_ld(&bw[XB_XCNT(j)]); if (cj > 0) { if (j < (int)myx) ++xr; ++nx; } if (j == (int)myx) nl = cj; }
        if (nl > 0 && nx > 0) { P.nloc = nl; P.nx = nx; P.xrank = xr; P.rank = (int)pl[0]; }
    }
    STEP(14, step_peer_u(c, P));
    STEP(15, step_peer_w(c));
    STEP(16, step_peer_v(c, P));
    STEP(17, step_ln2(c));
#else
    STEP(14, step_peer(c));
#endif
#undef STEP
}
}

extern "C" void kernel_launch(void* const* d_in, const int* in_sizes, int n_in, void* d_out, int out_size, void* d_ws, size_t ws_size, hipStream_t stream) {
    static int grid = 0;
    if (grid == 0) {
        if (n_in != 22 || in_sizes[0] != T * D || out_size != T * D || ws_size < WS_END) {
            fprintf(stderr, "kernel_launch: unexpected problem (n_in %d, in0 %d, out %d, ws %zu < %zu); nothing launched\n", n_in, n_in > 0 ? in_sizes[0] : -1, out_size, ws_size, (size_t)WS_END);
            grid = -1; return;
        }
        int dev = 0, cus = 0;
        if (hipGetDevice(&dev) != hipSuccess || hipDeviceGetAttribute(&cus, hipDeviceAttributeMultiprocessorCount, dev) != hipSuccess) { grid = -1; return; }
        if (hipFuncSetAttribute((const void*)fwd_kernel, hipFuncAttributeMaxDynamicSharedMemorySize, LDS_BYTES) != hipSuccess) { fprintf(stderr, "kernel_launch: hipFuncSetAttribute failed\n"); grid = -1; return; }
        int per_cu = 0;
        if (hipOccupancyMaxActiveBlocksPerMultiprocessor(&per_cu, (const void*)fwd_kernel, NTHR, LDS_BYTES) != hipSuccess || per_cu < 1) fprintf(stderr, "kernel_launch: occupancy query reports %d blocks per CU\n", per_cu);
        (void)hipGetLastError();
        grid = cus > 0 ? cus : 256;
    }
    if (grid < 0) return;
    (void)hipMemsetAsync((char*)d_ws + WS_CTL, 0, CTL_ZERO_BYTES, stream);
    Args a{};
    for (int i = 0; i < 22; ++i) a.in[i] = (const float*)d_in[i];
    a.out = (float*)d_out; a.ws = (unsigned char*)d_ws;
#if ONE_LAUNCH
    a.lo = 0; a.hi = NSTEPS;
    hipLaunchKernelGGL(fwd_kernel, dim3(grid), dim3(NTHR), LDS_BYTES, stream, a);
#else
    for (int i = 0; i < NSTEPS; ++i) { a.lo = i; a.hi = i + 1; hipLaunchKernelGGL(fwd_kernel, dim3(grid), dim3(NTHR), LDS_BYTES, stream, a); }
#endif
}
```

```cpp
#include <hip/hip_runtime.h>
#include <cstdio>
#include <cstdint>

#ifndef ONE_LAUNCH
#define ONE_LAUNCH 1
#endif
#ifndef FAST_GEMM
#define FAST_GEMM 1
#endif
#ifndef FAST_TOPK
#define FAST_TOPK 1
#endif
#ifndef FAST_MIX
#define FAST_MIX 15
#endif
#ifndef SLICED_PEER
#define SLICED_PEER 1
#endif
#ifndef PRO_REPEAT
#define PRO_REPEAT 0
#endif
#ifndef V_INT8
#define V_INT8 1
#endif
#ifndef HIDE_TABLES
#define HIDE_TABLES 1
#endif
#ifndef I8_GEMM3
#define I8_GEMM3 1
#endif
#ifndef I8_GEMM1
#define I8_GEMM1 1
#endif
#ifndef I8_GEMM2
#define I8_GEMM2 1
#endif
#ifndef PART16
#define PART16 1
#endif
#ifndef FUSE_TOPK
#define FUSE_TOPK 1
#endif
#ifndef WQ_ONEPASS
#define WQ_ONEPASS 1
#endif
#ifndef REPEAT_MASK
#define REPEAT_MASK 0
#endif

#define LAS __attribute__((address_space(3)))
typedef unsigned short bf16_t;
typedef float f32x4 __attribute__((ext_vector_type(4)));
typedef unsigned u32x4 __attribute__((ext_vector_type(4)));
typedef unsigned u32x2 __attribute__((ext_vector_type(2)));

namespace {
constexpr int NB = 4, SEQ = 4096, T = NB * SEQ, D = 2048;
constexpr int NH = 16, NCH = SEQ / 128;
constexpr int DINP = 4096;
constexpr int Z_OFF = 0, XBC_OFF = 1024, Q_OFF = 2560, K_OFF = 3584, V_OFF = 3712, DT_OFF = 3840;
constexpr int NMOD = 6 * D;
constexpr float ALPHA = 1.189207115002721f;
constexpr float EPS = 1e-5f;
constexpr int NTHR = 512, NWAVES = 8;

constexpr size_t MiB = 1u << 20;
constexpr size_t WS_CTL = 0, CTL_ZERO_BYTES = 1 * MiB;
constexpr size_t WS_MOD = 512 * 1024;
constexpr size_t WS_KEYS = 1 * MiB;
constexpr size_t WS_DTRAW = 2 * MiB;
constexpr size_t WS_DT = 3 * MiB;
constexpr size_t WS_ACUM = 4 * MiB;
constexpr size_t WS_SSP = 5 * MiB;
constexpr size_t WS_RS = 7 * MiB;
constexpr size_t WS_SCU = 7 * MiB + 256 * 1024, WS_SCV = 7 * MiB + 512 * 1024;
constexpr size_t WS_EXP = 8 * MiB;
constexpr size_t WS_GATE = 16 * MiB;
constexpr size_t WS_WIN = 24 * MiB;
constexpr size_t WS_WOUT = 40 * MiB;
constexpr size_t WS_WQ = 48 * MiB;
constexpr size_t WS_UB = 56 * MiB;
constexpr size_t WS_VB = 120 * MiB;
constexpr size_t WS_ACT = 184 * MiB;
constexpr size_t WS_PROJ = 248 * MiB;
constexpr size_t WS_XBCC = 376 * MiB;
constexpr size_t WS_STATES = 424 * MiB;
constexpr size_t WS_PREVB = 488 * MiB;
constexpr size_t WS_H2Q = 504 * MiB;
constexpr size_t WS_W8 = 5 * MiB;
constexpr size_t WS_WS = 7 * MiB + 128 * 1024;
constexpr size_t WS_SWQ = 7 * MiB + 64 * 1024, WS_SWIN = 7 * MiB + 80 * 1024, WS_SA1 = 7 * MiB + 320 * 1024;
constexpr int CW_AMXQ = 32768, CW_AMXIN = 36864;
constexpr size_t WS_A8 = WS_XBCC;
constexpr size_t WS_SA2 = 7 * MiB + 384 * 1024, WS_SWOUT = 7 * MiB + 96 * 1024;
constexpr int CW_AMXOUT = 40960;
constexpr size_t WS_HS = 7 * MiB;
constexpr size_t WS_END = 536 * MiB;
constexpr size_t WS_R1B = WS_PROJ, WS_X1B = WS_PROJ + 64 * MiB, WS_Q = WS_PROJ, WS_PARTA = WS_XBCC, WS_Y = WS_ACT;

constexpr int RING_BYTES = 131072;
constexpr int LDSCTL_OFF = 147456 - 64, MISC_OFF = LDSCTL_OFF;
constexpr int LDS_BYTES = 147456;

__device__ __forceinline__ float bf2f(unsigned v) { return __uint_as_float(v << 16); }
__device__ __forceinline__ float bflo(unsigned w) { return __uint_as_float(w << 16); }
__device__ __forceinline__ float bfhi(unsigned w) { return __uint_as_float(w & 0xffff0000u); }
__device__ __forceinline__ unsigned f2bf(float f) { unsigned u = __float_as_uint(f); return (u + 0x7fffu + ((u >> 16) & 1u)) >> 16; }
__device__ __forceinline__ unsigned pk2(float lo, float hi) { return f2bf(lo) | (f2bf(hi) << 16); }
typedef __bf16 bf16x2n __attribute__((ext_vector_type(2)));
typedef float f32x2n __attribute__((ext_vector_type(2)));
__device__ __forceinline__ unsigned cvtpk(float lo, float hi) { const bf16x2n r = __builtin_convertvector((f32x2n){lo, hi}, bf16x2n); return __builtin_bit_cast(unsigned, r); }
__device__ __forceinline__ float silu_f(float x) { return x / (1.f + expf(-x)); }
__device__ __forceinline__ float softplus_f(float x) { return x > 20.f ? x : log1pf(expf(x)); }
__device__ __forceinline__ float gelu_f(float x) { return 0.5f * x * (1.f + erff(x * 0.70710678118654752f)); }
__device__ __forceinline__ float wave_sum(float v) {
#pragma unroll
    for (int o = 1; o < 64; o <<= 1) v += __shfl_xor(v, o);
    return v;
}
__device__ __forceinline__ float dot8(u32x4 a, u32x4 b) {
    float s = bflo(a.x) * bflo(b.x); s += bfhi(a.x) * bfhi(b.x);
    s += bflo(a.y) * bflo(b.y); s += bfhi(a.y) * bfhi(b.y);
    s += bflo(a.z) * bflo(b.z); s += bfhi(a.z) * bfhi(b.z);
    s += bflo(a.w) * bflo(b.w); s += bfhi(a.w) * bfhi(b.w);
    return s;
}
__device__ __forceinline__ int win_src_col(int n) { return n < 2560 ? n : (n < 3840 ? n + 16 : (n < 3856 ? n - 1280 : -1)); }

#define XB_TMO      128
#define XB_XCNT(j)  (256  + 64 * (j))
#define XB_XSUB(j)  (1280 + 64 * (j))
#define XB_XGEN(j)  (2304 + 64 * (j))
#define XB_TOP      3328
#define XB_TOPGEN   3392
#define XCD_BAR_WORDS 3456
#define XB_SPIN_CAP (1u << 18)
__device__ __forceinline__ unsigned xb_ld(unsigned* p)              { return __hip_atomic_load(p, __ATOMIC_RELAXED, __HIP_MEMORY_SCOPE_AGENT); }
__device__ __forceinline__ unsigned xb_add(unsigned* p, unsigned v) { return __hip_atomic_fetch_add(p, v, __ATOMIC_RELAXED, __HIP_MEMORY_SCOPE_AGENT); }
__device__ __forceinline__ unsigned xb_xcc_id() { return (unsigned)__builtin_amdgcn_s_getreg((3 << 11) | 20) & 0xFu; }
#define XB_SPIN(cond, bar) do { unsigned _sp = 0; while (cond) { __builtin_amdgcn_s_sleep(1); \
    if ((++_sp & 255u) == 0u) { if (xb_ld(&(bar)[XB_TMO])) break; if (_sp > XB_SPIN_CAP) { atomicAdd(&(bar)[XB_TMO], 1u); break; } } } } while (0)
struct XcdBarrier { unsigned* bar; unsigned x; volatile LAS unsigned* st; };
__device__ __forceinline__ XcdBarrier xcd_barrier_post(unsigned* bar, volatile LAS unsigned* st) {
    XcdBarrier b; b.bar = bar; b.x = xb_xcc_id(); b.st = st;
    if (threadIdx.x == 0) (void)xb_add(&bar[XB_XCNT(b.x)], 1u);
    return b;
}
__device__ __forceinline__ void xcd_barrier_complete(unsigned* bar, unsigned x, unsigned& nloc, unsigned& nx) {
    const unsigned G = gridDim.x * gridDim.y * gridDim.z;
    unsigned sum, cnt, mine, sp = 0u;
    for (;;) {
        sum = 0u; cnt = 0u; mine = 0u;
#pragma unroll
        for (unsigned j = 0; j < 16; ++j) { const unsigned c = xb_ld(&bar[XB_XCNT(j)]); sum += c; cnt += (c > 0u) ? 1u : 0u; mine = (j == x) ? c : mine; }
        if (sum == G) break;
        __builtin_amdgcn_s_sleep(1);
        if ((++sp & 255u) == 0u) { if (xb_ld(&bar[XB_TMO])) break; if (sp > XB_SPIN_CAP) { atomicAdd(&bar[XB_TMO], 1u); break; } }
    }
    nloc = mine > 0u ? mine : 1u; nx = cnt > 0u ? cnt : 1u;
}
__device__ __forceinline__ void xcd_barrier(const XcdBarrier& b) {
    asm volatile("s_waitcnt vmcnt(0)" ::: "memory");
    __syncthreads();
    if (threadIdx.x == 0) {
        unsigned* bar = b.bar;
        __builtin_amdgcn_s_waitcnt(0);
        unsigned nloc = b.st[0], nx = b.st[1];
        if (nloc == 0u) { xcd_barrier_complete(bar, b.x, nloc, nx); b.st[0] = nloc; b.st[1] = nx; }
        const unsigned old = xb_add(&bar[XB_XSUB(b.x)], 1u);
        const unsigned gen = old / nloc;
        if (old + 1u == (gen + 1u) * nloc) {
            __builtin_amdgcn_fence(__ATOMIC_RELEASE, "agent");
            asm volatile("s_waitcnt vmcnt(0)" ::: "memory");
            const unsigned og = xb_add(&bar[XB_TOP], 1u);
            const unsigned tg = og / nx;
            if (og + 1u == (tg + 1u) * nx) xb_add(&bar[XB_TOPGEN], 1u);
            else XB_SPIN(xb_ld(&bar[XB_TOPGEN]) == tg, bar);
            __builtin_amdgcn_fence(__ATOMIC_ACQUIRE, "agent");
            xb_add(&bar[XB_XGEN(b.x)], 1u);
            asm volatile("s_waitcnt vmcnt(0)" ::: "memory");
        } else {
            XB_SPIN(xb_ld(&bar[XB_XGEN(b.x)]) == gen, bar);
            __builtin_amdgcn_fence(__ATOMIC_ACQUIRE, "agent");
            asm volatile("s_waitcnt vmcnt(0)" ::: "memory");
        }
    }
    __syncthreads();
}

struct Args { const float* in[22]; float* out; unsigned char* ws; int lo, hi; };
struct Ctx {
    const float* in[22]; float* out; unsigned char* ws; LAS unsigned char* lds;
    int tid, lane, wave, gw, ngw, gt, ngt;
};
#define IN_X c.in[0]
#define IN_C c.in[1]
#define IN_WADA c.in[2]
#define IN_BADA c.in[3]
#define IN_WIN c.in[4]
#define IN_CONVW c.in[5]
#define IN_CONVB c.in[6]
#define IN_DTBIAS c.in[7]
#define IN_ALOG c.in[8]
#define IN_DSKIP c.in[9]
#define IN_SSMG c.in[10]
#define IN_SINKS c.in[11]
#define IN_ATTG c.in[12]
#define IN_WOUT c.in[13]
#define IN_LN1G c.in[14]
#define IN_LN1B c.in[15]
#define IN_WQ c.in[16]
#define IN_KEYS c.in[17]
#define IN_U c.in[18]
#define IN_V c.in[19]
#define IN_LN2G c.in[20]
#define IN_LN2B c.in[21]
#define WSP(type, off) ((type*)(c.ws + (off)))


typedef float f32x2 __attribute__((ext_vector_type(2)));
typedef short bf16x8v __attribute__((ext_vector_type(8)));
typedef float f32x16 __attribute__((ext_vector_type(16)));
#define DPPF(v, ctrl) __int_as_float(__builtin_amdgcn_update_dpp(0, __float_as_int(v), (ctrl), 0xF, 0xF, true))
__device__ __forceinline__ float row_sum16(float v) {
    v += DPPF(v, 0xB1); v += DPPF(v, 0x4E); v += DPPF(v, 0x141); v += DPPF(v, 0x140); return v;
}
__device__ __forceinline__ float wave_sum63(float v) {
    v = row_sum16(v);
    v += __int_as_float(__builtin_amdgcn_update_dpp(0, __float_as_int(v), 0x142, 0xA, 0xF, false));
    v += __int_as_float(__builtin_amdgcn_update_dpp(0, __float_as_int(v), 0x143, 0xC, 0xF, false));
    return v;
}
__device__ __forceinline__ float lane63(float v) { return __int_as_float(__builtin_amdgcn_readlane(__float_as_int(v), 63)); }
__device__ __forceinline__ float wave_sum_all(float v) { return lane63(wave_sum63(v)); }
__device__ __forceinline__ void fp8_row_load(f32x4 (&v)[8], const float* src, int lane) {
#pragma unroll
    for (int j = 0; j < 2; ++j)
#pragma unroll
        for (int q = 0; q < 4; ++q) v[j * 4 + q] = *(const f32x4*)(src + j * 1024 + lane * 16 + q * 4);
}
#define DPPMAX(v, ctrl) fmaxf(v, __int_as_float(__builtin_amdgcn_update_dpp(0, __float_as_int(v), (ctrl), 0xF, 0xF, true)))
__device__ __forceinline__ unsigned pack_i8x4(f32x4 x) {
    const int q0 = (int)__builtin_rintf(x.x), q1 = (int)__builtin_rintf(x.y), q2 = (int)__builtin_rintf(x.z), q3 = (int)__builtin_rintf(x.w);
    return (unsigned)(q0 & 0xff) | ((unsigned)(q1 & 0xff) << 8) | ((unsigned)(q2 & 0xff) << 16) | ((unsigned)q3 << 24);
}
template <bool INT8>
__device__ __forceinline__ void fp8_row_finish(const f32x4 (&v)[8], unsigned char* tab, int row, float* scale, int lane) {
    float am = 0.f;
#pragma unroll
    for (int i = 0; i < 8; ++i) am = fmaxf(am, fmaxf(fmaxf(fabsf(v[i].x), fabsf(v[i].y)), fmaxf(fabsf(v[i].z), fabsf(v[i].w))));
    am = DPPMAX(am, 0xB1); am = DPPMAX(am, 0x4E); am = DPPMAX(am, 0x141); am = DPPMAX(am, 0x140);
    {
        const unsigned a0 = __builtin_amdgcn_readlane(__float_as_uint(am), 0), a1 = __builtin_amdgcn_readlane(__float_as_uint(am), 16);
        const unsigned a2 = __builtin_amdgcn_readlane(__float_as_uint(am), 32), a3 = __builtin_amdgcn_readlane(__float_as_uint(am), 48);
        const unsigned m01 = a0 > a1 ? a0 : a1, m23 = a2 > a3 ? a2 : a3; am = __uint_as_float(m01 > m23 ? m01 : m23);
    }
    const float top = INT8 ? 127.f : 448.f;
    const float inv = am > 0.f ? top / am : 0.f;
#pragma unroll
    for (int j = 0; j < 2; ++j) {
        u32x4 o;
#pragma unroll
        for (int q = 0; q < 4; ++q) { const f32x4 x = v[j * 4 + q] * inv;
            if (INT8) o[q] = pack_i8x4(x);
            else { int w = 0; w = __builtin_amdgcn_cvt_pk_fp8_f32(x.x, x.y, w, false); w = __builtin_amdgcn_cvt_pk_fp8_f32(x.z, x.w, w, true); o[q] = (unsigned)w; } }
#if SLICED_PEER
        *(u32x4*)(tab + ((size_t)(8 * j + (lane >> 3)) * 16384 + row) * 128 + (lane & 7) * 16) = o;
#else
        *(u32x4*)(tab + (size_t)row * D + j * 1024 + lane * 16) = o;
#endif
    }
    if (lane == 0) *scale = am / top;
}

template <bool WIN_MAP, bool GAINS = false>
__device__ __forceinline__ void colamax_items(const Ctx& c, const float* W, int Nsrc, unsigned* AMX, const float* g1 = nullptr, const float* g2 = nullptr) {
    const int nblk = (Nsrc + 255) / 256;
    for (int it = c.gw; it < 32 * nblk; it += c.ngw) {
        const int kb = it / nblk, nb = it % nblk, col = nb * 256 + c.lane * 4;
        if (col < Nsrc) {
            f32x4 m = {0.f, 0.f, 0.f, 0.f};
            const float* wp = W + (size_t)(kb * 64) * Nsrc + col;
#pragma unroll 16
            for (int kk = 0; kk < 64; ++kk) { f32x4 v = *(const f32x4*)(wp + (size_t)kk * Nsrc); if (GAINS) { const int k = kb * 64 + kk; v = v * (k < 1024 ? g1[k] : g2[k - 1024]); } m.x = fmaxf(m.x, fabsf(v.x)); m.y = fmaxf(m.y, fabsf(v.y)); m.z = fmaxf(m.z, fabsf(v.z)); m.w = fmaxf(m.w, fabsf(v.w)); }
#pragma unroll
            for (int j = 0; j < 4; ++j) { const int sc = col + j; const int dn = WIN_MAP ? (sc < 2560 ? sc : (sc < 2576 ? sc + 1280 : sc - 16)) : sc;
                atomicMax(AMX + dn, __float_as_uint(m[j])); }
        }
    }
}
template <bool WIN_MAP, bool GAINS = false>
__device__ __forceinline__ void transpose_item_i8(const float* W, int K, int Nsrc, int ND, unsigned char* WT, const unsigned* AMX, float* SW, LAS float* scr, int item, int lane, const float* g1 = nullptr, const float* g2 = nullptr) {
    const int nblk = ND / 32, kb = item / nblk, nb = item % nblk, k0 = 64 * kb, n0 = 32 * nb;
    const int n = n0 + (lane & 31), sc = WIN_MAP ? win_src_col(n) : n;
    const float am = __uint_as_float(AMX[n]), inv = am > 0.f ? 127.f / am : 0.f;
    float tv[32];
    const float* wp = W + (size_t)(k0 + (lane >> 5)) * Nsrc + (sc >= 0 ? sc : 0);
#pragma unroll
    for (int i = 0; i < 32; ++i) tv[i] = wp[(size_t)(2 * i) * Nsrc];
#pragma unroll
    for (int i = 0; i < 32; ++i) { const int kk = k0 + 2 * i + (lane >> 5); float v = sc >= 0 ? tv[i] * inv : 0.f; if (GAINS) v *= (kk < 1024 ? g1[kk] : g2[kk - 1024]); scr[(2 * i + (lane >> 5)) * 33 + (lane & 31)] = v; }
    asm volatile("s_waitcnt lgkmcnt(0)" ::: "memory");
#pragma unroll
    for (int j = 0; j < 2; ++j) {
        const int ch = lane + 64 * j, nn = ch >> 2, kc = ch & 3; const LAS float* sp = scr + (16 * kc) * 33 + nn;
        u32x4 o;
#pragma unroll
        for (int q = 0; q < 4; ++q) o[q] = pack_i8x4((f32x4){sp[(4 * q) * 33], sp[(4 * q + 1) * 33], sp[(4 * q + 2) * 33], sp[(4 * q + 3) * 33]});
        *(u32x4*)(WT + (size_t)(n0 + nn) * K + k0 + 16 * kc) = o;
    }
    if (kb == 0 && lane < 32) SW[n] = am * (1.f / 127.f);
    asm volatile("s_waitcnt lgkmcnt(0)" ::: "memory");
}
template <int MODE>
__device__ __forceinline__ void wquant_block(const Ctx& c, const float* W, int Nsrc, int nb, unsigned char* WT, float* SW, const float* g1, const float* g2) {
    constexpr int PITCH = 4112;
    LAS unsigned char* Lb = c.lds;
    LAS float* red = (LAS float*)(c.lds + 32 * PITCH);
    const int n = c.lane & 31, half = c.lane >> 5, n0 = nb * 32, dn = n0 + n, sc = MODE == 0 ? win_src_col(dn) : dn;
    const float* wp = W + (size_t)(c.wave * 256 + 2 * half) * Nsrc + (sc >= 0 ? sc : 0);
    float am = 0.f;
#pragma unroll 1
    for (int it0 = 0; it0 < 64; it0 += 8) {
        float v0[8], v1[8];
#pragma unroll
        for (int u = 0; u < 8; ++u) { const float* p = wp + (size_t)(4 * (it0 + u)) * Nsrc; v0[u] = p[0]; v1[u] = p[Nsrc]; }
#pragma unroll
        for (int u = 0; u < 8; ++u) {
            const int k = c.wave * 256 + 4 * (it0 + u) + 2 * half;
            float a = sc >= 0 ? v0[u] : 0.f, b = sc >= 0 ? v1[u] : 0.f;
            if (MODE == 1) { a *= (k < 1024 ? g1[k] : g2[k - 1024]); b *= (k + 1 < 1024 ? g1[k + 1] : g2[k + 1 - 1024]); }
            am = fmaxf(am, fmaxf(fabsf(a), fabsf(b)));
            *(LAS unsigned*)(Lb + n * PITCH + k * 2) = cvtpk(a, b);
        }
    }
    red[(c.wave * 2 + half) * 32 + n] = am;
    __syncthreads();
    if (c.tid < 32) {
        float m = 0.f;
#pragma unroll
        for (int j = 0; j < 16; ++j) m = fmaxf(m, red[j * 32 + c.tid]);
        red[512 + c.tid] = m > 0.f ? 127.f / m : 0.f; SW[n0 + c.tid] = m * (1.f / 127.f);
    }
    __syncthreads();
#pragma unroll 2
    for (int i = 0; i < 8; ++i) {
        const int id = i * NTHR + c.tid, nn = id >> 7, kc = id & 127; const float inv = red[512 + nn];
        const u32x4 r0 = *(const LAS u32x4*)(Lb + nn * PITCH + kc * 32), r1 = *(const LAS u32x4*)(Lb + nn * PITCH + kc * 32 + 16);
        u32x4 o;
        o.x = pack_i8x4((f32x4){bflo(r0.x), bfhi(r0.x), bflo(r0.y), bfhi(r0.y)} * inv); o.y = pack_i8x4((f32x4){bflo(r0.z), bfhi(r0.z), bflo(r0.w), bfhi(r0.w)} * inv);
        o.z = pack_i8x4((f32x4){bflo(r1.x), bfhi(r1.x), bflo(r1.y), bfhi(r1.y)} * inv); o.w = pack_i8x4((f32x4){bflo(r1.z), bfhi(r1.z), bflo(r1.w), bfhi(r1.w)} * inv);
        *(u32x4*)(WT + (size_t)(n0 + nn) * D + kc * 16) = o;
    }
    __syncthreads();
}
template <int MODE>
__device__ __forceinline__ void transpose_item(const float* W, int K, int Nsrc, int ND, bf16_t* WT, LAS float* scr, int item, int lane, const float* g1, const float* g2) {
    const int nblk = ND / 32, kb = item / nblk, nb = item % nblk, k0 = 64 * kb, n0 = 32 * nb;
    const int n = n0 + (lane & 31), sc = MODE == 0 ? win_src_col(n) : n;
    float tv[32];
    const float* wp = W + (size_t)(k0 + (lane >> 5)) * Nsrc + (sc >= 0 ? sc : 0);
#pragma unroll
    for (int i = 0; i < 32; ++i) tv[i] = wp[(size_t)(2 * i) * Nsrc];
#pragma unroll
    for (int i = 0; i < 32; ++i) {
        const int kk = 2 * i + (lane >> 5);
        float v = sc >= 0 ? tv[i] : 0.f;
        if (MODE == 1) v *= (k0 + kk < 1024) ? g1[k0 + kk] : g2[k0 + kk - 1024];
        scr[kk * 33 + (lane & 31)] = v;
    }
    asm volatile("s_waitcnt lgkmcnt(0)" ::: "memory");
    const int cch = lane & 7;
#pragma unroll
    for (int j = 0; j < 4; ++j) {
        const int nn = (lane >> 3) + 8 * j; const LAS float* s = scr + (8 * cch) * 33 + nn;
        u32x4 o; o.x = pk2(s[0 * 33], s[1 * 33]); o.y = pk2(s[2 * 33], s[3 * 33]); o.z = pk2(s[4 * 33], s[5 * 33]); o.w = pk2(s[6 * 33], s[7 * 33]);
        *(u32x4*)(WT + (size_t)(n0 + nn) * K + k0 + 8 * cch) = o;
    }
    asm volatile("s_waitcnt lgkmcnt(0)" ::: "memory");
}
__device__ __forceinline__ void cvt_f32_bf16(const Ctx& c, const float* src, bf16_t* dst, size_t n8) {
    for (size_t i = (size_t)c.gt; i < n8; i += (size_t)c.ngt) {
        const f32x4 a = ((const f32x4*)src)[2 * i], b = ((const f32x4*)src)[2 * i + 1];
        u32x4 o; o.x = pk2(a.x, a.y); o.y = pk2(a.z, a.w); o.z = pk2(b.x, b.y); o.w = pk2(b.z, b.w);
        ((u32x4*)dst)[i] = o;
    }
}
__device__ __forceinline__ void step_pro(const Ctx& c) {
    float* MOD = WSP(float, WS_MOD);
    for (int rep_ = 0; rep_ < 1 + ((PRO_REPEAT >> 0) & 1); ++rep_) {
    {
        LAS float* sl = (LAS float*)c.lds;
        LAS float* red = (LAS float*)(c.lds + 32768);
        for (int i = c.tid; i < 4 * D; i += NTHR) sl[i] = silu_f(IN_C[i]);
        __syncthreads();
        for (int cb = blockIdx.x; cb < NMOD / 48; cb += gridDim.x) {
            const int rsub = c.lane / 12, cq = c.lane % 12; const bool act = c.lane < 60;
            const float* wp = IN_WADA + (size_t)(c.wave * 256) * NMOD + cb * 48 + cq * 4;
            f32x4 a0 = {0.f, 0.f, 0.f, 0.f}, a1 = a0, a2 = a0, a3 = a0;
#pragma unroll 1
            for (int it0 = 0; it0 < 56; it0 += 8) {
                f32x4 wv[8];
#pragma unroll
                for (int u = 0; u < 8; ++u) { const int r = (it0 + u) * 5 + rsub; wv[u] = (act && r < 256) ? *(const f32x4*)(wp + (size_t)r * NMOD) : (f32x4){0.f, 0.f, 0.f, 0.f}; }
#pragma unroll
                for (int u = 0; u < 8; ++u) { const int r = (it0 + u) * 5 + rsub, k = c.wave * 256 + (r < 256 ? r : 255);
                    a0 += wv[u] * sl[k]; a1 += wv[u] * sl[D + k]; a2 += wv[u] * sl[2 * D + k]; a3 += wv[u] * sl[3 * D + k]; }
            }
            if (act) { LAS f32x4* o = (LAS f32x4*)(red + (c.wave * 60 + c.lane) * 16); o[0] = a0; o[1] = a1; o[2] = a2; o[3] = a3; }
            __syncthreads();
            if (c.tid < 192) {
                const int bb = c.tid / 48, j = c.tid % 48, q = j >> 2, e = j & 3;
                float sum = IN_BADA[cb * 48 + j];
#pragma unroll
                for (int w = 0; w < 8; ++w)
#pragma unroll
                    for (int rs = 0; rs < 5; ++rs) sum += red[(w * 60 + rs * 12 + q) * 16 + bb * 4 + e];
                MOD[bb * NMOD + cb * 48 + j] = sum;
            }
            __syncthreads();
        }
    }
    }
    for (int rep_ = 0; rep_ < 1 + ((PRO_REPEAT >> 1) & 1); ++rep_) {
    LAS float* scr = (LAS float*)(c.lds + c.wave * 16384);
    constexpr int I_IN = (D / 64) * (DINP / 32), I_SQ = (D / 64) * (D / 32);
    for (int it = c.gw; it < I_IN + 2 * I_SQ; it += c.ngw) {
        int r = it;
        if (r < I_IN) { if (!(I8_GEMM1 && FAST_GEMM)) transpose_item<0>(IN_WIN, D, 3856, DINP, WSP(bf16_t, WS_WIN), scr, r, c.lane, nullptr, nullptr); continue; } r -= I_IN;
        if (r < I_SQ) { if (!(I8_GEMM2 && FAST_GEMM)) transpose_item<1>(IN_WOUT, D, D, D, WSP(bf16_t, WS_WOUT), scr, r, c.lane, IN_SSMG, IN_ATTG); continue; } r -= I_SQ;
        if (!I8_GEMM3) transpose_item<2>(IN_WQ, D, D, D, WSP(bf16_t, WS_WQ), scr, r, c.lane, nullptr, nullptr);
    }
#if WQ_ONEPASS && I8_GEMM1 && I8_GEMM2 && I8_GEMM3 && FAST_GEMM
    __syncthreads();
    for (int it = blockIdx.x; it < 256; it += gridDim.x) {
        if (it < 128) wquant_block<0>(c, IN_WIN, 3856, it, WSP(unsigned char, WS_WIN), WSP(float, WS_SWIN), nullptr, nullptr);
        else if (it < 192) wquant_block<1>(c, IN_WOUT, D, it - 128, WSP(unsigned char, WS_WOUT), WSP(float, WS_SWOUT), IN_SSMG, IN_ATTG);
        else wquant_block<2>(c, IN_WQ, D, it - 192, WSP(unsigned char, WS_WQ), WSP(float, WS_SWQ), nullptr, nullptr);
    }
#else
    if (I8_GEMM3) colamax_items<false>(c, IN_WQ, D, WSP(unsigned, WS_CTL) + CW_AMXQ);
    if (I8_GEMM1 && FAST_GEMM) colamax_items<true>(c, IN_WIN, 3856, WSP(unsigned, WS_CTL) + CW_AMXIN);
    if (I8_GEMM2 && FAST_GEMM) colamax_items<false, true>(c, IN_WOUT, D, WSP(unsigned, WS_CTL) + CW_AMXOUT, IN_SSMG, IN_ATTG);
#endif
    }
    for (int rep_ = 0; rep_ < (HIDE_TABLES ? 0 : 1) + ((PRO_REPEAT >> 2) & 1); ++rep_) {
    {
#define TAB_SRC(r_) ((r_) < 16384 ? IN_U + (size_t)(r_) * D : IN_V + (size_t)((r_) - 16384) * D)
        f32x4 cur[8], nxt[8];
        int r = c.gw;
        if (r < 2 * 16384) fp8_row_load(cur, TAB_SRC(r), c.lane);
        for (; r < 2 * 16384; r += c.ngw) {
            const int rn = r + c.ngw;
            if (rn < 2 * 16384) fp8_row_load(nxt, TAB_SRC(rn), c.lane);
            if (r < 16384) fp8_row_finish<SLICED_PEER != 0>(cur, WSP(unsigned char, WS_UB), r, WSP(float, WS_SCU) + r, c.lane);
            else fp8_row_finish<(SLICED_PEER != 0) && (V_INT8 != 0)>(cur, WSP(unsigned char, WS_VB), r - 16384, WSP(float, WS_SCV) + (r - 16384), c.lane);
#pragma unroll
            for (int i = 0; i < 8; ++i) cur[i] = nxt[i];
        }
#undef TAB_SRC
    }
    }
    cvt_f32_bf16(c, IN_KEYS, WSP(bf16_t, WS_KEYS), (size_t)8 * 2 * 128 * 128 / 8);
}

__device__ __forceinline__ void step_h1(const Ctx& c) {
    const float* MOD = WSP(float, WS_MOD); bf16_t* H1 = WSP(bf16_t, WS_ACT);
    for (int t = c.gw; t < T; t += c.ngw) {
        const int b = t >> 12; const float* xr = IN_X + (size_t)t * D; const float* sh = MOD + b * NMOD; const float* sc = sh + D;
#if I8_GEMM1 && FAST_GEMM
        f32x4 hv[8]; float hmax = 0.f;
#pragma unroll
        for (int j = 0; j < 8; ++j) {
            const int col = j * 256 + c.lane * 4;
            const f32x4 xv = *(const f32x4*)(xr + col), s = *(const f32x4*)(sc + col), h = *(const f32x4*)(sh + col);
            hv[j] = xv * (s + 1.f) + h; hmax = fmaxf(hmax, fmaxf(fmaxf(fabsf(hv[j].x), fabsf(hv[j].y)), fmaxf(fabsf(hv[j].z), fabsf(hv[j].w))));
        }
        hmax = DPPMAX(hmax, 0xB1); hmax = DPPMAX(hmax, 0x4E); hmax = DPPMAX(hmax, 0x141); hmax = DPPMAX(hmax, 0x140);
        const unsigned a0 = __builtin_amdgcn_readlane(__float_as_uint(hmax), 0), a1 = __builtin_amdgcn_readlane(__float_as_uint(hmax), 16), a2 = __builtin_amdgcn_readlane(__float_as_uint(hmax), 32), a3 = __builtin_amdgcn_readlane(__float_as_uint(hmax), 48);
        const unsigned m01 = a0 > a1 ? a0 : a1, m23 = a2 > a3 ? a2 : a3; const float am = __uint_as_float(m01 > m23 ? m01 : m23), inv = am > 0.f ? 127.f / am : 0.f;
#pragma unroll
        for (int j = 0; j < 8; ++j) *(unsigned*)((unsigned char*)H1 + (size_t)t * D + j * 256 + c.lane * 4) = pack_i8x4(hv[j] * inv);
        if (c.lane == 0) WSP(float, WS_SA1)[t] = am * (1.f / 127.f);
#else
#pragma unroll
        for (int j = 0; j < 8; ++j) {
            const int col = j * 256 + c.lane * 4;
            const f32x4 xv = *(const f32x4*)(xr + col), s = *(const f32x4*)(sc + col), h = *(const f32x4*)(sh + col);
            u32x2 o; o.x = pk2(xv.x * (1.f + s.x) + h.x, xv.y * (1.f + s.y) + h.y); o.y = pk2(xv.z * (1.f + s.z) + h.z, xv.w * (1.f + s.w) + h.w);
            *(u32x2*)(H1 + (size_t)t * D + col) = o;
        }
#endif
    }
}

struct Epi1 {
    bf16_t* proj; float* dtraw;
    __device__ __forceinline__ float rho(int) const { return 1.f; }
    __device__ __forceinline__ float rowscale(int) const { return 1.f; }
    __device__ __forceinline__ void store8s(int row, int col, const float (&v)[8], float) const { store8(row, col, v); }
    __device__ __forceinline__ void store8(int row, int col, const float (&v)[8]) const {
        u32x4 o; o.x = pk2(v[0], v[1]); o.y = pk2(v[2], v[3]); o.z = pk2(v[4], v[5]); o.w = pk2(v[6], v[7]);
        *(u32x4*)(proj + (size_t)row * DINP + col) = o;
        if (col >= DT_OFF && col < DT_OFF + 16) {
            float* d = dtraw + (size_t)row * 16 + (col - DT_OFF);
            *(f32x4*)d = (f32x4){v[0], v[1], v[2], v[3]}; *(f32x4*)(d + 4) = (f32x4){v[4], v[5], v[6], v[7]};
        }
    }
};
struct Epi2 {
    const float* x; const float* mod; const float* ssp; bf16_t* r1;
    __device__ __forceinline__ void rs_pair(int row, float& r_ssd, float& r_att) const {
        float s1 = 0.f, s2 = 0.f;
#pragma unroll
        for (int j = 0; j < 4; ++j) { const f32x4 a = *(const f32x4*)(ssp + (size_t)row * 32 + 4 * j), b = *(const f32x4*)(ssp + (size_t)row * 32 + 16 + 4 * j);
            s1 += (a.x + a.y) + (a.z + a.w); s2 += (b.x + b.y) + (b.z + b.w); }
        r_ssd = rsqrtf(s1 * (1.f / 1024.f) + EPS); r_att = rsqrtf(s2 * (1.f / 1024.f) + EPS);
    }
    __device__ __forceinline__ float rho(int row) const { float a, b; rs_pair(row, a, b); return a / b; }
    __device__ __forceinline__ float rowscale(int row) const { float a, b; rs_pair(row, a, b); return b; }
    __device__ __forceinline__ void store8s(int row, int col, const float (&v)[8], float ra) const {
        const int b = row >> 12;
        const float* g = mod + b * NMOD + 2 * D + col;
        const f32x4 g0 = *(const f32x4*)g, g1 = *(const f32x4*)(g + 4);
        u32x4 o;
        o.x = cvtpk(g0.x * (ra * v[0]), g0.y * (ra * v[1])); o.y = cvtpk(g0.z * (ra * v[2]), g0.w * (ra * v[3]));
        o.z = cvtpk(g1.x * (ra * v[4]), g1.y * (ra * v[5])); o.w = cvtpk(g1.z * (ra * v[6]), g1.w * (ra * v[7]));
        *(u32x4*)(r1 + (size_t)row * D + col) = o;
    }
    __device__ __forceinline__ void store8(int row, int col, const float (&v)[8]) const { store8s(row, col, v, rowscale(row)); }
};
struct Epi3 {
    bf16_t* q;
    __device__ __forceinline__ float rho(int) const { return 1.f; }
    __device__ __forceinline__ float rowscale(int) const { return 1.f; }
    __device__ __forceinline__ void store8s(int row, int col, const float (&v)[8], float) const { store8(row, col, v); }
    __device__ __forceinline__ void store8(int row, int col, const float (&v)[8]) const {
        u32x4 o; o.x = pk2(v[0], v[1]); o.y = pk2(v[2], v[3]); o.z = pk2(v[4], v[5]); o.w = pk2(v[6], v[7]);
        *(u32x4*)(q + (size_t)row * D + col) = o;
    }
};

struct Epi1Q {
    bf16_t* proj; float* dtraw; const float* sa; const float* sw;
    __device__ __forceinline__ float rho(int) const { return 1.f; }
    __device__ __forceinline__ float rowscale(int row) const { return sa[row]; }
    __device__ __forceinline__ void store8s(int row, int col, const float (&v)[8], float rsc) const {
        const f32x4 s0 = *(const f32x4*)(sw + col) * rsc, s1 = *(const f32x4*)(sw + col + 4) * rsc;
        const float r0 = v[0] * s0.x, r1 = v[1] * s0.y, r2 = v[2] * s0.z, r3 = v[3] * s0.w, r4 = v[4] * s1.x, r5 = v[5] * s1.y, r6 = v[6] * s1.z, r7 = v[7] * s1.w;
        u32x4 o; o.x = cvtpk(r0, r1); o.y = cvtpk(r2, r3); o.z = cvtpk(r4, r5); o.w = cvtpk(r6, r7);
        *(u32x4*)(proj + (size_t)row * DINP + col) = o;
        if (col >= DT_OFF && col < DT_OFF + 16) { float* d = dtraw + (size_t)row * 16 + (col - DT_OFF); *(f32x4*)d = (f32x4){r0, r1, r2, r3}; *(f32x4*)(d + 4) = (f32x4){r4, r5, r6, r7}; }
    }
    __device__ __forceinline__ void store8(int row, int col, const float (&v)[8]) const { store8s(row, col, v, rowscale(row)); }
};
struct Epi2Q {
    const float* mod; const float* sa; const float* sw; bf16_t* r1;
    __device__ __forceinline__ float rho(int) const { return 1.f; }
    __device__ __forceinline__ float rowscale(int row) const { return sa[row]; }
    __device__ __forceinline__ void store8s(int row, int col, const float (&v)[8], float rsc) const {
        const int b = row >> 12; const float* g = mod + b * NMOD + 2 * D + col;
        const f32x4 s0 = *(const f32x4*)(sw + col) * *(const f32x4*)g * rsc, s1 = *(const f32x4*)(sw + col + 4) * *(const f32x4*)(g + 4) * rsc;
        u32x4 o; o.x = cvtpk(v[0] * s0.x, v[1] * s0.y); o.y = cvtpk(v[2] * s0.z, v[3] * s0.w); o.z = cvtpk(v[4] * s1.x, v[5] * s1.y); o.w = cvtpk(v[6] * s1.z, v[7] * s1.w);
        *(u32x4*)(r1 + (size_t)row * D + col) = o;
    }
    __device__ __forceinline__ void store8(int row, int col, const float (&v)[8]) const { store8s(row, col, v, rowscale(row)); }
};
struct Epi3Q {
    bf16_t* q; const float* hs; const float* swq;
    __device__ __forceinline__ float rho(int) const { return 1.f; }
    __device__ __forceinline__ float rowscale(int row) const { return hs[row]; }
    __device__ __forceinline__ void store8s(int row, int col, const float (&v)[8], float rsc) const {
        const f32x4 s0 = *(const f32x4*)(swq + col) * rsc, s1 = *(const f32x4*)(swq + col + 4) * rsc;
        u32x4 o; o.x = cvtpk(v[0] * s0.x, v[1] * s0.y); o.y = cvtpk(v[2] * s0.z, v[3] * s0.w); o.z = cvtpk(v[4] * s1.x, v[5] * s1.y); o.w = cvtpk(v[6] * s1.z, v[7] * s1.w);
        *(u32x4*)(q + (size_t)row * D + col) = o;
    }
    __device__ __forceinline__ void store8(int row, int col, const float (&v)[8]) const { store8s(row, col, v, rowscale(row)); }
};
template <class Epi, bool MIDK>
__device__ __forceinline__ void gemm_simple(const Ctx& c, const bf16_t* A, const bf16_t* Bt, int M, int N, int K, const Epi& E) {
    LAS float* As = (LAS float*)c.lds;
    LAS float* Bs = As + 32 * 132;
    const int tid = c.tid, ty = tid >> 4, tx = tid & 15, lr = tid >> 2, lk = (tid & 3) * 8;
    const int nTn = N / 128, ntile = (M / 128) * nTn;
    for (int tile = blockIdx.x; tile < ntile; tile += gridDim.x) {
        const int tm = tile / nTn, tn = tile % nTn;
        float acc[4][8];
#pragma unroll
        for (int i = 0; i < 4; ++i)
#pragma unroll
            for (int j = 0; j < 8; ++j) acc[i][j] = 0.f;
        const bf16_t* Ap = A + (size_t)(tm * 128 + lr) * K + lk;
        const bf16_t* Bp = Bt + (size_t)(tn * 128 + lr) * K + lk;
        for (int k0 = 0; k0 < K; k0 += 32) {
            if (MIDK && k0 == K / 2) {
#pragma unroll
                for (int i = 0; i < 4; ++i) { const float r = E.rho(tm * 128 + ty * 4 + i);
#pragma unroll
                    for (int j = 0; j < 8; ++j) acc[i][j] *= r; }
            }
            const u32x4 av = *(const u32x4*)(Ap + k0), bv = *(const u32x4*)(Bp + k0);
            __syncthreads();
            As[(lk + 0) * 132 + lr] = bflo(av.x); As[(lk + 1) * 132 + lr] = bfhi(av.x); As[(lk + 2) * 132 + lr] = bflo(av.y); As[(lk + 3) * 132 + lr] = bfhi(av.y);
            As[(lk + 4) * 132 + lr] = bflo(av.z); As[(lk + 5) * 132 + lr] = bfhi(av.z); As[(lk + 6) * 132 + lr] = bflo(av.w); As[(lk + 7) * 132 + lr] = bfhi(av.w);
            Bs[(lk + 0) * 132 + lr] = bflo(bv.x); Bs[(lk + 1) * 132 + lr] = bfhi(bv.x); Bs[(lk + 2) * 132 + lr] = bflo(bv.y); Bs[(lk + 3) * 132 + lr] = bfhi(bv.y);
            Bs[(lk + 4) * 132 + lr] = bflo(bv.z); Bs[(lk + 5) * 132 + lr] = bfhi(bv.z); Bs[(lk + 6) * 132 + lr] = bflo(bv.w); Bs[(lk + 7) * 132 + lr] = bfhi(bv.w);
            __syncthreads();
#pragma unroll 8
            for (int k = 0; k < 32; ++k) {
                const f32x4 a = *(const LAS f32x4*)(As + k * 132 + ty * 4);
                const f32x4 b0 = *(const LAS f32x4*)(Bs + k * 132 + tx * 8), b1 = *(const LAS f32x4*)(Bs + k * 132 + tx * 8 + 4);
                const float aa[4] = {a.x, a.y, a.z, a.w}; const float bb[8] = {b0.x, b0.y, b0.z, b0.w, b1.x, b1.y, b1.z, b1.w};
#pragma unroll
                for (int i = 0; i < 4; ++i)
#pragma unroll
                    for (int j = 0; j < 8; ++j) acc[i][j] += aa[i] * bb[j];
            }
        }
#pragma unroll
        for (int i = 0; i < 4; ++i) E.store8(tm * 128 + ty * 4 + i, tn * 128 + tx * 8, acc[i]);
    }
    __syncthreads();
}

namespace pg8 {
#define PG8_LAS __attribute__((address_space(3)))
typedef unsigned short bf16_t;
typedef short bf16x8 __attribute__((ext_vector_type(8)));
typedef float f32x4 __attribute__((ext_vector_type(4)));
typedef unsigned u32x4 __attribute__((ext_vector_type(4)));
constexpr int BM = 256, BK = 64, HALF = 128, HTB = HALF * BK * 2  , STAGE_BYTES = 8 * HTB, NXCD = 8, WGM = 4;

__host__ __device__ __forceinline__ int lds_byte(int r, int c) { const int st = (r >> 4) * 2 + (c >> 5), rr = r & 15, cc = c & 31, ob = rr * 64 + cc * 2; return st * 1024 + (ob ^ (((ob >> 9) & 1) << 5)); }
__host__ __device__ __forceinline__ void stage_rc(int b, int& R, int& C) { const int st = b / 1024, sb = b % 1024, swz = sb ^ (((sb >> 9) & 1) << 5); R = (st >> 1) * 16 + swz / 64; C = (st & 1) * 32 + (swz % 64) / 2; }
__host__ __device__ __forceinline__ int perm32(int rho) { const int n = rho >> 4, i = rho & 15; return 8 * (i >> 2) + 4 * n + (i & 3); }

struct Unit { int pm, pn; };
struct Gemm { const bf16_t* A; const bf16_t* Bt; int M, N, K; };

struct StaticOrder {
    int nM, nN, nwg, G, c;
    __host__ __device__ void init(int M, int N, int G_, int c_) { nM = M / BM; nN = N / BM; nwg = nM * nN; G = G_; c = c_; }
    __host__ __device__ bool next(int i, Unit& u) const {
        const long L = (long)i * G + c; if (L >= nwg) return false;
        int wgid = (int)L; { const int q = nwg / NXCD, r = nwg % NXCD, xcd = wgid % NXCD, off = wgid / NXCD; wgid = (xcd < r ? xcd * (q + 1) : r * (q + 1) + (xcd - r) * q) + off; }
        const int nig = WGM * nN, gid = wgid / nig, fm = gid * WGM, gsz = (nM - fm) < WGM ? (nM - fm) : WGM;
        u.pm = fm + ((wgid % nig) % gsz); u.pn = (wgid % nig) / gsz; return true;
    }
    __device__ __forceinline__ void a_ready(const Unit&) const {}
    __device__ __forceinline__ void done(const Unit&) const {}
};


template <class E, bool I8 = false> struct EpiA {
    static constexpr bool PERM = true, AFTER_DRAIN = false; E e;
    __device__ __forceinline__ void operator()(const f32x4 (&acc)[2][2][4][2], const Unit& u, int wr, int wc, int fr, int fq) const {
#pragma unroll
        for (int ai = 0; ai < 2; ++ai)
#pragma unroll
            for (int m = 0; m < 4; ++m) {
                const int row = u.pm * BM + ai * HALF + wr * 64 + m * 16 + fr; const float rsc = e.rowscale(row);
#pragma unroll
                for (int bj = 0; bj < 2; ++bj) {
                    const f32x4 v0 = acc[ai][bj][m][0], v1 = acc[ai][bj][m][1];
                    float v[8];
                    if constexpr (I8) {
#pragma unroll
                        for (int j = 0; j < 4; ++j) { v[j] = (float)__float_as_int(v0[j]); v[4 + j] = (float)__float_as_int(v1[j]); }
                    } else {
#pragma unroll
                        for (int j = 0; j < 4; ++j) { v[j] = v0[j]; v[4 + j] = v1[j]; }
                    }
                    e.store8s(row, u.pn * BM + bj * HALF + wc * 32 + 8 * fq, v, rsc);
                }
                if (m & 1) asm volatile("" ::: "memory");
            }
    }
    __device__ __forceinline__ void midk(f32x4 (&acc)[2][2][4][2], const Unit& u, int wr, int fr) const {
#pragma unroll
        for (int ai = 0; ai < 2; ++ai)
#pragma unroll
            for (int m = 0; m < 4; ++m) {
                const float r = e.rho(u.pm * BM + ai * HALF + wr * 64 + m * 16 + fr);
#pragma unroll
                for (int bj = 0; bj < 2; ++bj)
#pragma unroll
                    for (int n = 0; n < 2; ++n) acc[ai][bj][m][n] = acc[ai][bj][m][n] * r;
            }
    }
};
typedef int i32x4 __attribute__((ext_vector_type(4)));
template <class Epi, class Sched, bool ALIGN_EPI = false, bool SP2 = false, bool MIDK = false, bool I8 = false>
__device__ __forceinline__ void gemm_phase(PG8_LAS unsigned char* lds, const Gemm g, const Sched& S, const Epi& E) {
    const int tid = threadIdx.x, wid = __builtin_amdgcn_readfirstlane(tid >> 6), lane = tid & 63, wr = wid >> 2, wc = wid & 3, fr = lane & 15, fq = lane >> 4;
    const int K = g.K, nt = K / BK;
    unsigned voffA[2], voffB[2];
#pragma unroll
    for (int i = 0; i < 2; ++i) { int R, C; stage_rc(tid * 16 + i * 8192, R, C); const int Rb = Epi::PERM ? ((R & ~31) + perm32(R & 31)) : R;
        voffA[i] = (unsigned)(R * K + C) * 2u; voffB[i] = (unsigned)(Rb * K + C) * 2u; }
    const size_t kstep = (size_t)(BK * 2);
    const size_t hstep = (size_t)HALF * K * 2;
    const size_t tstep = 2 * hstep;
    const unsigned ldsw = (unsigned)wid * 1024u;
    const int aoff = lds_byte(wr * 64 + fr, fq * 8), boff = lds_byte(wc * 32 + fr, fq * 8);
#define PG8_SA(b, h) (((b) * 2 + (h)) * HTB)
#define PG8_SB(b, h) ((4 + (b) * 2 + (h)) * HTB)
#define PG8_STAGE(bufoff, gbase, voff) do { _Pragma("unroll") for (int _i = 0; _i < 2; ++_i) \
        __builtin_amdgcn_global_load_lds((const unsigned*)((const char*)(gbase) + (voff)[_i]), (PG8_LAS unsigned*)(lds + (bufoff) + ldsw + _i * 8192), 16, 0, 0); } while (0)
#define PG8_LDA(dst, b, h) do { _Pragma("unroll") for (int m = 0; m < 4; ++m) _Pragma("unroll") for (int k = 0; k < 2; ++k) dst[m][k] = *(const PG8_LAS bf16x8*)(lds + PG8_SA(b, h) + aoff + m * 2048 + k * 1024); } while (0)
#define PG8_LDB(dst, b, h) do { _Pragma("unroll") for (int n = 0; n < 2; ++n) _Pragma("unroll") for (int k = 0; k < 2; ++k) dst[n][k] = *(const PG8_LAS bf16x8*)(lds + PG8_SB(b, h) + boff + n * 2048 + k * 1024); } while (0)
#define PG8_MMA(ai, bj, At, Bt) do { __builtin_amdgcn_s_setprio(1); _Pragma("unroll") for (int m = 0; m < 4; ++m) _Pragma("unroll") for (int n = 0; n < 2; ++n) _Pragma("unroll") for (int k = 0; k < 2; ++k) { \
        if constexpr (I8) acc[ai][bj][m][n] = __builtin_bit_cast(f32x4, __builtin_amdgcn_mfma_i32_16x16x64_i8(__builtin_bit_cast(i32x4, Bt[n][k]), __builtin_bit_cast(i32x4, At[m][k]), __builtin_bit_cast(i32x4, acc[ai][bj][m][n]), 0, 0, 0)); \
        else acc[ai][bj][m][n] = __builtin_amdgcn_mfma_f32_16x16x32_bf16(Bt[n][k], At[m][k], acc[ai][bj][m][n], 0, 0, 0); } __builtin_amdgcn_s_setprio(0); } while (0)
#define PG8_WAIT_V(n) asm volatile("s_waitcnt vmcnt(" #n ")" ::: "memory")
#define PG8_WAIT_L(n) asm volatile("s_waitcnt lgkmcnt(" #n ")" ::: "memory")
#define PG8_BAR __builtin_amdgcn_s_barrier()
#define PG8_SCHED __builtin_amdgcn_sched_barrier(0)
    Unit cur, nxt; int ui = 0;
    if (!S.next(0, cur)) return;
    f32x4 acc[2][2][4][2];
#pragma unroll
    for (int a = 0; a < 2; ++a)
#pragma unroll
        for (int b = 0; b < 2; ++b)
#pragma unroll
            for (int m = 0; m < 4; ++m)
#pragma unroll
                for (int n = 0; n < 2; ++n) acc[a][b][m][n] = (f32x4){0.f, 0.f, 0.f, 0.f};
    bf16x8 At[4][2], B0[2][2], B1[2][2];
    const char* cA = (const char*)g.A + (size_t)cur.pm * tstep; const char* cB = (const char*)g.Bt + (size_t)cur.pn * tstep;
    S.a_ready(cur);
    if constexpr (SP2) {
        PG8_STAGE(PG8_SB(0, 0), cB, voffB); PG8_STAGE(PG8_SB(0, 1), cB + hstep, voffB); PG8_STAGE(PG8_SA(0, 0), cA, voffA); PG8_STAGE(PG8_SA(0, 1), cA + hstep, voffA);
        if (wr == 1) PG8_BAR;
        PG8_WAIT_V(2); PG8_BAR;
        PG8_STAGE(PG8_SB(1, 0), cB + kstep, voffB); PG8_STAGE(PG8_SA(1, 0), cA + kstep, voffA); PG8_STAGE(PG8_SB(1, 1), cB + hstep + kstep, voffB);
        PG8_WAIT_V(6); PG8_BAR;
    } else {
        PG8_STAGE(PG8_SB(0, 0), cB, voffB); PG8_STAGE(PG8_SA(0, 0), cA, voffA); PG8_STAGE(PG8_SB(0, 1), cB + hstep, voffB); PG8_STAGE(PG8_SA(0, 1), cA + hstep, voffA);
        if (wr == 1) PG8_BAR;
        PG8_WAIT_V(4); PG8_BAR;
        PG8_STAGE(PG8_SB(1, 0), cB + kstep, voffB); PG8_STAGE(PG8_SA(1, 0), cA + kstep, voffA); PG8_STAGE(PG8_SB(1, 1), cB + hstep + kstep, voffB);
        PG8_WAIT_V(6); PG8_BAR;
    }
    for (;;) {
        const bool has_next = S.next(ui + 1, nxt);
        const char* nA = has_next ? (const char*)g.A + (size_t)nxt.pm * tstep : cA; const char* nB = has_next ? (const char*)g.Bt + (size_t)nxt.pn * tstep : cB;
        for (int t = 0; t < nt; t += 2) {
            const bool last = (t == nt - 2);
            if constexpr (MIDK) { if (t == nt / 2) E.midk(acc, cur, wr, fr); }
            const char* a1 = cA + (size_t)(t + 1) * kstep;
            const char* a2 = last ? nA : cA + (size_t)(t + 2) * kstep; const char* b2 = last ? nB : cB + (size_t)(t + 2) * kstep;
            const char* a3 = a2 + kstep; const char* b3 = b2 + kstep;
            if (last && has_next) S.a_ready(nxt);
            if constexpr (SP2) {
            PG8_LDB(B0, 0, 0); PG8_LDB(B1, 0, 1); PG8_SCHED; PG8_LDA(At, 0, 0); PG8_STAGE(PG8_SA(1, 1), a1 + hstep, voffA);
            PG8_WAIT_V(8); PG8_WAIT_L(0); PG8_BAR; PG8_MMA(0, 0, At, B0); PG8_MMA(0, 1, At, B1); PG8_BAR; PG8_SCHED;
            PG8_LDA(At, 0, 1); PG8_STAGE(PG8_SB(0, 0), b2, voffB); PG8_STAGE(PG8_SB(0, 1), b2 + hstep, voffB); PG8_STAGE(PG8_SA(0, 0), a2, voffA);
            PG8_WAIT_V(8); PG8_WAIT_L(0); PG8_BAR; PG8_MMA(1, 0, At, B0); PG8_MMA(1, 1, At, B1); PG8_BAR; PG8_SCHED;
            PG8_LDB(B0, 1, 0); PG8_LDB(B1, 1, 1); PG8_SCHED; PG8_LDA(At, 1, 0); PG8_STAGE(PG8_SA(0, 1), a2 + hstep, voffA);
            PG8_WAIT_V(8); PG8_WAIT_L(0); PG8_BAR; PG8_MMA(0, 0, At, B0); PG8_MMA(0, 1, At, B1); PG8_BAR; PG8_SCHED;
            PG8_LDA(At, 1, 1); PG8_STAGE(PG8_SB(1, 0), b3, voffB); PG8_STAGE(PG8_SB(1, 1), b3 + hstep, voffB); PG8_STAGE(PG8_SA(1, 0), a3, voffA);
            PG8_WAIT_V(8); PG8_WAIT_L(0); PG8_BAR; PG8_MMA(1, 0, At, B0); PG8_MMA(1, 1, At, B1); PG8_BAR; PG8_SCHED;
            } else {
            PG8_LDB(B0, 0, 0); PG8_SCHED; PG8_LDA(At, 0, 0); PG8_STAGE(PG8_SA(1, 1), a1 + hstep, voffA);
            PG8_WAIT_L(8); PG8_BAR; PG8_WAIT_L(0); PG8_MMA(0, 0, At, B0); PG8_BAR; PG8_SCHED;
            PG8_LDB(B1, 0, 1); PG8_STAGE(PG8_SB(0, 0), b2, voffB);
            PG8_BAR; PG8_WAIT_L(0); PG8_MMA(0, 1, At, B1); PG8_BAR;
            PG8_LDA(At, 0, 1); PG8_STAGE(PG8_SA(0, 0), a2, voffA);
            PG8_BAR; PG8_WAIT_L(0); PG8_MMA(1, 0, At, B0); PG8_BAR; PG8_SCHED;
            PG8_STAGE(PG8_SB(0, 1), b2 + hstep, voffB);
            PG8_WAIT_V(6); PG8_BAR; PG8_MMA(1, 1, At, B1); PG8_BAR;
            PG8_LDB(B0, 1, 0); PG8_SCHED; PG8_LDA(At, 1, 0); PG8_STAGE(PG8_SA(0, 1), a2 + hstep, voffA);
            PG8_WAIT_L(8); PG8_BAR; PG8_WAIT_L(0); PG8_MMA(0, 0, At, B0); PG8_BAR; PG8_SCHED;
            PG8_LDB(B1, 1, 1); PG8_STAGE(PG8_SB(1, 0), b3, voffB);
            PG8_BAR; PG8_WAIT_L(0); PG8_MMA(0, 1, At, B1); PG8_BAR;
            PG8_LDA(At, 1, 1); PG8_STAGE(PG8_SA(1, 0), a3, voffA);
            PG8_BAR; PG8_WAIT_L(0); PG8_MMA(1, 0, At, B0); PG8_BAR; PG8_SCHED;
            PG8_STAGE(PG8_SB(1, 1), b3 + hstep, voffB);
            PG8_WAIT_V(6); PG8_BAR; PG8_MMA(1, 1, At, B1); PG8_BAR;
            }
        }
        if constexpr (ALIGN_EPI) { if (wr == 0) PG8_BAR; }
        if constexpr (!Epi::AFTER_DRAIN) { E(acc, cur, wr, wc, fr, fq); S.done(cur); }
        if (!has_next) break;
#pragma unroll
        for (int a = 0; a < 2; ++a)
#pragma unroll
            for (int b = 0; b < 2; ++b)
#pragma unroll
                for (int m = 0; m < 4; ++m)
#pragma unroll
                    for (int n = 0; n < 2; ++n) acc[a][b][m][n] = (f32x4){0.f, 0.f, 0.f, 0.f};
        cur = nxt; cA = nA; cB = nB; ++ui;
        if constexpr (ALIGN_EPI) { if (wr == 1) PG8_BAR; }
    }
    PG8_WAIT_V(0);
    if constexpr (!ALIGN_EPI) { if (wr == 0) PG8_BAR; }
    PG8_BAR;
    if constexpr (Epi::AFTER_DRAIN) { E.fused(acc, cur, wr, wc, fr, fq, lds, wid, lane); S.done(cur); }
#undef PG8_SA
#undef PG8_SB
#undef PG8_STAGE
#undef PG8_LDA
#undef PG8_LDB
#undef PG8_MMA
#undef PG8_WAIT_V
#undef PG8_WAIT_L
#undef PG8_BAR
#undef PG8_SCHED
}
}

__device__ __forceinline__ void step_conv(const Ctx& c) {
    const bf16_t* PROJ = WSP(bf16_t, WS_PROJ); bf16_t* XBCC = WSP(bf16_t, WS_XBCC);
    for (int idx = c.gt; idx < T * 768; idx += c.ngt) {
        const int t = idx / 768, ch = (idx % 768) * 2, pos = t & (SEQ - 1);
        float a0 = IN_CONVB[ch], a1 = IN_CONVB[ch + 1];
#pragma unroll
        for (int j = 0; j < 4; ++j) {
            if (pos - 3 + j >= 0) {
                const unsigned v = *(const unsigned*)(PROJ + (size_t)(t - 3 + j) * DINP + XBC_OFF + ch);
                a0 += IN_CONVW[j * 1536 + ch] * bflo(v); a1 += IN_CONVW[j * 1536 + ch + 1] * bfhi(v);
            }
        }
        *(unsigned*)(XBCC + (size_t)t * 1536 + ch) = pk2(silu_f(a0), silu_f(a1));
    }
    const float* DTRAW = WSP(float, WS_DTRAW); float* DT = WSP(float, WS_DT); float* ACUM = WSP(float, WS_ACUM);
    for (int idx = c.gt; idx < NB * NCH * NH; idx += c.ngt) {
        const int h = idx % NH, bc = idx / NH, t0 = bc * 128;
        const float A = -expf(IN_ALOG[h]), bias = IN_DTBIAS[h]; float cum = 0.f;
        for (int l = 0; l < 128; ++l) {
            const float dtv = softplus_f(DTRAW[(size_t)(t0 + l) * 16 + h] + bias); cum += dtv * A;
            DT[(size_t)idx * 128 + l] = dtv; ACUM[(size_t)idx * 128 + l] = cum;
        }
    }
}

__device__ __forceinline__ void step_ssd1_simple(const Ctx& c) {
    const bf16_t* XBCC = WSP(bf16_t, WS_XBCC); const float* DT = WSP(float, WS_DT); const float* ACUM = WSP(float, WS_ACUM); float* STATES = WSP(float, WS_STATES);
    LAS float* wl = (LAS float*)c.lds;
    for (int item = blockIdx.x; item < NB * NCH * NH; item += gridDim.x) {
        const int bc = item / NH, h = item % NH, g = h >> 3, t0 = bc * 128;
        __syncthreads();
        if (c.tid < 128) { const float aend = ACUM[(size_t)item * 128 + 127]; wl[c.tid] = expf(aend - ACUM[(size_t)item * 128 + c.tid]) * DT[(size_t)item * 128 + c.tid]; }
        __syncthreads();
        const int p = c.tid >> 3, n0 = (c.tid & 7) * 16;
        float acc[16];
#pragma unroll
        for (int j = 0; j < 16; ++j) acc[j] = 0.f;
        for (int l = 0; l < 128; ++l) {
            const bf16_t* row = XBCC + (size_t)(t0 + l) * 1536;
            const float xv = bf2f(row[h * 64 + p]) * wl[l];
            const u32x4 b0 = *(const u32x4*)(row + 1024 + g * 128 + n0), b1 = *(const u32x4*)(row + 1024 + g * 128 + n0 + 8);
            acc[0] += xv * bflo(b0.x); acc[1] += xv * bfhi(b0.x); acc[2] += xv * bflo(b0.y); acc[3] += xv * bfhi(b0.y);
            acc[4] += xv * bflo(b0.z); acc[5] += xv * bfhi(b0.z); acc[6] += xv * bflo(b0.w); acc[7] += xv * bfhi(b0.w);
            acc[8] += xv * bflo(b1.x); acc[9] += xv * bfhi(b1.x); acc[10] += xv * bflo(b1.y); acc[11] += xv * bfhi(b1.y);
            acc[12] += xv * bflo(b1.z); acc[13] += xv * bfhi(b1.z); acc[14] += xv * bflo(b1.w); acc[15] += xv * bfhi(b1.w);
        }
        float* o = STATES + ((size_t)item * 64 + p) * 128 + n0;
#pragma unroll
        for (int j = 0; j < 4; ++j) *(f32x4*)(o + 4 * j) = (f32x4){acc[4 * j], acc[4 * j + 1], acc[4 * j + 2], acc[4 * j + 3]};
    }
    __syncthreads();
}

__device__ __forceinline__ void step_scan(const Ctx& c) {
    const float* STATES = WSP(float, WS_STATES); const float* ACUM = WSP(float, WS_ACUM); bf16_t* PREVB = WSP(bf16_t, WS_PREVB);
    for (int idx = c.gt; idx < NB * NH * 64 * 32; idx += c.ngt) {
        const int n4 = idx & 31, p = (idx >> 5) & 63, h = (idx >> 11) & 15, b = idx >> 15;
        f32x4 carry_ = {0.f, 0.f, 0.f, 0.f};
#pragma unroll
        for (int half = 0; half < 2; ++half) {
            f32x4 st[16]; float dec[16];
#pragma unroll
            for (int j = 0; j < 16; ++j) { const size_t it = (size_t)(b * NCH + half * 16 + j) * NH + h; st[j] = *(const f32x4*)(STATES + (it * 64 + p) * 128 + n4 * 4); dec[j] = ACUM[it * 128 + 127]; }
            static_assert(NCH == 32, "two halves of 16 chunks");
            f32x4 hs = half == 0 ? (f32x4){0.f, 0.f, 0.f, 0.f} : carry_;
#pragma unroll
            for (int j = 0; j < 16; ++j) { const size_t it = (size_t)(b * NCH + half * 16 + j) * NH + h;
                *(u32x2*)(PREVB + (it * 64 + p) * 128 + n4 * 4) = (u32x2){pk2(hs.x, hs.y), pk2(hs.z, hs.w)};
                hs = hs * expf(dec[j]) + st[j]; }
            carry_ = hs;
        }
    }
}

__device__ __forceinline__ void step_cb_simple(const Ctx& c) {
    const bf16_t* XBCC = WSP(bf16_t, WS_XBCC); float* G = WSP(float, WS_STATES);
    for (int idx = c.gt; idx < NB * NCH * 2 * 128 * 128; idx += c.ngt) {
        const int s = idx & 127, l = (idx >> 7) & 127, g = (idx >> 14) & 1, bc = idx >> 15, t0 = bc * 128;
        const bf16_t* Cr = XBCC + (size_t)(t0 + l) * 1536 + 1280 + g * 128; const bf16_t* Br = XBCC + (size_t)(t0 + s) * 1536 + 1024 + g * 128;
        float sum = 0.f;
#pragma unroll 4
        for (int n = 0; n < 128; n += 8) sum += dot8(*(const u32x4*)(Cr + n), *(const u32x4*)(Br + n));
        G[idx] = sum;
    }
}

__device__ __forceinline__ void step_ssd2_simple(const Ctx& c) {
    const bf16_t* XBCC = WSP(bf16_t, WS_XBCC); const bf16_t* PROJ = WSP(bf16_t, WS_PROJ); const bf16_t* PREVB = WSP(bf16_t, WS_PREVB);
    const float* DT = WSP(float, WS_DT); const float* ACUM = WSP(float, WS_ACUM); const float* G = WSP(float, WS_STATES);
    bf16_t* YCAT = WSP(bf16_t, WS_ACT); float* SSP = WSP(float, WS_SSP);
    LAS float* ac = (LAS float*)c.lds; LAS float* dl = ac + 128;
    for (int item = blockIdx.x; item < NB * NCH * NH; item += gridDim.x) {
        const int bc = item / NH, h = item % NH, g = h >> 3, t0 = bc * 128;
        __syncthreads();
        if (c.tid < 128) { ac[c.tid] = ACUM[(size_t)item * 128 + c.tid]; dl[c.tid] = DT[(size_t)item * 128 + c.tid]; }
        __syncthreads();
        const int l = c.tid >> 2, p0 = (c.tid & 3) * 16, t = t0 + l;
        float acc[16];
#pragma unroll
        for (int j = 0; j < 16; ++j) acc[j] = 0.f;
        {
            const bf16_t* Cr = XBCC + (size_t)t * 1536 + 1280 + g * 128; const bf16_t* Pr = PREVB + ((size_t)item * 64 + p0) * 128;
            for (int n = 0; n < 128; n += 8) {
                const u32x4 cv = *(const u32x4*)(Cr + n);
#pragma unroll
                for (int j = 0; j < 16; ++j) acc[j] += dot8(cv, *(const u32x4*)(Pr + j * 128 + n));
            }
            const float el = expf(ac[l]);
#pragma unroll
            for (int j = 0; j < 16; ++j) acc[j] *= el;
        }
        const float al = ac[l]; const float* Gr = G + ((size_t)(bc * 2 + g) * 128 + l) * 128;
        for (int s = 0; s <= l; ++s) {
            const float coef = Gr[s] * expf(al - ac[s]) * dl[s];
            const bf16_t* xr = XBCC + (size_t)(t0 + s) * 1536 + h * 64 + p0;
            const u32x4 x0 = *(const u32x4*)xr, x1 = *(const u32x4*)(xr + 8);
            acc[0] += coef * bflo(x0.x); acc[1] += coef * bfhi(x0.x); acc[2] += coef * bflo(x0.y); acc[3] += coef * bfhi(x0.y);
            acc[4] += coef * bflo(x0.z); acc[5] += coef * bfhi(x0.z); acc[6] += coef * bflo(x0.w); acc[7] += coef * bfhi(x0.w);
            acc[8] += coef * bflo(x1.x); acc[9] += coef * bfhi(x1.x); acc[10] += coef * bflo(x1.y); acc[11] += coef * bfhi(x1.y);
            acc[12] += coef * bflo(x1.z); acc[13] += coef * bfhi(x1.z); acc[14] += coef * bflo(x1.w); acc[15] += coef * bfhi(x1.w);
        }
        {
            const bf16_t* xr = XBCC + (size_t)t * 1536 + h * 64 + p0; const bf16_t* zr = PROJ + (size_t)t * DINP + Z_OFF + h * 64 + p0;
            const float dsk = IN_DSKIP[h]; float ss = 0.f; unsigned ow[8];
#pragma unroll
            for (int j = 0; j < 16; j += 2) {
                const unsigned xw = *(const unsigned*)(xr + j), zw = *(const unsigned*)(zr + j);
                const float y0 = (acc[j] + dsk * bflo(xw)) * silu_f(bflo(zw)), y1 = (acc[j + 1] + dsk * bfhi(xw)) * silu_f(bfhi(zw));
                ss += y0 * y0 + y1 * y1; ow[j >> 1] = pk2(y0, y1);
            }
            bf16_t* o = YCAT + (size_t)t * D + h * 64 + p0;
            *(u32x4*)o = (u32x4){ow[0], ow[1], ow[2], ow[3]}; *(u32x4*)(o + 8) = (u32x4){ow[4], ow[5], ow[6], ow[7]};
            ss += __shfl_xor(ss, 1); ss += __shfl_xor(ss, 2);
            if ((c.tid & 3) == 0) SSP[(size_t)t * 32 + h] = ss;
        }
    }
    __syncthreads();
}

__device__ __forceinline__ void step_att_simple(const Ctx& c) {
    const bf16_t* PROJ = WSP(bf16_t, WS_PROJ); bf16_t* YCAT = WSP(bf16_t, WS_ACT); float* SSP = WSP(float, WS_SSP);
    for (int idx = c.gt; idx < T * 16; idx += c.ngt) {
        const int t = idx >> 4, hd = idx & 15, kvh = hd >> 3, pos = t & (SEQ - 1);
        float q[64], o[64];
        {
            const bf16_t* qr = PROJ + (size_t)t * DINP + Q_OFF + hd * 64;
#pragma unroll
            for (int d = 0; d < 64; d += 8) { const u32x4 v = *(const u32x4*)(qr + d);
                q[d] = 0.125f * bflo(v.x); q[d + 1] = 0.125f * bfhi(v.x); q[d + 2] = 0.125f * bflo(v.y); q[d + 3] = 0.125f * bfhi(v.y);
                q[d + 4] = 0.125f * bflo(v.z); q[d + 5] = 0.125f * bfhi(v.z); q[d + 6] = 0.125f * bflo(v.w); q[d + 7] = 0.125f * bfhi(v.w); }
        }
#pragma unroll
        for (int d = 0; d < 64; ++d) o[d] = 0.f;
        float m = IN_SINKS[hd], den = 1.f;
        const int j0 = pos - 127 > 0 ? pos - 127 : 0;
        for (int kp = j0; kp <= pos; ++kp) {
            const size_t tk = (size_t)(t - pos + kp);
            const bf16_t* kr = PROJ + tk * DINP + K_OFF + kvh * 64; const bf16_t* vr = PROJ + tk * DINP + V_OFF + kvh * 64;
            float s = 0.f;
#pragma unroll
            for (int d = 0; d < 64; d += 8) { const u32x4 v = *(const u32x4*)(kr + d);
                s += q[d] * bflo(v.x) + q[d + 1] * bfhi(v.x) + q[d + 2] * bflo(v.y) + q[d + 3] * bfhi(v.y) + q[d + 4] * bflo(v.z) + q[d + 5] * bfhi(v.z) + q[d + 6] * bflo(v.w) + q[d + 7] * bfhi(v.w); }
            if (s > m) { const float sc = expf(m - s); den *= sc;
#pragma unroll
                for (int d = 0; d < 64; ++d) o[d] *= sc;
                m = s; }
            const float p = expf(s - m); den += p;
#pragma unroll
            for (int d = 0; d < 64; d += 8) { const u32x4 v = *(const u32x4*)(vr + d);
                o[d] += p * bflo(v.x); o[d + 1] += p * bfhi(v.x); o[d + 2] += p * bflo(v.y); o[d + 3] += p * bfhi(v.y);
                o[d + 4] += p * bflo(v.z); o[d + 5] += p * bfhi(v.z); o[d + 6] += p * bflo(v.w); o[d + 7] += p * bfhi(v.w); }
        }
        const float inv = 1.f / den; float ss = 0.f;
        bf16_t* orow = YCAT + (size_t)t * D + 1024 + hd * 64;
#pragma unroll
        for (int d = 0; d < 64; d += 8) {
            float r[8];
#pragma unroll
            for (int e = 0; e < 8; ++e) { r[e] = o[d + e] * inv; ss += r[e] * r[e]; }
            *(u32x4*)(orow + d) = (u32x4){pk2(r[0], r[1]), pk2(r[2], r[3]), pk2(r[4], r[5]), pk2(r[6], r[7])};
        }
        SSP[(size_t)t * 32 + 16 + hd] = ss;
    }
}

__device__ __forceinline__ bf16x8v ld_frag16(const void* p) { return __builtin_bit_cast(bf16x8v, *(const u32x4*)p); }
__device__ __forceinline__ bf16x8v lds_frag16(const LAS unsigned char* p) { return __builtin_bit_cast(bf16x8v, *(const LAS u32x4*)p); }
__device__ __forceinline__ f32x16 zero16() { f32x16 z;
#pragma unroll
    for (int r = 0; r < 16; ++r) z[r] = 0.f;
    return z; }
#define MFMA32(a, b, c) __builtin_amdgcn_mfma_f32_32x32x16_bf16((a), (b), (c), 0, 0, 0)
__device__ __forceinline__ bf16x8v acc_frag(const f32x16& x, int ks2) {
    u32x4 w; w.x = cvtpk(x[8 * ks2 + 0], x[8 * ks2 + 1]); w.y = cvtpk(x[8 * ks2 + 2], x[8 * ks2 + 3]); w.z = cvtpk(x[8 * ks2 + 4], x[8 * ks2 + 5]); w.w = cvtpk(x[8 * ks2 + 6], x[8 * ks2 + 7]);
    return __builtin_bit_cast(bf16x8v, w);
}

__device__ __forceinline__ void step_dta(const Ctx& c) {
    const float* DTRAW = WSP(float, WS_DTRAW); float* DT = WSP(float, WS_DT); float* ACUM = WSP(float, WS_ACUM);
    for (int idx = c.gw; idx < NB * NCH * NH; idx += c.ngw) {
        const int h = idx % NH, bc = idx / NH, t0 = bc * 128, l0 = 2 * c.lane;
        const float A = -expf(IN_ALOG[h]), bias = IN_DTBIAS[h];
        const float d0 = softplus_f(DTRAW[(size_t)(t0 + l0) * 16 + h] + bias), d1 = softplus_f(DTRAW[(size_t)(t0 + l0 + 1) * 16 + h] + bias);
        const float a0 = d0 * A, a1 = d1 * A; float x = a0 + a1;
#pragma unroll
        for (int o = 1; o < 64; o <<= 1) { const float v = __shfl_up(x, o); if (c.lane >= o) x += v; }
        const float ex = x - (a0 + a1);
        *(f32x2*)(DT + (size_t)idx * 128 + l0) = (f32x2){d0, d1};
        *(f32x2*)(ACUM + (size_t)idx * 128 + l0) = (f32x2){ex + a0, ex + a0 + a1};
    }
}
__device__ __forceinline__ void step_conv_only(const Ctx& c) {
    const bf16_t* PROJ = WSP(bf16_t, WS_PROJ); bf16_t* XBCC = WSP(bf16_t, WS_XBCC);
    for (int idx = c.gt; idx < (T / 8) * 384; idx += c.ngt) {
        const int rb = idx / 384, ch = (idx % 384) * 4, t0 = rb * 8, pos0 = t0 & (SEQ - 1);
        f32x4 w[4];
#pragma unroll
        for (int j = 0; j < 4; ++j) w[j] = *(const f32x4*)(IN_CONVW + j * 1536 + ch);
        const f32x4 bias = *(const f32x4*)(IN_CONVB + ch);
        f32x4 xr[11];
#pragma unroll
        for (int i = 0; i < 11; ++i) {
            if (pos0 - 3 + i >= 0) { const u32x2 v = *(const u32x2*)(PROJ + (size_t)(t0 - 3 + i) * DINP + XBC_OFF + ch); xr[i] = (f32x4){bflo(v.x), bfhi(v.x), bflo(v.y), bfhi(v.y)}; }
            else xr[i] = (f32x4){0.f, 0.f, 0.f, 0.f};
        }
#pragma unroll
        for (int r = 0; r < 8; ++r) {
            const f32x4 a = bias + w[0] * xr[r] + w[1] * xr[r + 1] + w[2] * xr[r + 2] + w[3] * xr[r + 3];
            *(u32x2*)(XBCC + (size_t)(t0 + r) * 1536 + ch) = (u32x2){cvtpk(silu_f(a.x), silu_f(a.y)), cvtpk(silu_f(a.z), silu_f(a.w))};
        }
    }
}

__device__ __forceinline__ void step_ssd1_fast(const Ctx& c) {
    const bf16_t* XBCC = WSP(bf16_t, WS_XBCC); const float* DT = WSP(float, WS_DT); const float* ACUM = WSP(float, WS_ACUM); float* STATES = WSP(float, WS_STATES);
    LAS unsigned char* Bl = c.lds;
    LAS unsigned char* Xl = c.lds + 32768;
    LAS float* wl = (LAS float*)(c.lds + 65536);
    const int lane = c.lane, col = lane & 31, hh = lane >> 5, pt = c.wave >> 2, nt = c.wave & 3;
    for (int item = blockIdx.x; item < NB * NCH * 2; item += gridDim.x) {
        const int bc = item >> 1, g = item & 1, t0 = bc * 128;
        __syncthreads();
        for (int i = c.tid; i < 128 * 16; i += NTHR) { const int l = i >> 4, ch = i & 15;
            *(LAS u32x4*)(Bl + l * 256 + ch * 16) = *(const u32x4*)(XBCC + (size_t)(t0 + l) * 1536 + 1024 + g * 128 + ch * 8); }
        for (int i = c.tid; i < 8 * 128; i += NTHR) { const int r = i >> 7, l = i & 127; const size_t o = ((size_t)bc * 16 + g * 8 + r) * 128;
            wl[i] = expf(ACUM[o + 127] - ACUM[o + l]) * DT[o + l]; }
        __syncthreads();
#define SSD1_STAGE(r_) { _Pragma("unroll") for (int q_ = 0; q_ < 2; ++q_) { const int i_ = c.tid + q_ * NTHR, l_ = i_ >> 3, ch_ = i_ & 7; \
            const u32x4 v_ = *(const u32x4*)(XBCC + (size_t)(t0 + l_) * 1536 + (g * 8 + (r_)) * 64 + ch_ * 8); const float w_ = wl[(r_) * 128 + l_]; \
            u32x4 o_; o_.x = cvtpk(bflo(v_.x) * w_, bfhi(v_.x) * w_); o_.y = cvtpk(bflo(v_.y) * w_, bfhi(v_.y) * w_); o_.z = cvtpk(bflo(v_.z) * w_, bfhi(v_.z) * w_); o_.w = cvtpk(bflo(v_.w) * w_, bfhi(v_.w) * w_); \
            *(LAS u32x4*)(Xl + ((r_) & 1) * 16384 + l_ * 128 + ch_ * 16) = o_; } }
        SSD1_STAGE(0);
        __syncthreads();
        for (int r = 0; r < 8; ++r) {
            if (r + 1 < 8) SSD1_STAGE(r + 1);
            const LAS unsigned char* xb = Xl + (r & 1) * 16384 + (pt * 32 + col) * 2; const LAS unsigned char* bb = Bl + (nt * 32 + col) * 2;
            f32x16 acc = zero16();
#pragma unroll
            for (int ks = 0; ks < 8; ++ks) {
                bf16x8v af, bf;
#pragma unroll
                for (int j = 0; j < 8; ++j) { const int l = 16 * ks + 8 * hh + j; af[j] = *(const LAS short*)(xb + l * 128); bf[j] = *(const LAS short*)(bb + l * 256); }
                acc = MFMA32(af, bf, acc);
            }
            float* o = STATES + (((size_t)bc * 16 + g * 8 + r) * 64 + pt * 32) * 128 + nt * 32 + col;
#pragma unroll
            for (int rr = 0; rr < 16; ++rr) o[(size_t)((rr & 3) + 8 * (rr >> 2) + 4 * hh) * 128] = acc[rr];
            __syncthreads();
        }
#undef SSD1_STAGE
    }
    __syncthreads();
}

#define TABH_SRC(r_) ((r_) < 16384 ? IN_U + (size_t)(r_) * D : IN_V + (size_t)((r_) - 16384) * D)
#define TABH_FINISH(rowv, r_) { if ((r_) < 16384) fp8_row_finish<SLICED_PEER != 0>(rowv, WSP(unsigned char, WS_UB), (r_), WSP(float, WS_SCU) + (r_), c.lane); \
        else fp8_row_finish<(SLICED_PEER != 0) && (V_INT8 != 0)>(rowv, WSP(unsigned char, WS_VB), (r_) - 16384, WSP(float, WS_SCV) + ((r_) - 16384), c.lane); }
#define TABH_TICK() { if (HIDE_TABLES) { if (tabr < 2 * 16384) { TABH_FINISH(tabv, tabr); } tabr += c.ngw; if (tabr < 2 * 16384) fp8_row_load(tabv, TABH_SRC(tabr), c.lane); } }
__device__ __forceinline__ void step_ssd2_fast(const Ctx& c) {
    const bf16_t* XBCC = WSP(bf16_t, WS_XBCC); const bf16_t* PROJ = WSP(bf16_t, WS_PROJ); const bf16_t* PREVB = WSP(bf16_t, WS_PREVB);
    const float* DT = WSP(float, WS_DT); const float* ACUM = WSP(float, WS_ACUM); bf16_t* YCAT = WSP(bf16_t, WS_ACT); float* SSP = WSP(float, WS_SSP);
    const int lane = c.lane, col = lane & 31, hh = lane >> 5;
    LAS unsigned char* Xw = c.lds + c.wave * 16384;
    LAS float* ac = (LAS float*)(c.lds + 131072 + c.wave * 1024); LAS float* dl = ac + 128;
    f32x4 tabv[8]; int tabr = c.gw;
    if (HIDE_TABLES && tabr < 2 * 16384) fp8_row_load(tabv, TABH_SRC(tabr), c.lane);
    for (int item = blockIdx.x; item < NB * NCH * 2; item += gridDim.x) {
        const int bc = item >> 1, g = item & 1, t0 = bc * 128, hd = g * 8 + c.wave; const size_t ih = (size_t)bc * 16 + hd;
        asm volatile("s_waitcnt lgkmcnt(0)" ::: "memory");
#pragma unroll 4
        for (int i = lane; i < 128 * 8; i += 64) { const int srow = i >> 3, ch = i & 7;
            *(LAS u32x4*)(Xw + srow * 128 + ch * 16) = *(const u32x4*)(XBCC + (size_t)(t0 + srow) * 1536 + hd * 64 + ch * 8); }
        ac[lane] = ACUM[ih * 128 + lane]; ac[lane + 64] = ACUM[ih * 128 + 64 + lane]; dl[lane] = DT[ih * 128 + lane]; dl[lane + 64] = DT[ih * 128 + 64 + lane];
        asm volatile("s_waitcnt vmcnt(0) lgkmcnt(0)" ::: "memory");
        const float dsk = IN_DSKIP[hd];
#pragma unroll 1
        for (int lt = 0; lt < 4; ++lt) {
            const int l = lt * 32 + col, t = t0 + l;
            bf16x8v cf[8], pf0[8], pf1[8];
            const bf16_t* cp = XBCC + (size_t)t * 1536 + 1280 + g * 128 + hh * 8;
            const bf16_t* pp0 = PREVB + (ih * 64 + col) * 128 + hh * 8; const bf16_t* pp1 = pp0 + 32 * 128;
#pragma unroll
            for (int ks = 0; ks < 8; ++ks) { cf[ks] = ld_frag16(cp + ks * 16); pf0[ks] = ld_frag16(pp0 + ks * 16); pf1[ks] = ld_frag16(pp1 + ks * 16); }
            TABH_TICK();
            f32x16 acc[2]; acc[0] = zero16(); acc[1] = zero16();
#pragma unroll
            for (int ks = 0; ks < 8; ++ks) { acc[0] = MFMA32(pf0[ks], cf[ks], acc[0]); acc[1] = MFMA32(pf1[ks], cf[ks], acc[1]); }
            const float al = ac[l], el = expf(al);
#pragma unroll
            for (int p2 = 0; p2 < 2; ++p2)
#pragma unroll
                for (int r = 0; r < 16; ++r) acc[p2][r] *= el;
#pragma unroll 1
            for (int st = 0; st <= lt; ++st) {
                bf16x8v bfr[8];
                const bf16_t* bp = XBCC + (size_t)(t0 + st * 32 + col) * 1536 + 1024 + g * 128 + hh * 8;
#pragma unroll
                for (int ks = 0; ks < 8; ++ks) bfr[ks] = ld_frag16(bp + ks * 16);
                if (st == 0 || st == lt || (lt == 3 && st == 1)) { TABH_TICK(); }
                f32x16 gt = zero16();
#pragma unroll
                for (int ks = 0; ks < 8; ++ks) gt = MFMA32(bfr[ks], cf[ks], gt);
#pragma unroll
                for (int g4 = 0; g4 < 4; ++g4) {
                    const int sl0 = 8 * g4 + 4 * hh;
                    const f32x4 as = *(const LAS f32x4*)(ac + st * 32 + sl0), ds = *(const LAS f32x4*)(dl + st * 32 + sl0);
#pragma unroll
                    for (int e = 0; e < 4; ++e) {
                        const bool ok = (st < lt) || (sl0 + e <= col);
                        gt[4 * g4 + e] = ok ? gt[4 * g4 + e] * expf(al - as[e]) * ds[e] : 0.f;
                    }
                }
                const bf16x8v w0 = acc_frag(gt, 0), w1 = acc_frag(gt, 1);
#pragma unroll
                for (int p2 = 0; p2 < 2; ++p2) {
                    const LAS unsigned char* xb = Xw + (p2 * 32 + col) * 2 + (st * 32 + 4 * hh) * 128;
                    bf16x8v x0, x1;
#pragma unroll
                    for (int j = 0; j < 8; ++j) { const int srow = 8 * (j >> 2) + (j & 3); x0[j] = *(const LAS short*)(xb + srow * 128); x1[j] = *(const LAS short*)(xb + (16 + srow) * 128); }
                    acc[p2] = MFMA32(x0, w0, acc[p2]); acc[p2] = MFMA32(x1, w1, acc[p2]);
                }
            }
            u32x2 zw[2][4];
#pragma unroll
            for (int p2 = 0; p2 < 2; ++p2)
#pragma unroll
                for (int g4 = 0; g4 < 4; ++g4) zw[p2][g4] = *(const u32x2*)(PROJ + (size_t)t * DINP + Z_OFF + hd * 64 + p2 * 32 + 8 * g4 + 4 * hh);
            TABH_TICK();
            float ss = 0.f;
#pragma unroll
            for (int p2 = 0; p2 < 2; ++p2)
#pragma unroll
                for (int g4 = 0; g4 < 4; ++g4) {
                    const int p0 = p2 * 32 + 8 * g4 + 4 * hh;
                    const u32x2 xw = *(const LAS u32x2*)(Xw + l * 128 + p0 * 2), z2 = zw[p2][g4];
                    const float y0 = (acc[p2][4 * g4 + 0] + dsk * bflo(xw.x)) * silu_f(bflo(z2.x)), y1 = (acc[p2][4 * g4 + 1] + dsk * bfhi(xw.x)) * silu_f(bfhi(z2.x));
                    const float y2 = (acc[p2][4 * g4 + 2] + dsk * bflo(xw.y)) * silu_f(bflo(z2.y)), y3 = (acc[p2][4 * g4 + 3] + dsk * bfhi(xw.y)) * silu_f(bfhi(z2.y));
                    ss += (y0 * y0 + y1 * y1) + (y2 * y2 + y3 * y3);
                    *(u32x2*)(YCAT + (size_t)t * D + hd * 64 + p0) = (u32x2){cvtpk(y0, y1), cvtpk(y2, y3)};
                }
            ss += __shfl_xor(ss, 32);
            if (hh == 0) SSP[(size_t)t * 32 + hd] = ss;
        }
    }
    if (HIDE_TABLES) { while (tabr < 2 * 16384) { TABH_TICK(); } }
    __syncthreads();
}

__device__ __forceinline__ void step_att_fast(const Ctx& c) {
    const bf16_t* PROJ = WSP(bf16_t, WS_PROJ); bf16_t* YCAT = WSP(bf16_t, WS_ACT); float* SSP = WSP(float, WS_SSP);
    const int lane = c.lane, col = lane & 31, hh = lane >> 5;
    LAS unsigned char* Kl = c.lds;
    LAS unsigned char* Vt = c.lds + 256 * 144;
    const float NEG = -__builtin_huge_valf();
    for (int item = blockIdx.x; item < NB * NCH * 2; item += gridDim.x) {
        const int kvh = item & 1, nblk = (item >> 1) & 31, b = item >> 6, tq0 = b * SEQ + nblk * 128, tk0 = tq0 - 128;
        __syncthreads();
        for (int i = c.tid; i < 256 * 8; i += NTHR) {
            const int kj = i >> 3, ch = i & 7;
            if (nblk > 0 || kj >= 128) {
                const bf16_t* src = PROJ + (size_t)(tk0 + kj) * DINP + kvh * 64 + ch * 8;
                *(LAS u32x4*)(Kl + kj * 144 + ch * 16) = *(const u32x4*)(src + K_OFF);
                const u32x4 v = *(const u32x4*)(src + V_OFF);
                LAS unsigned char* vp = Vt + (ch * 8) * 520 + kj * 2;
                *(LAS unsigned short*)(vp + 0 * 520) = (unsigned short)(v.x & 0xffff); *(LAS unsigned short*)(vp + 1 * 520) = (unsigned short)(v.x >> 16);
                *(LAS unsigned short*)(vp + 2 * 520) = (unsigned short)(v.y & 0xffff); *(LAS unsigned short*)(vp + 3 * 520) = (unsigned short)(v.y >> 16);
                *(LAS unsigned short*)(vp + 4 * 520) = (unsigned short)(v.z & 0xffff); *(LAS unsigned short*)(vp + 5 * 520) = (unsigned short)(v.z >> 16);
                *(LAS unsigned short*)(vp + 6 * 520) = (unsigned short)(v.w & 0xffff); *(LAS unsigned short*)(vp + 7 * 520) = (unsigned short)(v.w >> 16);
            }
        }
        __syncthreads();
        const int hd = kvh * 8 + c.wave; const float sink = IN_SINKS[hd];
        for (int qt = 0; qt < 4; ++qt) {
            const int tq = tq0 + qt * 32 + col;
            bf16x8v qf[4];
#pragma unroll
            for (int ks = 0; ks < 4; ++ks) qf[ks] = ld_frag16(PROJ + (size_t)tq * DINP + Q_OFF + hd * 64 + ks * 16 + hh * 8);
            f32x16 S[5]; float m = sink;
#pragma unroll
            for (int jj = 0; jj < 5; ++jj) {
                const int j = qt + jj;
                if (nblk == 0 && j < 4) {
#pragma unroll
                    for (int r = 0; r < 16; ++r) S[jj][r] = NEG;
                } else {
                    f32x16 a = zero16();
#pragma unroll
                    for (int ks = 0; ks < 4; ++ks) a = MFMA32(lds_frag16(Kl + (j * 32 + col) * 144 + ks * 32 + hh * 16), qf[ks], a);
#pragma unroll
                    for (int r = 0; r < 16; ++r) {
                        const int kl = (r & 3) + 8 * (r >> 2) + 4 * hh;
                        float sv = a[r] * 0.125f;
                        if (jj == 0) sv = (kl > col) ? sv : NEG;
                        if (jj == 4) sv = (kl <= col) ? sv : NEG;
                        S[jj][r] = sv; m = fmaxf(m, sv);
                    }
                }
            }
            m = fmaxf(m, __shfl_xor(m, 32));
            float lsum = 0.f;
#pragma unroll
            for (int jj = 0; jj < 5; ++jj)
#pragma unroll
                for (int r = 0; r < 16; ++r) { const float p = expf(S[jj][r] - m); S[jj][r] = p; lsum += p; }
            lsum += __shfl_xor(lsum, 32); lsum += expf(sink - m);
            f32x16 O[2]; O[0] = zero16(); O[1] = zero16();
#pragma unroll
            for (int jj = 0; jj < 5; ++jj) {
                const int j = qt + jj;
                if (!(nblk == 0 && j < 4)) {
#pragma unroll
                    for (int ks2 = 0; ks2 < 2; ++ks2) {
                        const bf16x8v pf = acc_frag(S[jj], ks2);
#pragma unroll
                        for (int d2 = 0; d2 < 2; ++d2) {
                            const LAS unsigned char* vp = Vt + (d2 * 32 + col) * 520 + (j * 32 + 16 * ks2 + 4 * hh) * 2;
                            const u32x2 v0 = *(const LAS u32x2*)vp, v1 = *(const LAS u32x2*)(vp + 16);
                            O[d2] = MFMA32(__builtin_bit_cast(bf16x8v, ((u32x4){v0.x, v0.y, v1.x, v1.y})), pf, O[d2]);
                        }
                    }
                }
            }
            const float inv = 1.f / lsum; float ss = 0.f;
#pragma unroll
            for (int d2 = 0; d2 < 2; ++d2)
#pragma unroll
                for (int g4 = 0; g4 < 4; ++g4) {
                    const float o0 = O[d2][4 * g4] * inv, o1 = O[d2][4 * g4 + 1] * inv, o2 = O[d2][4 * g4 + 2] * inv, o3 = O[d2][4 * g4 + 3] * inv;
                    ss += (o0 * o0 + o1 * o1) + (o2 * o2 + o3 * o3);
                    *(u32x2*)(YCAT + (size_t)tq * D + 1024 + hd * 64 + d2 * 32 + 8 * g4 + 4 * hh) = (u32x2){cvtpk(o0, o1), cvtpk(o2, o3)};
                }
            ss += __shfl_xor(ss, 32);
            if (hh == 0) SSP[(size_t)tq * 32 + 16 + hd] = ss;
        }
    }
    __syncthreads();
}

__device__ __forceinline__ void step_rs(const Ctx& c) {
    const float* SSP = WSP(float, WS_SSP); float* RS = WSP(float, WS_RS);
    for (int t = c.gt; t < T; t += c.ngt) {
        float s1 = 0.f, s2 = 0.f;
#pragma unroll
        for (int j = 0; j < 4; ++j) { const f32x4 a = *(const f32x4*)(SSP + (size_t)t * 32 + 4 * j), b = *(const f32x4*)(SSP + (size_t)t * 32 + 16 + 4 * j);
            s1 += (a.x + a.y) + (a.z + a.w); s2 += (b.x + b.y) + (b.z + b.w); }
        const float r1 = rsqrtf(s1 * (1.f / 1024.f) + EPS), r2 = rsqrtf(s2 * (1.f / 1024.f) + EPS);
        RS[2 * t] = r1 / r2; RS[2 * t + 1] = r2;
    }
}

__device__ __forceinline__ void step_ln1(const Ctx& c) {
    const float* MOD = WSP(float, WS_MOD); bf16_t* H2 = WSP(bf16_t, WS_ACT); const bf16_t* GB = WSP(bf16_t, WS_R1B); bf16_t* X1B = WSP(bf16_t, WS_X1B); unsigned char* H2Q = WSP(unsigned char, WS_H2Q); float* HS = WSP(float, WS_HS);
    f32x4 xc[8], xn[8]; u32x2 gc[8], gn[8];
    int t = c.gw;
#define LN1_LOAD(xa, ga, tok) { _Pragma("unroll") for (int j_ = 0; j_ < 8; ++j_) { xa[j_] = *(const f32x4*)(IN_X + (size_t)(tok) * D + j_ * 256 + c.lane * 4); ga[j_] = *(const u32x2*)(GB + (size_t)(tok) * D + j_ * 256 + c.lane * 4); } }
    if (t < T) LN1_LOAD(xc, gc, t);
    for (; t < T; t += c.ngw) {
        const int tn = t + c.ngw;
        if (tn < T) LN1_LOAD(xn, gn, tn);
        const int b = t >> 12;
        f32x4 v[8]; float s = 0.f;
#pragma unroll
        for (int j = 0; j < 8; ++j) { v[j] = xc[j] * ALPHA + (f32x4){bflo(gc[j].x), bfhi(gc[j].x), bflo(gc[j].y), bfhi(gc[j].y)}; s += (v[j].x + v[j].y) + (v[j].z + v[j].w); }
        const float mean = wave_sum_all(s) * (1.f / D); float s2 = 0.f;
#pragma unroll
        for (int j = 0; j < 8; ++j) { v[j] = v[j] - mean; s2 += (v[j].x * v[j].x + v[j].y * v[j].y) + (v[j].z * v[j].z + v[j].w * v[j].w); }
        const float rstd = rsqrtf(wave_sum_all(s2) * (1.f / D) + EPS);
        const float* sh = MOD + b * NMOD + 3 * D; const float* sc = MOD + b * NMOD + 4 * D; float hmax = 0.f;
#pragma unroll
        for (int j = 0; j < 8; ++j) {
            const int col = j * 256 + c.lane * 4;
            const f32x4 g = *(const f32x4*)(IN_LN1G + col), bb = *(const f32x4*)(IN_LN1B + col), s_ = *(const f32x4*)(sc + col), h_ = *(const f32x4*)(sh + col);
            const f32x4 x1 = v[j] * rstd * g + bb;
            *(u32x2*)(X1B + (size_t)t * D + col) = (u32x2){cvtpk(x1.x, x1.y), cvtpk(x1.z, x1.w)};
            const f32x4 h2v = x1 * (s_ + 1.f) + h_;
            if (!(I8_GEMM3 && FAST_GEMM)) *(u32x2*)(H2 + (size_t)t * D + col) = (u32x2){cvtpk(h2v.x, h2v.y), cvtpk(h2v.z, h2v.w)};
            v[j] = h2v; hmax = fmaxf(hmax, fmaxf(fmaxf(fabsf(h2v.x), fabsf(h2v.y)), fmaxf(fabsf(h2v.z), fabsf(h2v.w))));
        }
        {
            hmax = DPPMAX(hmax, 0xB1); hmax = DPPMAX(hmax, 0x4E); hmax = DPPMAX(hmax, 0x141); hmax = DPPMAX(hmax, 0x140);
            const unsigned a0 = __builtin_amdgcn_readlane(__float_as_uint(hmax), 0), a1 = __builtin_amdgcn_readlane(__float_as_uint(hmax), 16);
            const unsigned a2 = __builtin_amdgcn_readlane(__float_as_uint(hmax), 32), a3 = __builtin_amdgcn_readlane(__float_as_uint(hmax), 48);
            const unsigned m01 = a0 > a1 ? a0 : a1, m23 = a2 > a3 ? a2 : a3; const float am = __uint_as_float(m01 > m23 ? m01 : m23);
            const float inv = am > 0.f ? 127.f / am : 0.f;
#pragma unroll
            for (int j = 0; j < 8; ++j) *(unsigned*)(H2Q + (size_t)t * D + j * 256 + c.lane * 4) = pack_i8x4(v[j] * inv);
            if (c.lane == 0) HS[t] = am * (1.f / 127.f);
        }
#pragma unroll
        for (int j = 0; j < 8; ++j) { xc[j] = xn[j]; gc[j] = gn[j]; }
    }
#undef LN1_LOAD
}

__device__ __forceinline__ void argmax_bfly(float& bv, int& bi) {
#pragma unroll
    for (int off = 32; off >= 1; off >>= 1) {
        const float ov = __shfl_xor(bv, off); const int oi = __shfl_xor(bi, off);
        if (ov > bv || (ov == bv && oi < bi)) { bv = ov; bi = oi; }
    }
}
__device__ __forceinline__ void step_topk_simple(const Ctx& c) {
    const bf16_t* Q = WSP(bf16_t, WS_PROJ); const bf16_t* KEYS = WSP(bf16_t, WS_KEYS); int* EXPERT = WSP(int, WS_EXP); float* GATE = WSP(float, WS_GATE);
    const int lane = c.lane; const float NEG = -__builtin_huge_valf();
    for (int item = c.gw; item < T * 8; item += c.ngw) {
        const int t = item >> 3, h = item & 7;
        const bf16_t* qrow = Q + (size_t)t * D + h * 256;
        float tv[2] = {0.f, 0.f}; int ti[2] = {0, 0};
#pragma unroll
        for (int cc = 0; cc < 2; ++cc) {
            float v0 = 0.f, v1 = 0.f;
            const bf16_t* k0 = KEYS + ((size_t)(h * 2 + cc) * 128 + lane) * 128; const bf16_t* k1 = k0 + 64 * 128;
            for (int d = 0; d < 128; d += 8) { const u32x4 qv = *(const u32x4*)(qrow + cc * 128 + d); v0 += dot8(qv, *(const u32x4*)(k0 + d)); v1 += dot8(qv, *(const u32x4*)(k1 + d)); }
            for (int r = 0; r < 16; ++r) {
                float bv = v0; int bi = lane; if (v1 > bv) { bv = v1; bi = lane + 64; }
                argmax_bfly(bv, bi);
                if (lane == r) { tv[cc] = bv; ti[cc] = bi; }
                if (bi == lane) v0 = NEG; if (bi == lane + 64) v1 = NEG;
            }
        }
        float cv[4]; const int ci0 = lane * 4;
#pragma unroll
        for (int q = 0; q < 4; ++q) { const int ci = ci0 + q; cv[q] = __shfl(tv[0], ci >> 4) + __shfl(tv[1], ci & 15); }
        float bestv = 0.f; int bestp = 0;
        for (int r = 0; r < 16; ++r) {
            float bv = cv[0]; int bi = ci0;
#pragma unroll
            for (int q = 1; q < 4; ++q) if (cv[q] > bv) { bv = cv[q]; bi = ci0 + q; }
            argmax_bfly(bv, bi);
            if (lane == r) { bestv = bv; bestp = bi; }
#pragma unroll
            for (int q = 0; q < 4; ++q) if (bi == ci0 + q) cv[q] = NEG;
        }
        const float mx = __shfl(bestv, 0);
        const float e = lane < 16 ? expf(bestv - mx) : 0.f; const float ssum = wave_sum(e);
        const int e0 = __shfl(ti[0], bestp >> 4), e1 = __shfl(ti[1], bestp & 15);
        if (lane < 16) { EXPERT[(size_t)item * 16 + lane] = e0 * 128 + e1; GATE[(size_t)item * 16 + lane] = e / ssum; }
    }
}

#define TK_CE(a, b) { const int t_ = max(a, b); b = min(a, b); a = t_; }
__device__ __forceinline__ int tk_mono(float x) { int b = __float_as_int(x); return b ^ ((b >> 31) & 0x7fffffff); }
__device__ __forceinline__ float tk_val(int key, int mask) { int b = key & ~mask; b ^= (b >> 31) & 0x7fffffff; return __int_as_float(b); }
__device__ __forceinline__ void tk_sort16(int (&k)[16]) {
#pragma unroll
    for (int size = 2; size <= 16; size <<= 1)
#pragma unroll
        for (int stride = size >> 1; stride > 0; stride >>= 1)
#pragma unroll
            for (int i = 0; i < 16; ++i) { const int j = i ^ stride; if (j > i) { if ((i & size) == 0) TK_CE(k[i], k[j]) else TK_CE(k[j], k[i]) } }
}
__device__ __forceinline__ void tk_clean16(int (&k)[16]) {
#pragma unroll
    for (int stride = 8; stride > 0; stride >>= 1)
#pragma unroll
        for (int i = 0; i < 16; ++i) { const int j = i ^ stride; if (j > i) TK_CE(k[i], k[j]) }
}
__device__ __forceinline__ void tk_merge16(int (&a)[16], const int (&b)[16]) {
#pragma unroll
    for (int i = 0; i < 16; ++i) a[i] = max(a[i], b[15 - i]);
    tk_clean16(a);
}
__device__ __forceinline__ void topk_groups(const Ctx& c, const int h, const int grp_first, const int grp_end, const int grp_step) {
    const bf16_t* Q = WSP(bf16_t, WS_PROJ); const bf16_t* KEYS = WSP(bf16_t, WS_KEYS); int* EXPERT = WSP(int, WS_EXP); float* GATE = WSP(float, WS_GATE);
    const int lane = c.lane, col = lane & 31, hh = lane >> 5;
    constexpr int KP = 272;
    LAS unsigned char* kl = c.lds;
    LAS int* tab = (LAS int*)(c.lds + 256 * KP) + c.wave * (32 * 33);
    __syncthreads();
    for (int i = c.tid; i < 256 * 16; i += NTHR) { const int r = i >> 4, ch = i & 15;
        *(LAS u32x4*)(kl + r * KP + ch * 16) = *(const u32x4*)(KEYS + ((size_t)h * 256 + r) * 128 + ch * 8); }
    __syncthreads();
    const int INTMIN = (int)0x80000000;
    for (int grp = grp_first; grp < grp_end; grp += grp_step) {
        const int t0 = grp * 32;
        int top[2][16];
#pragma unroll
        for (int cc = 0; cc < 2; ++cc) {
            bf16x8v qf[8];
            const bf16_t* qp = Q + (size_t)(t0 + col) * D + h * 256 + cc * 128 + hh * 8;
#pragma unroll
            for (int ks = 0; ks < 8; ++ks) qf[ks] = __builtin_bit_cast(bf16x8v, *(const u32x4*)(qp + ks * 16));
            int k[4][16];
#pragma unroll
            for (int nt = 0; nt < 4; ++nt) {
                f32x16 acc;
#pragma unroll
                for (int r = 0; r < 16; ++r) acc[r] = 0.f;
#pragma unroll
                for (int ks = 0; ks < 8; ++ks) {
                    const bf16x8v af = __builtin_bit_cast(bf16x8v, *(const LAS u32x4*)(kl + (cc * 128 + nt * 32 + col) * KP + ks * 32 + hh * 16));
                    acc = __builtin_amdgcn_mfma_f32_32x32x16_bf16(af, qf[ks], acc, 0, 0, 0);
                }
#pragma unroll
                for (int r = 0; r < 16; ++r) k[nt][r] = (tk_mono(acc[r]) & ~127) | (nt * 32 + (r & 3) + 8 * (r >> 2) + 4 * hh);
                tk_sort16(k[nt]);
            }
            tk_merge16(k[0], k[1]); tk_merge16(k[2], k[3]); tk_merge16(k[0], k[2]);
            int p[16];
#pragma unroll
            for (int i = 0; i < 16; ++i) p[i] = __shfl_xor(k[0][15 - i], 32);
#pragma unroll
            for (int i = 0; i < 16; ++i) k[0][i] = max(k[0][i], p[i]);
            tk_clean16(k[0]);
#pragma unroll
            for (int i = 0; i < 16; ++i) top[cc][i] = k[0][i];
        }
        if (hh == 0) {
#pragma unroll
            for (int i = 0; i < 16; ++i) { tab[col * 33 + i] = top[0][i] & 127; tab[col * 33 + 16 + i] = top[1][i] & 127; }
        }
        float va[16], vb[16];
#pragma unroll
        for (int i = 0; i < 16; ++i) { va[i] = tk_val(top[0][i], 127); vb[i] = tk_val(top[1][i], 127); }
#define TK_CAND(i, j) ((tk_mono(va[i] + vb[j]) & ~255) | ((i) * 16 + (j)))
        int m[16], l1[16], l3[16], l4[16];
#pragma unroll
        for (int j = 0; j < 16; ++j) m[j] = TK_CAND(0, j);
#pragma unroll
        for (int j = 0; j < 8; ++j) l1[j] = TK_CAND(1, j);
#pragma unroll
        for (int j = 8; j < 16; ++j) l1[j] = INTMIN;
        tk_merge16(m, l1);
        l3[0] = TK_CAND(2, 0); l3[1] = TK_CAND(2, 1); l3[2] = TK_CAND(2, 2); l3[3] = TK_CAND(2, 3); l3[4] = TK_CAND(2, 4);
        l3[5] = TK_CAND(3, 0); l3[6] = TK_CAND(3, 1); l3[7] = TK_CAND(3, 2); l3[8] = TK_CAND(3, 3);
        l3[9] = TK_CAND(4, 0); l3[10] = TK_CAND(4, 1); l3[11] = TK_CAND(4, 2);
        l3[12] = TK_CAND(5, 0); l3[13] = TK_CAND(5, 1); l3[14] = TK_CAND(6, 0); l3[15] = TK_CAND(6, 1);
        tk_sort16(l3); tk_merge16(m, l3);
        l4[0] = TK_CAND(7, 0); l4[1] = TK_CAND(7, 1);
#pragma unroll
        for (int i = 8; i < 16; ++i) l4[i - 6] = TK_CAND(i, 0);
#pragma unroll
        for (int i = 10; i < 16; ++i) l4[i] = INTMIN;
        tk_sort16(l4); tk_merge16(m, l4);
#undef TK_CAND
        float ev[16]; float ssum = 0.f; const float mx = tk_val(m[0], 255);
#pragma unroll
        for (int r = 0; r < 16; ++r) { ev[r] = expf(tk_val(m[r], 255) - mx); ssum += ev[r]; }
        const float inv = 1.f / ssum;
#if SLICED_PEER
        const size_t ob = (size_t)(t0 + col) * 128 + 2 * h;
        if (hh == 0) {
            int eo[16];
#pragma unroll
            for (int r = 0; r < 16; ++r) { const int code = m[r] & 255; eo[r] = tab[col * 33 + (code >> 4)] * 128 + tab[col * 33 + 16 + (code & 15)]; }
#pragma unroll
            for (int g = 0; g < 8; ++g) *(u32x2*)(EXPERT + ob + g * 16) = (u32x2){(unsigned)eo[g], (unsigned)eo[g + 8]};
        } else {
#pragma unroll
            for (int g = 0; g < 8; ++g) *(f32x2*)(GATE + ob + g * 16) = (f32x2){ev[g] * inv, ev[g + 8] * inv};
        }
#else
        const size_t ob = ((size_t)(t0 + col) * 8 + h) * 16;
        if (hh == 0) {
            int eo[16];
#pragma unroll
            for (int r = 0; r < 16; ++r) { const int code = m[r] & 255; eo[r] = tab[col * 33 + (code >> 4)] * 128 + tab[col * 33 + 16 + (code & 15)]; }
#pragma unroll
            for (int q = 0; q < 4; ++q) *(u32x4*)(EXPERT + ob + 4 * q) = (u32x4){(unsigned)eo[4 * q], (unsigned)eo[4 * q + 1], (unsigned)eo[4 * q + 2], (unsigned)eo[4 * q + 3]};
        } else {
#pragma unroll
            for (int q = 0; q < 4; ++q) *(f32x4*)(GATE + ob + 4 * q) = (f32x4){ev[4 * q] * inv, ev[4 * q + 1] * inv, ev[4 * q + 2] * inv, ev[4 * q + 3] * inv};
        }
#endif
    }
    __syncthreads();
}

__device__ __forceinline__ void step_topk_fast(const Ctx& c) {
    const int nper = (int)gridDim.x >> 3;
    topk_groups(c, (int)blockIdx.x & 7, (int)(blockIdx.x >> 3) + nper * c.wave, T / 32, nper * NWAVES);
}

#define PEER_LOAD(buf, TAB, kbase) { _Pragma("unroll") for (int u_ = 0; u_ < 4; ++u_) { const int k_ = (kbase) + u_; \
        const int e_ = __builtin_amdgcn_readlane(k_ < 64 ? er0 : er1, k_ & 63); const unsigned char* rp_ = (TAB) + (size_t)e_ * D + lane * 16; \
        buf[u_][0] = *(const u32x4*)rp_; buf[u_][1] = *(const u32x4*)(rp_ + 1024); } }
#define PEER_DOT(buf, kbase) { _Pragma("unroll") for (int u_ = 0; u_ < 4; ++u_) { f32x2 a2_ = {0.f, 0.f}; \
        _Pragma("unroll") for (int j_ = 0; j_ < 2; ++j_) _Pragma("unroll") for (int q_ = 0; q_ < 4; ++q_) { const int w_ = (int)buf[u_][j_][q_]; \
            a2_ += __builtin_amdgcn_cvt_pk_f32_fp8(w_, false) * hh[j_ * 8 + q_ * 2]; a2_ += __builtin_amdgcn_cvt_pk_f32_fp8(w_, true) * hh[j_ * 8 + q_ * 2 + 1]; } \
        const float tot_ = lane63(wave_sum63(a2_.x + a2_.y)); const int k_ = (kbase) + u_; \
        if (k_ < 64) ar0 = (lane == k_) ? tot_ : ar0; else ar1 = (lane == k_ - 64) ? tot_ : ar1; } }
#define PEER_AXPY(buf, kbase) { _Pragma("unroll") for (int u_ = 0; u_ < 4; ++u_) { const int k_ = (kbase) + u_; \
        const float w1_ = __int_as_float(__builtin_amdgcn_readlane(__float_as_int(k_ < 64 ? wr0 : wr1), k_ & 63)); const f32x2 ww_ = {w1_, w1_}; \
        _Pragma("unroll") for (int j_ = 0; j_ < 2; ++j_) _Pragma("unroll") for (int q_ = 0; q_ < 4; ++q_) { const int w_ = (int)buf[u_][j_][q_]; \
            yy[j_ * 8 + q_ * 2] += __builtin_amdgcn_cvt_pk_f32_fp8(w_, false) * ww_; yy[j_ * 8 + q_ * 2 + 1] += __builtin_amdgcn_cvt_pk_f32_fp8(w_, true) * ww_; } } }
__device__ __forceinline__ void step_peer(const Ctx& c) {
    const bf16_t* H2 = WSP(bf16_t, WS_ACT); const unsigned char* U8 = WSP(unsigned char, WS_UB); const unsigned char* V8 = WSP(unsigned char, WS_VB);
    const float* SCU = WSP(float, WS_SCU); const float* SCV = WSP(float, WS_SCV);
    const int* EXPERT = WSP(int, WS_EXP); const float* GATE = WSP(float, WS_GATE); const float* MOD = WSP(float, WS_MOD);
    const int lane = c.lane;
    for (int t = c.gw; t < T; t += c.ngw) {
        const int er0 = EXPERT[(size_t)t * 128 + lane], er1 = EXPERT[(size_t)t * 128 + 64 + lane];
        const float gr0 = GATE[(size_t)t * 128 + lane], gr1 = GATE[(size_t)t * 128 + 64 + lane];
        const float su0 = SCU[er0], su1 = SCU[er1], sv0 = SCV[er0], sv1 = SCV[er1];
        f32x2 hh[16];
#pragma unroll
        for (int j = 0; j < 2; ++j)
#pragma unroll
            for (int q = 0; q < 2; ++q) { const u32x4 v = *(const u32x4*)(H2 + (size_t)t * D + j * 1024 + lane * 16 + q * 8);
                hh[j * 8 + q * 4 + 0] = (f32x2){bflo(v.x), bfhi(v.x)}; hh[j * 8 + q * 4 + 1] = (f32x2){bflo(v.y), bfhi(v.y)};
                hh[j * 8 + q * 4 + 2] = (f32x2){bflo(v.z), bfhi(v.z)}; hh[j * 8 + q * 4 + 3] = (f32x2){bflo(v.w), bfhi(v.w)}; }
        float ar0 = 0.f, ar1 = 0.f;
        u32x4 A[4][2], B[4][2];
        PEER_LOAD(A, U8, 0);
        for (int kb = 0; kb < 128; kb += 8) {
            PEER_LOAD(B, U8, kb + 4);
            PEER_DOT(A, kb);
            if (kb + 8 < 128) PEER_LOAD(A, U8, kb + 8) else PEER_LOAD(A, V8, 0);
            PEER_DOT(B, kb + 4);
        }
        const float wr0 = gr0 * gelu_f(ar0 * su0) * sv0, wr1 = gr1 * gelu_f(ar1 * su1) * sv1;
        f32x2 yy[16];
#pragma unroll
        for (int i = 0; i < 16; ++i) yy[i] = (f32x2){0.f, 0.f};
        for (int kb = 0; kb < 128; kb += 8) {
            PEER_LOAD(B, V8, kb + 4);
            PEER_AXPY(A, kb);
            if (kb + 8 < 128) PEER_LOAD(A, V8, kb + 8);
            PEER_AXPY(B, kb + 4);
        }
        const int b = t >> 12; float* row = c.out + (size_t)t * D; const float* g2 = MOD + b * NMOD + 5 * D;
        float s = 0.f;
#pragma unroll
        for (int j = 0; j < 2; ++j)
#pragma unroll
            for (int q = 0; q < 4; ++q) {
                const int col = j * 1024 + lane * 16 + q * 4; const f32x4 xv = *(const f32x4*)(row + col), gv = *(const f32x4*)(g2 + col);
                f32x2& y0 = yy[j * 8 + q * 2]; f32x2& y1 = yy[j * 8 + q * 2 + 1];
                y0.x = ALPHA * xv.x + gv.x * y0.x; y0.y = ALPHA * xv.y + gv.y * y0.y; y1.x = ALPHA * xv.z + gv.z * y1.x; y1.y = ALPHA * xv.w + gv.w * y1.y;
                s += (y0.x + y0.y) + (y1.x + y1.y);
            }
        const float mean = wave_sum(s) * (1.f / D); float s2 = 0.f;
#pragma unroll
        for (int i = 0; i < 16; ++i) { yy[i] = yy[i] - mean; s2 += yy[i].x * yy[i].x + yy[i].y * yy[i].y; }
        const float rstd = rsqrtf(wave_sum(s2) * (1.f / D) + EPS);
#pragma unroll
        for (int j = 0; j < 2; ++j)
#pragma unroll
            for (int q = 0; q < 4; ++q) {
                const int col = j * 1024 + lane * 16 + q * 4; const f32x4 g = *(const f32x4*)(IN_LN2G + col), bb = *(const f32x4*)(IN_LN2B + col);
                const f32x2 y0 = yy[j * 8 + q * 2], y1 = yy[j * 8 + q * 2 + 1];
                *(f32x4*)(row + col) = (f32x4){y0.x * rstd * g.x + bb.x, y0.y * rstd * g.y + bb.y, y1.x * rstd * g.z + bb.z, y1.y * rstd * g.w + bb.w};
            }
    }
}

struct XcdPlace { int nloc, nx, xrank, rank; };
__device__ __forceinline__ float reduce8(float v) { v += DPPF(v, 0xB1); v += DPPF(v, 0x4E); v += DPPF(v, 0x141); return v; }
struct Sel8 { unsigned long long m1, m2, m4; };
__device__ __forceinline__ float cnd(float a, float b, unsigned long long m) { float r; asm("v_cndmask_b32 %0, %1, %2, %3" : "=v"(r) : "v"(a), "v"(b), "s"(m)); return r; }
__device__ __forceinline__ float sel8(const Sel8& S, float p0, float p1, float p2, float p3, float p4, float p5, float p6, float p7) {
    const float a0 = cnd(p0, p1, S.m1), a1 = cnd(p2, p3, S.m1), a2 = cnd(p4, p5, S.m1), a3 = cnd(p6, p7, S.m1);
    return cnd(cnd(a0, a1, S.m2), cnd(a2, a3, S.m2), S.m4);
}
#define PS_GATHER(buf, ids, tabp) { _Pragma("unroll") for (int q_ = 0; q_ < 4; ++q_) { \
        buf[4 * q_ + 0] = *(const u32x4*)((tabp) + (ids[q_].x * 128u + c16)); buf[4 * q_ + 1] = *(const u32x4*)((tabp) + (ids[q_].y * 128u + c16)); \
        buf[4 * q_ + 2] = *(const u32x4*)((tabp) + (ids[q_].z * 128u + c16)); buf[4 * q_ + 3] = *(const u32x4*)((tabp) + (ids[q_].w * 128u + c16)); } }
#define PS_IDS(ids, tok) { _Pragma("unroll") for (int q_ = 0; q_ < 4; ++q_) ids[q_] = *(const u32x4*)(EP + (size_t)(tok) * 128 + g * 16 + q_ * 4); }
__device__ __forceinline__ int cndi(int a, int b, unsigned long long m) { int r; asm("v_cndmask_b32 %0, %1, %2, %3" : "=v"(r) : "v"(a), "v"(b), "s"(m)); return r; }
__device__ __forceinline__ int sel8i(const Sel8& S, int p0, int p1, int p2, int p3, int p4, int p5, int p6, int p7) {
    const int a0 = cndi(p0, p1, S.m1), a1 = cndi(p2, p3, S.m1), a2 = cndi(p4, p5, S.m1), a3 = cndi(p6, p7, S.m1);
    return cndi(cndi(a0, a1, S.m2), cndi(a2, a3, S.m2), S.m4);
}
#define DPPI(v, ctrl) __builtin_amdgcn_update_dpp(0, (v), (ctrl), 0xF, 0xF, true)
__device__ __forceinline__ int reduce8i(int v) { v += DPPI(v, 0xB1); v += DPPI(v, 0x4E); v += DPPI(v, 0x141); return v; }
#define PU_PROCESS(buf, tok) { \
        const u32x4 hq_ = *(const u32x4*)(H2Q + (size_t)(tok) * D + slice * 128 + c16); \
        int p_[16]; \
        _Pragma("unroll") for (int i_ = 0; i_ < 16; ++i_) { int a_ = __builtin_amdgcn_sdot4((int)buf[i_].x, (int)hq_.x, 0, false); \
            a_ = __builtin_amdgcn_sdot4((int)buf[i_].y, (int)hq_.y, a_, false); a_ = __builtin_amdgcn_sdot4((int)buf[i_].z, (int)hq_.z, a_, false); a_ = __builtin_amdgcn_sdot4((int)buf[i_].w, (int)hq_.w, a_, false); \
            p_[i_] = reduce8i(a_); } \
        const int lo_ = sel8i(SL, p_[0], p_[1], p_[2], p_[3], p_[4], p_[5], p_[6], p_[7]), hi_ = sel8i(SL, p_[8], p_[9], p_[10], p_[11], p_[12], p_[13], p_[14], p_[15]); \
        if (PART16) {   \
            PARTA[((size_t)slice * T + (tok)) * 64 + lane] = (int)((((unsigned)(lo_ + 32) >> 6) & 0xffffu) | ((unsigned)((hi_ + 32) >> 6) << 16)); \
        } else { int* o_ = PARTA + ((size_t)slice * T + (tok)) * 128 + g * 16 + c8; o_[0] = lo_; o_[8] = hi_; } }
__device__ __forceinline__ void step_peer_u(const Ctx& c, const XcdPlace& P) {
    const unsigned char* H2Q = WSP(unsigned char, WS_H2Q); const unsigned char* U8 = WSP(unsigned char, WS_UB); const int* EP = WSP(int, WS_EXP); int* PARTA = WSP(int, WS_PARTA);
    const int lane = c.lane, g = lane >> 3, c8 = lane & 7, wid = P.rank * NWAVES + c.wave, nw = P.nloc * NWAVES;
    const Sel8 SL{__ballot((c8 & 1) != 0), __ballot((c8 & 2) != 0), __ballot((c8 & 4) != 0)};
    const unsigned c16 = (unsigned)c8 * 16u;
    for (int slice = P.xrank; slice < 16; slice += P.nx) {
        const unsigned char* ub = U8 + (size_t)slice * 16384 * 128;
        u32x4 idn[4]; u32x4 A[16], B[16];
        int t = wid;
        if (t < T) { PS_IDS(idn, t); PS_GATHER(A, idn, ub); }
        if (t + nw < T) { PS_IDS(idn, t + nw); PS_GATHER(B, idn, ub); }
        for (; t < T; t += 2 * nw) {
            if (t + 2 * nw < T) PS_IDS(idn, t + 2 * nw);
            PU_PROCESS(A, t);
            if (t + 2 * nw < T) { PS_GATHER(A, idn, ub); }
            if (t + nw < T) {
                if (t + 3 * nw < T) PS_IDS(idn, t + 3 * nw);
                PU_PROCESS(B, t + nw);
                if (t + 3 * nw < T) { PS_GATHER(B, idn, ub); }
            }
        }
    }
}
#if V_INT8
__device__ __forceinline__ void step_peer_w(const Ctx& c) {
    const int* PARTA = WSP(int, WS_PARTA); const int* EP = WSP(int, WS_EXP); const float* G = WSP(float, WS_GATE); unsigned* W8 = WSP(unsigned, WS_W8);
    const float* SCU = WSP(float, WS_SCU); const float* SCV = WSP(float, WS_SCV); const float* HS = WSP(float, WS_HS); float* WSC = WSP(float, WS_WS);
    const int g = c.lane >> 3, c8 = c.lane & 7, i0 = g * 16 + c8, i1 = i0 + 8;
    for (int t = c.gw; t < T; t += c.ngw) {
        int a0 = 0, a1 = 0;
#if PART16
#pragma unroll
        for (int sl = 0; sl < 16; ++sl) { const int p = PARTA[((size_t)sl * T + t) * 64 + c.lane]; a0 += (int)(short)(p & 0xffff); a1 += p >> 16; }
        const float descale = 64.f;
#else
#pragma unroll
        for (int sl = 0; sl < 16; ++sl) { a0 += PARTA[((size_t)sl * T + t) * 128 + i0]; a1 += PARTA[((size_t)sl * T + t) * 128 + i1]; }
        const float descale = 1.f;
#endif
        const size_t base = (size_t)t * 128;
        const int e0 = EP[base + i0], e1 = EP[base + i1]; const float g0 = G[base + i0], g1 = G[base + i1], hs = HS[t] * descale;
        const float w0 = g0 * gelu_f((float)a0 * (SCU[e0] * hs)) * SCV[e0], w1 = g1 * gelu_f((float)a1 * (SCU[e1] * hs)) * SCV[e1];
        float am = fmaxf(fabsf(w0), fabsf(w1));
        am = DPPMAX(am, 0xB1); am = DPPMAX(am, 0x4E); am = DPPMAX(am, 0x141); am = DPPMAX(am, 0x140);
        const unsigned m0 = __builtin_amdgcn_readlane(__float_as_uint(am), 0), m1 = __builtin_amdgcn_readlane(__float_as_uint(am), 16), m2 = __builtin_amdgcn_readlane(__float_as_uint(am), 32), m3 = __builtin_amdgcn_readlane(__float_as_uint(am), 48);
        const unsigned m01 = m0 > m1 ? m0 : m1, m23 = m2 > m3 ? m2 : m3; am = __uint_as_float(m01 > m23 ? m01 : m23);
        const float inv = am > 0.f ? 127.f / am : 0.f;
        const int q0 = (int)__builtin_rintf(w0 * inv) & 0xff, q1 = (int)__builtin_rintf(w1 * inv) & 0xff;
        const int pk = q0 | (q1 << 8);
        const int b0 = DPPI(pk, 0x00), b1 = DPPI(pk, 0x55), b2 = DPPI(pk, 0xAA), b3 = DPPI(pk, 0xFF);
        const unsigned dlo = (unsigned)(b0 & 0xff) | ((unsigned)(b1 & 0xff) << 8) | ((unsigned)(b2 & 0xff) << 16) | ((unsigned)(b3 & 0xff) << 24);
        const unsigned dhi = ((unsigned)(b0 >> 8) & 0xff) | (((unsigned)(b1 >> 8) & 0xff) << 8) | (((unsigned)(b2 >> 8) & 0xff) << 16) | (((unsigned)(b3 >> 8) & 0xff) << 24);
        if ((c.lane & 3) == 0) { W8[(size_t)t * 32 + g * 4 + (c8 >> 2)] = dlo; W8[(size_t)t * 32 + g * 4 + 2 + (c8 >> 2)] = dhi; }
        if (c.lane == 0) WSC[t] = am * (1.f / 127.f);
    }
}
#else
__device__ __forceinline__ void step_peer_w(const Ctx& c) {
    const int* PARTA = WSP(int, WS_PARTA); const int* EP = WSP(int, WS_EXP); float* GW = WSP(float, WS_GATE); const float* SCU = WSP(float, WS_SCU); const float* SCV = WSP(float, WS_SCV); const float* HS = WSP(float, WS_HS);
    for (int idx = c.gt; idx < T * 128; idx += c.ngt) {
        int a = 0;
#pragma unroll
        for (int sl = 0; sl < 16; ++sl) a += PARTA[(size_t)sl * T * 128 + idx];
        const int e = EP[idx];
        GW[idx] = GW[idx] * gelu_f((float)a * (SCU[e] * HS[idx >> 7])) * SCV[e];
    }
}
#endif
#if V_INT8
#define PV_PROCESS(buf, tok) { \
        const u32x4 wq_ = *(const u32x4*)(W8 + (size_t)(tok) * 32 + g * 4); const float wsc_ = WSC[tok]; \
        int acc_[16]; _Pragma("unroll") for (int q_ = 0; q_ < 16; ++q_) acc_[q_] = 0; \
        _Pragma("unroll") for (int j_ = 0; j_ < 4; ++j_) { const int w4_ = (int)wq_[j_]; \
            _Pragma("unroll") for (int q_ = 0; q_ < 4; ++q_) { \
                const unsigned a_ = buf[4 * j_][q_], b_ = buf[4 * j_ + 1][q_], c_ = buf[4 * j_ + 2][q_], d_ = buf[4 * j_ + 3][q_]; \
                const unsigned tl_ = __builtin_amdgcn_perm(b_, a_, 0x05010400u), th_ = __builtin_amdgcn_perm(b_, a_, 0x07030602u); \
                const unsigned ul_ = __builtin_amdgcn_perm(d_, c_, 0x05010400u), uh_ = __builtin_amdgcn_perm(d_, c_, 0x07030602u); \
                acc_[4 * q_ + 0] = __builtin_amdgcn_sdot4((int)__builtin_amdgcn_perm(ul_, tl_, 0x05040100u), w4_, acc_[4 * q_ + 0], false); \
                acc_[4 * q_ + 1] = __builtin_amdgcn_sdot4((int)__builtin_amdgcn_perm(ul_, tl_, 0x07060302u), w4_, acc_[4 * q_ + 1], false); \
                acc_[4 * q_ + 2] = __builtin_amdgcn_sdot4((int)__builtin_amdgcn_perm(uh_, th_, 0x05040100u), w4_, acc_[4 * q_ + 2], false); \
                acc_[4 * q_ + 3] = __builtin_amdgcn_sdot4((int)__builtin_amdgcn_perm(uh_, th_, 0x07060302u), w4_, acc_[4 * q_ + 3], false); } } \
        int p_[16]; \
        _Pragma("unroll") for (int q_ = 0; q_ < 16; ++q_) p_[q_] = acc_[q_] + DPPI(acc_[q_], 0x128); \
        int q8_[8]; \
        _Pragma("unroll") for (int k_ = 0; k_ < 8; ++k_) { const auto r_ = __builtin_amdgcn_permlane16_swap((unsigned)p_[k_], (unsigned)p_[k_ + 8], false, false); q8_[k_] = (int)r_[0] + (int)r_[1]; } \
        int r4_[4]; \
        _Pragma("unroll") for (int k_ = 0; k_ < 4; ++k_) { const auto r_ = __builtin_amdgcn_permlane32_swap((unsigned)q8_[k_], (unsigned)q8_[k_ + 4], false, false); r4_[k_] = (int)r_[0] + (int)r_[1]; } \
        if ((lane & 8) == 0) *(u32x2*)(Y + (size_t)(tok) * D + slice * 128 + ocol) = (u32x2){cvtpk((float)r4_[0] * wsc_, (float)r4_[1] * wsc_), cvtpk((float)r4_[2] * wsc_, (float)r4_[3] * wsc_)}; }
#else
#define PV_PROCESS(buf, tok) { \
        f32x4 wv_[4]; _Pragma("unroll") for (int q_ = 0; q_ < 4; ++q_) wv_[q_] = *(const f32x4*)(GW + (size_t)(tok) * 128 + g * 16 + q_ * 4); \
        f32x2 acc_[8]; _Pragma("unroll") for (int q_ = 0; q_ < 8; ++q_) acc_[q_] = (f32x2){0.f, 0.f}; \
        _Pragma("unroll") for (int i_ = 0; i_ < 16; ++i_) { const float w1_ = wv_[i_ >> 2][i_ & 3]; const f32x2 ww_ = {w1_, w1_}; \
            _Pragma("unroll") for (int q_ = 0; q_ < 4; ++q_) { const int w_ = (int)buf[i_][q_]; acc_[2 * q_] += __builtin_amdgcn_cvt_pk_f32_fp8(w_, false) * ww_; acc_[2 * q_ + 1] += __builtin_amdgcn_cvt_pk_f32_fp8(w_, true) * ww_; } } \
        float p_[16]; \
        _Pragma("unroll") for (int q_ = 0; q_ < 8; ++q_) { p_[2 * q_] = acc_[q_].x + DPPF(acc_[q_].x, 0x128); p_[2 * q_ + 1] = acc_[q_].y + DPPF(acc_[q_].y, 0x128); } \
        float q8_[8]; \
        _Pragma("unroll") for (int k_ = 0; k_ < 8; ++k_) { const auto r_ = __builtin_amdgcn_permlane16_swap(__float_as_uint(p_[k_]), __float_as_uint(p_[k_ + 8]), false, false); q8_[k_] = __uint_as_float(r_[0]) + __uint_as_float(r_[1]); } \
        float r4_[4]; \
        _Pragma("unroll") for (int k_ = 0; k_ < 4; ++k_) { const auto r_ = __builtin_amdgcn_permlane32_swap(__float_as_uint(q8_[k_]), __float_as_uint(q8_[k_ + 4]), false, false); r4_[k_] = __uint_as_float(r_[0]) + __uint_as_float(r_[1]); } \
        if ((lane & 8) == 0) *(u32x2*)(Y + (size_t)(tok) * D + slice * 128 + ocol) = (u32x2){cvtpk(r4_[0], r4_[1]), cvtpk(r4_[2], r4_[3])}; }
#endif
__device__ __forceinline__ void step_peer_v(const Ctx& c, const XcdPlace& P) {
    const unsigned char* V8 = WSP(unsigned char, WS_VB); const int* EP = WSP(int, WS_EXP); const float* GW = WSP(float, WS_GATE); bf16_t* Y = WSP(bf16_t, WS_Y);
    const unsigned* W8 = WSP(unsigned, WS_W8); const float* WSC = WSP(float, WS_WS); (void)GW; (void)W8; (void)WSC;
    const int lane = c.lane, g = lane >> 3, c8 = lane & 7, wid = P.rank * NWAVES + c.wave, nw = P.nloc * NWAVES;
    const int ocol = c8 * 16 + 8 * ((lane >> 4) & 1) + 4 * (lane >> 5);
    const unsigned c16 = (unsigned)c8 * 16u;
    for (int slice = P.xrank; slice < 16; slice += P.nx) {
        const unsigned char* vb = V8 + (size_t)slice * 16384 * 128;
        u32x4 idn[4]; u32x4 A[16], B[16];
        int t = wid;
        if (t < T) { PS_IDS(idn, t); PS_GATHER(A, idn, vb); }
        if (t + nw < T) { PS_IDS(idn, t + nw); PS_GATHER(B, idn, vb); }
        for (; t < T; t += 2 * nw) {
            if (t + 2 * nw < T) PS_IDS(idn, t + 2 * nw);
            PV_PROCESS(A, t);
            if (t + 2 * nw < T) { PS_GATHER(A, idn, vb); }
            if (t + nw < T) {
                if (t + 3 * nw < T) PS_IDS(idn, t + 3 * nw);
                PV_PROCESS(B, t + nw);
                if (t + 3 * nw < T) { PS_GATHER(B, idn, vb); }
            }
        }
    }
}
__device__ __forceinline__ void step_ln2(const Ctx& c) {
    const float* MOD = WSP(float, WS_MOD); const bf16_t* Y = WSP(bf16_t, WS_Y); const bf16_t* X1B = WSP(bf16_t, WS_X1B);
    u32x2 xc[8], xn[8], yc[8], yn[8];
    int t = c.gw;
#define LN2_LOAD(xa, ya, tok) { _Pragma("unroll") for (int j_ = 0; j_ < 8; ++j_) { xa[j_] = *(const u32x2*)(X1B + (size_t)(tok) * D + j_ * 256 + c.lane * 4); ya[j_] = *(const u32x2*)(Y + (size_t)(tok) * D + j_ * 256 + c.lane * 4); } }
    if (t < T) LN2_LOAD(xc, yc, t);
    for (; t < T; t += c.ngw) {
        const int tn = t + c.ngw;
        if (tn < T) LN2_LOAD(xn, yn, tn);
        const int b = t >> 12; float* row = c.out + (size_t)t * D; const float* g2 = MOD + b * NMOD + 5 * D;
        f32x4 v[8]; float s = 0.f;
#pragma unroll
        for (int j = 0; j < 8; ++j) { const int col = j * 256 + c.lane * 4; const f32x4 gv = *(const f32x4*)(g2 + col); const u32x2 xw = xc[j], yw = yc[j];
            v[j] = (f32x4){ALPHA * bflo(xw.x) + gv.x * bflo(yw.x), ALPHA * bfhi(xw.x) + gv.y * bfhi(yw.x), ALPHA * bflo(xw.y) + gv.z * bflo(yw.y), ALPHA * bfhi(xw.y) + gv.w * bfhi(yw.y)};
            s += (v[j].x + v[j].y) + (v[j].z + v[j].w); }
        const float mean = wave_sum_all(s) * (1.f / D); float s2 = 0.f;
#pragma unroll
        for (int j = 0; j < 8; ++j) { v[j] = v[j] - mean; s2 += (v[j].x * v[j].x + v[j].y * v[j].y) + (v[j].z * v[j].z + v[j].w * v[j].w); }
        const float rstd = rsqrtf(wave_sum_all(s2) * (1.f / D) + EPS);
#pragma unroll
        for (int j = 0; j < 8; ++j) { const int col = j * 256 + c.lane * 4; const f32x4 gg = *(const f32x4*)(IN_LN2G + col), bb = *(const f32x4*)(IN_LN2B + col);
            *(f32x4*)(row + col) = v[j] * rstd * gg + bb; }
#pragma unroll
        for (int j = 0; j < 8; ++j) { xc[j] = xn[j]; yc[j] = yn[j]; }
    }
#undef LN2_LOAD
}

__device__ __forceinline__ void step_requant(const Ctx& c) {
    const bf16_t* YCAT = WSP(bf16_t, WS_ACT); const float* SSP = WSP(float, WS_SSP); unsigned char* A8 = WSP(unsigned char, WS_A8); float* SA2 = WSP(float, WS_SA2);
    for (int t = c.gw; t < T; t += c.ngw) {
        float s1 = 0.f, s2 = 0.f;
#pragma unroll
        for (int j = 0; j < 4; ++j) { const f32x4 a = *(const f32x4*)(SSP + (size_t)t * 32 + 4 * j), b = *(const f32x4*)(SSP + (size_t)t * 32 + 16 + 4 * j); s1 += (a.x + a.y) + (a.z + a.w); s2 += (b.x + b.y) + (b.z + b.w); }
        const float r1 = rsqrtf(s1 * (1.f / 1024.f) + EPS), r2 = rsqrtf(s2 * (1.f / 1024.f) + EPS);
        f32x4 v[8]; float am = 0.f;
#pragma unroll
        for (int j = 0; j < 8; ++j) { const u32x2 w = *(const u32x2*)(YCAT + (size_t)t * D + j * 256 + c.lane * 4); const float r = j < 4 ? r1 : r2;
            v[j] = (f32x4){bflo(w.x), bfhi(w.x), bflo(w.y), bfhi(w.y)} * r; am = fmaxf(am, fmaxf(fmaxf(fabsf(v[j].x), fabsf(v[j].y)), fmaxf(fabsf(v[j].z), fabsf(v[j].w)))); }
        am = DPPMAX(am, 0xB1); am = DPPMAX(am, 0x4E); am = DPPMAX(am, 0x141); am = DPPMAX(am, 0x140);
        const unsigned a0 = __builtin_amdgcn_readlane(__float_as_uint(am), 0), a1 = __builtin_amdgcn_readlane(__float_as_uint(am), 16), a2 = __builtin_amdgcn_readlane(__float_as_uint(am), 32), a3 = __builtin_amdgcn_readlane(__float_as_uint(am), 48);
        const unsigned m01 = a0 > a1 ? a0 : a1, m23 = a2 > a3 ? a2 : a3; am = __uint_as_float(m01 > m23 ? m01 : m23);
        const float inv = am > 0.f ? 127.f / am : 0.f;
#pragma unroll
        for (int j = 0; j < 8; ++j) *(unsigned*)(A8 + (size_t)t * D + j * 256 + c.lane * 4) = pack_i8x4(v[j] * inv);
        if (c.lane == 0) SA2[t] = am * (1.f / 127.f);
    }
}
__device__ __forceinline__ void step_wq8(const Ctx& c) {
    LAS float* scr = (LAS float*)(c.lds + c.wave * 16384);
    if (I8_GEMM3 && FAST_GEMM) { for (int it = c.gw; it < (D / 64) * (D / 32); it += c.ngw) transpose_item_i8<false>(IN_WQ, D, D, D, WSP(unsigned char, WS_WQ), WSP(unsigned, WS_CTL) + CW_AMXQ, WSP(float, WS_SWQ), scr, it, c.lane); }
    if (I8_GEMM2 && FAST_GEMM) { for (int it = c.gw; it < (D / 64) * (D / 32); it += c.ngw) transpose_item_i8<false, true>(IN_WOUT, D, D, D, WSP(unsigned char, WS_WOUT), WSP(unsigned, WS_CTL) + CW_AMXOUT, WSP(float, WS_SWOUT), scr, it, c.lane, IN_SSMG, IN_ATTG); }
    if (I8_GEMM1 && FAST_GEMM) { for (int it = c.gw; it < (D / 64) * (DINP / 32); it += c.ngw) transpose_item_i8<true>(IN_WIN, D, 3856, DINP, WSP(unsigned char, WS_WIN), WSP(unsigned, WS_CTL) + CW_AMXIN, WSP(float, WS_SWIN), scr, it, c.lane); }
}

constexpr int NSTEPS = 18;
__global__ void __launch_bounds__(NTHR, 2) fwd_kernel(Args a) {
    extern __shared__ __attribute__((aligned(16))) unsigned char lds_raw[];
    Ctx c;
#pragma unroll
    for (int i = 0; i < 22; ++i) c.in[i] = a.in[i];
    c.out = a.out; c.ws = a.ws; c.lds = (LAS unsigned char*)lds_raw;
    c.tid = threadIdx.x; c.lane = c.tid & 63; c.wave = __builtin_amdgcn_readfirstlane(c.tid >> 6);
    c.gw = blockIdx.x * NWAVES + c.wave; c.ngw = gridDim.x * NWAVES; c.gt = blockIdx.x * NTHR + c.tid; c.ngt = gridDim.x * NTHR;
    for (int u = c.tid; u < (LDS_BYTES - LDSCTL_OFF) / 4; u += NTHR) ((LAS unsigned*)(c.lds + LDSCTL_OFF))[u] = 0u;
    __syncthreads();
    const bool multi = (a.hi - a.lo) > 1;
    XcdBarrier bar; bar.bar = (unsigned*)(c.ws + WS_CTL); bar.x = 0; bar.st = (volatile LAS unsigned*)(c.lds + MISC_OFF);
    if (multi) bar = xcd_barrier_post((unsigned*)(c.ws + WS_CTL), (volatile LAS unsigned*)(c.lds + MISC_OFF));
#define STEP_IDS() { int tid_ = (int)threadIdx.x; asm volatile("" : "+v"(tid_)); c.tid = tid_; c.lane = tid_ & 63; c.gt = (int)blockIdx.x * NTHR + tid_; }
#define STEP(i, ...) if (a.lo <= (i) && (i) < a.hi) { STEP_IDS(); __VA_ARGS__; if ((REPEAT_MASK >> (i)) & 1) { xcd_barrier(bar); __VA_ARGS__; } if ((i) + 1 < a.hi) xcd_barrier(bar); }
    STEP(0, step_pro(c));
#if WQ_ONEPASS && I8_GEMM1 && I8_GEMM2 && I8_GEMM3 && FAST_GEMM
    STEP(1, step_h1(c));
#else
    STEP(1, { step_h1(c); step_wq8(c); });
#endif
#if FAST_GEMM
#define RUN_GEMM(EPI, MIDK, Aoff, Boff, N_, ...) { pg8::Gemm g{WSP(bf16_t, Aoff), WSP(bf16_t, Boff), T, N_, D}; pg8::StaticOrder S; S.init(T, N_, (int)gridDim.x, (int)blockIdx.x); \
        pg8::EpiA<EPI> E{EPI{__VA_ARGS__}}; pg8::gemm_phase<pg8::EpiA<EPI>, pg8::StaticOrder, false, true, MIDK>(c.lds, g, S, E); }
#else
#define RUN_GEMM(EPI, MIDK, Aoff, Boff, N_, ...) { EPI e{__VA_ARGS__}; gemm_simple<EPI, MIDK>(c, WSP(bf16_t, Aoff), WSP(bf16_t, Boff), T, N_, D, e); }
#endif
#if I8_GEMM1 && FAST_GEMM
    STEP(2, { pg8::Gemm g{WSP(bf16_t, WS_ACT), WSP(bf16_t, WS_WIN), T, DINP, D / 2}; pg8::StaticOrder S; S.init(T, DINP, (int)gridDim.x, (int)blockIdx.x);
        pg8::EpiA<Epi1Q, true> E{Epi1Q{WSP(bf16_t, WS_PROJ), WSP(float, WS_DTRAW), WSP(float, WS_SA1), WSP(float, WS_SWIN)}}; pg8::gemm_phase<pg8::EpiA<Epi1Q, true>, pg8::StaticOrder, false, true, false, true>(c.lds, g, S, E); });
#else
    STEP(2, RUN_GEMM(Epi1, false, WS_ACT, WS_WIN, DINP, WSP(bf16_t, WS_PROJ), WSP(float, WS_DTRAW)));
#endif
#if (FAST_MIX & 5) == 5
    STEP(3, { step_att_fast(c); step_conv_only(c); step_dta(c); });
#elif FAST_MIX & 1
    STEP(3, { step_conv_only(c); step_dta(c); });
#else
    STEP(3, step_conv(c));
#endif
#if FAST_MIX & 2
    STEP(4, step_ssd1_fast(c));
#else
    STEP(4, step_ssd1_simple(c));
#endif
#if (FAST_MIX & 5) == 5
#elif FAST_MIX & 4
    STEP(5, step_att_fast(c));
#else
    STEP(5, step_att_simple(c));
#endif
    STEP(6, step_scan(c));
#if FAST_MIX & 8
    STEP(8, step_ssd2_fast(c));
#else
    STEP(7, step_cb_simple(c));
    STEP(8, step_ssd2_simple(c));
#endif
#if I8_GEMM2 && FAST_GEMM
    STEP(9, step_requant(c));
    STEP(10, { pg8::Gemm g{WSP(bf16_t, WS_A8), WSP(bf16_t, WS_WOUT), T, D, D / 2}; pg8::StaticOrder S; S.init(T, D, (int)gridDim.x, (int)blockIdx.x);
        pg8::EpiA<Epi2Q, true> E{Epi2Q{WSP(float, WS_MOD), WSP(float, WS_SA2), WSP(float, WS_SWOUT), WSP(bf16_t, WS_R1B)}}; pg8::gemm_phase<pg8::EpiA<Epi2Q, true>, pg8::StaticOrder, false, true, false, true>(c.lds, g, S, E); });
#else
    STEP(10, RUN_GEMM(Epi2, true, WS_ACT, WS_WOUT, D, IN_X, WSP(float, WS_MOD), WSP(float, WS_SSP), WSP(bf16_t, WS_R1B)));
#endif
    STEP(11, step_ln1(c));
#if I8_GEMM3 && FAST_GEMM && FUSE_TOPK && FAST_TOPK
    STEP(12, { pg8::Gemm g{WSP(bf16_t, WS_H2Q), WSP(bf16_t, WS_WQ), T, D, D / 2}; pg8::StaticOrder S; S.init(T, D, (int)gridDim.x, (int)blockIdx.x);
        pg8::EpiA<Epi3Q, true> E{Epi3Q{WSP(bf16_t, WS_PROJ), WSP(float, WS_HS), WSP(float, WS_SWQ)}}; pg8::gemm_phase<pg8::EpiA<Epi3Q, true>, pg8::StaticOrder, false, true, false, true>(c.lds, g, S, E);
        asm volatile("s_waitcnt vmcnt(0)" ::: "memory"); __syncthreads();
        pg8::Unit u; for (int i = 0; S.next(i, u); ++i) topk_groups(c, u.pn, u.pm * 8 + c.wave, u.pm * 8 + c.wave + 1, 1); });
#else
#if I8_GEMM3 && FAST_GEMM
    STEP(12, { pg8::Gemm g{WSP(bf16_t, WS_H2Q), WSP(bf16_t, WS_WQ), T, D, D / 2}; pg8::StaticOrder S; S.init(T, D, (int)gridDim.x, (int)blockIdx.x);
        pg8::EpiA<Epi3Q, true> E{Epi3Q{WSP(bf16_t, WS_PROJ), WSP(float, WS_HS), WSP(float, WS_SWQ)}}; pg8::gemm_phase<pg8::EpiA<Epi3Q, true>, pg8::StaticOrder, false, true, false, true>(c.lds, g, S, E); });
#else
    STEP(12, RUN_GEMM(Epi3, false, WS_ACT, WS_WQ, D, WSP(bf16_t, WS_PROJ)));
#endif
#if FAST_TOPK
    STEP(13, step_topk_fast(c));
#else
    STEP(13, step_topk_simple(c));
#endif
#endif
#if SLICED_PEER
    XcdPlace P; P.nloc = (int)gridDim.x; P.nx = 1; P.xrank = 0; P.rank = (int)blockIdx.x;
    if (multi && a.lo <= 14 && 14 < a.hi) {
        unsigned* bw = (unsigned*)(c.ws + WS_CTL); const unsigned myx = xb_xcc_id();
        LAS unsigned* pl = (LAS unsigned*)(c.lds + LDSCTL_OFF + 16);
        if (c.tid == 0) pl[0] = xb_add(bw + 16384 + 64 * myx, 1u);
        __syncthreads();
        int nx = 0, xr = 0, nl = 0;
#pragma unroll
        for (int j = 0; j < 16; ++j) { const int cj = (int)xb_ld(&bw[XB_XCNT(j)]); if (cj > 0) { if (j < (int)myx) ++xr; ++nx; } if (j == (int)myx) nl = cj; }
        if (nl > 0 && nx > 0) { P.nloc = nl; P.nx = nx; P.xrank = xr; P.rank = (int)pl[0]; }
    }
    STEP(14, step_peer_u(c, P));
    STEP(15, step_peer_w(c));
    STEP(16, step_peer_v(c, P));
    STEP(17, step_ln2(c));
#else
    STEP(14, step_peer(c));
#endif
#undef STEP
}
}

extern "C" void kernel_launch(void* const* d_in, const int* in_sizes, int n_in, void* d_out, int out_size, void* d_ws, size_t ws_size, hipStream_t stream) {
    static int grid = 0;
    if (grid == 0) {
        if (n_in != 22 || in_sizes[0] != T * D || out_size != T * D || ws_size < WS_END) {
            fprintf(stderr, "kernel_launch: unexpected problem (n_in %d, in0 %d, out %d, ws %zu < %zu); nothing launched\n", n_in, n_in > 0 ? in_sizes[0] : -1, out_size, ws_size, (size_t)WS_END);
            grid = -1; return;
        }
        int dev = 0, cus = 0;
        if (hipGetDevice(&dev) != hipSuccess || hipDeviceGetAttribute(&cus, hipDeviceAttributeMultiprocessorCount, dev) != hipSuccess) { grid = -1; return; }
        if (hipFuncSetAttribute((const void*)fwd_kernel, hipFuncAttributeMaxDynamicSharedMemorySize, LDS_BYTES) != hipSuccess) { fprintf(stderr, "kernel_launch: hipFuncSetAttribute failed\n"); grid = -1; return; }
        int per_cu = 0;
        if (hipOccupancyMaxActiveBlocksPerMultiprocessor(&per_cu, (const void*)fwd_kernel, NTHR, LDS_BYTES) != hipSuccess || per_cu < 1) fprintf(stderr, "kernel_launch: occupancy query reports %d blocks per CU\n", per_cu);
        (void)hipGetLastError();
        grid = cus > 0 ? cus : 256;
    }
    if (grid < 0) return;
    (void)hipMemsetAsync((char*)d_ws + WS_CTL, 0, CTL_ZERO_BYTES, stream);
    Args a{};
    for (int i = 0; i < 22; ++i) a.in[i] = (const float*)d_in[i];
    a.out = (float*)d_out; a.ws = (unsigned char*)d_ws;
#if ONE_LAUNCH
    a.lo = 0; a.hi = NSTEPS;
    hipLaunchKernelGGL(fwd_kernel, dim3(grid), dim3(NTHR), LDS_BYTES, stream, a);
#else
    for (int i = 0; i < NSTEPS; ++i) { a.lo = i; a.hi = i + 1; hipLaunchKernelGGL(fwd_kernel, dim3(grid), dim3(NTHR), LDS_BYTES, stream, a); }
#endif
}
```

```cpp
#include <hip/hip_runtime.h>
#include <cstdio>
#include <cstdint>

#ifndef ONE_LAUNCH
#define ONE_LAUNCH 1
#endif
#ifndef FAST_GEMM
#define FAST_GEMM 1
#endif
#ifndef FAST_TOPK
#define FAST_TOPK 1
#endif
#ifndef FAST_MIX
#define FAST_MIX 15
#endif
#ifndef SLICED_PEER
#define SLICED_PEER 1
#endif
#ifndef PRO_REPEAT
#define PRO_REPEAT 0
#endif
#ifndef V_INT8
#define V_INT8 1
#endif
#ifndef HIDE_TABLES
#define HIDE_TABLES 1
#endif
#ifndef I8_GEMM3
#define I8_GEMM3 1
#endif
#ifndef I8_GEMM1
#define I8_GEMM1 1
#endif
#ifndef I8_GEMM2
#define I8_GEMM2 1
#endif
#ifndef PART16
#define PART16 1
#endif
#ifndef FUSE_TOPK
#define FUSE_TOPK 1
#endif
#ifndef WQ_ONEPASS
#define WQ_ONEPASS 1
#endif
#ifndef TAB_PROBE
#define TAB_PROBE 0
#endif
#ifndef REPEAT_MASK
#define REPEAT_MASK 0
#endif

#define LAS __attribute__((address_space(3)))
typedef unsigned short bf16_t;
typedef float f32x4 __attribute__((ext_vector_type(4)));
typedef unsigned u32x4 __attribute__((ext_vector_type(4)));
typedef unsigned u32x2 __attribute__((ext_vector_type(2)));

namespace {
constexpr int NB = 4, SEQ = 4096, T = NB * SEQ, D = 2048;
constexpr int NH = 16, NCH = SEQ / 128;
constexpr int DINP = 4096;
constexpr int Z_OFF = 0, XBC_OFF = 1024, Q_OFF = 2560, K_OFF = 3584, V_OFF = 3712, DT_OFF = 3840;
constexpr int NMOD = 6 * D;
constexpr float ALPHA = 1.189207115002721f;
constexpr float EPS = 1e-5f;
constexpr int NTHR = 512, NWAVES = 8;

constexpr size_t MiB = 1u << 20;
constexpr size_t WS_CTL = 0, CTL_ZERO_BYTES = 1 * MiB;
constexpr size_t WS_MOD = 512 * 1024;
constexpr size_t WS_KEYS = 1 * MiB;
constexpr size_t WS_DTRAW = 2 * MiB;
constexpr size_t WS_DT = 3 * MiB;
constexpr size_t WS_ACUM = 4 * MiB;
constexpr size_t WS_SSP = 5 * MiB;
constexpr size_t WS_RS = 7 * MiB;
constexpr size_t WS_SCU = 7 * MiB + 256 * 1024, WS_SCV = 7 * MiB + 512 * 1024;
constexpr size_t WS_EXP = 8 * MiB;
constexpr size_t WS_GATE = 16 * MiB;
constexpr size_t WS_WIN = 24 * MiB;
constexpr size_t WS_WOUT = 40 * MiB;
constexpr size_t WS_WQ = 48 * MiB;
constexpr size_t WS_UB = 56 * MiB;
constexpr size_t WS_VB = 120 * MiB;
constexpr size_t WS_ACT = 184 * MiB;
constexpr size_t WS_PROJ = 248 * MiB;
constexpr size_t WS_XBCC = 376 * MiB;
constexpr size_t WS_STATES = 424 * MiB;
constexpr size_t WS_PREVB = 488 * MiB;
constexpr size_t WS_H2Q = 504 * MiB;
constexpr size_t WS_W8 = 5 * MiB;
constexpr size_t WS_WS = 7 * MiB + 128 * 1024;
constexpr size_t WS_SWQ = 7 * MiB + 64 * 1024, WS_SWIN = 7 * MiB + 80 * 1024, WS_SA1 = 7 * MiB + 320 * 1024;
constexpr int CW_AMXQ = 32768, CW_AMXIN = 36864;
constexpr size_t WS_A8 = WS_XBCC;
constexpr size_t WS_SA2 = 7 * MiB + 384 * 1024, WS_SWOUT = 7 * MiB + 96 * 1024;
constexpr int CW_AMXOUT = 40960;
constexpr size_t WS_HS = 7 * MiB;
constexpr size_t WS_END = 536 * MiB;
constexpr size_t WS_R1B = WS_PROJ, WS_X1B = WS_PROJ + 64 * MiB, WS_Q = WS_PROJ, WS_PARTA = WS_XBCC, WS_Y = WS_ACT;

constexpr int RING_BYTES = 131072;
constexpr int LDSCTL_OFF = 163840 - 64, MISC_OFF = LDSCTL_OFF;
constexpr int LDS_BYTES = 163840;

__device__ __forceinline__ float bf2f(unsigned v) { return __uint_as_float(v << 16); }
__device__ __forceinline__ float bflo(unsigned w) { return __uint_as_float(w << 16); }
__device__ __forceinline__ float bfhi(unsigned w) { return __uint_as_float(w & 0xffff0000u); }
__device__ __forceinline__ unsigned f2bf(float f) { unsigned u = __float_as_uint(f); return (u + 0x7fffu + ((u >> 16) & 1u)) >> 16; }
__device__ __forceinline__ unsigned pk2(float lo, float hi) { return f2bf(lo) | (f2bf(hi) << 16); }
typedef __bf16 bf16x2n __attribute__((ext_vector_type(2)));
typedef float f32x2n __attribute__((ext_vector_type(2)));
__device__ __forceinline__ unsigned cvtpk(float lo, float hi) { const bf16x2n r = __builtin_convertvector((f32x2n){lo, hi}, bf16x2n); return __builtin_bit_cast(unsigned, r); }
__device__ __forceinline__ float fexp(float x) { return __builtin_amdgcn_exp2f(x * 1.4426950408889634f); }
__device__ __forceinline__ float silu_f(float x) { return x * __builtin_amdgcn_rcpf(1.f + fexp(-x)); }
__device__ __forceinline__ float softplus_f(float x) { return x > 20.f ? x : log1pf(expf(x)); }
__device__ __forceinline__ float gelu_f(float x) { return 0.5f * x * (1.f + erff(x * 0.70710678118654752f)); }
__device__ __forceinline__ float wave_sum(float v) {
#pragma unroll
    for (int o = 1; o < 64; o <<= 1) v += __shfl_xor(v, o);
    return v;
}
__device__ __forceinline__ float dot8(u32x4 a, u32x4 b) {
    float s = bflo(a.x) * bflo(b.x); s += bfhi(a.x) * bfhi(b.x);
    s += bflo(a.y) * bflo(b.y); s += bfhi(a.y) * bfhi(b.y);
    s += bflo(a.z) * bflo(b.z); s += bfhi(a.z) * bfhi(b.z);
    s += bflo(a.w) * bflo(b.w); s += bfhi(a.w) * bfhi(b.w);
    return s;
}
__device__ __forceinline__ int win_src_col(int n) { return n < 2560 ? n : (n < 3840 ? n + 16 : (n < 3856 ? n - 1280 : -1)); }

#define XB_TMO      128
#define XB_XCNT(j)  (256  + 64 * (j))
#define XB_XSUB(j)  (1280 + 64 * (j))
#define XB_XGEN(j)  (2304 + 64 * (j))
#define XB_TOP      3328
#define XB_TOPGEN   3392
#define XCD_BAR_WORDS 3456
#define XB_SPIN_CAP (1u << 18)
__device__ __forceinline__ unsigned xb_ld(unsigned* p)              { return __hip_atomic_load(p, __ATOMIC_RELAXED, __HIP_MEMORY_SCOPE_AGENT); }
__device__ __forceinline__ unsigned xb_add(unsigned* p, unsigned v) { return __hip_atomic_fetch_add(p, v, __ATOMIC_RELAXED, __HIP_MEMORY_SCOPE_AGENT); }
__device__ __forceinline__ unsigned xb_xcc_id() { return (unsigned)__builtin_amdgcn_s_getreg((3 << 11) | 20) & 0xFu; }
#define XB_SPIN(cond, bar) do { unsigned _sp = 0; while (cond) { __builtin_amdgcn_s_sleep(1); \
    if ((++_sp & 255u) == 0u) { if (xb_ld(&(bar)[XB_TMO])) break; if (_sp > XB_SPIN_CAP) { atomicAdd(&(bar)[XB_TMO], 1u); break; } } } } while (0)
struct XcdBarrier { unsigned* bar; unsigned x; volatile LAS unsigned* st; };
__device__ __forceinline__ XcdBarrier xcd_barrier_post(unsigned* bar, volatile LAS unsigned* st) {
    XcdBarrier b; b.bar = bar; b.x = xb_xcc_id(); b.st = st;
    if (threadIdx.x == 0) (void)xb_add(&bar[XB_XCNT(b.x)], 1u);
    return b;
}
__device__ __forceinline__ void xcd_barrier_complete(unsigned* bar, unsigned x, unsigned& nloc, unsigned& nx) {
    const unsigned G = gridDim.x * gridDim.y * gridDim.z;
    unsigned sum, cnt, mine, sp = 0u;
    for (;;) {
        sum = 0u; cnt = 0u; mine = 0u;
#pragma unroll
        for (unsigned j = 0; j < 16; ++j) { const unsigned c = xb_ld(&bar[XB_XCNT(j)]); sum += c; cnt += (c > 0u) ? 1u : 0u; mine = (j == x) ? c : mine; }
        if (sum == G) break;
        __builtin_amdgcn_s_sleep(1);
        if ((++sp & 255u) == 0u) { if (xb_ld(&bar[XB_TMO])) break; if (sp > XB_SPIN_CAP) { atomicAdd(&bar[XB_TMO], 1u); break; } }
    }
    nloc = mine > 0u ? mine : 1u; nx = cnt > 0u ? cnt : 1u;
}
__device__ __forceinline__ void xcd_barrier(const XcdBarrier& b) {
    asm volatile("s_waitcnt vmcnt(0)" ::: "memory");
    __syncthreads();
    if (threadIdx.x == 0) {
        unsigned* bar = b.bar;
        __builtin_amdgcn_s_waitcnt(0);
        unsigned nloc = b.st[0], nx = b.st[1];
        if (nloc == 0u) { xcd_barrier_complete(bar, b.x, nloc, nx); b.st[0] = nloc; b.st[1] = nx; }
        const unsigned old = xb_add(&bar[XB_XSUB(b.x)], 1u);
        const unsigned gen = old / nloc;
        if (old + 1u == (gen + 1u) * nloc) {
            __builtin_amdgcn_fence(__ATOMIC_RELEASE, "agent");
            asm volatile("s_waitcnt vmcnt(0)" ::: "memory");
            const unsigned og = xb_add(&bar[XB_TOP], 1u);
            const unsigned tg = og / nx;
            if (og + 1u == (tg + 1u) * nx) xb_add(&bar[XB_TOPGEN], 1u);
            else XB_SPIN(xb_ld(&bar[XB_TOPGEN]) == tg, bar);
            __builtin_amdgcn_fence(__ATOMIC_ACQUIRE, "agent");
            xb_add(&bar[XB_XGEN(b.x)], 1u);
            asm volatile("s_waitcnt vmcnt(0)" ::: "memory");
        } else {
            XB_SPIN(xb_ld(&bar[XB_XGEN(b.x)]) == gen, bar);
            __builtin_amdgcn_fence(__ATOMIC_ACQUIRE, "agent");
            asm volatile("s_waitcnt vmcnt(0)" ::: "memory");
        }
    }
    __syncthreads();
}

struct Args { const float* in[22]; float* out; unsigned char* ws; int lo, hi; };
struct Ctx {
    const float* in[22]; float* out; unsigned char* ws; LAS unsigned char* lds;
    int tid, lane, wave, gw, ngw, gt, ngt;
};
#define IN_X c.in[0]
#define IN_C c.in[1]
#define IN_WADA c.in[2]
#define IN_BADA c.in[3]
#define IN_WIN c.in[4]
#define IN_CONVW c.in[5]
#define IN_CONVB c.in[6]
#define IN_DTBIAS c.in[7]
#define IN_ALOG c.in[8]
#define IN_DSKIP c.in[9]
#define IN_SSMG c.in[10]
#define IN_SINKS c.in[11]
#define IN_ATTG c.in[12]
#define IN_WOUT c.in[13]
#define IN_LN1G c.in[14]
#define IN_LN1B c.in[15]
#define IN_WQ c.in[16]
#define IN_KEYS c.in[17]
#define IN_U c.in[18]
#define IN_V c.in[19]
#define IN_LN2G c.in[20]
#define IN_LN2B c.in[21]
#define WSP(type, off) ((type*)(c.ws + (off)))


typedef float f32x2 __attribute__((ext_vector_type(2)));
typedef short bf16x8v __attribute__((ext_vector_type(8)));
typedef float f32x16 __attribute__((ext_vector_type(16)));
#define DPPF(v, ctrl) __int_as_float(__builtin_amdgcn_update_dpp(0, __float_as_int(v), (ctrl), 0xF, 0xF, true))
__device__ __forceinline__ float row_sum16(float v) {
    v += DPPF(v, 0xB1); v += DPPF(v, 0x4E); v += DPPF(v, 0x141); v += DPPF(v, 0x140); return v;
}
__device__ __forceinline__ float wave_sum63(float v) {
    v = row_sum16(v);
    v += __int_as_float(__builtin_amdgcn_update_dpp(0, __float_as_int(v), 0x142, 0xA, 0xF, false));
    v += __int_as_float(__builtin_amdgcn_update_dpp(0, __float_as_int(v), 0x143, 0xC, 0xF, false));
    return v;
}
__device__ __forceinline__ float lane63(float v) { return __int_as_float(__builtin_amdgcn_readlane(__float_as_int(v), 63)); }
__device__ __forceinline__ float wave_sum_all(float v) { return lane63(wave_sum63(v)); }
__device__ __forceinline__ void fp8_row_load(f32x4 (&v)[8], const float* src, int lane) {
#pragma unroll
    for (int j = 0; j < 2; ++j)
#pragma unroll
        for (int q = 0; q < 4; ++q) v[j * 4 + q] = *(const f32x4*)(src + j * 1024 + lane * 16 + q * 4);
}
#define DPPMAX(v, ctrl) fmaxf(v, __int_as_float(__builtin_amdgcn_update_dpp(0, __float_as_int(v), (ctrl), 0xF, 0xF, true)))
__device__ __forceinline__ unsigned pack_i8x4(f32x4 x) {
    const int q0 = (int)__builtin_rintf(x.x), q1 = (int)__builtin_rintf(x.y), q2 = (int)__builtin_rintf(x.z), q3 = (int)__builtin_rintf(x.w);
    return (unsigned)(q0 & 0xff) | ((unsigned)(q1 & 0xff) << 8) | ((unsigned)(q2 & 0xff) << 16) | ((unsigned)q3 << 24);
}
template <bool INT8>
__device__ __forceinline__ void fp8_row_finish(const f32x4 (&v)[8], unsigned char* tab, int row, float* scale, int lane) {
    float am = 0.f;
#pragma unroll
    for (int i = 0; i < 8; ++i) am = fmaxf(am, fmaxf(fmaxf(fabsf(v[i].x), fabsf(v[i].y)), fmaxf(fabsf(v[i].z), fabsf(v[i].w))));
    am = DPPMAX(am, 0xB1); am = DPPMAX(am, 0x4E); am = DPPMAX(am, 0x141); am = DPPMAX(am, 0x140);
    {
        const unsigned a0 = __builtin_amdgcn_readlane(__float_as_uint(am), 0), a1 = __builtin_amdgcn_readlane(__float_as_uint(am), 16);
        const unsigned a2 = __builtin_amdgcn_readlane(__float_as_uint(am), 32), a3 = __builtin_amdgcn_readlane(__float_as_uint(am), 48);
        const unsigned m01 = a0 > a1 ? a0 : a1, m23 = a2 > a3 ? a2 : a3; am = __uint_as_float(m01 > m23 ? m01 : m23);
    }
    const float top = INT8 ? 127.f : 448.f;
    const float inv = am > 0.f ? top / am : 0.f;
#pragma unroll
    for (int j = 0; j < 2; ++j) {
        u32x4 o;
#pragma unroll
        for (int q = 0; q < 4; ++q) { const f32x4 x = v[j * 4 + q] * inv;
            if (INT8) o[q] = pack_i8x4(x);
            else { int w = 0; w = __builtin_amdgcn_cvt_pk_fp8_f32(x.x, x.y, w, false); w = __builtin_amdgcn_cvt_pk_fp8_f32(x.z, x.w, w, true); o[q] = (unsigned)w; } }
#if SLICED_PEER
        *(u32x4*)(tab + ((size_t)(8 * j + (lane >> 3)) * 16384 + row) * 128 + (lane & 7) * 16) = o;
#else
        *(u32x4*)(tab + (size_t)row * D + j * 1024 + lane * 16) = o;
#endif
    }
    if (lane == 0) *scale = am / top;
}

template <bool WIN_MAP, bool GAINS = false>
__device__ __forceinline__ void colamax_items(const Ctx& c, const float* W, int Nsrc, unsigned* AMX, const float* g1 = nullptr, const float* g2 = nullptr) {
    const int nblk = (Nsrc + 255) / 256;
    for (int it = c.gw; it < 32 * nblk; it += c.ngw) {
        const int kb = it / nblk, nb = it % nblk, col = nb * 256 + c.lane * 4;
        if (col < Nsrc) {
            f32x4 m = {0.f, 0.f, 0.f, 0.f};
            const float* wp = W + (size_t)(kb * 64) * Nsrc + col;
#pragma unroll 16
            for (int kk = 0; kk < 64; ++kk) { f32x4 v = *(const f32x4*)(wp + (size_t)kk * Nsrc); if (GAINS) { const int k = kb * 64 + kk; v = v * (k < 1024 ? g1[k] : g2[k - 1024]); } m.x = fmaxf(m.x, fabsf(v.x)); m.y = fmaxf(m.y, fabsf(v.y)); m.z = fmaxf(m.z, fabsf(v.z)); m.w = fmaxf(m.w, fabsf(v.w)); }
#pragma unroll
            for (int j = 0; j < 4; ++j) { const int sc = col + j; const int dn = WIN_MAP ? (sc < 2560 ? sc : (sc < 2576 ? sc + 1280 : sc - 16)) : sc;
                atomicMax(AMX + dn, __float_as_uint(m[j])); }
        }
    }
}
template <bool WIN_MAP, bool GAINS = false>
__device__ __forceinline__ void transpose_item_i8(const float* W, int K, int Nsrc, int ND, unsigned char* WT, const unsigned* AMX, float* SW, LAS float* scr, int item, int lane, const float* g1 = nullptr, const float* g2 = nullptr) {
    const int nblk = ND / 32, kb = item / nblk, nb = item % nblk, k0 = 64 * kb, n0 = 32 * nb;
    const int n = n0 + (lane & 31), sc = WIN_MAP ? win_src_col(n) : n;
    const float am = __uint_as_float(AMX[n]), inv = am > 0.f ? 127.f / am : 0.f;
    float tv[32];
    const float* wp = W + (size_t)(k0 + (lane >> 5)) * Nsrc + (sc >= 0 ? sc : 0);
#pragma unroll
    for (int i = 0; i < 32; ++i) tv[i] = wp[(size_t)(2 * i) * Nsrc];
#pragma unroll
    for (int i = 0; i < 32; ++i) { const int kk = k0 + 2 * i + (lane >> 5); float v = sc >= 0 ? tv[i] * inv : 0.f; if (GAINS) v *= (kk < 1024 ? g1[kk] : g2[kk - 1024]); scr[(2 * i + (lane >> 5)) * 33 + (lane & 31)] = v; }
    asm volatile("s_waitcnt lgkmcnt(0)" ::: "memory");
#pragma unroll
    for (int j = 0; j < 2; ++j) {
        const int ch = lane + 64 * j, nn = ch >> 2, kc = ch & 3; const LAS float* sp = scr + (16 * kc) * 33 + nn;
        u32x4 o;
#pragma unroll
        for (int q = 0; q < 4; ++q) o[q] = pack_i8x4((f32x4){sp[(4 * q) * 33], sp[(4 * q + 1) * 33], sp[(4 * q + 2) * 33], sp[(4 * q + 3) * 33]});
        *(u32x4*)(WT + (size_t)(n0 + nn) * K + k0 + 16 * kc) = o;
    }
    if (kb == 0 && lane < 32) SW[n] = am * (1.f / 127.f);
    asm volatile("s_waitcnt lgkmcnt(0)" ::: "memory");
}
template <int MODE>
__device__ __forceinline__ void wquant_block(const Ctx& c, const float* W, int Nsrc, int nb, unsigned char* WT, float* SW, const float* g1, const float* g2) {
    constexpr int PITCH = 4112;
    LAS unsigned char* Lb = c.lds;
    LAS float* red = (LAS float*)(c.lds + 32 * PITCH);
    const int n = c.lane & 31, half = c.lane >> 5, n0 = nb * 32, dn = n0 + n, sc = MODE == 0 ? win_src_col(dn) : dn;
    const float* wp = W + (size_t)(c.wave * 256 + 2 * half) * Nsrc + (sc >= 0 ? sc : 0);
    float am = 0.f;
#pragma unroll 1
    for (int it0 = 0; it0 < 64; it0 += 8) {
        float v0[8], v1[8];
#pragma unroll
        for (int u = 0; u < 8; ++u) { const float* p = wp + (size_t)(4 * (it0 + u)) * Nsrc; v0[u] = p[0]; v1[u] = p[Nsrc]; }
#pragma unroll
        for (int u = 0; u < 8; ++u) {
            const int k = c.wave * 256 + 4 * (it0 + u) + 2 * half;
            float a = sc >= 0 ? v0[u] : 0.f, b = sc >= 0 ? v1[u] : 0.f;
            if (MODE == 1) { a *= (k < 1024 ? g1[k] : g2[k - 1024]); b *= (k + 1 < 1024 ? g1[k + 1] : g2[k + 1 - 1024]); }
            am = fmaxf(am, fmaxf(fabsf(a), fabsf(b)));
            *(LAS unsigned*)(Lb + n * PITCH + k * 2) = cvtpk(a, b);
        }
    }
    red[(c.wave * 2 + half) * 32 + n] = am;
    __syncthreads();
    if (c.tid < 32) {
        float m = 0.f;
#pragma unroll
        for (int j = 0; j < 16; ++j) m = fmaxf(m, red[j * 32 + c.tid]);
        red[512 + c.tid] = m > 0.f ? 127.f / m : 0.f; SW[n0 + c.tid] = m * (1.f / 127.f);
    }
    __syncthreads();
#pragma unroll 2
    for (int i = 0; i < 8; ++i) {
        const int id = i * NTHR + c.tid, nn = id >> 7, kc = id & 127; const float inv = red[512 + nn];
        const u32x4 r0 = *(const LAS u32x4*)(Lb + nn * PITCH + kc * 32), r1 = *(const LAS u32x4*)(Lb + nn * PITCH + kc * 32 + 16);
        u32x4 o;
        o.x = pack_i8x4((f32x4){bflo(r0.x), bfhi(r0.x), bflo(r0.y), bfhi(r0.y)} * inv); o.y = pack_i8x4((f32x4){bflo(r0.z), bfhi(r0.z), bflo(r0.w), bfhi(r0.w)} * inv);
        o.z = pack_i8x4((f32x4){bflo(r1.x), bfhi(r1.x), bflo(r1.y), bfhi(r1.y)} * inv); o.w = pack_i8x4((f32x4){bflo(r1.z), bfhi(r1.z), bflo(r1.w), bfhi(r1.w)} * inv);
        *(u32x4*)(WT + (size_t)(n0 + nn) * D + kc * 16) = o;
    }
    __syncthreads();
}
template <int MODE>
__device__ __forceinline__ void transpose_item(const float* W, int K, int Nsrc, int ND, bf16_t* WT, LAS float* scr, int item, int lane, const float* g1, const float* g2) {
    const int nblk = ND / 32, kb = item / nblk, nb = item % nblk, k0 = 64 * kb, n0 = 32 * nb;
    const int n = n0 + (lane & 31), sc = MODE == 0 ? win_src_col(n) : n;
    float tv[32];
    const float* wp = W + (size_t)(k0 + (lane >> 5)) * Nsrc + (sc >= 0 ? sc : 0);
#pragma unroll
    for (int i = 0; i < 32; ++i) tv[i] = wp[(size_t)(2 * i) * Nsrc];
#pragma unroll
    for (int i = 0; i < 32; ++i) {
        const int kk = 2 * i + (lane >> 5);
        float v = sc >= 0 ? tv[i] : 0.f;
        if (MODE == 1) v *= (k0 + kk < 1024) ? g1[k0 + kk] : g2[k0 + kk - 1024];
        scr[kk * 33 + (lane & 31)] = v;
    }
    asm volatile("s_waitcnt lgkmcnt(0)" ::: "memory");
    const int cch = lane & 7;
#pragma unroll
    for (int j = 0; j < 4; ++j) {
        const int nn = (lane >> 3) + 8 * j; const LAS float* s = scr + (8 * cch) * 33 + nn;
        u32x4 o; o.x = pk2(s[0 * 33], s[1 * 33]); o.y = pk2(s[2 * 33], s[3 * 33]); o.z = pk2(s[4 * 33], s[5 * 33]); o.w = pk2(s[6 * 33], s[7 * 33]);
        *(u32x4*)(WT + (size_t)(n0 + nn) * K + k0 + 8 * cch) = o;
    }
    asm volatile("s_waitcnt lgkmcnt(0)" ::: "memory");
}
__device__ __forceinline__ void cvt_f32_bf16(const Ctx& c, const float* src, bf16_t* dst, size_t n8) {
    for (size_t i = (size_t)c.gt; i < n8; i += (size_t)c.ngt) {
        const f32x4 a = ((const f32x4*)src)[2 * i], b = ((const f32x4*)src)[2 * i + 1];
        u32x4 o; o.x = pk2(a.x, a.y); o.y = pk2(a.z, a.w); o.z = pk2(b.x, b.y); o.w = pk2(b.z, b.w);
        ((u32x4*)dst)[i] = o;
    }
}
__device__ __forceinline__ void step_pro(const Ctx& c) {
    float* MOD = WSP(float, WS_MOD);
    for (int rep_ = 0; rep_ < 1 + ((PRO_REPEAT >> 0) & 1); ++rep_) {
    {
        LAS float* sl = (LAS float*)c.lds;
        LAS float* red = (LAS float*)(c.lds + 32768);
        for (int i = c.tid; i < 4 * D; i += NTHR) sl[i] = silu_f(IN_C[i]);
        __syncthreads();
        for (int cb = blockIdx.x; cb < NMOD / 48; cb += gridDim.x) {
            const int rsub = c.lane / 12, cq = c.lane % 12; const bool act = c.lane < 60;
            const float* wp = IN_WADA + (size_t)(c.wave * 256) * NMOD + cb * 48 + cq * 4;
            f32x4 a0 = {0.f, 0.f, 0.f, 0.f}, a1 = a0, a2 = a0, a3 = a0;
#pragma unroll 1
            for (int it0 = 0; it0 < 56; it0 += 8) {
                f32x4 wv[8];
#pragma unroll
                for (int u = 0; u < 8; ++u) { const int r = (it0 + u) * 5 + rsub; wv[u] = (act && r < 256) ? *(const f32x4*)(wp + (size_t)r * NMOD) : (f32x4){0.f, 0.f, 0.f, 0.f}; }
#pragma unroll
                for (int u = 0; u < 8; ++u) { const int r = (it0 + u) * 5 + rsub, k = c.wave * 256 + (r < 256 ? r : 255);
                    a0 += wv[u] * sl[k]; a1 += wv[u] * sl[D + k]; a2 += wv[u] * sl[2 * D + k]; a3 += wv[u] * sl[3 * D + k]; }
            }
            if (act) { LAS f32x4* o = (LAS f32x4*)(red + (c.wave * 60 + c.lane) * 16); o[0] = a0; o[1] = a1; o[2] = a2; o[3] = a3; }
            __syncthreads();
            if (c.tid < 192) {
                const int bb = c.tid / 48, j = c.tid % 48, q = j >> 2, e = j & 3;
                float sum = IN_BADA[cb * 48 + j];
#pragma unroll
                for (int w = 0; w < 8; ++w)
#pragma unroll
                    for (int rs = 0; rs < 5; ++rs) sum += red[(w * 60 + rs * 12 + q) * 16 + bb * 4 + e];
                MOD[bb * NMOD + cb * 48 + j] = sum;
            }
            __syncthreads();
        }
    }
    }
    for (int rep_ = 0; rep_ < 1 + ((PRO_REPEAT >> 1) & 1); ++rep_) {
    LAS float* scr = (LAS float*)(c.lds + c.wave * 16384);
    constexpr int I_IN = (D / 64) * (DINP / 32), I_SQ = (D / 64) * (D / 32);
    for (int it = c.gw; it < I_IN + 2 * I_SQ; it += c.ngw) {
        int r = it;
        if (r < I_IN) { if (!(I8_GEMM1 && FAST_GEMM)) transpose_item<0>(IN_WIN, D, 3856, DINP, WSP(bf16_t, WS_WIN), scr, r, c.lane, nullptr, nullptr); continue; } r -= I_IN;
        if (r < I_SQ) { if (!(I8_GEMM2 && FAST_GEMM)) transpose_item<1>(IN_WOUT, D, D, D, WSP(bf16_t, WS_WOUT), scr, r, c.lane, IN_SSMG, IN_ATTG); continue; } r -= I_SQ;
        if (!I8_GEMM3) transpose_item<2>(IN_WQ, D, D, D, WSP(bf16_t, WS_WQ), scr, r, c.lane, nullptr, nullptr);
    }
#if WQ_ONEPASS && I8_GEMM1 && I8_GEMM2 && I8_GEMM3 && FAST_GEMM
    __syncthreads();
    for (int it = blockIdx.x; it < 256; it += gridDim.x) {
        if (it < 128) wquant_block<0>(c, IN_WIN, 3856, it, WSP(unsigned char, WS_WIN), WSP(float, WS_SWIN), nullptr, nullptr);
        else if (it < 192) wquant_block<1>(c, IN_WOUT, D, it - 128, WSP(unsigned char, WS_WOUT), WSP(float, WS_SWOUT), IN_SSMG, IN_ATTG);
        else wquant_block<2>(c, IN_WQ, D, it - 192, WSP(unsigned char, WS_WQ), WSP(float, WS_SWQ), nullptr, nullptr);
    }
#else
    if (I8_GEMM3) colamax_items<false>(c, IN_WQ, D, WSP(unsigned, WS_CTL) + CW_AMXQ);
    if (I8_GEMM1 && FAST_GEMM) colamax_items<true>(c, IN_WIN, 3856, WSP(unsigned, WS_CTL) + CW_AMXIN);
    if (I8_GEMM2 && FAST_GEMM) colamax_items<false, true>(c, IN_WOUT, D, WSP(unsigned, WS_CTL) + CW_AMXOUT, IN_SSMG, IN_ATTG);
#endif
    }
    for (int rep_ = 0; rep_ < (HIDE_TABLES ? 0 : 1) + ((PRO_REPEAT >> 2) & 1); ++rep_) {
    {
#define TAB_SRC(r_) ((r_) < 16384 ? IN_U + (size_t)(r_) * D : IN_V + (size_t)((r_) - 16384) * D)
        f32x4 cur[8], nxt[8];
        int r = c.gw;
        if (r < 2 * 16384) fp8_row_load(cur, TAB_SRC(r), c.lane);
        for (; r < 2 * 16384; r += c.ngw) {
            const int rn = r + c.ngw;
            if (rn < 2 * 16384) fp8_row_load(nxt, TAB_SRC(rn), c.lane);
            if (r < 16384) fp8_row_finish<SLICED_PEER != 0>(cur, WSP(unsigned char, WS_UB), r, WSP(float, WS_SCU) + r, c.lane);
            else fp8_row_finish<(SLICED_PEER != 0) && (V_INT8 != 0)>(cur, WSP(unsigned char, WS_VB), r - 16384, WSP(float, WS_SCV) + (r - 16384), c.lane);
#pragma unroll
            for (int i = 0; i < 8; ++i) cur[i] = nxt[i];
        }
#undef TAB_SRC
    }
    }
    cvt_f32_bf16(c, IN_KEYS, WSP(bf16_t, WS_KEYS), (size_t)8 * 2 * 128 * 128 / 8);
}

__device__ __forceinline__ void step_h1(const Ctx& c) {
    const float* MOD = WSP(float, WS_MOD); bf16_t* H1 = WSP(bf16_t, WS_ACT);
    for (int t = c.gw; t < T; t += c.ngw) {
        const int b = t >> 12; const float* xr = IN_X + (size_t)t * D; const float* sh = MOD + b * NMOD; const float* sc = sh + D;
#if I8_GEMM1 && FAST_GEMM
        f32x4 hv[8]; float hmax = 0.f;
#pragma unroll
        for (int j = 0; j < 8; ++j) {
            const int col = j * 256 + c.lane * 4;
            const f32x4 xv = *(const f32x4*)(xr + col), s = *(const f32x4*)(sc + col), h = *(const f32x4*)(sh + col);
            hv[j] = xv * (s + 1.f) + h; hmax = fmaxf(hmax, fmaxf(fmaxf(fabsf(hv[j].x), fabsf(hv[j].y)), fmaxf(fabsf(hv[j].z), fabsf(hv[j].w))));
        }
        hmax = DPPMAX(hmax, 0xB1); hmax = DPPMAX(hmax, 0x4E); hmax = DPPMAX(hmax, 0x141); hmax = DPPMAX(hmax, 0x140);
        const unsigned a0 = __builtin_amdgcn_readlane(__float_as_uint(hmax), 0), a1 = __builtin_amdgcn_readlane(__float_as_uint(hmax), 16), a2 = __builtin_amdgcn_readlane(__float_as_uint(hmax), 32), a3 = __builtin_amdgcn_readlane(__float_as_uint(hmax), 48);
        const unsigned m01 = a0 > a1 ? a0 : a1, m23 = a2 > a3 ? a2 : a3; const float am = __uint_as_float(m01 > m23 ? m01 : m23), inv = am > 0.f ? 127.f / am : 0.f;
#pragma unroll
        for (int j = 0; j < 8; ++j) *(unsigned*)((unsigned char*)H1 + (size_t)t * D + j * 256 + c.lane * 4) = pack_i8x4(hv[j] * inv);
        if (c.lane == 0) WSP(float, WS_SA1)[t] = am * (1.f / 127.f);
#else
#pragma unroll
        for (int j = 0; j < 8; ++j) {
            const int col = j * 256 + c.lane * 4;
            const f32x4 xv = *(const f32x4*)(xr + col), s = *(const f32x4*)(sc + col), h = *(const f32x4*)(sh + col);
            u32x2 o; o.x = pk2(xv.x * (1.f + s.x) + h.x, xv.y * (1.f + s.y) + h.y); o.y = pk2(xv.z * (1.f + s.z) + h.z, xv.w * (1.f + s.w) + h.w);
            *(u32x2*)(H1 + (size_t)t * D + col) = o;
        }
#endif
    }
}

struct Epi1 {
    bf16_t* proj; float* dtraw;
    __device__ __forceinline__ float rho(int) const { return 1.f; }
    __device__ __forceinline__ float rowscale(int) const { return 1.f; }
    __device__ __forceinline__ void store8s(int row, int col, const float (&v)[8], float) const { store8(row, col, v); }
    __device__ __forceinline__ void store8(int row, int col, const float (&v)[8]) const {
        u32x4 o; o.x = pk2(v[0], v[1]); o.y = pk2(v[2], v[3]); o.z = pk2(v[4], v[5]); o.w = pk2(v[6], v[7]);
        *(u32x4*)(proj + (size_t)row * DINP + col) = o;
        if (col >= DT_OFF && col < DT_OFF + 16) {
            float* d = dtraw + (size_t)row * 16 + (col - DT_OFF);
            *(f32x4*)d = (f32x4){v[0], v[1], v[2], v[3]}; *(f32x4*)(d + 4) = (f32x4){v[4], v[5], v[6], v[7]};
        }
    }
};
struct Epi2 {
    const float* x; const float* mod; const float* ssp; bf16_t* r1;
    __device__ __forceinline__ void rs_pair(int row, float& r_ssd, float& r_att) const {
        float s1 = 0.f, s2 = 0.f;
#pragma unroll
        for (int j = 0; j < 4; ++j) { const f32x4 a = *(const f32x4*)(ssp + (size_t)row * 32 + 4 * j), b = *(const f32x4*)(ssp + (size_t)row * 32 + 16 + 4 * j);
            s1 += (a.x + a.y) + (a.z + a.w); s2 += (b.x + b.y) + (b.z + b.w); }
        r_ssd = rsqrtf(s1 * (1.f / 1024.f) + EPS); r_att = rsqrtf(s2 * (1.f / 1024.f) + EPS);
    }
    __device__ __forceinline__ float rho(int row) const { float a, b; rs_pair(row, a, b); return a / b; }
    __device__ __forceinline__ float rowscale(int row) const { float a, b; rs_pair(row, a, b); return b; }
    __device__ __forceinline__ void store8s(int row, int col, const float (&v)[8], float ra) const {
        const int b = row >> 12;
        const float* g = mod + b * NMOD + 2 * D + col;
        const f32x4 g0 = *(const f32x4*)g, g1 = *(const f32x4*)(g + 4);
        u32x4 o;
        o.x = cvtpk(g0.x * (ra * v[0]), g0.y * (ra * v[1])); o.y = cvtpk(g0.z * (ra * v[2]), g0.w * (ra * v[3]));
        o.z = cvtpk(g1.x * (ra * v[4]), g1.y * (ra * v[5])); o.w = cvtpk(g1.z * (ra * v[6]), g1.w * (ra * v[7]));
        *(u32x4*)(r1 + (size_t)row * D + col) = o;
    }
    __device__ __forceinline__ void store8(int row, int col, const float (&v)[8]) const { store8s(row, col, v, rowscale(row)); }
};
struct Epi3 {
    bf16_t* q;
    __device__ __forceinline__ float rho(int) const { return 1.f; }
    __device__ __forceinline__ float rowscale(int) const { return 1.f; }
    __device__ __forceinline__ void store8s(int row, int col, const float (&v)[8], float) const { store8(row, col, v); }
    __device__ __forceinline__ void store8(int row, int col, const float (&v)[8]) const {
        u32x4 o; o.x = pk2(v[0], v[1]); o.y = pk2(v[2], v[3]); o.z = pk2(v[4], v[5]); o.w = pk2(v[6], v[7]);
        *(u32x4*)(q + (size_t)row * D + col) = o;
    }
};

struct Epi1Q {
    bf16_t* proj; float* dtraw; const float* sa; const float* sw;
    __device__ __forceinline__ float rho(int) const { return 1.f; }
    __device__ __forceinline__ float rowscale(int row) const { return sa[row]; }
    __device__ __forceinline__ void store8s(int row, int col, const float (&v)[8], float rsc) const {
        const f32x4 s0 = *(const f32x4*)(sw + col) * rsc, s1 = *(const f32x4*)(sw + col + 4) * rsc;
        const float r0 = v[0] * s0.x, r1 = v[1] * s0.y, r2 = v[2] * s0.z, r3 = v[3] * s0.w, r4 = v[4] * s1.x, r5 = v[5] * s1.y, r6 = v[6] * s1.z, r7 = v[7] * s1.w;
        u32x4 o; o.x = cvtpk(r0, r1); o.y = cvtpk(r2, r3); o.z = cvtpk(r4, r5); o.w = cvtpk(r6, r7);
        *(u32x4*)(proj + (size_t)row * DINP + col) = o;
        if (col >= DT_OFF && col < DT_OFF + 16) { float* d = dtraw + (size_t)row * 16 + (col - DT_OFF); *(f32x4*)d = (f32x4){r0, r1, r2, r3}; *(f32x4*)(d + 4) = (f32x4){r4, r5, r6, r7}; }
    }
    __device__ __forceinline__ void store8(int row, int col, const float (&v)[8]) const { store8s(row, col, v, rowscale(row)); }
};
struct Epi2Q {
    const float* mod; const float* sa; const float* sw; bf16_t* r1;
    __device__ __forceinline__ float rho(int) const { return 1.f; }
    __device__ __forceinline__ float rowscale(int row) const { return sa[row]; }
    __device__ __forceinline__ void store8s(int row, int col, const float (&v)[8], float rsc) const {
        const int b = row >> 12; const float* g = mod + b * NMOD + 2 * D + col;
        const f32x4 s0 = *(const f32x4*)(sw + col) * *(const f32x4*)g * rsc, s1 = *(const f32x4*)(sw + col + 4) * *(const f32x4*)(g + 4) * rsc;
        u32x4 o; o.x = cvtpk(v[0] * s0.x, v[1] * s0.y); o.y = cvtpk(v[2] * s0.z, v[3] * s0.w); o.z = cvtpk(v[4] * s1.x, v[5] * s1.y); o.w = cvtpk(v[6] * s1.z, v[7] * s1.w);
        *(u32x4*)(r1 + (size_t)row * D + col) = o;
    }
    __device__ __forceinline__ void store8(int row, int col, const float (&v)[8]) const { store8s(row, col, v, rowscale(row)); }
};
struct Epi3Q {
    bf16_t* q; const float* hs; const float* swq;
    __device__ __forceinline__ float rho(int) const { return 1.f; }
    __device__ __forceinline__ float rowscale(int row) const { return hs[row]; }
    __device__ __forceinline__ void store8s(int row, int col, const float (&v)[8], float rsc) const {
        const f32x4 s0 = *(const f32x4*)(swq + col) * rsc, s1 = *(const f32x4*)(swq + col + 4) * rsc;
        u32x4 o; o.x = cvtpk(v[0] * s0.x, v[1] * s0.y); o.y = cvtpk(v[2] * s0.z, v[3] * s0.w); o.z = cvtpk(v[4] * s1.x, v[5] * s1.y); o.w = cvtpk(v[6] * s1.z, v[7] * s1.w);
        *(u32x4*)(q + (size_t)row * D + col) = o;
    }
    __device__ __forceinline__ void store8(int row, int col, const float (&v)[8]) const { store8s(row, col, v, rowscale(row)); }
};
template <class Epi, bool MIDK>
__device__ __forceinline__ void gemm_simple(const Ctx& c, const bf16_t* A, const bf16_t* Bt, int M, int N, int K, const Epi& E) {
    LAS float* As = (LAS float*)c.lds;
    LAS float* Bs = As + 32 * 132;
    const int tid = c.tid, ty = tid >> 4, tx = tid & 15, lr = tid >> 2, lk = (tid & 3) * 8;
    const int nTn = N / 128, ntile = (M / 128) * nTn;
    for (int tile = blockIdx.x; tile < ntile; tile += gridDim.x) {
        const int tm = tile / nTn, tn = tile % nTn;
        float acc[4][8];
#pragma unroll
        for (int i = 0; i < 4; ++i)
#pragma unroll
            for (int j = 0; j < 8; ++j) acc[i][j] = 0.f;
        const bf16_t* Ap = A + (size_t)(tm * 128 + lr) * K + lk;
        const bf16_t* Bp = Bt + (size_t)(tn * 128 + lr) * K + lk;
        for (int k0 = 0; k0 < K; k0 += 32) {
            if (MIDK && k0 == K / 2) {
#pragma unroll
                for (int i = 0; i < 4; ++i) { const float r = E.rho(tm * 128 + ty * 4 + i);
#pragma unroll
                    for (int j = 0; j < 8; ++j) acc[i][j] *= r; }
            }
            const u32x4 av = *(const u32x4*)(Ap + k0), bv = *(const u32x4*)(Bp + k0);
            __syncthreads();
            As[(lk + 0) * 132 + lr] = bflo(av.x); As[(lk + 1) * 132 + lr] = bfhi(av.x); As[(lk + 2) * 132 + lr] = bflo(av.y); As[(lk + 3) * 132 + lr] = bfhi(av.y);
            As[(lk + 4) * 132 + lr] = bflo(av.z); As[(lk + 5) * 132 + lr] = bfhi(av.z); As[(lk + 6) * 132 + lr] = bflo(av.w); As[(lk + 7) * 132 + lr] = bfhi(av.w);
            Bs[(lk + 0) * 132 + lr] = bflo(bv.x); Bs[(lk + 1) * 132 + lr] = bfhi(bv.x); Bs[(lk + 2) * 132 + lr] = bflo(bv.y); Bs[(lk + 3) * 132 + lr] = bfhi(bv.y);
            Bs[(lk + 4) * 132 + lr] = bflo(bv.z); Bs[(lk + 5) * 132 + lr] = bfhi(bv.z); Bs[(lk + 6) * 132 + lr] = bflo(bv.w); Bs[(lk + 7) * 132 + lr] = bfhi(bv.w);
            __syncthreads();
#pragma unroll 8
            for (int k = 0; k < 32; ++k) {
                const f32x4 a = *(const LAS f32x4*)(As + k * 132 + ty * 4);
                const f32x4 b0 = *(const LAS f32x4*)(Bs + k * 132 + tx * 8), b1 = *(const LAS f32x4*)(Bs + k * 132 + tx * 8 + 4);
                const float aa[4] = {a.x, a.y, a.z, a.w}; const float bb[8] = {b0.x, b0.y, b0.z, b0.w, b1.x, b1.y, b1.z, b1.w};
#pragma unroll
                for (int i = 0; i < 4; ++i)
#pragma unroll
                    for (int j = 0; j < 8; ++j) acc[i][j] += aa[i] * bb[j];
            }
        }
#pragma unroll
        for (int i = 0; i < 4; ++i) E.store8(tm * 128 + ty * 4 + i, tn * 128 + tx * 8, acc[i]);
    }
    __syncthreads();
}

namespace pg8 {
#define PG8_LAS __attribute__((address_space(3)))
typedef unsigned short bf16_t;
typedef short bf16x8 __attribute__((ext_vector_type(8)));
typedef float f32x4 __attribute__((ext_vector_type(4)));
typedef unsigned u32x4 __attribute__((ext_vector_type(4)));
constexpr int BM = 256, BK = 64, HALF = 128, HTB = HALF * BK * 2  , STAGE_BYTES = 8 * HTB, NXCD = 8, WGM = 8;

__host__ __device__ __forceinline__ int lds_byte(int r, int c) { const int st = (r >> 4) * 2 + (c >> 5), rr = r & 15, cc = c & 31, ob = rr * 64 + cc * 2; return st * 1024 + (ob ^ (((ob >> 9) & 1) << 5)); }
__host__ __device__ __forceinline__ void stage_rc(int b, int& R, int& C) { const int st = b / 1024, sb = b % 1024, swz = sb ^ (((sb >> 9) & 1) << 5); R = (st >> 1) * 16 + swz / 64; C = (st & 1) * 32 + (swz % 64) / 2; }
__host__ __device__ __forceinline__ int perm32(int rho) { const int n = rho >> 4, i = rho & 15; return 8 * (i >> 2) + 4 * n + (i & 3); }

struct Unit { int pm, pn; };
struct Gemm { const bf16_t* A; const bf16_t* Bt; int M, N, K; };

struct StaticOrder {
    int nM, nN, nwg, G, c;
    __host__ __device__ void init(int M, int N, int G_, int c_) { nM = M / BM; nN = N / BM; nwg = nM * nN; G = G_; c = c_; }
    __host__ __device__ bool next(int i, Unit& u) const {
        const long L = (long)i * G + c; if (L >= nwg) return false;
        int wgid = (int)L; { const int q = nwg / NXCD, r = nwg % NXCD, xcd = wgid % NXCD, off = wgid / NXCD; wgid = (xcd < r ? xcd * (q + 1) : r * (q + 1) + (xcd - r) * q) + off; }
        const int nig = WGM * nN, gid = wgid / nig, fm = gid * WGM, gsz = (nM - fm) < WGM ? (nM - fm) : WGM;
        u.pm = fm + ((wgid % nig) % gsz); u.pn = (wgid % nig) / gsz; return true;
    }
    __device__ __forceinline__ void a_ready(const Unit&) const {}
    __device__ __forceinline__ void done(const Unit&) const {}
};


template <class E, bool I8 = false> struct EpiA {
    static constexpr bool PERM = true, AFTER_DRAIN = false; E e;
    __device__ __forceinline__ void operator()(const f32x4 (&acc)[2][2][4][2], const Unit& u, int wr, int wc, int fr, int fq) const {
#pragma unroll
        for (int ai = 0; ai < 2; ++ai)
#pragma unroll
            for (int m = 0; m < 4; ++m) {
                const int row = u.pm * BM + ai * HALF + wr * 64 + m * 16 + fr; const float rsc = e.rowscale(row);
#pragma unroll
                for (int bj = 0; bj < 2; ++bj) {
                    const f32x4 v0 = acc[ai][bj][m][0], v1 = acc[ai][bj][m][1];
                    float v[8];
                    if constexpr (I8) {
#pragma unroll
                        for (int j = 0; j < 4; ++j) { v[j] = (float)__float_as_int(v0[j]); v[4 + j] = (float)__float_as_int(v1[j]); }
                    } else {
#pragma unroll
                        for (int j = 0; j < 4; ++j) { v[j] = v0[j]; v[4 + j] = v1[j]; }
                    }
                    e.store8s(row, u.pn * BM + bj * HALF + wc * 32 + 8 * fq, v, rsc);
                }
                if (m & 1) asm volatile("" ::: "memory");
            }
    }
    __device__ __forceinline__ void midk(f32x4 (&acc)[2][2][4][2], const Unit& u, int wr, int fr) const {
#pragma unroll
        for (int ai = 0; ai < 2; ++ai)
#pragma unroll
            for (int m = 0; m < 4; ++m) {
                const float r = e.rho(u.pm * BM + ai * HALF + wr * 64 + m * 16 + fr);
#pragma unroll
                for (int bj = 0; bj < 2; ++bj)
#pragma unroll
                    for (int n = 0; n < 2; ++n) acc[ai][bj][m][n] = acc[ai][bj][m][n] * r;
            }
    }
};
typedef int i32x4 __attribute__((ext_vector_type(4)));
template <class Epi, class Sched, bool ALIGN_EPI = false, bool SP2 = false, bool MIDK = false, bool I8 = false>
__device__ __forceinline__ void gemm_phase(PG8_LAS unsigned char* lds, const Gemm g, const Sched& S, const Epi& E) {
    const int tid = threadIdx.x, wid = __builtin_amdgcn_readfirstlane(tid >> 6), lane = tid & 63, wr = wid >> 2, wc = wid & 3, fr = lane & 15, fq = lane >> 4;
    const int K = g.K, nt = K / BK;
    unsigned voffA[2], voffB[2];
#pragma unroll
    for (int i = 0; i < 2; ++i) { int R, C; stage_rc(tid * 16 + i * 8192, R, C); const int Rb = Epi::PERM ? ((R & ~31) + perm32(R & 31)) : R;
        voffA[i] = (unsigned)(R * K + C) * 2u; voffB[i] = (unsigned)(Rb * K + C) * 2u; }
    const size_t kstep = (size_t)(BK * 2);
    const size_t hstep = (size_t)HALF * K * 2;
    const size_t tstep = 2 * hstep;
    const unsigned ldsw = (unsigned)wid * 1024u;
    const int aoff = lds_byte(wr * 64 + fr, fq * 8), boff = lds_byte(wc * 32 + fr, fq * 8);
#define PG8_SA(b, h) (((b) * 2 + (h)) * HTB)
#define PG8_SB(b, h) ((4 + (b) * 2 + (h)) * HTB)
#define PG8_STAGE(bufoff, gbase, voff) do { _Pragma("unroll") for (int _i = 0; _i < 2; ++_i) \
        __builtin_amdgcn_global_load_lds((const unsigned*)((const char*)(gbase) + (voff)[_i]), (PG8_LAS unsigned*)(lds + (bufoff) + ldsw + _i * 8192), 16, 0, 0); } while (0)
#define PG8_LDA(dst, b, h) do { _Pragma("unroll") for (int m = 0; m < 4; ++m) _Pragma("unroll") for (int k = 0; k < 2; ++k) dst[m][k] = *(const PG8_LAS bf16x8*)(lds + PG8_SA(b, h) + aoff + m * 2048 + k * 1024); } while (0)
#define PG8_LDB(dst, b, h) do { _Pragma("unroll") for (int n = 0; n < 2; ++n) _Pragma("unroll") for (int k = 0; k < 2; ++k) dst[n][k] = *(const PG8_LAS bf16x8*)(lds + PG8_SB(b, h) + boff + n * 2048 + k * 1024); } while (0)
#define PG8_MMA(ai, bj, At, Bt) do { __builtin_amdgcn_s_setprio(1); _Pragma("unroll") for (int m = 0; m < 4; ++m) _Pragma("unroll") for (int n = 0; n < 2; ++n) _Pragma("unroll") for (int k = 0; k < 2; ++k) { \
        if constexpr (I8) acc[ai][bj][m][n] = __builtin_bit_cast(f32x4, __builtin_amdgcn_mfma_i32_16x16x64_i8(__builtin_bit_cast(i32x4, Bt[n][k]), __builtin_bit_cast(i32x4, At[m][k]), __builtin_bit_cast(i32x4, acc[ai][bj][m][n]), 0, 0, 0)); \
        else acc[ai][bj][m][n] = __builtin_amdgcn_mfma_f32_16x16x32_bf16(Bt[n][k], At[m][k], acc[ai][bj][m][n], 0, 0, 0); } __builtin_amdgcn_s_setprio(0); } while (0)
#define PG8_WAIT_V(n) asm volatile("s_waitcnt vmcnt(" #n ")" ::: "memory")
#define PG8_WAIT_L(n) asm volatile("s_waitcnt lgkmcnt(" #n ")" ::: "memory")
#define PG8_BAR __builtin_amdgcn_s_barrier()
#define PG8_SCHED __builtin_amdgcn_sched_barrier(0)
    Unit cur, nxt; int ui = 0;
    if (!S.next(0, cur)) return;
    f32x4 acc[2][2][4][2];
#pragma unroll
    for (int a = 0; a < 2; ++a)
#pragma unroll
        for (int b = 0; b < 2; ++b)
#pragma unroll
            for (int m = 0; m < 4; ++m)
#pragma unroll
                for (int n = 0; n < 2; ++n) acc[a][b][m][n] = (f32x4){0.f, 0.f, 0.f, 0.f};
    bf16x8 At[4][2], B0[2][2], B1[2][2];
    const char* cA = (const char*)g.A + (size_t)cur.pm * tstep; const char* cB = (const char*)g.Bt + (size_t)cur.pn * tstep;
    S.a_ready(cur);
    if constexpr (SP2) {
        PG8_STAGE(PG8_SB(0, 0), cB, voffB); PG8_STAGE(PG8_SB(0, 1), cB + hstep, voffB); PG8_STAGE(PG8_SA(0, 0), cA, voffA); PG8_STAGE(PG8_SA(0, 1), cA + hstep, voffA);
        if (wr == 1) PG8_BAR;
        PG8_WAIT_V(2); PG8_BAR;
        PG8_STAGE(PG8_SB(1, 0), cB + kstep, voffB); PG8_STAGE(PG8_SA(1, 0), cA + kstep, voffA); PG8_STAGE(PG8_SB(1, 1), cB + hstep + kstep, voffB);
        PG8_WAIT_V(6); PG8_BAR;
    } else {
        PG8_STAGE(PG8_SB(0, 0), cB, voffB); PG8_STAGE(PG8_SA(0, 0), cA, voffA); PG8_STAGE(PG8_SB(0, 1), cB + hstep, voffB); PG8_STAGE(PG8_SA(0, 1), cA + hstep, voffA);
        if (wr == 1) PG8_BAR;
        PG8_WAIT_V(4); PG8_BAR;
        PG8_STAGE(PG8_SB(1, 0), cB + kstep, voffB); PG8_STAGE(PG8_SA(1, 0), cA + kstep, voffA); PG8_STAGE(PG8_SB(1, 1), cB + hstep + kstep, voffB);
        PG8_WAIT_V(6); PG8_BAR;
    }
    for (;;) {
        const bool has_next = S.next(ui + 1, nxt);
        const char* nA = has_next ? (const char*)g.A + (size_t)nxt.pm * tstep : cA; const char* nB = has_next ? (const char*)g.Bt + (size_t)nxt.pn * tstep : cB;
        for (int t = 0; t < nt; t += 2) {
            const bool last = (t == nt - 2);
            if constexpr (MIDK) { if (t == nt / 2) E.midk(acc, cur, wr, fr); }
            const char* a1 = cA + (size_t)(t + 1) * kstep;
            const char* a2 = last ? nA : cA + (size_t)(t + 2) * kstep; const char* b2 = last ? nB : cB + (size_t)(t + 2) * kstep;
            const char* a3 = a2 + kstep; const char* b3 = b2 + kstep;
            if (last && has_next) S.a_ready(nxt);
            if constexpr (SP2) {
            PG8_LDB(B0, 0, 0); PG8_LDB(B1, 0, 1); PG8_SCHED; PG8_LDA(At, 0, 0); PG8_STAGE(PG8_SA(1, 1), a1 + hstep, voffA);
            PG8_WAIT_V(8); PG8_WAIT_L(0); PG8_BAR; PG8_MMA(0, 0, At, B0); PG8_MMA(0, 1, At, B1); PG8_BAR; PG8_SCHED;
            PG8_LDA(At, 0, 1); PG8_STAGE(PG8_SB(0, 0), b2, voffB); PG8_STAGE(PG8_SB(0, 1), b2 + hstep, voffB); PG8_STAGE(PG8_SA(0, 0), a2, voffA);
            PG8_WAIT_V(8); PG8_WAIT_L(0); PG8_BAR; PG8_MMA(1, 0, At, B0); PG8_MMA(1, 1, At, B1); PG8_BAR; PG8_SCHED;
            PG8_LDB(B0, 1, 0); PG8_LDB(B1, 1, 1); PG8_SCHED; PG8_LDA(At, 1, 0); PG8_STAGE(PG8_SA(0, 1), a2 + hstep, voffA);
            PG8_WAIT_V(8); PG8_WAIT_L(0); PG8_BAR; PG8_MMA(0, 0, At, B0); PG8_MMA(0, 1, At, B1); PG8_BAR; PG8_SCHED;
            PG8_LDA(At, 1, 1); PG8_STAGE(PG8_SB(1, 0), b3, voffB); PG8_STAGE(PG8_SB(1, 1), b3 + hstep, voffB); PG8_STAGE(PG8_SA(1, 0), a3, voffA);
            PG8_WAIT_V(8); PG8_WAIT_L(0); PG8_BAR; PG8_MMA(1, 0, At, B0); PG8_MMA(1, 1, At, B1); PG8_BAR; PG8_SCHED;
            } else {
            PG8_LDB(B0, 0, 0); PG8_SCHED; PG8_LDA(At, 0, 0); PG8_STAGE(PG8_SA(1, 1), a1 + hstep, voffA);
            PG8_WAIT_L(8); PG8_BAR; PG8_WAIT_L(0); PG8_MMA(0, 0, At, B0); PG8_BAR; PG8_SCHED;
            PG8_LDB(B1, 0, 1); PG8_STAGE(PG8_SB(0, 0), b2, voffB);
            PG8_BAR; PG8_WAIT_L(0); PG8_MMA(0, 1, At, B1); PG8_BAR;
            PG8_LDA(At, 0, 1); PG8_STAGE(PG8_SA(0, 0), a2, voffA);
            PG8_BAR; PG8_WAIT_L(0); PG8_MMA(1, 0, At, B0); PG8_BAR; PG8_SCHED;
            PG8_STAGE(PG8_SB(0, 1), b2 + hstep, voffB);
            PG8_WAIT_V(6); PG8_BAR; PG8_MMA(1, 1, At, B1); PG8_BAR;
            PG8_LDB(B0, 1, 0); PG8_SCHED; PG8_LDA(At, 1, 0); PG8_STAGE(PG8_SA(0, 1), a2 + hstep, voffA);
            PG8_WAIT_L(8); PG8_BAR; PG8_WAIT_L(0); PG8_MMA(0, 0, At, B0); PG8_BAR; PG8_SCHED;
            PG8_LDB(B1, 1, 1); PG8_STAGE(PG8_SB(1, 0), b3, voffB);
            PG8_BAR; PG8_WAIT_L(0); PG8_MMA(0, 1, At, B1); PG8_BAR;
            PG8_LDA(At, 1, 1); PG8_STAGE(PG8_SA(1, 0), a3, voffA);
            PG8_BAR; PG8_WAIT_L(0); PG8_MMA(1, 0, At, B0); PG8_BAR; PG8_SCHED;
            PG8_STAGE(PG8_SB(1, 1), b3 + hstep, voffB);
            PG8_WAIT_V(6); PG8_BAR; PG8_MMA(1, 1, At, B1); PG8_BAR;
            }
        }
        if constexpr (ALIGN_EPI) { if (wr == 0) PG8_BAR; }
        if constexpr (!Epi::AFTER_DRAIN) { E(acc, cur, wr, wc, fr, fq); S.done(cur); }
        if (!has_next) break;
#pragma unroll
        for (int a = 0; a < 2; ++a)
#pragma unroll
            for (int b = 0; b < 2; ++b)
#pragma unroll
                for (int m = 0; m < 4; ++m)
#pragma unroll
                    for (int n = 0; n < 2; ++n) acc[a][b][m][n] = (f32x4){0.f, 0.f, 0.f, 0.f};
        cur = nxt; cA = nA; cB = nB; ++ui;
        if constexpr (ALIGN_EPI) { if (wr == 1) PG8_BAR; }
    }
    PG8_WAIT_V(0);
    if constexpr (!ALIGN_EPI) { if (wr == 0) PG8_BAR; }
    PG8_BAR;
    if constexpr (Epi::AFTER_DRAIN) { E.fused(acc, cur, wr, wc, fr, fq, lds, wid, lane); S.done(cur); }
#undef PG8_SA
#undef PG8_SB
#undef PG8_STAGE
#undef PG8_LDA
#undef PG8_LDB
#undef PG8_MMA
#undef PG8_WAIT_V
#undef PG8_WAIT_L
#undef PG8_BAR
#undef PG8_SCHED
}
}

__device__ __forceinline__ void step_conv(const Ctx& c) {
    const bf16_t* PROJ = WSP(bf16_t, WS_PROJ); bf16_t* XBCC = WSP(bf16_t, WS_XBCC);
    for (int idx = c.gt; idx < T * 768; idx += c.ngt) {
        const int t = idx / 768, ch = (idx % 768) * 2, pos = t & (SEQ - 1);
        float a0 = IN_CONVB[ch], a1 = IN_CONVB[ch + 1];
#pragma unroll
        for (int j = 0; j < 4; ++j) {
            if (pos - 3 + j >= 0) {
                const unsigned v = *(const unsigned*)(PROJ + (size_t)(t - 3 + j) * DINP + XBC_OFF + ch);
                a0 += IN_CONVW[j * 1536 + ch] * bflo(v); a1 += IN_CONVW[j * 1536 + ch + 1] * bfhi(v);
            }
        }
        *(unsigned*)(XBCC + (size_t)t * 1536 + ch) = pk2(silu_f(a0), silu_f(a1));
    }
    const float* DTRAW = WSP(float, WS_DTRAW); float* DT = WSP(float, WS_DT); float* ACUM = WSP(float, WS_ACUM);
    for (int idx = c.gt; idx < NB * NCH * NH; idx += c.ngt) {
        const int h = idx % NH, bc = idx / NH, t0 = bc * 128;
        const float A = -expf(IN_ALOG[h]), bias = IN_DTBIAS[h]; float cum = 0.f;
        for (int l = 0; l < 128; ++l) {
            const float dtv = softplus_f(DTRAW[(size_t)(t0 + l) * 16 + h] + bias); cum += dtv * A;
            DT[(size_t)idx * 128 + l] = dtv; ACUM[(size_t)idx * 128 + l] = cum;
        }
    }
}

__device__ __forceinline__ void step_ssd1_simple(const Ctx& c) {
    const bf16_t* XBCC = WSP(bf16_t, WS_XBCC); const float* DT = WSP(float, WS_DT); const float* ACUM = WSP(float, WS_ACUM); float* STATES = WSP(float, WS_STATES);
    LAS float* wl = (LAS float*)c.lds;
    for (int item = blockIdx.x; item < NB * NCH * NH; item += gridDim.x) {
        const int bc = item / NH, h = item % NH, g = h >> 3, t0 = bc * 128;
        __syncthreads();
        if (c.tid < 128) { const float aend = ACUM[(size_t)item * 128 + 127]; wl[c.tid] = fexp(aend - ACUM[(size_t)item * 128 + c.tid]) * DT[(size_t)item * 128 + c.tid]; }
        __syncthreads();
        const int p = c.tid >> 3, n0 = (c.tid & 7) * 16;
        float acc[16];
#pragma unroll
        for (int j = 0; j < 16; ++j) acc[j] = 0.f;
        for (int l = 0; l < 128; ++l) {
            const bf16_t* row = XBCC + (size_t)(t0 + l) * 1536;
            const float xv = bf2f(row[h * 64 + p]) * wl[l];
            const u32x4 b0 = *(const u32x4*)(row + 1024 + g * 128 + n0), b1 = *(const u32x4*)(row + 1024 + g * 128 + n0 + 8);
            acc[0] += xv * bflo(b0.x); acc[1] += xv * bfhi(b0.x); acc[2] += xv * bflo(b0.y); acc[3] += xv * bfhi(b0.y);
            acc[4] += xv * bflo(b0.z); acc[5] += xv * bfhi(b0.z); acc[6] += xv * bflo(b0.w); acc[7] += xv * bfhi(b0.w);
            acc[8] += xv * bflo(b1.x); acc[9] += xv * bfhi(b1.x); acc[10] += xv * bflo(b1.y); acc[11] += xv * bfhi(b1.y);
            acc[12] += xv * bflo(b1.z); acc[13] += xv * bfhi(b1.z); acc[14] += xv * bflo(b1.w); acc[15] += xv * bfhi(b1.w);
        }
        float* o = STATES + ((size_t)item * 64 + p) * 128 + n0;
#pragma unroll
        for (int j = 0; j < 4; ++j) *(f32x4*)(o + 4 * j) = (f32x4){acc[4 * j], acc[4 * j + 1], acc[4 * j + 2], acc[4 * j + 3]};
    }
    __syncthreads();
}

__device__ __forceinline__ void step_scan(const Ctx& c) {
    const float* STATES = WSP(float, WS_STATES); const float* ACUM = WSP(float, WS_ACUM); bf16_t* PREVB = WSP(bf16_t, WS_PREVB);
    for (int idx = c.gt; idx < NB * NH * 64 * 32; idx += c.ngt) {
        const int n4 = idx & 31, p = (idx >> 5) & 63, h = (idx >> 11) & 15, b = idx >> 15;
        f32x4 carry_ = {0.f, 0.f, 0.f, 0.f};
        const unsigned so = (unsigned)(((b * NCH * NH + h) * 64 + p) * 128 + n4 * 4), ao = (unsigned)((b * NCH * NH + h) * 128 + 127);
#pragma unroll
        for (int half = 0; half < 2; ++half) {
            f32x4 st[16]; float dec[16];
#pragma unroll
            for (int j = 0; j < 16; ++j) { const int ch = half * 16 + j;
                st[j] = *(const f32x4*)((const char*)(STATES + (size_t)ch * (NH * 64 * 128)) + so * 4u); dec[j] = *(const float*)((const char*)(ACUM + (size_t)ch * (NH * 128)) + ao * 4u); }
            static_assert(NCH == 32, "two halves of 16 chunks");
            f32x4 hs = half == 0 ? (f32x4){0.f, 0.f, 0.f, 0.f} : carry_;
#pragma unroll
            for (int j = 0; j < 16; ++j) { const int ch = half * 16 + j;
                *(u32x2*)((char*)(PREVB + (size_t)ch * (NH * 64 * 128)) + so * 2u) = (u32x2){pk2(hs.x, hs.y), pk2(hs.z, hs.w)};
                hs = hs * fexp(dec[j]) + st[j]; }
            carry_ = hs;
        }
    }
}

__device__ __forceinline__ void step_cb_simple(const Ctx& c) {
    const bf16_t* XBCC = WSP(bf16_t, WS_XBCC); float* G = WSP(float, WS_STATES);
    for (int idx = c.gt; idx < NB * NCH * 2 * 128 * 128; idx += c.ngt) {
        const int s = idx & 127, l = (idx >> 7) & 127, g = (idx >> 14) & 1, bc = idx >> 15, t0 = bc * 128;
        const bf16_t* Cr = XBCC + (size_t)(t0 + l) * 1536 + 1280 + g * 128; const bf16_t* Br = XBCC + (size_t)(t0 + s) * 1536 + 1024 + g * 128;
        float sum = 0.f;
#pragma unroll 4
        for (int n = 0; n < 128; n += 8) sum += dot8(*(const u32x4*)(Cr + n), *(const u32x4*)(Br + n));
        G[idx] = sum;
    }
}

__device__ __forceinline__ void step_ssd2_simple(const Ctx& c) {
    const bf16_t* XBCC = WSP(bf16_t, WS_XBCC); const bf16_t* PROJ = WSP(bf16_t, WS_PROJ); const bf16_t* PREVB = WSP(bf16_t, WS_PREVB);
    const float* DT = WSP(float, WS_DT); const float* ACUM = WSP(float, WS_ACUM); const float* G = WSP(float, WS_STATES);
    bf16_t* YCAT = WSP(bf16_t, WS_ACT); float* SSP = WSP(float, WS_SSP);
    LAS float* ac = (LAS float*)c.lds; LAS float* dl = ac + 128;
    for (int item = blockIdx.x; item < NB * NCH * NH; item += gridDim.x) {
        const int bc = item / NH, h = item % NH, g = h >> 3, t0 = bc * 128;
        __syncthreads();
        if (c.tid < 128) { ac[c.tid] = ACUM[(size_t)item * 128 + c.tid]; dl[c.tid] = DT[(size_t)item * 128 + c.tid]; }
        __syncthreads();
        const int l = c.tid >> 2, p0 = (c.tid & 3) * 16, t = t0 + l;
        float acc[16];
#pragma unroll
        for (int j = 0; j < 16; ++j) acc[j] = 0.f;
        {
            const bf16_t* Cr = XBCC + (size_t)t * 1536 + 1280 + g * 128; const bf16_t* Pr = PREVB + ((size_t)item * 64 + p0) * 128;
            for (int n = 0; n < 128; n += 8) {
                const u32x4 cv = *(const u32x4*)(Cr + n);
#pragma unroll
                for (int j = 0; j < 16; ++j) acc[j] += dot8(cv, *(const u32x4*)(Pr + j * 128 + n));
            }
            const float el = fexp(ac[l]);
#pragma unroll
            for (int j = 0; j < 16; ++j) acc[j] *= el;
        }
        const float al = ac[l]; const float* Gr = G + ((size_t)(bc * 2 + g) * 128 + l) * 128;
        for (int s = 0; s <= l; ++s) {
            const float coef = Gr[s] * fexp(al - ac[s]) * dl[s];
            const bf16_t* xr = XBCC + (size_t)(t0 + s) * 1536 + h * 64 + p0;
            const u32x4 x0 = *(const u32x4*)xr, x1 = *(const u32x4*)(xr + 8);
            acc[0] += coef * bflo(x0.x); acc[1] += coef * bfhi(x0.x); acc[2] += coef * bflo(x0.y); acc[3] += coef * bfhi(x0.y);
            acc[4] += coef * bflo(x0.z); acc[5] += coef * bfhi(x0.z); acc[6] += coef * bflo(x0.w); acc[7] += coef * bfhi(x0.w);
            acc[8] += coef * bflo(x1.x); acc[9] += coef * bfhi(x1.x); acc[10] += coef * bflo(x1.y); acc[11] += coef * bfhi(x1.y);
            acc[12] += coef * bflo(x1.z); acc[13] += coef * bfhi(x1.z); acc[14] += coef * bflo(x1.w); acc[15] += coef * bfhi(x1.w);
        }
        {
            const bf16_t* xr = XBCC + (size_t)t * 1536 + h * 64 + p0; const bf16_t* zr = PROJ + (size_t)t * DINP + Z_OFF + h * 64 + p0;
            const float dsk = IN_DSKIP[h]; float ss = 0.f; unsigned ow[8];
#pragma unroll
            for (int j = 0; j < 16; j += 2) {
                const unsigned xw = *(const unsigned*)(xr + j), zw = *(const unsigned*)(zr + j);
                const float y0 = (acc[j] + dsk * bflo(xw)) * silu_f(bflo(zw)), y1 = (acc[j + 1] + dsk * bfhi(xw)) * silu_f(bfhi(zw));
                ss += y0 * y0 + y1 * y1; ow[j >> 1] = pk2(y0, y1);
            }
            bf16_t* o = YCAT + (size_t)t * D + h * 64 + p0;
            *(u32x4*)o = (u32x4){ow[0], ow[1], ow[2], ow[3]}; *(u32x4*)(o + 8) = (u32x4){ow[4], ow[5], ow[6], ow[7]};
            ss += __shfl_xor(ss, 1); ss += __shfl_xor(ss, 2);
            if ((c.tid & 3) == 0) SSP[(size_t)t * 32 + h] = ss;
        }
    }
    __syncthreads();
}

__device__ __forceinline__ void step_att_simple(const Ctx& c) {
    const bf16_t* PROJ = WSP(bf16_t, WS_PROJ); bf16_t* YCAT = WSP(bf16_t, WS_ACT); float* SSP = WSP(float, WS_SSP);
    for (int idx = c.gt; idx < T * 16; idx += c.ngt) {
        const int t = idx >> 4, hd = idx & 15, kvh = hd >> 3, pos = t & (SEQ - 1);
        float q[64], o[64];
        {
            const bf16_t* qr = PROJ + (size_t)t * DINP + Q_OFF + hd * 64;
#pragma unroll
            for (int d = 0; d < 64; d += 8) { const u32x4 v = *(const u32x4*)(qr + d);
                q[d] = 0.125f * bflo(v.x); q[d + 1] = 0.125f * bfhi(v.x); q[d + 2] = 0.125f * bflo(v.y); q[d + 3] = 0.125f * bfhi(v.y);
                q[d + 4] = 0.125f * bflo(v.z); q[d + 5] = 0.125f * bfhi(v.z); q[d + 6] = 0.125f * bflo(v.w); q[d + 7] = 0.125f * bfhi(v.w); }
        }
#pragma unroll
        for (int d = 0; d < 64; ++d) o[d] = 0.f;
        float m = IN_SINKS[hd], den = 1.f;
        const int j0 = pos - 127 > 0 ? pos - 127 : 0;
        for (int kp = j0; kp <= pos; ++kp) {
            const size_t tk = (size_t)(t - pos + kp);
            const bf16_t* kr = PROJ + tk * DINP + K_OFF + kvh * 64; const bf16_t* vr = PROJ + tk * DINP + V_OFF + kvh * 64;
            float s = 0.f;
#pragma unroll
            for (int d = 0; d < 64; d += 8) { const u32x4 v = *(const u32x4*)(kr + d);
                s += q[d] * bflo(v.x) + q[d + 1] * bfhi(v.x) + q[d + 2] * bflo(v.y) + q[d + 3] * bfhi(v.y) + q[d + 4] * bflo(v.z) + q[d + 5] * bfhi(v.z) + q[d + 6] * bflo(v.w) + q[d + 7] * bfhi(v.w); }
            if (s > m) { const float sc = fexp(m - s); den *= sc;
#pragma unroll
                for (int d = 0; d < 64; ++d) o[d] *= sc;
                m = s; }
            const float p = fexp(s - m); den += p;
#pragma unroll
            for (int d = 0; d < 64; d += 8) { const u32x4 v = *(const u32x4*)(vr + d);
                o[d] += p * bflo(v.x); o[d + 1] += p * bfhi(v.x); o[d + 2] += p * bflo(v.y); o[d + 3] += p * bfhi(v.y);
                o[d + 4] += p * bflo(v.z); o[d + 5] += p * bfhi(v.z); o[d + 6] += p * bflo(v.w); o[d + 7] += p * bfhi(v.w); }
        }
        const float inv = 1.f / den; float ss = 0.f;
        bf16_t* orow = YCAT + (size_t)t * D + 1024 + hd * 64;
#pragma unroll
        for (int d = 0; d < 64; d += 8) {
            float r[8];
#pragma unroll
            for (int e = 0; e < 8; ++e) { r[e] = o[d + e] * inv; ss += r[e] * r[e]; }
            *(u32x4*)(orow + d) = (u32x4){pk2(r[0], r[1]), pk2(r[2], r[3]), pk2(r[4], r[5]), pk2(r[6], r[7])};
        }
        SSP[(size_t)t * 32 + 16 + hd] = ss;
    }
}

__device__ __forceinline__ bf16x8v ld_frag16(const void* p) { return __builtin_bit_cast(bf16x8v, *(const u32x4*)p); }
__device__ __forceinline__ bf16x8v lds_frag16(const LAS unsigned char* p) { return __builtin_bit_cast(bf16x8v, *(const LAS u32x4*)p); }
__device__ __forceinline__ f32x16 zero16() { f32x16 z;
#pragma unroll
    for (int r = 0; r < 16; ++r) z[r] = 0.f;
    return z; }
#define MFMA32(a, b, c) __builtin_amdgcn_mfma_f32_32x32x16_bf16((a), (b), (c), 0, 0, 0)
__device__ __forceinline__ bf16x8v acc_frag(const f32x16& x, int ks2) {
    u32x4 w; w.x = cvtpk(x[8 * ks2 + 0], x[8 * ks2 + 1]); w.y = cvtpk(x[8 * ks2 + 2], x[8 * ks2 + 3]); w.z = cvtpk(x[8 * ks2 + 4], x[8 * ks2 + 5]); w.w = cvtpk(x[8 * ks2 + 6], x[8 * ks2 + 7]);
    return __builtin_bit_cast(bf16x8v, w);
}

__device__ __forceinline__ void step_dta(const Ctx& c) {
    const float* DTRAW = WSP(float, WS_DTRAW); float* DT = WSP(float, WS_DT); float* ACUM = WSP(float, WS_ACUM);
    for (int idx = c.gw; idx < NB * NCH * NH; idx += c.ngw) {
        const int h = idx % NH, bc = idx / NH, t0 = bc * 128, l0 = 2 * c.lane;
        const float A = -expf(IN_ALOG[h]), bias = IN_DTBIAS[h];
        const float d0 = softplus_f(DTRAW[(size_t)(t0 + l0) * 16 + h] + bias), d1 = softplus_f(DTRAW[(size_t)(t0 + l0 + 1) * 16 + h] + bias);
        const float a0 = d0 * A, a1 = d1 * A; float x = a0 + a1;
#pragma unroll
        for (int o = 1; o < 64; o <<= 1) { const float v = __shfl_up(x, o); if (c.lane >= o) x += v; }
        const float ex = x - (a0 + a1);
        *(f32x2*)(DT + (size_t)idx * 128 + l0) = (f32x2){d0, d1};
        *(f32x2*)(ACUM + (size_t)idx * 128 + l0) = (f32x2){ex + a0, ex + a0 + a1};
    }
}
__device__ __forceinline__ void step_conv_only(const Ctx& c) {
    const bf16_t* PROJ = WSP(bf16_t, WS_PROJ); bf16_t* XBCC = WSP(bf16_t, WS_XBCC);
    for (int idx = c.gt; idx < (T / 8) * 384; idx += c.ngt) {
        const int rb = idx / 384, ch = (idx % 384) * 4, t0 = rb * 8, pos0 = t0 & (SEQ - 1);
        f32x4 w[4];
#pragma unroll
        for (int j = 0; j < 4; ++j) w[j] = *(const f32x4*)(IN_CONVW + j * 1536 + ch);
        const f32x4 bias = *(const f32x4*)(IN_CONVB + ch);
        f32x4 xr[11];
#pragma unroll
        for (int i = 0; i < 11; ++i) {
            if (pos0 - 3 + i >= 0) { const u32x2 v = *(const u32x2*)(PROJ + (size_t)(t0 - 3 + i) * DINP + XBC_OFF + ch); xr[i] = (f32x4){bflo(v.x), bfhi(v.x), bflo(v.y), bfhi(v.y)}; }
            else xr[i] = (f32x4){0.f, 0.f, 0.f, 0.f};
        }
#pragma unroll
        for (int r = 0; r < 8; ++r) {
            const f32x4 a = bias + w[0] * xr[r] + w[1] * xr[r + 1] + w[2] * xr[r + 2] + w[3] * xr[r + 3];
            *(u32x2*)(XBCC + (size_t)(t0 + r) * 1536 + ch) = (u32x2){cvtpk(silu_f(a.x), silu_f(a.y)), cvtpk(silu_f(a.z), silu_f(a.w))};
        }
    }
}

__device__ __forceinline__ void step_ssd1_fast(const Ctx& c) {
    const bf16_t* XBCC = WSP(bf16_t, WS_XBCC); const float* DT = WSP(float, WS_DT); const float* ACUM = WSP(float, WS_ACUM); float* STATES = WSP(float, WS_STATES);
    LAS unsigned char* Bl = c.lds;
    LAS unsigned char* Xl = c.lds + 32768;
    LAS float* wl = (LAS float*)(c.lds + 65536);
    const int lane = c.lane, col = lane & 31, hh = lane >> 5, pt = c.wave >> 2, nt = c.wave & 3;
    for (int item = blockIdx.x; item < NB * NCH * 2; item += gridDim.x) {
        const int bc = item >> 1, g = item & 1, t0 = bc * 128;
        __syncthreads();
        for (int i = c.tid; i < 128 * 16; i += NTHR) { const int l = i >> 4, ch = i & 15;
            *(LAS u32x4*)(Bl + l * 256 + ch * 16) = *(const u32x4*)(XBCC + (size_t)(t0 + l) * 1536 + 1024 + g * 128 + ch * 8); }
        for (int i = c.tid; i < 8 * 128; i += NTHR) { const int r = i >> 7, l = i & 127; const size_t o = ((size_t)bc * 16 + g * 8 + r) * 128;
            wl[i] = fexp(ACUM[o + 127] - ACUM[o + l]) * DT[o + l]; }
        __syncthreads();
#define SSD1_STAGE(r_) { _Pragma("unroll") for (int q_ = 0; q_ < 2; ++q_) { const int i_ = c.tid + q_ * NTHR, l_ = i_ >> 3, ch_ = i_ & 7; \
            const u32x4 v_ = *(const u32x4*)(XBCC + (size_t)(t0 + l_) * 1536 + (g * 8 + (r_)) * 64 + ch_ * 8); const float w_ = wl[(r_) * 128 + l_]; \
            u32x4 o_; o_.x = cvtpk(bflo(v_.x) * w_, bfhi(v_.x) * w_); o_.y = cvtpk(bflo(v_.y) * w_, bfhi(v_.y) * w_); o_.z = cvtpk(bflo(v_.z) * w_, bfhi(v_.z) * w_); o_.w = cvtpk(bflo(v_.w) * w_, bfhi(v_.w) * w_); \
            *(LAS u32x4*)(Xl + ((r_) & 1) * 16384 + l_ * 128 + ch_ * 16) = o_; } }
        SSD1_STAGE(0);
        __syncthreads();
        for (int r = 0; r < 8; ++r) {
            if (r + 1 < 8) SSD1_STAGE(r + 1);
            const LAS unsigned char* xb = Xl + (r & 1) * 16384 + (pt * 32 + col) * 2; const LAS unsigned char* bb = Bl + (nt * 32 + col) * 2;
            f32x16 acc = zero16();
#pragma unroll
            for (int ks = 0; ks < 8; ++ks) {
                bf16x8v af, bf;
#pragma unroll
                for (int j = 0; j < 8; ++j) { const int l = 16 * ks + 8 * hh + j; af[j] = *(const LAS short*)(xb + l * 128); bf[j] = *(const LAS short*)(bb + l * 256); }
                acc = MFMA32(af, bf, acc);
            }
            float* o = STATES + (((size_t)bc * 16 + g * 8 + r) * 64 + pt * 32) * 128 + nt * 32 + col;
#pragma unroll
            for (int rr = 0; rr < 16; ++rr) o[(size_t)((rr & 3) + 8 * (rr >> 2) + 4 * hh) * 128] = acc[rr];
            __syncthreads();
        }
#undef SSD1_STAGE
    }
    __syncthreads();
}

#define TABH_SRC(r_) ((r_) < 16384 ? IN_U + (size_t)(r_) * D : IN_V + (size_t)((r_) - 16384) * D)
#define TABH_FINISH(rowv, r_) { if ((r_) < 16384) fp8_row_finish<SLICED_PEER != 0>(rowv, WSP(unsigned char, WS_UB), (r_), WSP(float, WS_SCU) + (r_), c.lane); \
        else fp8_row_finish<(SLICED_PEER != 0) && (V_INT8 != 0)>(rowv, WSP(unsigned char, WS_VB), (r_) - 16384, WSP(float, WS_SCV) + ((r_) - 16384), c.lane); }
#define TABH_TICK() { if (HIDE_TABLES) { if (tabr < 2 * 16384) { TABH_FINISH(tabv, tabr); } tabr += c.ngw; if (tabr < 2 * 16384) fp8_row_load(tabv, TABH_SRC(tabr), c.lane); } }
__device__ __forceinline__ void step_ssd2_fast(const Ctx& c) {
    const bf16_t* XBCC = WSP(bf16_t, WS_XBCC); const bf16_t* PROJ = WSP(bf16_t, WS_PROJ); const bf16_t* PREVB = WSP(bf16_t, WS_PREVB);
    const float* DT = WSP(float, WS_DT); const float* ACUM = WSP(float, WS_ACUM); bf16_t* YCAT = WSP(bf16_t, WS_ACT); float* SSP = WSP(float, WS_SSP);
    const int lane = c.lane, col = lane & 31, hh = lane >> 5;
    LAS unsigned char* Xw = c.lds + c.wave * 16384;
    LAS float* ac = (LAS float*)(c.lds + 131072 + c.wave * 1024); LAS float* dl = ac + 128;
    LAS unsigned char* Gl = c.lds + 139264;
    f32x4 tabv[8]; int tabr = c.gw;
    if (HIDE_TABLES && tabr < 2 * 16384) fp8_row_load(tabv, TABH_SRC(tabr), c.lane);
    for (int item = blockIdx.x; item < NB * NCH * 2; item += gridDim.x) {
        const int bc = item >> 1, g = item & 1, t0 = bc * 128, hd = g * 8 + c.wave; const size_t ih = (size_t)bc * 16 + hd;
        __syncthreads();
#pragma unroll 1
        for (int tile = c.wave; tile < 10; tile += 8) {
            const int lt_ = tile < 1 ? 0 : tile < 3 ? 1 : tile < 6 ? 2 : 3, st_ = tile - (lt_ * (lt_ + 1)) / 2;
            bf16x8v cg[8], bg[8];
            const bf16_t* cp = XBCC + (size_t)(t0 + lt_ * 32 + col) * 1536 + 1280 + g * 128 + hh * 8;
            const bf16_t* bp = XBCC + (size_t)(t0 + st_ * 32 + col) * 1536 + 1024 + g * 128 + hh * 8;
#pragma unroll
            for (int ks = 0; ks < 8; ++ks) { cg[ks] = ld_frag16(cp + ks * 16); bg[ks] = ld_frag16(bp + ks * 16); }
            f32x16 gt = zero16();
#pragma unroll
            for (int ks = 0; ks < 8; ++ks) gt = MFMA32(bg[ks], cg[ks], gt);
            const u32x4 o0 = {cvtpk(gt[0], gt[1]), cvtpk(gt[2], gt[3]), cvtpk(gt[4], gt[5]), cvtpk(gt[6], gt[7])};
            const u32x4 o1 = {cvtpk(gt[8], gt[9]), cvtpk(gt[10], gt[11]), cvtpk(gt[12], gt[13]), cvtpk(gt[14], gt[15])};
            *(LAS u32x4*)(Gl + tile * 2048 + lane * 32) = o0; *(LAS u32x4*)(Gl + tile * 2048 + lane * 32 + 16) = o1;
        }
#pragma unroll 4
        for (int i = lane; i < 128 * 8; i += 64) { const int srow = i >> 3, ch = i & 7;
            *(LAS u32x4*)(Xw + srow * 128 + ch * 16) = *(const u32x4*)(XBCC + (size_t)(t0 + srow) * 1536 + hd * 64 + ch * 8); }
        ac[lane] = ACUM[ih * 128 + lane]; ac[lane + 64] = ACUM[ih * 128 + 64 + lane]; dl[lane] = DT[ih * 128 + lane]; dl[lane + 64] = DT[ih * 128 + 64 + lane];
        asm volatile("s_waitcnt vmcnt(0) lgkmcnt(0)" ::: "memory");
        __syncthreads();
        const float dsk = IN_DSKIP[hd];
#pragma unroll 1
        for (int lt = 0; lt < 4; ++lt) {
            const int l = lt * 32 + col, t = t0 + l;
            bf16x8v cf[8], pf0[8], pf1[8];
            const bf16_t* cp = XBCC + (size_t)t * 1536 + 1280 + g * 128 + hh * 8;
            const bf16_t* pp0 = PREVB + (ih * 64 + col) * 128 + hh * 8; const bf16_t* pp1 = pp0 + 32 * 128;
#pragma unroll
            for (int ks = 0; ks < 8; ++ks) { cf[ks] = ld_frag16(cp + ks * 16); pf0[ks] = ld_frag16(pp0 + ks * 16); pf1[ks] = ld_frag16(pp1 + ks * 16); }
            u32x2 zw[2][4];
#pragma unroll
            for (int p2 = 0; p2 < 2; ++p2)
#pragma unroll
                for (int g4 = 0; g4 < 4; ++g4) zw[p2][g4] = *(const u32x2*)(PROJ + (size_t)t * DINP + Z_OFF + hd * 64 + p2 * 32 + 8 * g4 + 4 * hh);
            TABH_TICK();
            f32x16 acc[2]; acc[0] = zero16(); acc[1] = zero16();
#pragma unroll
            for (int ks = 0; ks < 8; ++ks) { acc[0] = MFMA32(pf0[ks], cf[ks], acc[0]); acc[1] = MFMA32(pf1[ks], cf[ks], acc[1]); }
            const float al = ac[l], el = fexp(al);
#pragma unroll
            for (int p2 = 0; p2 < 2; ++p2)
#pragma unroll
                for (int r = 0; r < 16; ++r) acc[p2][r] *= el;
#pragma unroll 1
            for (int st = 0; st <= lt; ++st) {
                const LAS unsigned char* gp = Gl + ((lt * (lt + 1)) / 2 + st) * 2048 + lane * 32;
                const u32x4 g0 = *(const LAS u32x4*)gp, g1 = *(const LAS u32x4*)(gp + 16);
                if (st == 0 || st == lt || (lt == 3 && st == 1)) { TABH_TICK(); }
                f32x16 gt;
#pragma unroll
                for (int i = 0; i < 4; ++i) { gt[2 * i] = bflo(g0[i]); gt[2 * i + 1] = bfhi(g0[i]); gt[8 + 2 * i] = bflo(g1[i]); gt[8 + 2 * i + 1] = bfhi(g1[i]); }
#pragma unroll
                for (int g4 = 0; g4 < 4; ++g4) {
                    const int sl0 = 8 * g4 + 4 * hh;
                    const f32x4 as = *(const LAS f32x4*)(ac + st * 32 + sl0), ds = *(const LAS f32x4*)(dl + st * 32 + sl0);
#pragma unroll
                    for (int e = 0; e < 4; ++e) {
                        const bool ok = (st < lt) || (sl0 + e <= col);
                        gt[4 * g4 + e] = ok ? gt[4 * g4 + e] * fexp(al - as[e]) * ds[e] : 0.f;
                    }
                }
                const bf16x8v w0 = acc_frag(gt, 0), w1 = acc_frag(gt, 1);
#pragma unroll
                for (int p2 = 0; p2 < 2; ++p2) {
                    const LAS unsigned char* xb = Xw + (p2 * 32 + col) * 2 + (st * 32 + 4 * hh) * 128;
                    bf16x8v x0, x1;
#pragma unroll
                    for (int j = 0; j < 8; ++j) { const int srow = 8 * (j >> 2) + (j & 3); x0[j] = *(const LAS short*)(xb + srow * 128); x1[j] = *(const LAS short*)(xb + (16 + srow) * 128); }
                    acc[p2] = MFMA32(x0, w0, acc[p2]); acc[p2] = MFMA32(x1, w1, acc[p2]);
                }
            }
            TABH_TICK();
            float ss = 0.f;
#pragma unroll
            for (int p2 = 0; p2 < 2; ++p2)
#pragma unroll
                for (int g4 = 0; g4 < 4; ++g4) {
                    const int p0 = p2 * 32 + 8 * g4 + 4 * hh;
                    const u32x2 xw = *(const LAS u32x2*)(Xw + l * 128 + p0 * 2), z2 = zw[p2][g4];
                    const float y0 = (acc[p2][4 * g4 + 0] + dsk * bflo(xw.x)) * silu_f(bflo(z2.x)), y1 = (acc[p2][4 * g4 + 1] + dsk * bfhi(xw.x)) * silu_f(bfhi(z2.x));
                    const float y2 = (acc[p2][4 * g4 + 2] + dsk * bflo(xw.y)) * silu_f(bflo(z2.y)), y3 = (acc[p2][4 * g4 + 3] + dsk * bfhi(xw.y)) * silu_f(bfhi(z2.y));
                    ss += (y0 * y0 + y1 * y1) + (y2 * y2 + y3 * y3);
                    *(u32x2*)(YCAT + (size_t)t * D + hd * 64 + p0) = (u32x2){cvtpk(y0, y1), cvtpk(y2, y3)};
                }
            ss += __shfl_xor(ss, 32);
            if (hh == 0) SSP[(size_t)t * 32 + hd] = ss;
        }
    }
    if (HIDE_TABLES) { while (tabr < 2 * 16384) { TABH_TICK(); } }
    __syncthreads();
}

__device__ __forceinline__ void step_att_fast(const Ctx& c) {
    const bf16_t* PROJ = WSP(bf16_t, WS_PROJ); bf16_t* YCAT = WSP(bf16_t, WS_ACT); float* SSP = WSP(float, WS_SSP);
    const int lane = c.lane, col = lane & 31, hh = lane >> 5;
    LAS unsigned char* Kl = c.lds;
    LAS unsigned char* Vt = c.lds + 256 * 144;
    const float NEG = -__builtin_huge_valf();
    for (int item = blockIdx.x; item < NB * NCH * 2; item += gridDim.x) {
        const int kvh = item & 1, nblk = (item >> 1) & 31, b = item >> 6, tq0 = b * SEQ + nblk * 128, tk0 = tq0 - 128;
        __syncthreads();
        for (int i = c.tid; i < 256 * 8; i += NTHR) {
            const int kj = i >> 3, ch = i & 7;
            if (nblk > 0 || kj >= 128) {
                const bf16_t* src = PROJ + (size_t)(tk0 + kj) * DINP + kvh * 64 + ch * 8;
                *(LAS u32x4*)(Kl + kj * 144 + ch * 16) = *(const u32x4*)(src + K_OFF);
                const u32x4 v = *(const u32x4*)(src + V_OFF);
                LAS unsigned char* vp = Vt + (ch * 8) * 520 + kj * 2;
                *(LAS unsigned short*)(vp + 0 * 520) = (unsigned short)(v.x & 0xffff); *(LAS unsigned short*)(vp + 1 * 520) = (unsigned short)(v.x >> 16);
                *(LAS unsigned short*)(vp + 2 * 520) = (unsigned short)(v.y & 0xffff); *(LAS unsigned short*)(vp + 3 * 520) = (unsigned short)(v.y >> 16);
                *(LAS unsigned short*)(vp + 4 * 520) = (unsigned short)(v.z & 0xffff); *(LAS unsigned short*)(vp + 5 * 520) = (unsigned short)(v.z >> 16);
                *(LAS unsigned short*)(vp + 6 * 520) = (unsigned short)(v.w & 0xffff); *(LAS unsigned short*)(vp + 7 * 520) = (unsigned short)(v.w >> 16);
            }
        }
        __syncthreads();
        const int hd = kvh * 8 + c.wave; const float sink = IN_SINKS[hd];
        for (int qt = 0; qt < 4; ++qt) {
            const int tq = tq0 + qt * 32 + col;
            bf16x8v qf[4];
#pragma unroll
            for (int ks = 0; ks < 4; ++ks) qf[ks] = ld_frag16(PROJ + (size_t)tq * DINP + Q_OFF + hd * 64 + ks * 16 + hh * 8);
            f32x16 S[5]; float m = sink;
#pragma unroll
            for (int jj = 0; jj < 5; ++jj) {
                const int j = qt + jj;
                if (nblk == 0 && j < 4) {
#pragma unroll
                    for (int r = 0; r < 16; ++r) S[jj][r] = NEG;
                } else {
                    f32x16 a = zero16();
#pragma unroll
                    for (int ks = 0; ks < 4; ++ks) a = MFMA32(lds_frag16(Kl + (j * 32 + col) * 144 + ks * 32 + hh * 16), qf[ks], a);
#pragma unroll
                    for (int r = 0; r < 16; ++r) {
                        const int kl = (r & 3) + 8 * (r >> 2) + 4 * hh;
                        float sv = a[r] * 0.125f;
                        if (jj == 0) sv = (kl > col) ? sv : NEG;
                        if (jj == 4) sv = (kl <= col) ? sv : NEG;
                        S[jj][r] = sv; m = fmaxf(m, sv);
                    }
                }
            }
            m = fmaxf(m, __shfl_xor(m, 32));
            float lsum = 0.f;
#pragma unroll
            for (int jj = 0; jj < 5; ++jj)
#pragma unroll
                for (int r = 0; r < 16; ++r) { const float p = fexp(S[jj][r] - m); S[jj][r] = p; lsum += p; }
            lsum += __shfl_xor(lsum, 32); lsum += fexp(sink - m);
            f32x16 O[2]; O[0] = zero16(); O[1] = zero16();
#pragma unroll
            for (int jj = 0; jj < 5; ++jj) {
                const int j = qt + jj;
                if (!(nblk == 0 && j < 4)) {
#pragma unroll
                    for (int ks2 = 0; ks2 < 2; ++ks2) {
                        const bf16x8v pf = acc_frag(S[jj], ks2);
#pragma unroll
                        for (int d2 = 0; d2 < 2; ++d2) {
                            const LAS unsigned char* vp = Vt + (d2 * 32 + col) * 520 + (j * 32 + 16 * ks2 + 4 * hh) * 2;
                            const u32x2 v0 = *(const LAS u32x2*)vp, v1 = *(const LAS u32x2*)(vp + 16);
                            O[d2] = MFMA32(__builtin_bit_cast(bf16x8v, ((u32x4){v0.x, v0.y, v1.x, v1.y})), pf, O[d2]);
                        }
                    }
                }
            }
            const float inv = 1.f / lsum; float ss = 0.f;
#pragma unroll
            for (int d2 = 0; d2 < 2; ++d2)
#pragma unroll
                for (int g4 = 0; g4 < 4; ++g4) {
                    const float o0 = O[d2][4 * g4] * inv, o1 = O[d2][4 * g4 + 1] * inv, o2 = O[d2][4 * g4 + 2] * inv, o3 = O[d2][4 * g4 + 3] * inv;
                    ss += (o0 * o0 + o1 * o1) + (o2 * o2 + o3 * o3);
                    *(u32x2*)(YCAT + (size_t)tq * D + 1024 + hd * 64 + d2 * 32 + 8 * g4 + 4 * hh) = (u32x2){cvtpk(o0, o1), cvtpk(o2, o3)};
                }
            ss += __shfl_xor(ss, 32);
            if (hh == 0) SSP[(size_t)tq * 32 + 16 + hd] = ss;
        }
    }
    __syncthreads();
}

__device__ __forceinline__ void step_rs(const Ctx& c) {
    const float* SSP = WSP(float, WS_SSP); float* RS = WSP(float, WS_RS);
    for (int t = c.gt; t < T; t += c.ngt) {
        float s1 = 0.f, s2 = 0.f;
#pragma unroll
        for (int j = 0; j < 4; ++j) { const f32x4 a = *(const f32x4*)(SSP + (size_t)t * 32 + 4 * j), b = *(const f32x4*)(SSP + (size_t)t * 32 + 16 + 4 * j);
            s1 += (a.x + a.y) + (a.z + a.w); s2 += (b.x + b.y) + (b.z + b.w); }
        const float r1 = rsqrtf(s1 * (1.f / 1024.f) + EPS), r2 = rsqrtf(s2 * (1.f / 1024.f) + EPS);
        RS[2 * t] = r1 / r2; RS[2 * t + 1] = r2;
    }
}

__device__ __forceinline__ void step_ln1(const Ctx& c) {
    const float* MOD = WSP(float, WS_MOD); bf16_t* H2 = WSP(bf16_t, WS_ACT); const bf16_t* GB = WSP(bf16_t, WS_R1B); bf16_t* X1B = WSP(bf16_t, WS_X1B); unsigned char* H2Q = WSP(unsigned char, WS_H2Q); float* HS = WSP(float, WS_HS);
    f32x4 xc[8], xn[8]; u32x2 gc[8], gn[8];
    int t = c.gw;
#define LN1_LOAD(xa, ga, tok) { _Pragma("unroll") for (int j_ = 0; j_ < 8; ++j_) { xa[j_] = *(const f32x4*)(IN_X + (size_t)(tok) * D + j_ * 256 + c.lane * 4); ga[j_] = *(const u32x2*)(GB + (size_t)(tok) * D + j_ * 256 + c.lane * 4); } }
    if (t < T) LN1_LOAD(xc, gc, t);
    for (; t < T; t += c.ngw) {
        const int tn = t + c.ngw;
        if (tn < T) LN1_LOAD(xn, gn, tn);
        const int b = t >> 12;
        f32x4 v[8]; float s = 0.f;
#pragma unroll
        for (int j = 0; j < 8; ++j) { v[j] = xc[j] * ALPHA + (f32x4){bflo(gc[j].x), bfhi(gc[j].x), bflo(gc[j].y), bfhi(gc[j].y)}; s += (v[j].x + v[j].y) + (v[j].z + v[j].w); }
        const float mean = wave_sum_all(s) * (1.f / D); float s2 = 0.f;
#pragma unroll
        for (int j = 0; j < 8; ++j) { v[j] = v[j] - mean; s2 += (v[j].x * v[j].x + v[j].y * v[j].y) + (v[j].z * v[j].z + v[j].w * v[j].w); }
        const float rstd = rsqrtf(wave_sum_all(s2) * (1.f / D) + EPS);
        const float* sh = MOD + b * NMOD + 3 * D; const float* sc = MOD + b * NMOD + 4 * D; float hmax = 0.f;
#pragma unroll
        for (int j = 0; j < 8; ++j) {
            const int col = j * 256 + c.lane * 4;
            const f32x4 g = *(const f32x4*)(IN_LN1G + col), bb = *(const f32x4*)(IN_LN1B + col), s_ = *(const f32x4*)(sc + col), h_ = *(const f32x4*)(sh + col);
            const f32x4 x1 = v[j] * rstd * g + bb;
            *(u32x2*)(X1B + (size_t)t * D + col) = (u32x2){cvtpk(x1.x, x1.y), cvtpk(x1.z, x1.w)};
            const f32x4 h2v = x1 * (s_ + 1.f) + h_;
            if (!(I8_GEMM3 && FAST_GEMM)) *(u32x2*)(H2 + (size_t)t * D + col) = (u32x2){cvtpk(h2v.x, h2v.y), cvtpk(h2v.z, h2v.w)};
            v[j] = h2v; hmax = fmaxf(hmax, fmaxf(fmaxf(fabsf(h2v.x), fabsf(h2v.y)), fmaxf(fabsf(h2v.z), fabsf(h2v.w))));
        }
        {
            hmax = DPPMAX(hmax, 0xB1); hmax = DPPMAX(hmax, 0x4E); hmax = DPPMAX(hmax, 0x141); hmax = DPPMAX(hmax, 0x140);
            const unsigned a0 = __builtin_amdgcn_readlane(__float_as_uint(hmax), 0), a1 = __builtin_amdgcn_readlane(__float_as_uint(hmax), 16);
            const unsigned a2 = __builtin_amdgcn_readlane(__float_as_uint(hmax), 32), a3 = __builtin_amdgcn_readlane(__float_as_uint(hmax), 48);
            const unsigned m01 = a0 > a1 ? a0 : a1, m23 = a2 > a3 ? a2 : a3; const float am = __uint_as_float(m01 > m23 ? m01 : m23);
            const float inv = am > 0.f ? 127.f / am : 0.f;
#pragma unroll
            for (int j = 0; j < 8; ++j) *(unsigned*)(H2Q + (size_t)t * D + j * 256 + c.lane * 4) = pack_i8x4(v[j] * inv);
            if (c.lane == 0) HS[t] = am * (1.f / 127.f);
        }
#pragma unroll
        for (int j = 0; j < 8; ++j) { xc[j] = xn[j]; gc[j] = gn[j]; }
    }
#undef LN1_LOAD
}

__device__ __forceinline__ void argmax_bfly(float& bv, int& bi) {
#pragma unroll
    for (int off = 32; off >= 1; off >>= 1) {
        const float ov = __shfl_xor(bv, off); const int oi = __shfl_xor(bi, off);
        if (ov > bv || (ov == bv && oi < bi)) { bv = ov; bi = oi; }
    }
}
__device__ __forceinline__ void step_topk_simple(const Ctx& c) {
    const bf16_t* Q = WSP(bf16_t, WS_PROJ); const bf16_t* KEYS = WSP(bf16_t, WS_KEYS); int* EXPERT = WSP(int, WS_EXP); float* GATE = WSP(float, WS_GATE);
    const int lane = c.lane; const float NEG = -__builtin_huge_valf();
    for (int item = c.gw; item < T * 8; item += c.ngw) {
        const int t = item >> 3, h = item & 7;
        const bf16_t* qrow = Q + (size_t)t * D + h * 256;
        float tv[2] = {0.f, 0.f}; int ti[2] = {0, 0};
#pragma unroll
        for (int cc = 0; cc < 2; ++cc) {
            float v0 = 0.f, v1 = 0.f;
            const bf16_t* k0 = KEYS + ((size_t)(h * 2 + cc) * 128 + lane) * 128; const bf16_t* k1 = k0 + 64 * 128;
            for (int d = 0; d < 128; d += 8) { const u32x4 qv = *(const u32x4*)(qrow + cc * 128 + d); v0 += dot8(qv, *(const u32x4*)(k0 + d)); v1 += dot8(qv, *(const u32x4*)(k1 + d)); }
            for (int r = 0; r < 16; ++r) {
                float bv = v0; int bi = lane; if (v1 > bv) { bv = v1; bi = lane + 64; }
                argmax_bfly(bv, bi);
                if (lane == r) { tv[cc] = bv; ti[cc] = bi; }
                if (bi == lane) v0 = NEG; if (bi == lane + 64) v1 = NEG;
            }
        }
        float cv[4]; const int ci0 = lane * 4;
#pragma unroll
        for (int q = 0; q < 4; ++q) { const int ci = ci0 + q; cv[q] = __shfl(tv[0], ci >> 4) + __shfl(tv[1], ci & 15); }
        float bestv = 0.f; int bestp = 0;
        for (int r = 0; r < 16; ++r) {
            float bv = cv[0]; int bi = ci0;
#pragma unroll
            for (int q = 1; q < 4; ++q) if (cv[q] > bv) { bv = cv[q]; bi = ci0 + q; }
            argmax_bfly(bv, bi);
            if (lane == r) { bestv = bv; bestp = bi; }
#pragma unroll
            for (int q = 0; q < 4; ++q) if (bi == ci0 + q) cv[q] = NEG;
        }
        const float mx = __shfl(bestv, 0);
        const float e = lane < 16 ? fexp(bestv - mx) : 0.f; const float ssum = wave_sum(e);
        const int e0 = __shfl(ti[0], bestp >> 4), e1 = __shfl(ti[1], bestp & 15);
        if (lane < 16) { EXPERT[(size_t)item * 16 + lane] = e0 * 128 + e1; GATE[(size_t)item * 16 + lane] = e / ssum; }
    }
}

#define TK_CE(a, b) { const int t_ = max(a, b); b = min(a, b); a = t_; }
__device__ __forceinline__ int tk_mono(float x) { int b = __float_as_int(x); return b ^ ((b >> 31) & 0x7fffffff); }
__device__ __forceinline__ float tk_val(int key, int mask) { int b = key & ~mask; b ^= (b >> 31) & 0x7fffffff; return __int_as_float(b); }
__device__ __forceinline__ void tk_sort16(int (&k)[16]) {
#pragma unroll
    for (int size = 2; size <= 16; size <<= 1)
#pragma unroll
        for (int stride = size >> 1; stride > 0; stride >>= 1)
#pragma unroll
            for (int i = 0; i < 16; ++i) { const int j = i ^ stride; if (j > i) { if ((i & size) == 0) TK_CE(k[i], k[j]) else TK_CE(k[j], k[i]) } }
}
__device__ __forceinline__ void tk_clean16(int (&k)[16]) {
#pragma unroll
    for (int stride = 8; stride > 0; stride >>= 1)
#pragma unroll
        for (int i = 0; i < 16; ++i) { const int j = i ^ stride; if (j > i) TK_CE(k[i], k[j]) }
}
__device__ __forceinline__ void tk_merge16(int (&a)[16], const int (&b)[16]) {
#pragma unroll
    for (int i = 0; i < 16; ++i) a[i] = max(a[i], b[15 - i]);
    tk_clean16(a);
}
__device__ __forceinline__ void topk_groups(const Ctx& c, const int h, const int grp_first, const int grp_end, const int grp_step) {
    const bf16_t* Q = WSP(bf16_t, WS_PROJ); const bf16_t* KEYS = WSP(bf16_t, WS_KEYS); int* EXPERT = WSP(int, WS_EXP); float* GATE = WSP(float, WS_GATE);
    const int lane = c.lane, col = lane & 31, hh = lane >> 5;
    constexpr int KP = 272;
    LAS unsigned char* kl = c.lds;
    LAS int* tab = (LAS int*)(c.lds + 256 * KP) + c.wave * (32 * 33);
    __syncthreads();
    for (int i = c.tid; i < 256 * 16; i += NTHR) { const int r = i >> 4, ch = i & 15;
        *(LAS u32x4*)(kl + r * KP + ch * 16) = *(const u32x4*)(KEYS + ((size_t)h * 256 + r) * 128 + ch * 8); }
    __syncthreads();
    const int INTMIN = (int)0x80000000;
    for (int grp = grp_first; grp < grp_end; grp += grp_step) {
        const int t0 = grp * 32;
        int top[2][16];
#pragma unroll
        for (int cc = 0; cc < 2; ++cc) {
            bf16x8v qf[8];
            const bf16_t* qp = Q + (size_t)(t0 + col) * D + h * 256 + cc * 128 + hh * 8;
#pragma unroll
            for (int ks = 0; ks < 8; ++ks) qf[ks] = __builtin_bit_cast(bf16x8v, *(const u32x4*)(qp + ks * 16));
            int k[4][16];
#pragma unroll
            for (int nt = 0; nt < 4; ++nt) {
                f32x16 acc;
#pragma unroll
                for (int r = 0; r < 16; ++r) acc[r] = 0.f;
#pragma unroll
                for (int ks = 0; ks < 8; ++ks) {
                    const bf16x8v af = __builtin_bit_cast(bf16x8v, *(const LAS u32x4*)(kl + (cc * 128 + nt * 32 + col) * KP + ks * 32 + hh * 16));
                    acc = __builtin_amdgcn_mfma_f32_32x32x16_bf16(af, qf[ks], acc, 0, 0, 0);
                }
#pragma unroll
                for (int r = 0; r < 16; ++r) k[nt][r] = (tk_mono(acc[r]) & ~127) | (nt * 32 + (r & 3) + 8 * (r >> 2) + 4 * hh);
                tk_sort16(k[nt]);
            }
            tk_merge16(k[0], k[1]); tk_merge16(k[2], k[3]); tk_merge16(k[0], k[2]);
            int p[16];
#pragma unroll
            for (int i = 0; i < 16; ++i) p[i] = __shfl_xor(k[0][15 - i], 32);
#pragma unroll
            for (int i = 0; i < 16; ++i) k[0][i] = max(k[0][i], p[i]);
            tk_clean16(k[0]);
#pragma unroll
            for (int i = 0; i < 16; ++i) top[cc][i] = k[0][i];
        }
        if (hh == 0) {
#pragma unroll
            for (int i = 0; i < 16; ++i) { tab[col * 33 + i] = top[0][i] & 127; tab[col * 33 + 16 + i] = top[1][i] & 127; }
        }
        float va[16], vb[16];
#pragma unroll
        for (int i = 0; i < 16; ++i) { va[i] = tk_val(top[0][i], 127); vb[i] = tk_val(top[1][i], 127); }
#define TK_CAND(i, j) ((tk_mono(va[i] + vb[j]) & ~255) | ((i) * 16 + (j)))
        int m[16], l1[16], l3[16], l4[16];
#pragma unroll
        for (int j = 0; j < 16; ++j) m[j] = TK_CAND(0, j);
#pragma unroll
        for (int j = 0; j < 8; ++j) l1[j] = TK_CAND(1, j);
#pragma unroll
        for (int j = 8; j < 16; ++j) l1[j] = INTMIN;
        tk_merge16(m, l1);
        l3[0] = TK_CAND(2, 0); l3[1] = TK_CAND(2, 1); l3[2] = TK_CAND(2, 2); l3[3] = TK_CAND(2, 3); l3[4] = TK_CAND(2, 4);
        l3[5] = TK_CAND(3, 0); l3[6] = TK_CAND(3, 1); l3[7] = TK_CAND(3, 2); l3[8] = TK_CAND(3, 3);
        l3[9] = TK_CAND(4, 0); l3[10] = TK_CAND(4, 1); l3[11] = TK_CAND(4, 2);
        l3[12] = TK_CAND(5, 0); l3[13] = TK_CAND(5, 1); l3[14] = TK_CAND(6, 0); l3[15] = TK_CAND(6, 1);
        tk_sort16(l3); tk_merge16(m, l3);
        l4[0] = TK_CAND(7, 0); l4[1] = TK_CAND(7, 1);
#pragma unroll
        for (int i = 8; i < 16; ++i) l4[i - 6] = TK_CAND(i, 0);
#pragma unroll
        for (int i = 10; i < 16; ++i) l4[i] = INTMIN;
        tk_sort16(l4); tk_merge16(m, l4);
#undef TK_CAND
        float ev[16]; float ssum = 0.f; const float mx = tk_val(m[0], 255);
#pragma unroll
        for (int r = 0; r < 16; ++r) { ev[r] = fexp(tk_val(m[r], 255) - mx); ssum += ev[r]; }
        const float inv = 1.f / ssum;
#if SLICED_PEER
        const size_t ob = (size_t)(t0 + col) * 128 + 2 * h;
        if (hh == 0) {
            int eo[16];
#pragma unroll
            for (int r = 0; r < 16; ++r) { const int code = m[r] & 255; eo[r] = tab[col * 33 + (code >> 4)] * 128 + tab[col * 33 + 16 + (code & 15)]; }
#pragma unroll
            for (int g = 0; g < 8; ++g) *(u32x2*)(EXPERT + ob + g * 16) = (u32x2){(unsigned)eo[g], (unsigned)eo[g + 8]};
        } else {
#pragma unroll
            for (int g = 0; g < 8; ++g) *(f32x2*)(GATE + ob + g * 16) = (f32x2){ev[g] * inv, ev[g + 8] * inv};
        }
#else
        const size_t ob = ((size_t)(t0 + col) * 8 + h) * 16;
        if (hh == 0) {
            int eo[16];
#pragma unroll
            for (int r = 0; r < 16; ++r) { const int code = m[r] & 255; eo[r] = tab[col * 33 + (code >> 4)] * 128 + tab[col * 33 + 16 + (code & 15)]; }
#pragma unroll
            for (int q = 0; q < 4; ++q) *(u32x4*)(EXPERT + ob + 4 * q) = (u32x4){(unsigned)eo[4 * q], (unsigned)eo[4 * q + 1], (unsigned)eo[4 * q + 2], (unsigned)eo[4 * q + 3]};
        } else {
#pragma unroll
            for (int q = 0; q < 4; ++q) *(f32x4*)(GATE + ob + 4 * q) = (f32x4){ev[4 * q] * inv, ev[4 * q + 1] * inv, ev[4 * q + 2] * inv, ev[4 * q + 3] * inv};
        }
#endif
    }
    __syncthreads();
}

__device__ __forceinline__ void step_topk_fast(const Ctx& c) {
    const int nper = (int)gridDim.x >> 3;
    topk_groups(c, (int)blockIdx.x & 7, (int)(blockIdx.x >> 3) + nper * c.wave, T / 32, nper * NWAVES);
}

#define PEER_LOAD(buf, TAB, kbase) { _Pragma("unroll") for (int u_ = 0; u_ < 4; ++u_) { const int k_ = (kbase) + u_; \
        const int e_ = __builtin_amdgcn_readlane(k_ < 64 ? er0 : er1, k_ & 63); const unsigned char* rp_ = (TAB) + (size_t)e_ * D + lane * 16; \
        buf[u_][0] = *(const u32x4*)rp_; buf[u_][1] = *(const u32x4*)(rp_ + 1024); } }
#define PEER_DOT(buf, kbase) { _Pragma("unroll") for (int u_ = 0; u_ < 4; ++u_) { f32x2 a2_ = {0.f, 0.f}; \
        _Pragma("unroll") for (int j_ = 0; j_ < 2; ++j_) _Pragma("unroll") for (int q_ = 0; q_ < 4; ++q_) { const int w_ = (int)buf[u_][j_][q_]; \
            a2_ += __builtin_amdgcn_cvt_pk_f32_fp8(w_, false) * hh[j_ * 8 + q_ * 2]; a2_ += __builtin_amdgcn_cvt_pk_f32_fp8(w_, true) * hh[j_ * 8 + q_ * 2 + 1]; } \
        const float tot_ = lane63(wave_sum63(a2_.x + a2_.y)); const int k_ = (kbase) + u_; \
        if (k_ < 64) ar0 = (lane == k_) ? tot_ : ar0; else ar1 = (lane == k_ - 64) ? tot_ : ar1; } }
#define PEER_AXPY(buf, kbase) { _Pragma("unroll") for (int u_ = 0; u_ < 4; ++u_) { const int k_ = (kbase) + u_; \
        const float w1_ = __int_as_float(__builtin_amdgcn_readlane(__float_as_int(k_ < 64 ? wr0 : wr1), k_ & 63)); const f32x2 ww_ = {w1_, w1_}; \
        _Pragma("unroll") for (int j_ = 0; j_ < 2; ++j_) _Pragma("unroll") for (int q_ = 0; q_ < 4; ++q_) { const int w_ = (int)buf[u_][j_][q_]; \
            yy[j_ * 8 + q_ * 2] += __builtin_amdgcn_cvt_pk_f32_fp8(w_, false) * ww_; yy[j_ * 8 + q_ * 2 + 1] += __builtin_amdgcn_cvt_pk_f32_fp8(w_, true) * ww_; } } }
__device__ __forceinline__ void step_peer(const Ctx& c) {
    const bf16_t* H2 = WSP(bf16_t, WS_ACT); const unsigned char* U8 = WSP(unsigned char, WS_UB); const unsigned char* V8 = WSP(unsigned char, WS_VB);
    const float* SCU = WSP(float, WS_SCU); const float* SCV = WSP(float, WS_SCV);
    const int* EXPERT = WSP(int, WS_EXP); const float* GATE = WSP(float, WS_GATE); const float* MOD = WSP(float, WS_MOD);
    const int lane = c.lane;
    for (int t = c.gw; t < T; t += c.ngw) {
        const int er0 = EXPERT[(size_t)t * 128 + lane], er1 = EXPERT[(size_t)t * 128 + 64 + lane];
        const float gr0 = GATE[(size_t)t * 128 + lane], gr1 = GATE[(size_t)t * 128 + 64 + lane];
        const float su0 = SCU[er0], su1 = SCU[er1], sv0 = SCV[er0], sv1 = SCV[er1];
        f32x2 hh[16];
#pragma unroll
        for (int j = 0; j < 2; ++j)
#pragma unroll
            for (int q = 0; q < 2; ++q) { const u32x4 v = *(const u32x4*)(H2 + (size_t)t * D + j * 1024 + lane * 16 + q * 8);
                hh[j * 8 + q * 4 + 0] = (f32x2){bflo(v.x), bfhi(v.x)}; hh[j * 8 + q * 4 + 1] = (f32x2){bflo(v.y), bfhi(v.y)};
                hh[j * 8 + q * 4 + 2] = (f32x2){bflo(v.z), bfhi(v.z)}; hh[j * 8 + q * 4 + 3] = (f32x2){bflo(v.w), bfhi(v.w)}; }
        float ar0 = 0.f, ar1 = 0.f;
        u32x4 A[4][2], B[4][2];
        PEER_LOAD(A, U8, 0);
        for (int kb = 0; kb < 128; kb += 8) {
            PEER_LOAD(B, U8, kb + 4);
            PEER_DOT(A, kb);
            if (kb + 8 < 128) PEER_LOAD(A, U8, kb + 8) else PEER_LOAD(A, V8, 0);
            PEER_DOT(B, kb + 4);
        }
        const float wr0 = gr0 * gelu_f(ar0 * su0) * sv0, wr1 = gr1 * gelu_f(ar1 * su1) * sv1;
        f32x2 yy[16];
#pragma unroll
        for (int i = 0; i < 16; ++i) yy[i] = (f32x2){0.f, 0.f};
        for (int kb = 0; kb < 128; kb += 8) {
            PEER_LOAD(B, V8, kb + 4);
            PEER_AXPY(A, kb);
            if (kb + 8 < 128) PEER_LOAD(A, V8, kb + 8);
            PEER_AXPY(B, kb + 4);
        }
        const int b = t >> 12; float* row = c.out + (size_t)t * D; const float* g2 = MOD + b * NMOD + 5 * D;
        float s = 0.f;
#pragma unroll
        for (int j = 0; j < 2; ++j)
#pragma unroll
            for (int q = 0; q < 4; ++q) {
                const int col = j * 1024 + lane * 16 + q * 4; const f32x4 xv = *(const f32x4*)(row + col), gv = *(const f32x4*)(g2 + col);
                f32x2& y0 = yy[j * 8 + q * 2]; f32x2& y1 = yy[j * 8 + q * 2 + 1];
                y0.x = ALPHA * xv.x + gv.x * y0.x; y0.y = ALPHA * xv.y + gv.y * y0.y; y1.x = ALPHA * xv.z + gv.z * y1.x; y1.y = ALPHA * xv.w + gv.w * y1.y;
                s += (y0.x + y0.y) + (y1.x + y1.y);
            }
        const float mean = wave_sum(s) * (1.f / D); float s2 = 0.f;
#pragma unroll
        for (int i = 0; i < 16; ++i) { yy[i] = yy[i] - mean; s2 += yy[i].x * yy[i].x + yy[i].y * yy[i].y; }
        const float rstd = rsqrtf(wave_sum(s2) * (1.f / D) + EPS);
#pragma unroll
        for (int j = 0; j < 2; ++j)
#pragma unroll
            for (int q = 0; q < 4; ++q) {
                const int col = j * 1024 + lane * 16 + q * 4; const f32x4 g = *(const f32x4*)(IN_LN2G + col), bb = *(const f32x4*)(IN_LN2B + col);
                const f32x2 y0 = yy[j * 8 + q * 2], y1 = yy[j * 8 + q * 2 + 1];
                *(f32x4*)(row + col) = (f32x4){y0.x * rstd * g.x + bb.x, y0.y * rstd * g.y + bb.y, y1.x * rstd * g.z + bb.z, y1.y * rstd * g.w + bb.w};
            }
    }
}

struct XcdPlace { int nloc, nx, xrank, rank; };
__device__ __forceinline__ float reduce8(float v) { v += DPPF(v, 0xB1); v += DPPF(v, 0x4E); v += DPPF(v, 0x141); return v; }
struct Sel8 { unsigned long long m1, m2, m4; };
__device__ __forceinline__ float cnd(float a, float b, unsigned long long m) { float r; asm("v_cndmask_b32 %0, %1, %2, %3" : "=v"(r) : "v"(a), "v"(b), "s"(m)); return r; }
__device__ __forceinline__ float sel8(const Sel8& S, float p0, float p1, float p2, float p3, float p4, float p5, float p6, float p7) {
    const float a0 = cnd(p0, p1, S.m1), a1 = cnd(p2, p3, S.m1), a2 = cnd(p4, p5, S.m1), a3 = cnd(p6, p7, S.m1);
    return cnd(cnd(a0, a1, S.m2), cnd(a2, a3, S.m2), S.m4);
}
#define PS_GATHER(buf, ids, tabp) { _Pragma("unroll") for (int q_ = 0; q_ < 4; ++q_) { \
        buf[4 * q_ + 0] = *(const u32x4*)((tabp) + (ids[q_].x * 128u + c16)); buf[4 * q_ + 1] = *(const u32x4*)((tabp) + (ids[q_].y * 128u + c16)); \
        buf[4 * q_ + 2] = *(const u32x4*)((tabp) + (ids[q_].z * 128u + c16)); buf[4 * q_ + 3] = *(const u32x4*)((tabp) + (ids[q_].w * 128u + c16)); } }
#define PS_IDS(ids, tok) { _Pragma("unroll") for (int q_ = 0; q_ < 4; ++q_) ids[q_] = *(const u32x4*)(EP + (size_t)(tok) * 128 + g * 16 + q_ * 4); }
__device__ __forceinline__ int cndi(int a, int b, unsigned long long m) { int r; asm("v_cndmask_b32 %0, %1, %2, %3" : "=v"(r) : "v"(a), "v"(b), "s"(m)); return r; }
__device__ __forceinline__ int sel8i(const Sel8& S, int p0, int p1, int p2, int p3, int p4, int p5, int p6, int p7) {
    const int a0 = cndi(p0, p1, S.m1), a1 = cndi(p2, p3, S.m1), a2 = cndi(p4, p5, S.m1), a3 = cndi(p6, p7, S.m1);
    return cndi(cndi(a0, a1, S.m2), cndi(a2, a3, S.m2), S.m4);
}
#define DPPI(v, ctrl) __builtin_amdgcn_update_dpp(0, (v), (ctrl), 0xF, 0xF, true)
__device__ __forceinline__ int reduce8i(int v) { v += DPPI(v, 0xB1); v += DPPI(v, 0x4E); v += DPPI(v, 0x141); return v; }
#define PU_PROCESS(buf, tok) { \
        const u32x4 hq_ = *(const u32x4*)(H2Q + (size_t)(tok) * D + slice * 128 + c16); \
        int p_[16]; \
        _Pragma("unroll") for (int i_ = 0; i_ < 16; ++i_) { int a_ = __builtin_amdgcn_sdot4((int)buf[i_].x, (int)hq_.x, 0, false); \
            a_ = __builtin_amdgcn_sdot4((int)buf[i_].y, (int)hq_.y, a_, false); a_ = __builtin_amdgcn_sdot4((int)buf[i_].z, (int)hq_.z, a_, false); a_ = __builtin_amdgcn_sdot4((int)buf[i_].w, (int)hq_.w, a_, false); \
            p_[i_] = reduce8i(a_); } \
        const int lo_ = sel8i(SL, p_[0], p_[1], p_[2], p_[3], p_[4], p_[5], p_[6], p_[7]), hi_ = sel8i(SL, p_[8], p_[9], p_[10], p_[11], p_[12], p_[13], p_[14], p_[15]); \
        if (PART16) {   \
            PARTA[((size_t)slice * T + (tok)) * 64 + lane] = (int)((((unsigned)(lo_ + 32) >> 6) & 0xffffu) | ((unsigned)((hi_ + 32) >> 6) << 16)); \
        } else { int* o_ = PARTA + ((size_t)slice * T + (tok)) * 128 + g * 16 + c8; o_[0] = lo_; o_[8] = hi_; } }
__device__ __forceinline__ void step_peer_u(const Ctx& c, const XcdPlace& P) {
    const unsigned char* H2Q = WSP(unsigned char, WS_H2Q); const unsigned char* U8 = WSP(unsigned char, WS_UB); const int* EP = WSP(int, WS_EXP); int* PARTA = WSP(int, WS_PARTA);
    const int lane = c.lane, g = lane >> 3, c8 = lane & 7, wid = P.rank * NWAVES + c.wave, nw = P.nloc * NWAVES;
    const Sel8 SL{__ballot((c8 & 1) != 0), __ballot((c8 & 2) != 0), __ballot((c8 & 4) != 0)};
    const unsigned c16 = (unsigned)c8 * 16u;
    for (int slice = P.xrank; slice < 16; slice += P.nx) {
        const unsigned char* ub = U8 + (size_t)slice * 16384 * 128;
        u32x4 idn[4]; u32x4 A[16], B[16];
        int t = wid;
        if (t < T) { PS_IDS(idn, t); PS_GATHER(A, idn, ub); }
        if (t + nw < T) { PS_IDS(idn, t + nw); PS_GATHER(B, idn, ub); }
        for (; t < T; t += 2 * nw) {
            if (t + 2 * nw < T) PS_IDS(idn, t + 2 * nw);
            PU_PROCESS(A, t);
            if (t + 2 * nw < T) { PS_GATHER(A, idn, ub); }
            if (t + nw < T) {
                if (t + 3 * nw < T) PS_IDS(idn, t + 3 * nw);
                PU_PROCESS(B, t + nw);
                if (t + 3 * nw < T) { PS_GATHER(B, idn, ub); }
            }
        }
    }
}
#if V_INT8
__device__ __forceinline__ void step_peer_w(const Ctx& c) {
    const int* PARTA = WSP(int, WS_PARTA); const int* EP = WSP(int, WS_EXP); const float* G = WSP(float, WS_GATE); unsigned* W8 = WSP(unsigned, WS_W8);
    const float* SCU = WSP(float, WS_SCU); const float* SCV = WSP(float, WS_SCV); const float* HS = WSP(float, WS_HS); float* WSC = WSP(float, WS_WS);
    const int g = c.lane >> 3, c8 = c.lane & 7, i0 = g * 16 + c8, i1 = i0 + 8;
    for (int t = c.gw; t < T; t += c.ngw) {
        int a0 = 0, a1 = 0;
#if PART16
#pragma unroll
        for (int sl = 0; sl < 16; ++sl) { const int p = PARTA[((size_t)sl * T + t) * 64 + c.lane]; a0 += (int)(short)(p & 0xffff); a1 += p >> 16; }
        const float descale = 64.f;
#else
#pragma unroll
        for (int sl = 0; sl < 16; ++sl) { a0 += PARTA[((size_t)sl * T + t) * 128 + i0]; a1 += PARTA[((size_t)sl * T + t) * 128 + i1]; }
        const float descale = 1.f;
#endif
        const size_t base = (size_t)t * 128;
        const int e0 = EP[base + i0], e1 = EP[base + i1]; const float g0 = G[base + i0], g1 = G[base + i1], hs = HS[t] * descale;
        const float w0 = g0 * gelu_f((float)a0 * (SCU[e0] * hs)) * SCV[e0], w1 = g1 * gelu_f((float)a1 * (SCU[e1] * hs)) * SCV[e1];
        float am = fmaxf(fabsf(w0), fabsf(w1));
        am = DPPMAX(am, 0xB1); am = DPPMAX(am, 0x4E); am = DPPMAX(am, 0x141); am = DPPMAX(am, 0x140);
        const unsigned m0 = __builtin_amdgcn_readlane(__float_as_uint(am), 0), m1 = __builtin_amdgcn_readlane(__float_as_uint(am), 16), m2 = __builtin_amdgcn_readlane(__float_as_uint(am), 32), m3 = __builtin_amdgcn_readlane(__float_as_uint(am), 48);
        const unsigned m01 = m0 > m1 ? m0 : m1, m23 = m2 > m3 ? m2 : m3; am = __uint_as_float(m01 > m23 ? m01 : m23);
        const float inv = am > 0.f ? 127.f / am : 0.f;
        const int q0 = (int)__builtin_rintf(w0 * inv) & 0xff, q1 = (int)__builtin_rintf(w1 * inv) & 0xff;
        const int pk = q0 | (q1 << 8);
        const int b0 = DPPI(pk, 0x00), b1 = DPPI(pk, 0x55), b2 = DPPI(pk, 0xAA), b3 = DPPI(pk, 0xFF);
        const unsigned dlo = (unsigned)(b0 & 0xff) | ((unsigned)(b1 & 0xff) << 8) | ((unsigned)(b2 & 0xff) << 16) | ((unsigned)(b3 & 0xff) << 24);
        const unsigned dhi = ((unsigned)(b0 >> 8) & 0xff) | (((unsigned)(b1 >> 8) & 0xff) << 8) | (((unsigned)(b2 >> 8) & 0xff) << 16) | (((unsigned)(b3 >> 8) & 0xff) << 24);
        if ((c.lane & 3) == 0) { W8[(size_t)t * 32 + g * 4 + (c8 >> 2)] = dlo; W8[(size_t)t * 32 + g * 4 + 2 + (c8 >> 2)] = dhi; }
        if (c.lane == 0) WSC[t] = am * (1.f / 127.f);
    }
}
#else
__device__ __forceinline__ void step_peer_w(const Ctx& c) {
    const int* PARTA = WSP(int, WS_PARTA); const int* EP = WSP(int, WS_EXP); float* GW = WSP(float, WS_GATE); const float* SCU = WSP(float, WS_SCU); const float* SCV = WSP(float, WS_SCV); const float* HS = WSP(float, WS_HS);
    for (int idx = c.gt; idx < T * 128; idx += c.ngt) {
        int a = 0;
#pragma unroll
        for (int sl = 0; sl < 16; ++sl) a += PARTA[(size_t)sl * T * 128 + idx];
        const int e = EP[idx];
        GW[idx] = GW[idx] * gelu_f((float)a * (SCU[e] * HS[idx >> 7])) * SCV[e];
    }
}
#endif
#if V_INT8
#define PV_PROCESS(buf, tok) { \
        const u32x4 wq_ = *(const u32x4*)(W8 + (size_t)(tok) * 32 + g * 4); const float wsc_ = WSC[tok]; \
        int acc_[16]; _Pragma("unroll") for (int q_ = 0; q_ < 16; ++q_) acc_[q_] = 0; \
        _Pragma("unroll") for (int j_ = 0; j_ < 4; ++j_) { const int w4_ = (int)wq_[j_]; \
            _Pragma("unroll") for (int q_ = 0; q_ < 4; ++q_) { \
                const unsigned a_ = buf[4 * j_][q_], b_ = buf[4 * j_ + 1][q_], c_ = buf[4 * j_ + 2][q_], d_ = buf[4 * j_ + 3][q_]; \
                const unsigned tl_ = __builtin_amdgcn_perm(b_, a_, 0x05010400u), th_ = __builtin_amdgcn_perm(b_, a_, 0x07030602u); \
                const unsigned ul_ = __builtin_amdgcn_perm(d_, c_, 0x05010400u), uh_ = __builtin_amdgcn_perm(d_, c_, 0x07030602u); \
                acc_[4 * q_ + 0] = __builtin_amdgcn_sdot4((int)__builtin_amdgcn_perm(ul_, tl_, 0x05040100u), w4_, acc_[4 * q_ + 0], false); \
                acc_[4 * q_ + 1] = __builtin_amdgcn_sdot4((int)__builtin_amdgcn_perm(ul_, tl_, 0x07060302u), w4_, acc_[4 * q_ + 1], false); \
                acc_[4 * q_ + 2] = __builtin_amdgcn_sdot4((int)__builtin_amdgcn_perm(uh_, th_, 0x05040100u), w4_, acc_[4 * q_ + 2], false); \
                acc_[4 * q_ + 3] = __builtin_amdgcn_sdot4((int)__builtin_amdgcn_perm(uh_, th_, 0x07060302u), w4_, acc_[4 * q_ + 3], false); } } \
        int p_[16]; \
        _Pragma("unroll") for (int q_ = 0; q_ < 16; ++q_) p_[q_] = acc_[q_] + DPPI(acc_[q_], 0x128); \
        int q8_[8]; \
        _Pragma("unroll") for (int k_ = 0; k_ < 8; ++k_) { const auto r_ = __builtin_amdgcn_permlane16_swap((unsigned)p_[k_], (unsigned)p_[k_ + 8], false, false); q8_[k_] = (int)r_[0] + (int)r_[1]; } \
        int r4_[4]; \
        _Pragma("unroll") for (int k_ = 0; k_ < 4; ++k_) { const auto r_ = __builtin_amdgcn_permlane32_swap((unsigned)q8_[k_], (unsigned)q8_[k_ + 4], false, false); r4_[k_] = (int)r_[0] + (int)r_[1]; } \
        if ((lane & 8) == 0) *(u32x2*)(Y + (size_t)(tok) * D + slice * 128 + ocol) = (u32x2){cvtpk((float)r4_[0] * wsc_, (float)r4_[1] * wsc_), cvtpk((float)r4_[2] * wsc_, (float)r4_[3] * wsc_)}; }
#else
#define PV_PROCESS(buf, tok) { \
        f32x4 wv_[4]; _Pragma("unroll") for (int q_ = 0; q_ < 4; ++q_) wv_[q_] = *(const f32x4*)(GW + (size_t)(tok) * 128 + g * 16 + q_ * 4); \
        f32x2 acc_[8]; _Pragma("unroll") for (int q_ = 0; q_ < 8; ++q_) acc_[q_] = (f32x2){0.f, 0.f}; \
        _Pragma("unroll") for (int i_ = 0; i_ < 16; ++i_) { const float w1_ = wv_[i_ >> 2][i_ & 3]; const f32x2 ww_ = {w1_, w1_}; \
            _Pragma("unroll") for (int q_ = 0; q_ < 4; ++q_) { const int w_ = (int)buf[i_][q_]; acc_[2 * q_] += __builtin_amdgcn_cvt_pk_f32_fp8(w_, false) * ww_; acc_[2 * q_ + 1] += __builtin_amdgcn_cvt_pk_f32_fp8(w_, true) * ww_; } } \
        float p_[16]; \
        _Pragma("unroll") for (int q_ = 0; q_ < 8; ++q_) { p_[2 * q_] = acc_[q_].x + DPPF(acc_[q_].x, 0x128); p_[2 * q_ + 1] = acc_[q_].y + DPPF(acc_[q_].y, 0x128); } \
        float q8_[8]; \
        _Pragma("unroll") for (int k_ = 0; k_ < 8; ++k_) { const auto r_ = __builtin_amdgcn_permlane16_swap(__float_as_uint(p_[k_]), __float_as_uint(p_[k_ + 8]), false, false); q8_[k_] = __uint_as_float(r_[0]) + __uint_as_float(r_[1]); } \
        float r4_[4]; \
        _Pragma("unroll") for (int k_ = 0; k_ < 4; ++k_) { const auto r_ = __builtin_amdgcn_permlane32_swap(__float_as_uint(q8_[k_]), __float_as_uint(q8_[k_ + 4]), false, false); r4_[k_] = __uint_as_float(r_[0]) + __uint_as_float(r_[1]); } \
        if ((lane & 8) == 0) *(u32x2*)(Y + (size_t)(tok) * D + slice * 128 + ocol) = (u32x2){cvtpk(r4_[0], r4_[1]), cvtpk(r4_[2], r4_[3])}; }
#endif
__device__ __forceinline__ void step_peer_v(const Ctx& c, const XcdPlace& P) {
    const unsigned char* V8 = WSP(unsigned char, WS_VB); const int* EP = WSP(int, WS_EXP); const float* GW = WSP(float, WS_GATE); bf16_t* Y = WSP(bf16_t, WS_Y);
    const unsigned* W8 = WSP(unsigned, WS_W8); const float* WSC = WSP(float, WS_WS); (void)GW; (void)W8; (void)WSC;
    const int lane = c.lane, g = lane >> 3, c8 = lane & 7, wid = P.rank * NWAVES + c.wave, nw = P.nloc * NWAVES;
    const int ocol = c8 * 16 + 8 * ((lane >> 4) & 1) + 4 * (lane >> 5);
    const unsigned c16 = (unsigned)c8 * 16u;
    for (int slice = P.xrank; slice < 16; slice += P.nx) {
        const unsigned char* vb = V8 + (size_t)slice * 16384 * 128;
        u32x4 idn[4]; u32x4 A[16], B[16];
        int t = wid;
        if (t < T) { PS_IDS(idn, t); PS_GATHER(A, idn, vb); }
        if (t + nw < T) { PS_IDS(idn, t + nw); PS_GATHER(B, idn, vb); }
        for (; t < T; t += 2 * nw) {
            if (t + 2 * nw < T) PS_IDS(idn, t + 2 * nw);
            PV_PROCESS(A, t);
            if (t + 2 * nw < T) { PS_GATHER(A, idn, vb); }
            if (t + nw < T) {
                if (t + 3 * nw < T) PS_IDS(idn, t + 3 * nw);
                PV_PROCESS(B, t + nw);
                if (t + 3 * nw < T) { PS_GATHER(B, idn, vb); }
            }
        }
    }
}
__device__ __forceinline__ void step_ln2(const Ctx& c) {
    const float* MOD = WSP(float, WS_MOD); const bf16_t* Y = WSP(bf16_t, WS_Y); const bf16_t* X1B = WSP(bf16_t, WS_X1B);
    u32x2 xc[8], xn[8], yc[8], yn[8];
    int t = c.gw;
#define LN2_LOAD(xa, ya, tok) { _Pragma("unroll") for (int j_ = 0; j_ < 8; ++j_) { xa[j_] = *(const u32x2*)(X1B + (size_t)(tok) * D + j_ * 256 + c.lane * 4); ya[j_] = *(const u32x2*)(Y + (size_t)(tok) * D + j_ * 256 + c.lane * 4); } }
    if (t < T) LN2_LOAD(xc, yc, t);
    for (; t < T; t += c.ngw) {
        const int tn = t + c.ngw;
        if (tn < T) LN2_LOAD(xn, yn, tn);
        const int b = t >> 12; float* row = c.out + (size_t)t * D; const float* g2 = MOD + b * NMOD + 5 * D;
        f32x4 v[8]; float s = 0.f;
#pragma unroll
        for (int j = 0; j < 8; ++j) { const int col = j * 256 + c.lane * 4; const f32x4 gv = *(const f32x4*)(g2 + col); const u32x2 xw = xc[j], yw = yc[j];
            v[j] = (f32x4){ALPHA * bflo(xw.x) + gv.x * bflo(yw.x), ALPHA * bfhi(xw.x) + gv.y * bfhi(yw.x), ALPHA * bflo(xw.y) + gv.z * bflo(yw.y), ALPHA * bfhi(xw.y) + gv.w * bfhi(yw.y)};
            s += (v[j].x + v[j].y) + (v[j].z + v[j].w); }
        const float mean = wave_sum_all(s) * (1.f / D); float s2 = 0.f;
#pragma unroll
        for (int j = 0; j < 8; ++j) { v[j] = v[j] - mean; s2 += (v[j].x * v[j].x + v[j].y * v[j].y) + (v[j].z * v[j].z + v[j].w * v[j].w); }
        const float rstd = rsqrtf(wave_sum_all(s2) * (1.f / D) + EPS);
#pragma unroll
        for (int j = 0; j < 8; ++j) { const int col = j * 256 + c.lane * 4; const f32x4 gg = *(const f32x4*)(IN_LN2G + col), bb = *(const f32x4*)(IN_LN2B + col);
            *(f32x4*)(row + col) = v[j] * rstd * gg + bb; }
#pragma unroll
        for (int j = 0; j < 8; ++j) { xc[j] = xn[j]; yc[j] = yn[j]; }
    }
#undef LN2_LOAD
}

__device__ __forceinline__ void step_requant(const Ctx& c) {
    const bf16_t* YCAT = WSP(bf16_t, WS_ACT); const float* SSP = WSP(float, WS_SSP); unsigned char* A8 = WSP(unsigned char, WS_A8); float* SA2 = WSP(float, WS_SA2);
    for (int t = c.gw; t < T; t += c.ngw) {
        float s1 = 0.f, s2 = 0.f;
#pragma unroll
        for (int j = 0; j < 4; ++j) { const f32x4 a = *(const f32x4*)(SSP + (size_t)t * 32 + 4 * j), b = *(const f32x4*)(SSP + (size_t)t * 32 + 16 + 4 * j); s1 += (a.x + a.y) + (a.z + a.w); s2 += (b.x + b.y) + (b.z + b.w); }
        const float r1 = rsqrtf(s1 * (1.f / 1024.f) + EPS), r2 = rsqrtf(s2 * (1.f / 1024.f) + EPS);
        f32x4 v[8]; float am = 0.f;
#pragma unroll
        for (int j = 0; j < 8; ++j) { const u32x2 w = *(const u32x2*)(YCAT + (size_t)t * D + j * 256 + c.lane * 4); const float r = j < 4 ? r1 : r2;
            v[j] = (f32x4){bflo(w.x), bfhi(w.x), bflo(w.y), bfhi(w.y)} * r; am = fmaxf(am, fmaxf(fmaxf(fabsf(v[j].x), fabsf(v[j].y)), fmaxf(fabsf(v[j].z), fabsf(v[j].w)))); }
        am = DPPMAX(am, 0xB1); am = DPPMAX(am, 0x4E); am = DPPMAX(am, 0x141); am = DPPMAX(am, 0x140);
        const unsigned a0 = __builtin_amdgcn_readlane(__float_as_uint(am), 0), a1 = __builtin_amdgcn_readlane(__float_as_uint(am), 16), a2 = __builtin_amdgcn_readlane(__float_as_uint(am), 32), a3 = __builtin_amdgcn_readlane(__float_as_uint(am), 48);
        const unsigned m01 = a0 > a1 ? a0 : a1, m23 = a2 > a3 ? a2 : a3; am = __uint_as_float(m01 > m23 ? m01 : m23);
        const float inv = am > 0.f ? 127.f / am : 0.f;
#pragma unroll
        for (int j = 0; j < 8; ++j) *(unsigned*)(A8 + (size_t)t * D + j * 256 + c.lane * 4) = pack_i8x4(v[j] * inv);
        if (c.lane == 0) SA2[t] = am * (1.f / 127.f);
    }
}
__device__ __forceinline__ void step_wq8(const Ctx& c) {
    LAS float* scr = (LAS float*)(c.lds + c.wave * 16384);
    if (I8_GEMM3 && FAST_GEMM) { for (int it = c.gw; it < (D / 64) * (D / 32); it += c.ngw) transpose_item_i8<false>(IN_WQ, D, D, D, WSP(unsigned char, WS_WQ), WSP(unsigned, WS_CTL) + CW_AMXQ, WSP(float, WS_SWQ), scr, it, c.lane); }
    if (I8_GEMM2 && FAST_GEMM) { for (int it = c.gw; it < (D / 64) * (D / 32); it += c.ngw) transpose_item_i8<false, true>(IN_WOUT, D, D, D, WSP(unsigned char, WS_WOUT), WSP(unsigned, WS_CTL) + CW_AMXOUT, WSP(float, WS_SWOUT), scr, it, c.lane, IN_SSMG, IN_ATTG); }
    if (I8_GEMM1 && FAST_GEMM) { for (int it = c.gw; it < (D / 64) * (DINP / 32); it += c.ngw) transpose_item_i8<true>(IN_WIN, D, 3856, DINP, WSP(unsigned char, WS_WIN), WSP(unsigned, WS_CTL) + CW_AMXIN, WSP(float, WS_SWIN), scr, it, c.lane); }
}

#if TAB_PROBE
__device__ __forceinline__ void tabp_load_coal(f32x4 (&v)[8], const float* src, int lane) {
#pragma unroll
    for (int i = 0; i < 8; ++i) v[i] = *(const f32x4*)(src + i * 256 + lane * 4);
}
template <int ROWMAJOR>
__device__ __forceinline__ void tabp_finish_coal(const f32x4 (&v)[8], unsigned char* tab, int row, float* scale, int lane) {
    float am = 0.f;
#pragma unroll
    for (int i = 0; i < 8; ++i) am = fmaxf(am, fmaxf(fmaxf(fabsf(v[i].x), fabsf(v[i].y)), fmaxf(fabsf(v[i].z), fabsf(v[i].w))));
    am = DPPMAX(am, 0xB1); am = DPPMAX(am, 0x4E); am = DPPMAX(am, 0x141); am = DPPMAX(am, 0x140);
    { const unsigned a0 = __builtin_amdgcn_readlane(__float_as_uint(am), 0), a1 = __builtin_amdgcn_readlane(__float_as_uint(am), 16);
      const unsigned a2 = __builtin_amdgcn_readlane(__float_as_uint(am), 32), a3 = __builtin_amdgcn_readlane(__float_as_uint(am), 48);
      const unsigned m01 = a0 > a1 ? a0 : a1, m23 = a2 > a3 ? a2 : a3; am = __uint_as_float(m01 > m23 ? m01 : m23); }
    const float inv = am > 0.f ? 127.f / am : 0.f;
#pragma unroll
    for (int i = 0; i < 8; ++i) {
        const unsigned o = pack_i8x4(v[i] * inv);
        if (ROWMAJOR) *(unsigned*)(tab + (size_t)row * D + i * 256 + lane * 4) = o;
        else *(unsigned*)(tab + ((size_t)(2 * i) * 16384 + row) * 128 + ((unsigned)(lane >> 5) * (16384u * 128u) + (unsigned)(lane & 31) * 4u)) = o;
    }
    if (lane == 0) *scale = am / 127.f;
}
__device__ __forceinline__ void step_tab_probe(const Ctx& c) {
#define TABP_SRC(r_) ((r_) < 16384 ? IN_U + (size_t)(r_) * D : IN_V + (size_t)((r_) - 16384) * D)
    f32x4 cur[8], nxt[8];
    int r = c.gw;
#if TAB_PROBE == 1
    if (r < 2 * 16384) fp8_row_load(cur, TABP_SRC(r), c.lane);
    for (; r < 2 * 16384; r += c.ngw) {
        const int rn = r + c.ngw;
        if (rn < 2 * 16384) fp8_row_load(nxt, TABP_SRC(rn), c.lane);
        if (r < 16384) fp8_row_finish<true>(cur, WSP(unsigned char, WS_UB), r, WSP(float, WS_SCU) + r, c.lane);
        else fp8_row_finish<true>(cur, WSP(unsigned char, WS_VB), r - 16384, WSP(float, WS_SCV) + (r - 16384), c.lane);
#pragma unroll
        for (int i = 0; i < 8; ++i) cur[i] = nxt[i];
    }
#elif TAB_PROBE == 2 || TAB_PROBE == 3
    if (r < 2 * 16384) tabp_load_coal(cur, TABP_SRC(r), c.lane);
    for (; r < 2 * 16384; r += c.ngw) {
        const int rn = r + c.ngw;
        if (rn < 2 * 16384) tabp_load_coal(nxt, TABP_SRC(rn), c.lane);
        if (r < 16384) tabp_finish_coal<TAB_PROBE == 3>(cur, WSP(unsigned char, WS_UB), r, WSP(float, WS_SCU) + r, c.lane);
        else tabp_finish_coal<TAB_PROBE == 3>(cur, WSP(unsigned char, WS_VB), r - 16384, WSP(float, WS_SCV) + (r - 16384), c.lane);
#pragma unroll
        for (int i = 0; i < 8; ++i) cur[i] = nxt[i];
    }
#elif TAB_PROBE == 4
    float acc_ = 0.f;
    for (; r < 2 * 16384; r += c.ngw) { tabp_load_coal(cur, TABP_SRC(r), c.lane);
#pragma unroll
        for (int i = 0; i < 8; ++i) acc_ += (cur[i].x + cur[i].y) + (cur[i].z + cur[i].w); }
    if (acc_ == 1.2345e-30f) WSP(float, WS_SCU)[0] = acc_;
#endif
#undef TABP_SRC
}
#endif

constexpr int NSTEPS = 18;
__global__ void __launch_bounds__(NTHR, 2) fwd_kernel(Args a) {
    extern __shared__ __attribute__((aligned(16))) unsigned char lds_raw[];
    Ctx c;
#pragma unroll
    for (int i = 0; i < 22; ++i) c.in[i] = a.in[i];
    c.out = a.out; c.ws = a.ws; c.lds = (LAS unsigned char*)lds_raw;
    c.tid = threadIdx.x; c.lane = c.tid & 63; c.wave = __builtin_amdgcn_readfirstlane(c.tid >> 6);
    c.gw = blockIdx.x * NWAVES + c.wave; c.ngw = gridDim.x * NWAVES; c.gt = blockIdx.x * NTHR + c.tid; c.ngt = gridDim.x * NTHR;
    for (int u = c.tid; u < (LDS_BYTES - LDSCTL_OFF) / 4; u += NTHR) ((LAS unsigned*)(c.lds + LDSCTL_OFF))[u] = 0u;
    __syncthreads();
    const bool multi = (a.hi - a.lo) > 1;
    XcdBarrier bar; bar.bar = (unsigned*)(c.ws + WS_CTL); bar.x = 0; bar.st = (volatile LAS unsigned*)(c.lds + MISC_OFF);
    if (multi) bar = xcd_barrier_post((unsigned*)(c.ws + WS_CTL), (volatile LAS unsigned*)(c.lds + MISC_OFF));
#define STEP_IDS() { int tid_ = (int)threadIdx.x; asm volatile("" : "+v"(tid_)); c.tid = tid_; c.lane = tid_ & 63; c.gt = (int)blockIdx.x * NTHR + tid_; }
#define STEP(i, ...) if (a.lo <= (i) && (i) < a.hi) { STEP_IDS(); __VA_ARGS__; if ((REPEAT_MASK >> (i)) & 1) { xcd_barrier(bar); __VA_ARGS__; } if ((i) + 1 < a.hi) xcd_barrier(bar); }
    STEP(0, step_pro(c));
#if WQ_ONEPASS && I8_GEMM1 && I8_GEMM2 && I8_GEMM3 && FAST_GEMM
    STEP(1, step_h1(c));
#else
    STEP(1, { step_h1(c); step_wq8(c); });
#endif
#if FAST_GEMM
#define RUN_GEMM(EPI, MIDK, Aoff, Boff, N_, ...) { pg8::Gemm g{WSP(bf16_t, Aoff), WSP(bf16_t, Boff), T, N_, D}; pg8::StaticOrder S; S.init(T, N_, (int)gridDim.x, (int)blockIdx.x); \
        pg8::EpiA<EPI> E{EPI{__VA_ARGS__}}; pg8::gemm_phase<pg8::EpiA<EPI>, pg8::StaticOrder, false, true, MIDK>(c.lds, g, S, E); }
#else
#define RUN_GEMM(EPI, MIDK, Aoff, Boff, N_, ...) { EPI e{__VA_ARGS__}; gemm_simple<EPI, MIDK>(c, WSP(bf16_t, Aoff), WSP(bf16_t, Boff), T, N_, D, e); }
#endif
#if I8_GEMM1 && FAST_GEMM
    STEP(2, { pg8::Gemm g{WSP(bf16_t, WS_ACT), WSP(bf16_t, WS_WIN), T, DINP, D / 2}; pg8::StaticOrder S; S.init(T, DINP, (int)gridDim.x, (int)blockIdx.x);
        pg8::EpiA<Epi1Q, true> E{Epi1Q{WSP(bf16_t, WS_PROJ), WSP(float, WS_DTRAW), WSP(float, WS_SA1), WSP(float, WS_SWIN)}}; pg8::gemm_phase<pg8::EpiA<Epi1Q, true>, pg8::StaticOrder, false, true, false, true>(c.lds, g, S, E); });
#else
    STEP(2, RUN_GEMM(Epi1, false, WS_ACT, WS_WIN, DINP, WSP(bf16_t, WS_PROJ), WSP(float, WS_DTRAW)));
#endif
#if (FAST_MIX & 5) == 5
    STEP(3, { step_att_fast(c); step_conv_only(c); step_dta(c); });
#elif FAST_MIX & 1
    STEP(3, { step_conv_only(c); step_dta(c); });
#else
    STEP(3, step_conv(c));
#endif
#if FAST_MIX & 2
    STEP(4, step_ssd1_fast(c));
#else
    STEP(4, step_ssd1_simple(c));
#endif
#if (FAST_MIX & 5) == 5
#elif FAST_MIX & 4
    STEP(5, step_att_fast(c));
#else
    STEP(5, step_att_simple(c));
#endif
    STEP(6, step_scan(c));
#if FAST_MIX & 8
    STEP(8, step_ssd2_fast(c));
#else
    STEP(7, step_cb_simple(c));
    STEP(8, step_ssd2_simple(c));
#endif
#if I8_GEMM2 && FAST_GEMM
    STEP(9, step_requant(c));
    STEP(10, { pg8::Gemm g{WSP(bf16_t, WS_A8), WSP(bf16_t, WS_WOUT), T, D, D / 2}; pg8::StaticOrder S; S.init(T, D, (int)gridDim.x, (int)blockIdx.x);
        pg8::EpiA<Epi2Q, true> E{Epi2Q{WSP(float, WS_MOD), WSP(float, WS_SA2), WSP(float, WS_SWOUT), WSP(bf16_t, WS_R1B)}}; pg8::gemm_phase<pg8::EpiA<Epi2Q, true>, pg8::StaticOrder, false, true, false, true>(c.lds, g, S, E); });
#else
    STEP(10, RUN_GEMM(Epi2, true, WS_ACT, WS_WOUT, D, IN_X, WSP(float, WS_MOD), WSP(float, WS_SSP), WSP(bf16_t, WS_R1B)));
#endif
    STEP(11, step_ln1(c));
#if I8_GEMM3 && FAST_GEMM && FUSE_TOPK && FAST_TOPK
    STEP(12, { pg8::Gemm g{WSP(bf16_t, WS_H2Q), WSP(bf16_t, WS_WQ), T, D, D / 2}; pg8::StaticOrder S; S.init(T, D, (int)gridDim.x, (int)blockIdx.x);
        pg8::EpiA<Epi3Q, true> E{Epi3Q{WSP(bf16_t, WS_PROJ), WSP(float, WS_HS), WSP(float, WS_SWQ)}}; pg8::gemm_phase<pg8::EpiA<Epi3Q, true>, pg8::StaticOrder, false, true, false, true>(c.lds, g, S, E);
        asm volatile("s_waitcnt vmcnt(0)" ::: "memory"); __syncthreads();
        pg8::Unit u; for (int i = 0; S.next(i, u); ++i) topk_groups(c, u.pn, u.pm * 8 + c.wave, u.pm * 8 + c.wave + 1, 1); });
#else
#if I8_GEMM3 && FAST_GEMM
    STEP(12, { pg8::Gemm g{WSP(bf16_t, WS_H2Q), WSP(bf16_t, WS_WQ), T, D, D / 2}; pg8::StaticOrder S; S.init(T, D, (int)gridDim.x, (int)blockIdx.x);
        pg8::EpiA<Epi3Q, true> E{Epi3Q{WSP(bf16_t, WS_PROJ), WSP(float, WS_HS), WSP(float, WS_SWQ)}}; pg8::gemm_phase<pg8::EpiA<Epi3Q, true>, pg8::StaticOrder, false, true, false, true>(c.lds, g, S, E); });
#else
    STEP(12, RUN_GEMM(Epi3, false, WS_ACT, WS_WQ, D, WSP(bf16_t, WS_PROJ)));
#endif
#if FAST_TOPK
    STEP(13, step_topk_fast(c));
#else
    STEP(13, step_topk_simple(c));
#endif
#endif
#if SLICED_PEER
    XcdPlace P; P.nloc = (int)gridDim.x; P.nx = 1; P.xrank = 0; P.rank = (int)blockIdx.x;
    if (multi && a.lo <= 14 && 14 < a.hi) {
        unsigned* bw = (unsigned*)(c.ws + WS_CTL); const unsigned myx = xb_xcc_id();
        LAS unsigned* pl = (LAS unsigned*)(c.lds + LDSCTL_OFF + 16);
        if (c.tid == 0) pl[0] = xb_add(bw + 16384 + 64 * myx, 1u);
        __syncthreads();
        int nx = 0, xr = 0, nl = 0;
#pragma unroll
        for (int j = 0; j < 16; ++j) { const int cj = (int)xb_ld(&bw[XB_XCNT(j)]); if (cj > 0) { if (j < (int)myx) ++xr; ++nx; } if (j == (int)myx) nl = cj; }
        if (nl > 0 && nx > 0) { P.nloc = nl; P.nx = nx; P.xrank = xr; P.rank = (int)pl[0]; }
    }
    STEP(14, step_peer_u(c, P));
    STEP(15, step_peer_w(c));
    STEP(16, step_peer_v(c, P));
#if TAB_PROBE
    STEP(17, { step_ln2(c); xcd_barrier(bar); step_tab_probe(c); });
#else
    STEP(17, step_ln2(c));
#endif
#else
    STEP(14, step_peer(c));
#endif
#undef STEP
}
}

extern "C" void kernel_launch(void* const* d_in, const int* in_sizes, int n_in, void* d_out, int out_size, void* d_ws, size_t ws_size, hipStream_t stream) {
    static int grid = 0;
    if (grid == 0) {
        if (n_in != 22 || in_sizes[0] != T * D || out_size != T * D || ws_size < WS_END) {
            fprintf(stderr, "kernel_launch: unexpected problem (n_in %d, in0 %d, out %d, ws %zu < %zu); nothing launched\n", n_in, n_in > 0 ? in_sizes[0] : -1, out_size, ws_size, (size_t)WS_END);
            grid = -1; return;
        }
        int dev = 0, cus = 0;
        if (hipGetDevice(&dev) != hipSuccess || hipDeviceGetAttribute(&cus, hipDeviceAttributeMultiprocessorCount, dev) != hipSuccess) { grid = -1; return; }
        if (hipFuncSetAttribute((const void*)fwd_kernel, hipFuncAttributeMaxDynamicSharedMemorySize, LDS_BYTES) != hipSuccess) { fprintf(stderr, "kernel_launch: hipFuncSetAttribute failed\n"); grid = -1; return; }
        int per_cu = 0;
        if (hipOccupancyMaxActiveBlocksPerMultiprocessor(&per_cu, (const void*)fwd_kernel, NTHR, LDS_BYTES) != hipSuccess || per_cu < 1) fprintf(stderr, "kernel_launch: occupancy query reports %d blocks per CU\n", per_cu);
        (void)hipGetLastError();
        grid = cus > 0 ? cus : 256;
    }
    if (grid < 0) return;
    (void)hipMemsetAsync((char*)d_ws + WS_CTL, 0, CTL_ZERO_BYTES, stream);
    Args a{};
    for (int i = 0; i < 22; ++i) a.in[i] = (const float*)d_in[i];
    a.out = (float*)d_out; a.ws = (unsigned char*)d_ws;
#if ONE_LAUNCH
    a.lo = 0; a.hi = NSTEPS;
    hipLaunchKernelGGL(fwd_kernel, dim3(grid), dim3(NTHR), LDS_BYTES, stream, a);
#else
    for (int i = 0; i < NSTEPS; ++i) { a.lo = i; a.hi = i + 1; hipLaunchKernelGGL(fwd_kernel, dim3(grid), dim3(NTHR), LDS_BYTES, stream, a); }
#endif
}
```

```cpp
#include <hip/hip_runtime.h>
#include <cstdio>
#include <cstdint>

#ifndef ONE_LAUNCH
#define ONE_LAUNCH 1
#endif
#ifndef FAST_GEMM
#define FAST_GEMM 1
#endif
#ifndef FAST_TOPK
#define FAST_TOPK 1
#endif
#ifndef FAST_MIX
#define FAST_MIX 15
#endif
#ifndef SLICED_PEER
#define SLICED_PEER 1
#endif
#ifndef PRO_REPEAT
#define PRO_REPEAT 0
#endif
#ifndef V_INT8
#define V_INT8 1
#endif
#ifndef HIDE_TABLES
#define HIDE_TABLES 1
#endif
#ifndef I8_GEMM3
#define I8_GEMM3 1
#endif
#ifndef I8_GEMM1
#define I8_GEMM1 1
#endif
#ifndef I8_GEMM2
#define I8_GEMM2 1
#endif
#ifndef PART16
#define PART16 1
#endif
#ifndef FUSE_TOPK
#define FUSE_TOPK 1
#endif
#ifndef WQ_ONEPASS
#define WQ_ONEPASS 1
#endif
#ifndef TAB_PROBE
#define TAB_PROBE 0
#endif
#ifndef SSD2_PROBE
#define SSD2_PROBE 0
#endif
#ifndef REPEAT_MASK
#define REPEAT_MASK 0
#endif

#define LAS __attribute__((address_space(3)))
typedef unsigned short bf16_t;
typedef float f32x4 __attribute__((ext_vector_type(4)));
typedef unsigned u32x4 __attribute__((ext_vector_type(4)));
typedef unsigned u32x2 __attribute__((ext_vector_type(2)));

namespace {
constexpr int NB = 4, SEQ = 4096, T = NB * SEQ, D = 2048;
constexpr int NH = 16, NCH = SEQ / 128;
constexpr int DINP = 4096;
constexpr int Z_OFF = 0, XBC_OFF = 1024, Q_OFF = 2560, K_OFF = 3584, V_OFF = 3712, DT_OFF = 3840;
constexpr int NMOD = 6 * D;
constexpr float ALPHA = 1.189207115002721f;
constexpr float EPS = 1e-5f;
constexpr int NTHR = 512, NWAVES = 8;

constexpr size_t MiB = 1u << 20;
constexpr size_t WS_CTL = 0, CTL_ZERO_BYTES = 1 * MiB;
constexpr size_t WS_MOD = 512 * 1024;
constexpr size_t WS_KEYS = 1 * MiB;
constexpr size_t WS_DTRAW = 2 * MiB;
constexpr size_t WS_DT = 3 * MiB;
constexpr size_t WS_ACUM = 4 * MiB;
constexpr size_t WS_SSP = 5 * MiB;
constexpr size_t WS_RS = 7 * MiB;
constexpr size_t WS_SCU = 7 * MiB + 256 * 1024, WS_SCV = 7 * MiB + 512 * 1024;
constexpr size_t WS_EXP = 8 * MiB;
constexpr size_t WS_GATE = 16 * MiB;
constexpr size_t WS_WIN = 24 * MiB;
constexpr size_t WS_WOUT = 40 * MiB;
constexpr size_t WS_WQ = 48 * MiB;
constexpr size_t WS_UB = 56 * MiB;
constexpr size_t WS_VB = 120 * MiB;
constexpr size_t WS_ACT = 184 * MiB;
constexpr size_t WS_PROJ = 248 * MiB;
constexpr size_t WS_XBCC = 376 * MiB;
constexpr size_t WS_STATES = 424 * MiB;
constexpr size_t WS_PREVB = 488 * MiB;
constexpr size_t WS_H2Q = 504 * MiB;
constexpr size_t WS_W8 = 5 * MiB;
constexpr size_t WS_WS = 7 * MiB + 128 * 1024;
constexpr size_t WS_SWQ = 7 * MiB + 64 * 1024, WS_SWIN = 7 * MiB + 80 * 1024, WS_SA1 = 7 * MiB + 320 * 1024;
constexpr int CW_AMXQ = 32768, CW_AMXIN = 36864;
constexpr size_t WS_A8 = WS_XBCC;
constexpr size_t WS_SA2 = 7 * MiB + 384 * 1024, WS_SWOUT = 7 * MiB + 96 * 1024;
constexpr int CW_AMXOUT = 40960;
constexpr size_t WS_HS = 7 * MiB;
constexpr size_t WS_END = 536 * MiB;
constexpr size_t WS_R1B = WS_PROJ, WS_X1B = WS_PROJ + 64 * MiB, WS_Q = WS_PROJ, WS_PARTA = WS_XBCC, WS_Y = WS_ACT;

constexpr int RING_BYTES = 131072;
constexpr int LDSCTL_OFF = 163840 - 64, MISC_OFF = LDSCTL_OFF;
constexpr int LDS_BYTES = 163840;

__device__ __forceinline__ float bf2f(unsigned v) { return __uint_as_float(v << 16); }
__device__ __forceinline__ float bflo(unsigned w) { return __uint_as_float(w << 16); }
__device__ __forceinline__ float bfhi(unsigned w) { return __uint_as_float(w & 0xffff0000u); }
__device__ __forceinline__ unsigned f2bf(float f) { unsigned u = __float_as_uint(f); return (u + 0x7fffu + ((u >> 16) & 1u)) >> 16; }
__device__ __forceinline__ unsigned pk2(float lo, float hi) { return f2bf(lo) | (f2bf(hi) << 16); }
typedef __bf16 bf16x2n __attribute__((ext_vector_type(2)));
typedef float f32x2n __attribute__((ext_vector_type(2)));
__device__ __forceinline__ unsigned cvtpk(float lo, float hi) { const bf16x2n r = __builtin_convertvector((f32x2n){lo, hi}, bf16x2n); return __builtin_bit_cast(unsigned, r); }
__device__ __forceinline__ float fexp(float x) { return __builtin_amdgcn_exp2f(x * 1.4426950408889634f); }
__device__ __forceinline__ float silu_f(float x) { return x * __builtin_amdgcn_rcpf(1.f + fexp(-x)); }
__device__ __forceinline__ float softplus_f(float x) { return x > 20.f ? x : log1pf(expf(x)); }
__device__ __forceinline__ float gelu_f(float x) { return 0.5f * x * (1.f + erff(x * 0.70710678118654752f)); }
__device__ __forceinline__ float wave_sum(float v) {
#pragma unroll
    for (int o = 1; o < 64; o <<= 1) v += __shfl_xor(v, o);
    return v;
}
__device__ __forceinline__ float dot8(u32x4 a, u32x4 b) {
    float s = bflo(a.x) * bflo(b.x); s += bfhi(a.x) * bfhi(b.x);
    s += bflo(a.y) * bflo(b.y); s += bfhi(a.y) * bfhi(b.y);
    s += bflo(a.z) * bflo(b.z); s += bfhi(a.z) * bfhi(b.z);
    s += bflo(a.w) * bflo(b.w); s += bfhi(a.w) * bfhi(b.w);
    return s;
}
__device__ __forceinline__ int win_src_col(int n) { return n < 2560 ? n : (n < 3840 ? n + 16 : (n < 3856 ? n - 1280 : -1)); }

#define XB_TMO      128
#define XB_XCNT(j)  (256  + 64 * (j))
#define XB_XSUB(j)  (1280 + 64 * (j))
#define XB_XGEN(j)  (2304 + 64 * (j))
#define XB_TOP      3328
#define XB_TOPGEN   3392
#define XCD_BAR_WORDS 3456
#define XB_SPIN_CAP (1u << 18)
__device__ __forceinline__ unsigned xb_ld(unsigned* p)              { return __hip_atomic_load(p, __ATOMIC_RELAXED, __HIP_MEMORY_SCOPE_AGENT); }
__device__ __forceinline__ unsigned xb_add(unsigned* p, unsigned v) { return __hip_atomic_fetch_add(p, v, __ATOMIC_RELAXED, __HIP_MEMORY_SCOPE_AGENT); }
__device__ __forceinline__ unsigned xb_xcc_id() { return (unsigned)__builtin_amdgcn_s_getreg((3 << 11) | 20) & 0xFu; }
#define XB_SPIN(cond, bar) do { unsigned _sp = 0; while (cond) { __builtin_amdgcn_s_sleep(1); \
    if ((++_sp & 255u) == 0u) { if (xb_ld(&(bar)[XB_TMO])) break; if (_sp > XB_SPIN_CAP) { atomicAdd(&(bar)[XB_TMO], 1u); break; } } } } while (0)
struct XcdBarrier { unsigned* bar; unsigned x; volatile LAS unsigned* st; };
__device__ __forceinline__ XcdBarrier xcd_barrier_post(unsigned* bar, volatile LAS unsigned* st) {
    XcdBarrier b; b.bar = bar; b.x = xb_xcc_id(); b.st = st;
    if (threadIdx.x == 0) (void)xb_add(&bar[XB_XCNT(b.x)], 1u);
    return b;
}
__device__ __forceinline__ void xcd_barrier_complete(unsigned* bar, unsigned x, unsigned& nloc, unsigned& nx) {
    const unsigned G = gridDim.x * gridDim.y * gridDim.z;
    unsigned sum, cnt, mine, sp = 0u;
    for (;;) {
        sum = 0u; cnt = 0u; mine = 0u;
#pragma unroll
        for (unsigned j = 0; j < 16; ++j) { const unsigned c = xb_ld(&bar[XB_XCNT(j)]); sum += c; cnt += (c > 0u) ? 1u : 0u; mine = (j == x) ? c : mine; }
        if (sum == G) break;
        __builtin_amdgcn_s_sleep(1);
        if ((++sp & 255u) == 0u) { if (xb_ld(&bar[XB_TMO])) break; if (sp > XB_SPIN_CAP) { atomicAdd(&bar[XB_TMO], 1u); break; } }
    }
    nloc = mine > 0u ? mine : 1u; nx = cnt > 0u ? cnt : 1u;
}
__device__ __forceinline__ void xcd_barrier(const XcdBarrier& b) {
    asm volatile("s_waitcnt vmcnt(0)" ::: "memory");
    __syncthreads();
    if (threadIdx.x == 0) {
        unsigned* bar = b.bar;
        __builtin_amdgcn_s_waitcnt(0);
        unsigned nloc = b.st[0], nx = b.st[1];
        if (nloc == 0u) { xcd_barrier_complete(bar, b.x, nloc, nx); b.st[0] = nloc; b.st[1] = nx; }
        const unsigned old = xb_add(&bar[XB_XSUB(b.x)], 1u);
        const unsigned gen = old / nloc;
        if (old + 1u == (gen + 1u) * nloc) {
            __builtin_amdgcn_fence(__ATOMIC_RELEASE, "agent");
            asm volatile("s_waitcnt vmcnt(0)" ::: "memory");
            const unsigned og = xb_add(&bar[XB_TOP], 1u);
            const unsigned tg = og / nx;
            if (og + 1u == (tg + 1u) * nx) xb_add(&bar[XB_TOPGEN], 1u);
            else XB_SPIN(xb_ld(&bar[XB_TOPGEN]) == tg, bar);
            __builtin_amdgcn_fence(__ATOMIC_ACQUIRE, "agent");
            xb_add(&bar[XB_XGEN(b.x)], 1u);
            asm volatile("s_waitcnt vmcnt(0)" ::: "memory");
        } else {
            XB_SPIN(xb_ld(&bar[XB_XGEN(b.x)]) == gen, bar);
            __builtin_amdgcn_fence(__ATOMIC_ACQUIRE, "agent");
            asm volatile("s_waitcnt vmcnt(0)" ::: "memory");
        }
    }
    __syncthreads();
}

struct Args { const float* in[22]; float* out; unsigned char* ws; int lo, hi; };
struct Ctx {
    const float* in[22]; float* out; unsigned char* ws; LAS unsigned char* lds;
    int tid, lane, wave, gw, ngw, gt, ngt;
};
#define IN_X c.in[0]
#define IN_C c.in[1]
#define IN_WADA c.in[2]
#define IN_BADA c.in[3]
#define IN_WIN c.in[4]
#define IN_CONVW c.in[5]
#define IN_CONVB c.in[6]
#define IN_DTBIAS c.in[7]
#define IN_ALOG c.in[8]
#define IN_DSKIP c.in[9]
#define IN_SSMG c.in[10]
#define IN_SINKS c.in[11]
#define IN_ATTG c.in[12]
#define IN_WOUT c.in[13]
#define IN_LN1G c.in[14]
#define IN_LN1B c.in[15]
#define IN_WQ c.in[16]
#define IN_KEYS c.in[17]
#define IN_U c.in[18]
#define IN_V c.in[19]
#define IN_LN2G c.in[20]
#define IN_LN2B c.in[21]
#define WSP(type, off) ((type*)(c.ws + (off)))


typedef float f32x2 __attribute__((ext_vector_type(2)));
typedef short bf16x8v __attribute__((ext_vector_type(8)));
typedef float f32x16 __attribute__((ext_vector_type(16)));
#define DPPF(v, ctrl) __int_as_float(__builtin_amdgcn_update_dpp(0, __float_as_int(v), (ctrl), 0xF, 0xF, true))
__device__ __forceinline__ float row_sum16(float v) {
    v += DPPF(v, 0xB1); v += DPPF(v, 0x4E); v += DPPF(v, 0x141); v += DPPF(v, 0x140); return v;
}
__device__ __forceinline__ float wave_sum63(float v) {
    v = row_sum16(v);
    v += __int_as_float(__builtin_amdgcn_update_dpp(0, __float_as_int(v), 0x142, 0xA, 0xF, false));
    v += __int_as_float(__builtin_amdgcn_update_dpp(0, __float_as_int(v), 0x143, 0xC, 0xF, false));
    return v;
}
__device__ __forceinline__ float lane63(float v) { return __int_as_float(__builtin_amdgcn_readlane(__float_as_int(v), 63)); }
__device__ __forceinline__ float wave_sum_all(float v) { return lane63(wave_sum63(v)); }
__device__ __forceinline__ void fp8_row_load(f32x4 (&v)[8], const float* src, int lane) {
#pragma unroll
    for (int j = 0; j < 2; ++j)
#pragma unroll
        for (int q = 0; q < 4; ++q) v[j * 4 + q] = *(const f32x4*)(src + j * 1024 + lane * 16 + q * 4);
}
#define DPPMAX(v, ctrl) fmaxf(v, __int_as_float(__builtin_amdgcn_update_dpp(0, __float_as_int(v), (ctrl), 0xF, 0xF, true)))
__device__ __forceinline__ unsigned pack_i8x4(f32x4 x) {
    const float M = 12582912.f;
    const unsigned a = __float_as_uint(x.x + M), b = __float_as_uint(x.y + M), c = __float_as_uint(x.z + M), d = __float_as_uint(x.w + M);
    return __builtin_amdgcn_perm(b, a, 0x0c0c0400u) | __builtin_amdgcn_perm(d, c, 0x04000c0cu);
}
template <bool INT8>
__device__ __forceinline__ void fp8_row_finish(const f32x4 (&v)[8], unsigned char* tab, int row, float* scale, int lane) {
    float am = 0.f;
#pragma unroll
    for (int i = 0; i < 8; ++i) am = fmaxf(am, fmaxf(fmaxf(fabsf(v[i].x), fabsf(v[i].y)), fmaxf(fabsf(v[i].z), fabsf(v[i].w))));
    am = DPPMAX(am, 0xB1); am = DPPMAX(am, 0x4E); am = DPPMAX(am, 0x141); am = DPPMAX(am, 0x140);
    {
        const unsigned a0 = __builtin_amdgcn_readlane(__float_as_uint(am), 0), a1 = __builtin_amdgcn_readlane(__float_as_uint(am), 16);
        const unsigned a2 = __builtin_amdgcn_readlane(__float_as_uint(am), 32), a3 = __builtin_amdgcn_readlane(__float_as_uint(am), 48);
        const unsigned m01 = a0 > a1 ? a0 : a1, m23 = a2 > a3 ? a2 : a3; am = __uint_as_float(m01 > m23 ? m01 : m23);
    }
    const float top = INT8 ? 127.f : 448.f;
    const float inv = am > 0.f ? top / am : 0.f;
#pragma unroll
    for (int j = 0; j < 2; ++j) {
        u32x4 o;
#pragma unroll
        for (int q = 0; q < 4; ++q) { const f32x4 x = v[j * 4 + q] * inv;
            if (INT8) o[q] = pack_i8x4(x);
            else { int w = 0; w = __builtin_amdgcn_cvt_pk_fp8_f32(x.x, x.y, w, false); w = __builtin_amdgcn_cvt_pk_fp8_f32(x.z, x.w, w, true); o[q] = (unsigned)w; } }
#if SLICED_PEER
        *(u32x4*)(tab + ((size_t)(8 * j + (lane >> 3)) * 16384 + row) * 128 + (lane & 7) * 16) = o;
#else
        *(u32x4*)(tab + (size_t)row * D + j * 1024 + lane * 16) = o;
#endif
    }
    if (lane == 0) *scale = am / top;
}

template <bool WIN_MAP, bool GAINS = false>
__device__ __forceinline__ void colamax_items(const Ctx& c, const float* W, int Nsrc, unsigned* AMX, const float* g1 = nullptr, const float* g2 = nullptr) {
    const int nblk = (Nsrc + 255) / 256;
    for (int it = c.gw; it < 32 * nblk; it += c.ngw) {
        const int kb = it / nblk, nb = it % nblk, col = nb * 256 + c.lane * 4;
        if (col < Nsrc) {
            f32x4 m = {0.f, 0.f, 0.f, 0.f};
            const float* wp = W + (size_t)(kb * 64) * Nsrc + col;
#pragma unroll 16
            for (int kk = 0; kk < 64; ++kk) { f32x4 v = *(const f32x4*)(wp + (size_t)kk * Nsrc); if (GAINS) { const int k = kb * 64 + kk; v = v * (k < 1024 ? g1[k] : g2[k - 1024]); } m.x = fmaxf(m.x, fabsf(v.x)); m.y = fmaxf(m.y, fabsf(v.y)); m.z = fmaxf(m.z, fabsf(v.z)); m.w = fmaxf(m.w, fabsf(v.w)); }
#pragma unroll
            for (int j = 0; j < 4; ++j) { const int sc = col + j; const int dn = WIN_MAP ? (sc < 2560 ? sc : (sc < 2576 ? sc + 1280 : sc - 16)) : sc;
                atomicMax(AMX + dn, __float_as_uint(m[j])); }
        }
    }
}
template <bool WIN_MAP, bool GAINS = false>
__device__ __forceinline__ void transpose_item_i8(const float* W, int K, int Nsrc, int ND, unsigned char* WT, const unsigned* AMX, float* SW, LAS float* scr, int item, int lane, const float* g1 = nullptr, const float* g2 = nullptr) {
    const int nblk = ND / 32, kb = item / nblk, nb = item % nblk, k0 = 64 * kb, n0 = 32 * nb;
    const int n = n0 + (lane & 31), sc = WIN_MAP ? win_src_col(n) : n;
    const float am = __uint_as_float(AMX[n]), inv = am > 0.f ? 127.f / am : 0.f;
    float tv[32];
    const float* wp = W + (size_t)(k0 + (lane >> 5)) * Nsrc + (sc >= 0 ? sc : 0);
#pragma unroll
    for (int i = 0; i < 32; ++i) tv[i] = wp[(size_t)(2 * i) * Nsrc];
#pragma unroll
    for (int i = 0; i < 32; ++i) { const int kk = k0 + 2 * i + (lane >> 5); float v = sc >= 0 ? tv[i] * inv : 0.f; if (GAINS) v *= (kk < 1024 ? g1[kk] : g2[kk - 1024]); scr[(2 * i + (lane >> 5)) * 33 + (lane & 31)] = v; }
    asm volatile("s_waitcnt lgkmcnt(0)" ::: "memory");
#pragma unroll
    for (int j = 0; j < 2; ++j) {
        const int ch = lane + 64 * j, nn = ch >> 2, kc = ch & 3; const LAS float* sp = scr + (16 * kc) * 33 + nn;
        u32x4 o;
#pragma unroll
        for (int q = 0; q < 4; ++q) o[q] = pack_i8x4((f32x4){sp[(4 * q) * 33], sp[(4 * q + 1) * 33], sp[(4 * q + 2) * 33], sp[(4 * q + 3) * 33]});
        *(u32x4*)(WT + (size_t)(n0 + nn) * K + k0 + 16 * kc) = o;
    }
    if (kb == 0 && lane < 32) SW[n] = am * (1.f / 127.f);
    asm volatile("s_waitcnt lgkmcnt(0)" ::: "memory");
}
template <int MODE>
__device__ __forceinline__ void wquant_block(const Ctx& c, const float* W, int Nsrc, int nb, unsigned char* WT, float* SW, const float* g1, const float* g2) {
    constexpr int PITCH = 4112;
    LAS unsigned char* Lb = c.lds;
    LAS float* red = (LAS float*)(c.lds + 32 * PITCH);
    const int n = c.lane & 31, half = c.lane >> 5, n0 = nb * 32, dn = n0 + n, sc = MODE == 0 ? win_src_col(dn) : dn;
    const float* wp = W + (size_t)(c.wave * 256 + 2 * half) * Nsrc + (sc >= 0 ? sc : 0);
    float am = 0.f;
#pragma unroll 1
    for (int it0 = 0; it0 < 64; it0 += 8) {
        float v0[8], v1[8];
#pragma unroll
        for (int u = 0; u < 8; ++u) { const float* p = wp + (size_t)(4 * (it0 + u)) * Nsrc; v0[u] = p[0]; v1[u] = p[Nsrc]; }
#pragma unroll
        for (int u = 0; u < 8; ++u) {
            const int k = c.wave * 256 + 4 * (it0 + u) + 2 * half;
            float a = sc >= 0 ? v0[u] : 0.f, b = sc >= 0 ? v1[u] : 0.f;
            if (MODE == 1) { a *= (k < 1024 ? g1[k] : g2[k - 1024]); b *= (k + 1 < 1024 ? g1[k + 1] : g2[k + 1 - 1024]); }
            am = fmaxf(am, fmaxf(fabsf(a), fabsf(b)));
            *(LAS unsigned*)(Lb + n * PITCH + k * 2) = cvtpk(a, b);
        }
    }
    red[(c.wave * 2 + half) * 32 + n] = am;
    __syncthreads();
    if (c.tid < 32) {
        float m = 0.f;
#pragma unroll
        for (int j = 0; j < 16; ++j) m = fmaxf(m, red[j * 32 + c.tid]);
        red[512 + c.tid] = m > 0.f ? 127.f / m : 0.f; SW[n0 + c.tid] = m * (1.f / 127.f);
    }
    __syncthreads();
#pragma unroll 2
    for (int i = 0; i < 8; ++i) {
        const int id = i * NTHR + c.tid, nn = id >> 7, kc = id & 127; const float inv = red[512 + nn];
        const u32x4 r0 = *(const LAS u32x4*)(Lb + nn * PITCH + kc * 32), r1 = *(const LAS u32x4*)(Lb + nn * PITCH + kc * 32 + 16);
        u32x4 o;
        o.x = pack_i8x4((f32x4){bflo(r0.x), bfhi(r0.x), bflo(r0.y), bfhi(r0.y)} * inv); o.y = pack_i8x4((f32x4){bflo(r0.z), bfhi(r0.z), bflo(r0.w), bfhi(r0.w)} * inv);
        o.z = pack_i8x4((f32x4){bflo(r1.x), bfhi(r1.x), bflo(r1.y), bfhi(r1.y)} * inv); o.w = pack_i8x4((f32x4){bflo(r1.z), bfhi(r1.z), bflo(r1.w), bfhi(r1.w)} * inv);
        *(u32x4*)(WT + (size_t)(n0 + nn) * D + kc * 16) = o;
    }
    __syncthreads();
}
template <int MODE>
__device__ __forceinline__ void transpose_item(const float* W, int K, int Nsrc, int ND, bf16_t* WT, LAS float* scr, int item, int lane, const float* g1, const float* g2) {
    const int nblk = ND / 32, kb = item / nblk, nb = item % nblk, k0 = 64 * kb, n0 = 32 * nb;
    const int n = n0 + (lane & 31), sc = MODE == 0 ? win_src_col(n) : n;
    float tv[32];
    const float* wp = W + (size_t)(k0 + (lane >> 5)) * Nsrc + (sc >= 0 ? sc : 0);
#pragma unroll
    for (int i = 0; i < 32; ++i) tv[i] = wp[(size_t)(2 * i) * Nsrc];
#pragma unroll
    for (int i = 0; i < 32; ++i) {
        const int kk = 2 * i + (lane >> 5);
        float v = sc >= 0 ? tv[i] : 0.f;
        if (MODE == 1) v *= (k0 + kk < 1024) ? g1[k0 + kk] : g2[k0 + kk - 1024];
        scr[kk * 33 + (lane & 31)] = v;
    }
    asm volatile("s_waitcnt lgkmcnt(0)" ::: "memory");
    const int cch = lane & 7;
#pragma unroll
    for (int j = 0; j < 4; ++j) {
        const int nn = (lane >> 3) + 8 * j; const LAS float* s = scr + (8 * cch) * 33 + nn;
        u32x4 o; o.x = pk2(s[0 * 33], s[1 * 33]); o.y = pk2(s[2 * 33], s[3 * 33]); o.z = pk2(s[4 * 33], s[5 * 33]); o.w = pk2(s[6 * 33], s[7 * 33]);
        *(u32x4*)(WT + (size_t)(n0 + nn) * K + k0 + 8 * cch) = o;
    }
    asm volatile("s_waitcnt lgkmcnt(0)" ::: "memory");
}
__device__ __forceinline__ void cvt_f32_bf16(const Ctx& c, const float* src, bf16_t* dst, size_t n8) {
    for (size_t i = (size_t)c.gt; i < n8; i += (size_t)c.ngt) {
        const f32x4 a = ((const f32x4*)src)[2 * i], b = ((const f32x4*)src)[2 * i + 1];
        u32x4 o; o.x = pk2(a.x, a.y); o.y = pk2(a.z, a.w); o.z = pk2(b.x, b.y); o.w = pk2(b.z, b.w);
        ((u32x4*)dst)[i] = o;
    }
}
__device__ __forceinline__ void step_pro(const Ctx& c) {
    float* MOD = WSP(float, WS_MOD);
    for (int rep_ = 0; rep_ < 1 + ((PRO_REPEAT >> 0) & 1); ++rep_) {
    {
        LAS float* sl = (LAS float*)c.lds;
        LAS float* red = (LAS float*)(c.lds + 32768);
        for (int i = c.tid; i < 4 * D; i += NTHR) sl[i] = silu_f(IN_C[i]);
        __syncthreads();
        for (int cb = blockIdx.x; cb < NMOD / 48; cb += gridDim.x) {
            const int rsub = c.lane / 12, cq = c.lane % 12; const bool act = c.lane < 60;
            const float* wp = IN_WADA + (size_t)(c.wave * 256) * NMOD + cb * 48 + cq * 4;
            f32x4 a0 = {0.f, 0.f, 0.f, 0.f}, a1 = a0, a2 = a0, a3 = a0;
#pragma unroll 1
            for (int it0 = 0; it0 < 56; it0 += 8) {
                f32x4 wv[8];
#pragma unroll
                for (int u = 0; u < 8; ++u) { const int r = (it0 + u) * 5 + rsub; wv[u] = (act && r < 256) ? *(const f32x4*)(wp + (size_t)r * NMOD) : (f32x4){0.f, 0.f, 0.f, 0.f}; }
#pragma unroll
                for (int u = 0; u < 8; ++u) { const int r = (it0 + u) * 5 + rsub, k = c.wave * 256 + (r < 256 ? r : 255);
                    a0 += wv[u] * sl[k]; a1 += wv[u] * sl[D + k]; a2 += wv[u] * sl[2 * D + k]; a3 += wv[u] * sl[3 * D + k]; }
            }
            if (act) { LAS f32x4* o = (LAS f32x4*)(red + (c.wave * 60 + c.lane) * 16); o[0] = a0; o[1] = a1; o[2] = a2; o[3] = a3; }
            __syncthreads();
            if (c.tid < 192) {
                const int bb = c.tid / 48, j = c.tid % 48, q = j >> 2, e = j & 3;
                float sum = IN_BADA[cb * 48 + j];
#pragma unroll
                for (int w = 0; w < 8; ++w)
#pragma unroll
                    for (int rs = 0; rs < 5; ++rs) sum += red[(w * 60 + rs * 12 + q) * 16 + bb * 4 + e];
                MOD[bb * NMOD + cb * 48 + j] = sum;
            }
            __syncthreads();
        }
    }
    }
    for (int rep_ = 0; rep_ < 1 + ((PRO_REPEAT >> 1) & 1); ++rep_) {
    LAS float* scr = (LAS float*)(c.lds + c.wave * 16384);
    constexpr int I_IN = (D / 64) * (DINP / 32), I_SQ = (D / 64) * (D / 32);
    for (int it = c.gw; it < I_IN + 2 * I_SQ; it += c.ngw) {
        int r = it;
        if (r < I_IN) { if (!(I8_GEMM1 && FAST_GEMM)) transpose_item<0>(IN_WIN, D, 3856, DINP, WSP(bf16_t, WS_WIN), scr, r, c.lane, nullptr, nullptr); continue; } r -= I_IN;
        if (r < I_SQ) { if (!(I8_GEMM2 && FAST_GEMM)) transpose_item<1>(IN_WOUT, D, D, D, WSP(bf16_t, WS_WOUT), scr, r, c.lane, IN_SSMG, IN_ATTG); continue; } r -= I_SQ;
        if (!I8_GEMM3) transpose_item<2>(IN_WQ, D, D, D, WSP(bf16_t, WS_WQ), scr, r, c.lane, nullptr, nullptr);
    }
#if WQ_ONEPASS && I8_GEMM1 && I8_GEMM2 && I8_GEMM3 && FAST_GEMM
    __syncthreads();
    for (int it = blockIdx.x; it < 256; it += gridDim.x) {
        if (it < 128) wquant_block<0>(c, IN_WIN, 3856, it, WSP(unsigned char, WS_WIN), WSP(float, WS_SWIN), nullptr, nullptr);
        else if (it < 192) wquant_block<1>(c, IN_WOUT, D, it - 128, WSP(unsigned char, WS_WOUT), WSP(float, WS_SWOUT), IN_SSMG, IN_ATTG);
        else wquant_block<2>(c, IN_WQ, D, it - 192, WSP(unsigned char, WS_WQ), WSP(float, WS_SWQ), nullptr, nullptr);
    }
#else
    if (I8_GEMM3) colamax_items<false>(c, IN_WQ, D, WSP(unsigned, WS_CTL) + CW_AMXQ);
    if (I8_GEMM1 && FAST_GEMM) colamax_items<true>(c, IN_WIN, 3856, WSP(unsigned, WS_CTL) + CW_AMXIN);
    if (I8_GEMM2 && FAST_GEMM) colamax_items<false, true>(c, IN_WOUT, D, WSP(unsigned, WS_CTL) + CW_AMXOUT, IN_SSMG, IN_ATTG);
#endif
    }
    for (int rep_ = 0; rep_ < (HIDE_TABLES ? 0 : 1) + ((PRO_REPEAT >> 2) & 1); ++rep_) {
    {
#define TAB_SRC(r_) ((r_) < 16384 ? IN_U + (size_t)(r_) * D : IN_V + (size_t)((r_) - 16384) * D)
        f32x4 cur[8], nxt[8];
        int r = c.gw;
        if (r < 2 * 16384) fp8_row_load(cur, TAB_SRC(r), c.lane);
        for (; r < 2 * 16384; r += c.ngw) {
            const int rn = r + c.ngw;
            if (rn < 2 * 16384) fp8_row_load(nxt, TAB_SRC(rn), c.lane);
            if (r < 16384) fp8_row_finish<SLICED_PEER != 0>(cur, WSP(unsigned char, WS_UB), r, WSP(float, WS_SCU) + r, c.lane);
            else fp8_row_finish<(SLICED_PEER != 0) && (V_INT8 != 0)>(cur, WSP(unsigned char, WS_VB), r - 16384, WSP(float, WS_SCV) + (r - 16384), c.lane);
#pragma unroll
            for (int i = 0; i < 8; ++i) cur[i] = nxt[i];
        }
#undef TAB_SRC
    }
    }
    cvt_f32_bf16(c, IN_KEYS, WSP(bf16_t, WS_KEYS), (size_t)8 * 2 * 128 * 128 / 8);
}

__device__ __forceinline__ void step_h1(const Ctx& c) {
    const float* MOD = WSP(float, WS_MOD); bf16_t* H1 = WSP(bf16_t, WS_ACT);
    for (int t = c.gw; t < T; t += c.ngw) {
        const int b = t >> 12; const float* xr = IN_X + (size_t)t * D; const float* sh = MOD + b * NMOD; const float* sc = sh + D;
#if I8_GEMM1 && FAST_GEMM
        f32x4 hv[8]; float hmax = 0.f;
#pragma unroll
        for (int j = 0; j < 8; ++j) {
            const int col = j * 256 + c.lane * 4;
            const f32x4 xv = *(const f32x4*)(xr + col), s = *(const f32x4*)(sc + col), h = *(const f32x4*)(sh + col);
            hv[j] = xv * (s + 1.f) + h; hmax = fmaxf(hmax, fmaxf(fmaxf(fabsf(hv[j].x), fabsf(hv[j].y)), fmaxf(fabsf(hv[j].z), fabsf(hv[j].w))));
        }
        hmax = DPPMAX(hmax, 0xB1); hmax = DPPMAX(hmax, 0x4E); hmax = DPPMAX(hmax, 0x141); hmax = DPPMAX(hmax, 0x140);
        const unsigned a0 = __builtin_amdgcn_readlane(__float_as_uint(hmax), 0), a1 = __builtin_amdgcn_readlane(__float_as_uint(hmax), 16), a2 = __builtin_amdgcn_readlane(__float_as_uint(hmax), 32), a3 = __builtin_amdgcn_readlane(__float_as_uint(hmax), 48);
        const unsigned m01 = a0 > a1 ? a0 : a1, m23 = a2 > a3 ? a2 : a3; const float am = __uint_as_float(m01 > m23 ? m01 : m23), inv = am > 0.f ? 127.f / am : 0.f;
#pragma unroll
        for (int j = 0; j < 8; ++j) *(unsigned*)((unsigned char*)H1 + (size_t)t * D + j * 256 + c.lane * 4) = pack_i8x4(hv[j] * inv);
        if (c.lane == 0) WSP(float, WS_SA1)[t] = am * (1.f / 127.f);
#else
#pragma unroll
        for (int j = 0; j < 8; ++j) {
            const int col = j * 256 + c.lane * 4;
            const f32x4 xv = *(const f32x4*)(xr + col), s = *(const f32x4*)(sc + col), h = *(const f32x4*)(sh + col);
            u32x2 o; o.x = pk2(xv.x * (1.f + s.x) + h.x, xv.y * (1.f + s.y) + h.y); o.y = pk2(xv.z * (1.f + s.z) + h.z, xv.w * (1.f + s.w) + h.w);
            *(u32x2*)(H1 + (size_t)t * D + col) = o;
        }
#endif
    }
}

struct Epi1 {
    bf16_t* proj; float* dtraw;
    __device__ __forceinline__ float rho(int) const { return 1.f; }
    __device__ __forceinline__ float rowscale(int) const { return 1.f; }
    __device__ __forceinline__ void store8s(int row, int col, const float (&v)[8], float) const { store8(row, col, v); }
    __device__ __forceinline__ void store8(int row, int col, const float (&v)[8]) const {
        u32x4 o; o.x = pk2(v[0], v[1]); o.y = pk2(v[2], v[3]); o.z = pk2(v[4], v[5]); o.w = pk2(v[6], v[7]);
        *(u32x4*)(proj + (size_t)row * DINP + col) = o;
        if (col >= DT_OFF && col < DT_OFF + 16) {
            float* d = dtraw + (size_t)row * 16 + (col - DT_OFF);
            *(f32x4*)d = (f32x4){v[0], v[1], v[2], v[3]}; *(f32x4*)(d + 4) = (f32x4){v[4], v[5], v[6], v[7]};
        }
    }
};
struct Epi2 {
    const float* x; const float* mod; const float* ssp; bf16_t* r1;
    __device__ __forceinline__ void rs_pair(int row, float& r_ssd, float& r_att) const {
        float s1 = 0.f, s2 = 0.f;
#pragma unroll
        for (int j = 0; j < 4; ++j) { const f32x4 a = *(const f32x4*)(ssp + (size_t)row * 32 + 4 * j), b = *(const f32x4*)(ssp + (size_t)row * 32 + 16 + 4 * j);
            s1 += (a.x + a.y) + (a.z + a.w); s2 += (b.x + b.y) + (b.z + b.w); }
        r_ssd = rsqrtf(s1 * (1.f / 1024.f) + EPS); r_att = rsqrtf(s2 * (1.f / 1024.f) + EPS);
    }
    __device__ __forceinline__ float rho(int row) const { float a, b; rs_pair(row, a, b); return a / b; }
    __device__ __forceinline__ float rowscale(int row) const { float a, b; rs_pair(row, a, b); return b; }
    __device__ __forceinline__ void store8s(int row, int col, const float (&v)[8], float ra) const {
        const int b = row >> 12;
        const float* g = mod + b * NMOD + 2 * D + col;
        const f32x4 g0 = *(const f32x4*)g, g1 = *(const f32x4*)(g + 4);
        u32x4 o;
        o.x = cvtpk(g0.x * (ra * v[0]), g0.y * (ra * v[1])); o.y = cvtpk(g0.z * (ra * v[2]), g0.w * (ra * v[3]));
        o.z = cvtpk(g1.x * (ra * v[4]), g1.y * (ra * v[5])); o.w = cvtpk(g1.z * (ra * v[6]), g1.w * (ra * v[7]));
        *(u32x4*)(r1 + (size_t)row * D + col) = o;
    }
    __device__ __forceinline__ void store8(int row, int col, const float (&v)[8]) const { store8s(row, col, v, rowscale(row)); }
};
struct Epi3 {
    bf16_t* q;
    __device__ __forceinline__ float rho(int) const { return 1.f; }
    __device__ __forceinline__ float rowscale(int) const { return 1.f; }
    __device__ __forceinline__ void store8s(int row, int col, const float (&v)[8], float) const { store8(row, col, v); }
    __device__ __forceinline__ void store8(int row, int col, const float (&v)[8]) const {
        u32x4 o; o.x = pk2(v[0], v[1]); o.y = pk2(v[2], v[3]); o.z = pk2(v[4], v[5]); o.w = pk2(v[6], v[7]);
        *(u32x4*)(q + (size_t)row * D + col) = o;
    }
};

struct Epi1Q {
    bf16_t* proj; float* dtraw; const float* sa; const float* sw;
    __device__ __forceinline__ float rho(int) const { return 1.f; }
    __device__ __forceinline__ float rowscale(int row) const { return sa[row]; }
    __device__ __forceinline__ void store8s(int row, int col, const float (&v)[8], float rsc) const {
        const f32x4 s0 = *(const f32x4*)(sw + col) * rsc, s1 = *(const f32x4*)(sw + col + 4) * rsc;
        const float r0 = v[0] * s0.x, r1 = v[1] * s0.y, r2 = v[2] * s0.z, r3 = v[3] * s0.w, r4 = v[4] * s1.x, r5 = v[5] * s1.y, r6 = v[6] * s1.z, r7 = v[7] * s1.w;
        u32x4 o; o.x = cvtpk(r0, r1); o.y = cvtpk(r2, r3); o.z = cvtpk(r4, r5); o.w = cvtpk(r6, r7);
        *(u32x4*)(proj + (size_t)row * DINP + col) = o;
        if (col >= DT_OFF && col < DT_OFF + 16) { float* d = dtraw + (size_t)row * 16 + (col - DT_OFF); *(f32x4*)d = (f32x4){r0, r1, r2, r3}; *(f32x4*)(d + 4) = (f32x4){r4, r5, r6, r7}; }
    }
    __device__ __forceinline__ void store8(int row, int col, const float (&v)[8]) const { store8s(row, col, v, rowscale(row)); }
};
struct Epi2Q {
    const float* mod; const float* sa; const float* sw; bf16_t* r1;
    __device__ __forceinline__ float rho(int) const { return 1.f; }
    __device__ __forceinline__ float rowscale(int row) const { return sa[row]; }
    __device__ __forceinline__ void store8s(int row, int col, const float (&v)[8], float rsc) const {
        const int b = row >> 12; const float* g = mod + b * NMOD + 2 * D + col;
        const f32x4 s0 = *(const f32x4*)(sw + col) * *(const f32x4*)g * rsc, s1 = *(const f32x4*)(sw + col + 4) * *(const f32x4*)(g + 4) * rsc;
        u32x4 o; o.x = cvtpk(v[0] * s0.x, v[1] * s0.y); o.y = cvtpk(v[2] * s0.z, v[3] * s0.w); o.z = cvtpk(v[4] * s1.x, v[5] * s1.y); o.w = cvtpk(v[6] * s1.z, v[7] * s1.w);
        *(u32x4*)(r1 + (size_t)row * D + col) = o;
    }
    __device__ __forceinline__ void store8(int row, int col, const float (&v)[8]) const { store8s(row, col, v, rowscale(row)); }
};
struct Epi3Q {
    bf16_t* q; const float* hs; const float* swq;
    __device__ __forceinline__ float rho(int) const { return 1.f; }
    __device__ __forceinline__ float rowscale(int row) const { return hs[row]; }
    __device__ __forceinline__ void store8s(int row, int col, const float (&v)[8], float rsc) const {
        const f32x4 s0 = *(const f32x4*)(swq + col) * rsc, s1 = *(const f32x4*)(swq + col + 4) * rsc;
        u32x4 o; o.x = cvtpk(v[0] * s0.x, v[1] * s0.y); o.y = cvtpk(v[2] * s0.z, v[3] * s0.w); o.z = cvtpk(v[4] * s1.x, v[5] * s1.y); o.w = cvtpk(v[6] * s1.z, v[7] * s1.w);
        *(u32x4*)(q + (size_t)row * D + col) = o;
    }
    __device__ __forceinline__ void store8(int row, int col, const float (&v)[8]) const { store8s(row, col, v, rowscale(row)); }
};
template <class Epi, bool MIDK>
__device__ __forceinline__ void gemm_simple(const Ctx& c, const bf16_t* A, const bf16_t* Bt, int M, int N, int K, const Epi& E) {
    LAS float* As = (LAS float*)c.lds;
    LAS float* Bs = As + 32 * 132;
    const int tid = c.tid, ty = tid >> 4, tx = tid & 15, lr = tid >> 2, lk = (tid & 3) * 8;
    const int nTn = N / 128, ntile = (M / 128) * nTn;
    for (int tile = blockIdx.x; tile < ntile; tile += gridDim.x) {
        const int tm = tile / nTn, tn = tile % nTn;
        float acc[4][8];
#pragma unroll
        for (int i = 0; i < 4; ++i)
#pragma unroll
            for (int j = 0; j < 8; ++j) acc[i][j] = 0.f;
        const bf16_t* Ap = A + (size_t)(tm * 128 + lr) * K + lk;
        const bf16_t* Bp = Bt + (size_t)(tn * 128 + lr) * K + lk;
        for (int k0 = 0; k0 < K; k0 += 32) {
            if (MIDK && k0 == K / 2) {
#pragma unroll
                for (int i = 0; i < 4; ++i) { const float r = E.rho(tm * 128 + ty * 4 + i);
#pragma unroll
                    for (int j = 0; j < 8; ++j) acc[i][j] *= r; }
            }
            const u32x4 av = *(const u32x4*)(Ap + k0), bv = *(const u32x4*)(Bp + k0);
            __syncthreads();
            As[(lk + 0) * 132 + lr] = bflo(av.x); As[(lk + 1) * 132 + lr] = bfhi(av.x); As[(lk + 2) * 132 + lr] = bflo(av.y); As[(lk + 3) * 132 + lr] = bfhi(av.y);
            As[(lk + 4) * 132 + lr] = bflo(av.z); As[(lk + 5) * 132 + lr] = bfhi(av.z); As[(lk + 6) * 132 + lr] = bflo(av.w); As[(lk + 7) * 132 + lr] = bfhi(av.w);
            Bs[(lk + 0) * 132 + lr] = bflo(bv.x); Bs[(lk + 1) * 132 + lr] = bfhi(bv.x); Bs[(lk + 2) * 132 + lr] = bflo(bv.y); Bs[(lk + 3) * 132 + lr] = bfhi(bv.y);
            Bs[(lk + 4) * 132 + lr] = bflo(bv.z); Bs[(lk + 5) * 132 + lr] = bfhi(bv.z); Bs[(lk + 6) * 132 + lr] = bflo(bv.w); Bs[(lk + 7) * 132 + lr] = bfhi(bv.w);
            __syncthreads();
#pragma unroll 8
            for (int k = 0; k < 32; ++k) {
                const f32x4 a = *(const LAS f32x4*)(As + k * 132 + ty * 4);
                const f32x4 b0 = *(const LAS f32x4*)(Bs + k * 132 + tx * 8), b1 = *(const LAS f32x4*)(Bs + k * 132 + tx * 8 + 4);
                const float aa[4] = {a.x, a.y, a.z, a.w}; const float bb[8] = {b0.x, b0.y, b0.z, b0.w, b1.x, b1.y, b1.z, b1.w};
#pragma unroll
                for (int i = 0; i < 4; ++i)
#pragma unroll
                    for (int j = 0; j < 8; ++j) acc[i][j] += aa[i] * bb[j];
            }
        }
#pragma unroll
        for (int i = 0; i < 4; ++i) E.store8(tm * 128 + ty * 4 + i, tn * 128 + tx * 8, acc[i]);
    }
    __syncthreads();
}

namespace pg8 {
#define PG8_LAS __attribute__((address_space(3)))
typedef unsigned short bf16_t;
typedef short bf16x8 __attribute__((ext_vector_type(8)));
typedef float f32x4 __attribute__((ext_vector_type(4)));
typedef unsigned u32x4 __attribute__((ext_vector_type(4)));
constexpr int BM = 256, BK = 64, HALF = 128, HTB = HALF * BK * 2  , STAGE_BYTES = 8 * HTB, NXCD = 8, WGM = 8;

__host__ __device__ __forceinline__ int lds_byte(int r, int c) { const int st = (r >> 4) * 2 + (c >> 5), rr = r & 15, cc = c & 31, ob = rr * 64 + cc * 2; return st * 1024 + (ob ^ (((ob >> 9) & 1) << 5)); }
__host__ __device__ __forceinline__ void stage_rc(int b, int& R, int& C) { const int st = b / 1024, sb = b % 1024, swz = sb ^ (((sb >> 9) & 1) << 5); R = (st >> 1) * 16 + swz / 64; C = (st & 1) * 32 + (swz % 64) / 2; }
__host__ __device__ __forceinline__ int perm32(int rho) { const int n = rho >> 4, i = rho & 15; return 8 * (i >> 2) + 4 * n + (i & 3); }

struct Unit { int pm, pn; };
struct Gemm { const bf16_t* A; const bf16_t* Bt; int M, N, K; };

struct StaticOrder {
    int nM, nN, nwg, G, c;
    __host__ __device__ void init(int M, int N, int G_, int c_) { nM = M / BM; nN = N / BM; nwg = nM * nN; G = G_; c = c_; }
    __host__ __device__ bool next(int i, Unit& u) const {
        const long L = (long)i * G + c; if (L >= nwg) return false;
        int wgid = (int)L; { const int q = nwg / NXCD, r = nwg % NXCD, xcd = wgid % NXCD, off = wgid / NXCD; wgid = (xcd < r ? xcd * (q + 1) : r * (q + 1) + (xcd - r) * q) + off; }
        const int nig = WGM * nN, gid = wgid / nig, fm = gid * WGM, gsz = (nM - fm) < WGM ? (nM - fm) : WGM;
        u.pm = fm + ((wgid % nig) % gsz); u.pn = (wgid % nig) / gsz; return true;
    }
    __device__ __forceinline__ void a_ready(const Unit&) const {}
    __device__ __forceinline__ void done(const Unit&) const {}
};


template <class E, bool I8 = false> struct EpiA {
    static constexpr bool PERM = true, AFTER_DRAIN = false; E e;
    __device__ __forceinline__ void operator()(const f32x4 (&acc)[2][2][4][2], const Unit& u, int wr, int wc, int fr, int fq) const {
#pragma unroll
        for (int ai = 0; ai < 2; ++ai)
#pragma unroll
            for (int m = 0; m < 4; ++m) {
                const int row = u.pm * BM + ai * HALF + wr * 64 + m * 16 + fr; const float rsc = e.rowscale(row);
#pragma unroll
                for (int bj = 0; bj < 2; ++bj) {
                    const f32x4 v0 = acc[ai][bj][m][0], v1 = acc[ai][bj][m][1];
                    float v[8];
                    if constexpr (I8) {
#pragma unroll
                        for (int j = 0; j < 4; ++j) { v[j] = (float)__float_as_int(v0[j]); v[4 + j] = (float)__float_as_int(v1[j]); }
                    } else {
#pragma unroll
                        for (int j = 0; j < 4; ++j) { v[j] = v0[j]; v[4 + j] = v1[j]; }
                    }
                    e.store8s(row, u.pn * BM + bj * HALF + wc * 32 + 8 * fq, v, rsc);
                }
                if (m & 1) asm volatile("" ::: "memory");
            }
    }
    __device__ __forceinline__ void midk(f32x4 (&acc)[2][2][4][2], const Unit& u, int wr, int fr) const {
#pragma unroll
        for (int ai = 0; ai < 2; ++ai)
#pragma unroll
            for (int m = 0; m < 4; ++m) {
                const float r = e.rho(u.pm * BM + ai * HALF + wr * 64 + m * 16 + fr);
#pragma unroll
                for (int bj = 0; bj < 2; ++bj)
#pragma unroll
                    for (int n = 0; n < 2; ++n) acc[ai][bj][m][n] = acc[ai][bj][m][n] * r;
            }
    }
};
typedef int i32x4 __attribute__((ext_vector_type(4)));
template <class Epi, class Sched, bool ALIGN_EPI = false, bool SP2 = false, bool MIDK = false, bool I8 = false>
__device__ __forceinline__ void gemm_phase(PG8_LAS unsigned char* lds, const Gemm g, const Sched& S, const Epi& E) {
    const int tid = threadIdx.x, wid = __builtin_amdgcn_readfirstlane(tid >> 6), lane = tid & 63, wr = wid >> 2, wc = wid & 3, fr = lane & 15, fq = lane >> 4;
    const int K = g.K, nt = K / BK;
    unsigned voffA[2], voffB[2];
#pragma unroll
    for (int i = 0; i < 2; ++i) { int R, C; stage_rc(tid * 16 + i * 8192, R, C); const int Rb = Epi::PERM ? ((R & ~31) + perm32(R & 31)) : R;
        voffA[i] = (unsigned)(R * K + C) * 2u; voffB[i] = (unsigned)(Rb * K + C) * 2u; }
    const size_t kstep = (size_t)(BK * 2);
    const size_t hstep = (size_t)HALF * K * 2;
    const size_t tstep = 2 * hstep;
    const unsigned ldsw = (unsigned)wid * 1024u;
    const int aoff = lds_byte(wr * 64 + fr, fq * 8), boff = lds_byte(wc * 32 + fr, fq * 8);
#define PG8_SA(b, h) (((b) * 2 + (h)) * HTB)
#define PG8_SB(b, h) ((4 + (b) * 2 + (h)) * HTB)
#define PG8_STAGE(bufoff, gbase, voff) do { _Pragma("unroll") for (int _i = 0; _i < 2; ++_i) \
        __builtin_amdgcn_global_load_lds((const unsigned*)((const char*)(gbase) + (voff)[_i]), (PG8_LAS unsigned*)(lds + (bufoff) + ldsw + _i * 8192), 16, 0, 0); } while (0)
#define PG8_LDA(dst, b, h) do { _Pragma("unroll") for (int m = 0; m < 4; ++m) _Pragma("unroll") for (int k = 0; k < 2; ++k) dst[m][k] = *(const PG8_LAS bf16x8*)(lds + PG8_SA(b, h) + aoff + m * 2048 + k * 1024); } while (0)
#define PG8_LDB(dst, b, h) do { _Pragma("unroll") for (int n = 0; n < 2; ++n) _Pragma("unroll") for (int k = 0; k < 2; ++k) dst[n][k] = *(const PG8_LAS bf16x8*)(lds + PG8_SB(b, h) + boff + n * 2048 + k * 1024); } while (0)
#define PG8_MMA(ai, bj, At, Bt) do { __builtin_amdgcn_s_setprio(1); _Pragma("unroll") for (int m = 0; m < 4; ++m) _Pragma("unroll") for (int n = 0; n < 2; ++n) _Pragma("unroll") for (int k = 0; k < 2; ++k) { \
        if constexpr (I8) acc[ai][bj][m][n] = __builtin_bit_cast(f32x4, __builtin_amdgcn_mfma_i32_16x16x64_i8(__builtin_bit_cast(i32x4, Bt[n][k]), __builtin_bit_cast(i32x4, At[m][k]), __builtin_bit_cast(i32x4, acc[ai][bj][m][n]), 0, 0, 0)); \
        else acc[ai][bj][m][n] = __builtin_amdgcn_mfma_f32_16x16x32_bf16(Bt[n][k], At[m][k], acc[ai][bj][m][n], 0, 0, 0); } __builtin_amdgcn_s_setprio(0); } while (0)
#define PG8_WAIT_V(n) asm volatile("s_waitcnt vmcnt(" #n ")" ::: "memory")
#define PG8_WAIT_L(n) asm volatile("s_waitcnt lgkmcnt(" #n ")" ::: "memory")
#define PG8_BAR __builtin_amdgcn_s_barrier()
#define PG8_SCHED __builtin_amdgcn_sched_barrier(0)
    Unit cur, nxt; int ui = 0;
    if (!S.next(0, cur)) return;
    f32x4 acc[2][2][4][2];
#pragma unroll
    for (int a = 0; a < 2; ++a)
#pragma unroll
        for (int b = 0; b < 2; ++b)
#pragma unroll
            for (int m = 0; m < 4; ++m)
#pragma unroll
                for (int n = 0; n < 2; ++n) acc[a][b][m][n] = (f32x4){0.f, 0.f, 0.f, 0.f};
    bf16x8 At[4][2], B0[2][2], B1[2][2];
    const char* cA = (const char*)g.A + (size_t)cur.pm * tstep; const char* cB = (const char*)g.Bt + (size_t)cur.pn * tstep;
    S.a_ready(cur);
    if constexpr (SP2) {
        PG8_STAGE(PG8_SB(0, 0), cB, voffB); PG8_STAGE(PG8_SB(0, 1), cB + hstep, voffB); PG8_STAGE(PG8_SA(0, 0), cA, voffA); PG8_STAGE(PG8_SA(0, 1), cA + hstep, voffA);
        if (wr == 1) PG8_BAR;
        PG8_WAIT_V(2); PG8_BAR;
        PG8_STAGE(PG8_SB(1, 0), cB + kstep, voffB); PG8_STAGE(PG8_SA(1, 0), cA + kstep, voffA); PG8_STAGE(PG8_SB(1, 1), cB + hstep + kstep, voffB);
        PG8_WAIT_V(6); PG8_BAR;
    } else {
        PG8_STAGE(PG8_SB(0, 0), cB, voffB); PG8_STAGE(PG8_SA(0, 0), cA, voffA); PG8_STAGE(PG8_SB(0, 1), cB + hstep, voffB); PG8_STAGE(PG8_SA(0, 1), cA + hstep, voffA);
        if (wr == 1) PG8_BAR;
        PG8_WAIT_V(4); PG8_BAR;
        PG8_STAGE(PG8_SB(1, 0), cB + kstep, voffB); PG8_STAGE(PG8_SA(1, 0), cA + kstep, voffA); PG8_STAGE(PG8_SB(1, 1), cB + hstep + kstep, voffB);
        PG8_WAIT_V(6); PG8_BAR;
    }
    for (;;) {
        const bool has_next = S.next(ui + 1, nxt);
        const char* nA = has_next ? (const char*)g.A + (size_t)nxt.pm * tstep : cA; const char* nB = has_next ? (const char*)g.Bt + (size_t)nxt.pn * tstep : cB;
        for (int t = 0; t < nt; t += 2) {
            const bool last = (t == nt - 2);
            if constexpr (MIDK) { if (t == nt / 2) E.midk(acc, cur, wr, fr); }
            const char* a1 = cA + (size_t)(t + 1) * kstep;
            const char* a2 = last ? nA : cA + (size_t)(t + 2) * kstep; const char* b2 = last ? nB : cB + (size_t)(t + 2) * kstep;
            const char* a3 = a2 + kstep; const char* b3 = b2 + kstep;
            if (last && has_next) S.a_ready(nxt);
            if constexpr (SP2) {
            PG8_LDB(B0, 0, 0); PG8_LDB(B1, 0, 1); PG8_SCHED; PG8_LDA(At, 0, 0); PG8_STAGE(PG8_SA(1, 1), a1 + hstep, voffA);
            PG8_WAIT_V(8); PG8_WAIT_L(0); PG8_BAR; PG8_MMA(0, 0, At, B0); PG8_MMA(0, 1, At, B1); PG8_BAR; PG8_SCHED;
            PG8_LDA(At, 0, 1); PG8_STAGE(PG8_SB(0, 0), b2, voffB); PG8_STAGE(PG8_SB(0, 1), b2 + hstep, voffB); PG8_STAGE(PG8_SA(0, 0), a2, voffA);
            PG8_WAIT_V(8); PG8_WAIT_L(0); PG8_BAR; PG8_MMA(1, 0, At, B0); PG8_MMA(1, 1, At, B1); PG8_BAR; PG8_SCHED;
            PG8_LDB(B0, 1, 0); PG8_LDB(B1, 1, 1); PG8_SCHED; PG8_LDA(At, 1, 0); PG8_STAGE(PG8_SA(0, 1), a2 + hstep, voffA);
            PG8_WAIT_V(8); PG8_WAIT_L(0); PG8_BAR; PG8_MMA(0, 0, At, B0); PG8_MMA(0, 1, At, B1); PG8_BAR; PG8_SCHED;
            PG8_LDA(At, 1, 1); PG8_STAGE(PG8_SB(1, 0), b3, voffB); PG8_STAGE(PG8_SB(1, 1), b3 + hstep, voffB); PG8_STAGE(PG8_SA(1, 0), a3, voffA);
            PG8_WAIT_V(8); PG8_WAIT_L(0); PG8_BAR; PG8_MMA(1, 0, At, B0); PG8_MMA(1, 1, At, B1); PG8_BAR; PG8_SCHED;
            } else {
            PG8_LDB(B0, 0, 0); PG8_SCHED; PG8_LDA(At, 0, 0); PG8_STAGE(PG8_SA(1, 1), a1 + hstep, voffA);
            PG8_WAIT_L(8); PG8_BAR; PG8_WAIT_L(0); PG8_MMA(0, 0, At, B0); PG8_BAR; PG8_SCHED;
            PG8_LDB(B1, 0, 1); PG8_STAGE(PG8_SB(0, 0), b2, voffB);
            PG8_BAR; PG8_WAIT_L(0); PG8_MMA(0, 1, At, B1); PG8_BAR;
            PG8_LDA(At, 0, 1); PG8_STAGE(PG8_SA(0, 0), a2, voffA);
            PG8_BAR; PG8_WAIT_L(0); PG8_MMA(1, 0, At, B0); PG8_BAR; PG8_SCHED;
            PG8_STAGE(PG8_SB(0, 1), b2 + hstep, voffB);
            PG8_WAIT_V(6); PG8_BAR; PG8_MMA(1, 1, At, B1); PG8_BAR;
            PG8_LDB(B0, 1, 0); PG8_SCHED; PG8_LDA(At, 1, 0); PG8_STAGE(PG8_SA(0, 1), a2 + hstep, voffA);
            PG8_WAIT_L(8); PG8_BAR; PG8_WAIT_L(0); PG8_MMA(0, 0, At, B0); PG8_BAR; PG8_SCHED;
            PG8_LDB(B1, 1, 1); PG8_STAGE(PG8_SB(1, 0), b3, voffB);
            PG8_BAR; PG8_WAIT_L(0); PG8_MMA(0, 1, At, B1); PG8_BAR;
            PG8_LDA(At, 1, 1); PG8_STAGE(PG8_SA(1, 0), a3, voffA);
            PG8_BAR; PG8_WAIT_L(0); PG8_MMA(1, 0, At, B0); PG8_BAR; PG8_SCHED;
            PG8_STAGE(PG8_SB(1, 1), b3 + hstep, voffB);
            PG8_WAIT_V(6); PG8_BAR; PG8_MMA(1, 1, At, B1); PG8_BAR;
            }
        }
        if constexpr (ALIGN_EPI) { if (wr == 0) PG8_BAR; }
        if constexpr (!Epi::AFTER_DRAIN) { E(acc, cur, wr, wc, fr, fq); S.done(cur); }
        if (!has_next) break;
#pragma unroll
        for (int a = 0; a < 2; ++a)
#pragma unroll
            for (int b = 0; b < 2; ++b)
#pragma unroll
                for (int m = 0; m < 4; ++m)
#pragma unroll
                    for (int n = 0; n < 2; ++n) acc[a][b][m][n] = (f32x4){0.f, 0.f, 0.f, 0.f};
        cur = nxt; cA = nA; cB = nB; ++ui;
        if constexpr (ALIGN_EPI) { if (wr == 1) PG8_BAR; }
    }
    PG8_WAIT_V(0);
    if constexpr (!ALIGN_EPI) { if (wr == 0) PG8_BAR; }
    PG8_BAR;
    if constexpr (Epi::AFTER_DRAIN) { E.fused(acc, cur, wr, wc, fr, fq, lds, wid, lane); S.done(cur); }
#undef PG8_SA
#undef PG8_SB
#undef PG8_STAGE
#undef PG8_LDA
#undef PG8_LDB
#undef PG8_MMA
#undef PG8_WAIT_V
#undef PG8_WAIT_L
#undef PG8_BAR
#undef PG8_SCHED
}
}

__device__ __forceinline__ void step_conv(const Ctx& c) {
    const bf16_t* PROJ = WSP(bf16_t, WS_PROJ); bf16_t* XBCC = WSP(bf16_t, WS_XBCC);
    for (int idx = c.gt; idx < T * 768; idx += c.ngt) {
        const int t = idx / 768, ch = (idx % 768) * 2, pos = t & (SEQ - 1);
        float a0 = IN_CONVB[ch], a1 = IN_CONVB[ch + 1];
#pragma unroll
        for (int j = 0; j < 4; ++j) {
            if (pos - 3 + j >= 0) {
                const unsigned v = *(const unsigned*)(PROJ + (size_t)(t - 3 + j) * DINP + XBC_OFF + ch);
                a0 += IN_CONVW[j * 1536 + ch] * bflo(v); a1 += IN_CONVW[j * 1536 + ch + 1] * bfhi(v);
            }
        }
        *(unsigned*)(XBCC + (size_t)t * 1536 + ch) = pk2(silu_f(a0), silu_f(a1));
    }
    const float* DTRAW = WSP(float, WS_DTRAW); float* DT = WSP(float, WS_DT); float* ACUM = WSP(float, WS_ACUM);
    for (int idx = c.gt; idx < NB * NCH * NH; idx += c.ngt) {
        const int h = idx % NH, bc = idx / NH, t0 = bc * 128;
        const float A = -expf(IN_ALOG[h]), bias = IN_DTBIAS[h]; float cum = 0.f;
        for (int l = 0; l < 128; ++l) {
            const float dtv = softplus_f(DTRAW[(size_t)(t0 + l) * 16 + h] + bias); cum += dtv * A;
            DT[(size_t)idx * 128 + l] = dtv; ACUM[(size_t)idx * 128 + l] = cum;
        }
    }
}

__device__ __forceinline__ void step_ssd1_simple(const Ctx& c) {
    const bf16_t* XBCC = WSP(bf16_t, WS_XBCC); const float* DT = WSP(float, WS_DT); const float* ACUM = WSP(float, WS_ACUM); float* STATES = WSP(float, WS_STATES);
    LAS float* wl = (LAS float*)c.lds;
    for (int item = blockIdx.x; item < NB * NCH * NH; item += gridDim.x) {
        const int bc = item / NH, h = item % NH, g = h >> 3, t0 = bc * 128;
        __syncthreads();
        if (c.tid < 128) { const float aend = ACUM[(size_t)item * 128 + 127]; wl[c.tid] = fexp(aend - ACUM[(size_t)item * 128 + c.tid]) * DT[(size_t)item * 128 + c.tid]; }
        __syncthreads();
        const int p = c.tid >> 3, n0 = (c.tid & 7) * 16;
        float acc[16];
#pragma unroll
        for (int j = 0; j < 16; ++j) acc[j] = 0.f;
        for (int l = 0; l < 128; ++l) {
            const bf16_t* row = XBCC + (size_t)(t0 + l) * 1536;
            const float xv = bf2f(row[h * 64 + p]) * wl[l];
            const u32x4 b0 = *(const u32x4*)(row + 1024 + g * 128 + n0), b1 = *(const u32x4*)(row + 1024 + g * 128 + n0 + 8);
            acc[0] += xv * bflo(b0.x); acc[1] += xv * bfhi(b0.x); acc[2] += xv * bflo(b0.y); acc[3] += xv * bfhi(b0.y);
            acc[4] += xv * bflo(b0.z); acc[5] += xv * bfhi(b0.z); acc[6] += xv * bflo(b0.w); acc[7] += xv * bfhi(b0.w);
            acc[8] += xv * bflo(b1.x); acc[9] += xv * bfhi(b1.x); acc[10] += xv * bflo(b1.y); acc[11] += xv * bfhi(b1.y);
            acc[12] += xv * bflo(b1.z); acc[13] += xv * bfhi(b1.z); acc[14] += xv * bflo(b1.w); acc[15] += xv * bfhi(b1.w);
        }
        float* o = STATES + ((size_t)item * 64 + p) * 128 + n0;
#pragma unroll
        for (int j = 0; j < 4; ++j) *(f32x4*)(o + 4 * j) = (f32x4){acc[4 * j], acc[4 * j + 1], acc[4 * j + 2], acc[4 * j + 3]};
    }
    __syncthreads();
}

__device__ __forceinline__ void step_scan(const Ctx& c) {
    const float* STATES = WSP(float, WS_STATES); const float* ACUM = WSP(float, WS_ACUM); bf16_t* PREVB = WSP(bf16_t, WS_PREVB);
    for (int idx = c.gt; idx < NB * NH * 64 * 32; idx += c.ngt) {
        const int n4 = idx & 31, p = (idx >> 5) & 63, h = (idx >> 11) & 15, b = idx >> 15;
        f32x4 carry_ = {0.f, 0.f, 0.f, 0.f};
        const unsigned so = (unsigned)(((b * NCH * NH + h) * 64 + p) * 128 + n4 * 4), ao = (unsigned)((b * NCH * NH + h) * 128 + 127);
#pragma unroll
        for (int half = 0; half < 2; ++half) {
            f32x4 st[16]; float dec[16];
#pragma unroll
            for (int j = 0; j < 16; ++j) { const int ch = half * 16 + j;
                st[j] = *(const f32x4*)((const char*)(STATES + (size_t)ch * (NH * 64 * 128)) + so * 4u); dec[j] = *(const float*)((const char*)(ACUM + (size_t)ch * (NH * 128)) + ao * 4u); }
            static_assert(NCH == 32, "two halves of 16 chunks");
            f32x4 hs = half == 0 ? (f32x4){0.f, 0.f, 0.f, 0.f} : carry_;
#pragma unroll
            for (int j = 0; j < 16; ++j) { const int ch = half * 16 + j;
                *(u32x2*)((char*)(PREVB + (size_t)ch * (NH * 64 * 128)) + so * 2u) = (u32x2){pk2(hs.x, hs.y), pk2(hs.z, hs.w)};
                hs = hs * fexp(dec[j]) + st[j]; }
            carry_ = hs;
        }
    }
}

__device__ __forceinline__ void step_cb_simple(const Ctx& c) {
    const bf16_t* XBCC = WSP(bf16_t, WS_XBCC); float* G = WSP(float, WS_STATES);
    for (int idx = c.gt; idx < NB * NCH * 2 * 128 * 128; idx += c.ngt) {
        const int s = idx & 127, l = (idx >> 7) & 127, g = (idx >> 14) & 1, bc = idx >> 15, t0 = bc * 128;
        const bf16_t* Cr = XBCC + (size_t)(t0 + l) * 1536 + 1280 + g * 128; const bf16_t* Br = XBCC + (size_t)(t0 + s) * 1536 + 1024 + g * 128;
        float sum = 0.f;
#pragma unroll 4
        for (int n = 0; n < 128; n += 8) sum += dot8(*(const u32x4*)(Cr + n), *(const u32x4*)(Br + n));
        G[idx] = sum;
    }
}

__device__ __forceinline__ void step_ssd2_simple(const Ctx& c) {
    const bf16_t* XBCC = WSP(bf16_t, WS_XBCC); const bf16_t* PROJ = WSP(bf16_t, WS_PROJ); const bf16_t* PREVB = WSP(bf16_t, WS_PREVB);
    const float* DT = WSP(float, WS_DT); const float* ACUM = WSP(float, WS_ACUM); const float* G = WSP(float, WS_STATES);
    bf16_t* YCAT = WSP(bf16_t, WS_ACT); float* SSP = WSP(float, WS_SSP);
    LAS float* ac = (LAS float*)c.lds; LAS float* dl = ac + 128;
    for (int item = blockIdx.x; item < NB * NCH * NH; item += gridDim.x) {
        const int bc = item / NH, h = item % NH, g = h >> 3, t0 = bc * 128;
        __syncthreads();
        if (c.tid < 128) { ac[c.tid] = ACUM[(size_t)item * 128 + c.tid]; dl[c.tid] = DT[(size_t)item * 128 + c.tid]; }
        __syncthreads();
        const int l = c.tid >> 2, p0 = (c.tid & 3) * 16, t = t0 + l;
        float acc[16];
#pragma unroll
        for (int j = 0; j < 16; ++j) acc[j] = 0.f;
        {
            const bf16_t* Cr = XBCC + (size_t)t * 1536 + 1280 + g * 128; const bf16_t* Pr = PREVB + ((size_t)item * 64 + p0) * 128;
            for (int n = 0; n < 128; n += 8) {
                const u32x4 cv = *(const u32x4*)(Cr + n);
#pragma unroll
                for (int j = 0; j < 16; ++j) acc[j] += dot8(cv, *(const u32x4*)(Pr + j * 128 + n));
            }
            const float el = fexp(ac[l]);
#pragma unroll
            for (int j = 0; j < 16; ++j) acc[j] *= el;
        }
        const float al = ac[l]; const float* Gr = G + ((size_t)(bc * 2 + g) * 128 + l) * 128;
        for (int s = 0; s <= l; ++s) {
            const float coef = Gr[s] * fexp(al - ac[s]) * dl[s];
            const bf16_t* xr = XBCC + (size_t)(t0 + s) * 1536 + h * 64 + p0;
            const u32x4 x0 = *(const u32x4*)xr, x1 = *(const u32x4*)(xr + 8);
            acc[0] += coef * bflo(x0.x); acc[1] += coef * bfhi(x0.x); acc[2] += coef * bflo(x0.y); acc[3] += coef * bfhi(x0.y);
            acc[4] += coef * bflo(x0.z); acc[5] += coef * bfhi(x0.z); acc[6] += coef * bflo(x0.w); acc[7] += coef * bfhi(x0.w);
            acc[8] += coef * bflo(x1.x); acc[9] += coef * bfhi(x1.x); acc[10] += coef * bflo(x1.y); acc[11] += coef * bfhi(x1.y);
            acc[12] += coef * bflo(x1.z); acc[13] += coef * bfhi(x1.z); acc[14] += coef * bflo(x1.w); acc[15] += coef * bfhi(x1.w);
        }
        {
            const bf16_t* xr = XBCC + (size_t)t * 1536 + h * 64 + p0; const bf16_t* zr = PROJ + (size_t)t * DINP + Z_OFF + h * 64 + p0;
            const float dsk = IN_DSKIP[h]; float ss = 0.f; unsigned ow[8];
#pragma unroll
            for (int j = 0; j < 16; j += 2) {
                const unsigned xw = *(const unsigned*)(xr + j), zw = *(const unsigned*)(zr + j);
                const float y0 = (acc[j] + dsk * bflo(xw)) * silu_f(bflo(zw)), y1 = (acc[j + 1] + dsk * bfhi(xw)) * silu_f(bfhi(zw));
                ss += y0 * y0 + y1 * y1; ow[j >> 1] = pk2(y0, y1);
            }
            bf16_t* o = YCAT + (size_t)t * D + h * 64 + p0;
            *(u32x4*)o = (u32x4){ow[0], ow[1], ow[2], ow[3]}; *(u32x4*)(o + 8) = (u32x4){ow[4], ow[5], ow[6], ow[7]};
            ss += __shfl_xor(ss, 1); ss += __shfl_xor(ss, 2);
            if ((c.tid & 3) == 0) SSP[(size_t)t * 32 + h] = ss;
        }
    }
    __syncthreads();
}

__device__ __forceinline__ void step_att_simple(const Ctx& c) {
    const bf16_t* PROJ = WSP(bf16_t, WS_PROJ); bf16_t* YCAT = WSP(bf16_t, WS_ACT); float* SSP = WSP(float, WS_SSP);
    for (int idx = c.gt; idx < T * 16; idx += c.ngt) {
        const int t = idx >> 4, hd = idx & 15, kvh = hd >> 3, pos = t & (SEQ - 1);
        float q[64], o[64];
        {
            const bf16_t* qr = PROJ + (size_t)t * DINP + Q_OFF + hd * 64;
#pragma unroll
            for (int d = 0; d < 64; d += 8) { const u32x4 v = *(const u32x4*)(qr + d);
                q[d] = 0.125f * bflo(v.x); q[d + 1] = 0.125f * bfhi(v.x); q[d + 2] = 0.125f * bflo(v.y); q[d + 3] = 0.125f * bfhi(v.y);
                q[d + 4] = 0.125f * bflo(v.z); q[d + 5] = 0.125f * bfhi(v.z); q[d + 6] = 0.125f * bflo(v.w); q[d + 7] = 0.125f * bfhi(v.w); }
        }
#pragma unroll
        for (int d = 0; d < 64; ++d) o[d] = 0.f;
        float m = IN_SINKS[hd], den = 1.f;
        const int j0 = pos - 127 > 0 ? pos - 127 : 0;
        for (int kp = j0; kp <= pos; ++kp) {
            const size_t tk = (size_t)(t - pos + kp);
            const bf16_t* kr = PROJ + tk * DINP + K_OFF + kvh * 64; const bf16_t* vr = PROJ + tk * DINP + V_OFF + kvh * 64;
            float s = 0.f;
#pragma unroll
            for (int d = 0; d < 64; d += 8) { const u32x4 v = *(const u32x4*)(kr + d);
                s += q[d] * bflo(v.x) + q[d + 1] * bfhi(v.x) + q[d + 2] * bflo(v.y) + q[d + 3] * bfhi(v.y) + q[d + 4] * bflo(v.z) + q[d + 5] * bfhi(v.z) + q[d + 6] * bflo(v.w) + q[d + 7] * bfhi(v.w); }
            if (s > m) { const float sc = fexp(m - s); den *= sc;
#pragma unroll
                for (int d = 0; d < 64; ++d) o[d] *= sc;
                m = s; }
            const float p = fexp(s - m); den += p;
#pragma unroll
            for (int d = 0; d < 64; d += 8) { const u32x4 v = *(const u32x4*)(vr + d);
                o[d] += p * bflo(v.x); o[d + 1] += p * bfhi(v.x); o[d + 2] += p * bflo(v.y); o[d + 3] += p * bfhi(v.y);
                o[d + 4] += p * bflo(v.z); o[d + 5] += p * bfhi(v.z); o[d + 6] += p * bflo(v.w); o[d + 7] += p * bfhi(v.w); }
        }
        const float inv = 1.f / den; float ss = 0.f;
        bf16_t* orow = YCAT + (size_t)t * D + 1024 + hd * 64;
#pragma unroll
        for (int d = 0; d < 64; d += 8) {
            float r[8];
#pragma unroll
            for (int e = 0; e < 8; ++e) { r[e] = o[d + e] * inv; ss += r[e] * r[e]; }
            *(u32x4*)(orow + d) = (u32x4){pk2(r[0], r[1]), pk2(r[2], r[3]), pk2(r[4], r[5]), pk2(r[6], r[7])};
        }
        SSP[(size_t)t * 32 + 16 + hd] = ss;
    }
}

__device__ __forceinline__ bf16x8v ld_frag16(const void* p) { return __builtin_bit_cast(bf16x8v, *(const u32x4*)p); }
__device__ __forceinline__ bf16x8v lds_frag16(const LAS unsigned char* p) { return __builtin_bit_cast(bf16x8v, *(const LAS u32x4*)p); }
__device__ __forceinline__ f32x16 zero16() { f32x16 z;
#pragma unroll
    for (int r = 0; r < 16; ++r) z[r] = 0.f;
    return z; }
#define MFMA32(a, b, c) __builtin_amdgcn_mfma_f32_32x32x16_bf16((a), (b), (c), 0, 0, 0)
__device__ __forceinline__ bf16x8v acc_frag(const f32x16& x, int ks2) {
    u32x4 w; w.x = cvtpk(x[8 * ks2 + 0], x[8 * ks2 + 1]); w.y = cvtpk(x[8 * ks2 + 2], x[8 * ks2 + 3]); w.z = cvtpk(x[8 * ks2 + 4], x[8 * ks2 + 5]); w.w = cvtpk(x[8 * ks2 + 6], x[8 * ks2 + 7]);
    return __builtin_bit_cast(bf16x8v, w);
}

__device__ __forceinline__ void step_dta(const Ctx& c) {
    const float* DTRAW = WSP(float, WS_DTRAW); float* DT = WSP(float, WS_DT); float* ACUM = WSP(float, WS_ACUM);
    for (int idx = c.gw; idx < NB * NCH * NH; idx += c.ngw) {
        const int h = idx % NH, bc = idx / NH, t0 = bc * 128, l0 = 2 * c.lane;
        const float A = -expf(IN_ALOG[h]), bias = IN_DTBIAS[h];
        const float d0 = softplus_f(DTRAW[(size_t)(t0 + l0) * 16 + h] + bias), d1 = softplus_f(DTRAW[(size_t)(t0 + l0 + 1) * 16 + h] + bias);
        const float a0 = d0 * A, a1 = d1 * A; float x = a0 + a1;
#pragma unroll
        for (int o = 1; o < 64; o <<= 1) { const float v = __shfl_up(x, o); if (c.lane >= o) x += v; }
        const float ex = x - (a0 + a1);
        *(f32x2*)(DT + (size_t)idx * 128 + l0) = (f32x2){d0, d1};
        *(f32x2*)(ACUM + (size_t)idx * 128 + l0) = (f32x2){ex + a0, ex + a0 + a1};
    }
}
__device__ __forceinline__ void step_conv_only(const Ctx& c) {
    const bf16_t* PROJ = WSP(bf16_t, WS_PROJ); bf16_t* XBCC = WSP(bf16_t, WS_XBCC);
    for (int idx = c.gt; idx < (T / 8) * 384; idx += c.ngt) {
        const int rb = idx / 384, ch = (idx % 384) * 4, t0 = rb * 8, pos0 = t0 & (SEQ - 1);
        f32x4 w[4];
#pragma unroll
        for (int j = 0; j < 4; ++j) w[j] = *(const f32x4*)(IN_CONVW + j * 1536 + ch);
        const f32x4 bias = *(const f32x4*)(IN_CONVB + ch);
        f32x4 xr[11];
#pragma unroll
        for (int i = 0; i < 11; ++i) {
            if (pos0 - 3 + i >= 0) { const u32x2 v = *(const u32x2*)(PROJ + (size_t)(t0 - 3 + i) * DINP + XBC_OFF + ch); xr[i] = (f32x4){bflo(v.x), bfhi(v.x), bflo(v.y), bfhi(v.y)}; }
            else xr[i] = (f32x4){0.f, 0.f, 0.f, 0.f};
        }
#pragma unroll
        for (int r = 0; r < 8; ++r) {
            const f32x4 a = bias + w[0] * xr[r] + w[1] * xr[r + 1] + w[2] * xr[r + 2] + w[3] * xr[r + 3];
            *(u32x2*)(XBCC + (size_t)(t0 + r) * 1536 + ch) = (u32x2){cvtpk(silu_f(a.x), silu_f(a.y)), cvtpk(silu_f(a.z), silu_f(a.w))};
        }
    }
}

__device__ __forceinline__ void step_ssd1_fast(const Ctx& c) {
    const bf16_t* XBCC = WSP(bf16_t, WS_XBCC); const float* DT = WSP(float, WS_DT); const float* ACUM = WSP(float, WS_ACUM); float* STATES = WSP(float, WS_STATES);
    LAS unsigned char* Bl = c.lds;
    LAS unsigned char* Xl = c.lds + 32768;
    LAS float* wl = (LAS float*)(c.lds + 65536);
    const int lane = c.lane, col = lane & 31, hh = lane >> 5, pt = c.wave >> 2, nt = c.wave & 3;
    for (int item = blockIdx.x; item < NB * NCH * 2; item += gridDim.x) {
        const int bc = item >> 1, g = item & 1, t0 = bc * 128;
        __syncthreads();
        for (int i = c.tid; i < 128 * 16; i += NTHR) { const int l = i >> 4, ch = i & 15;
            *(LAS u32x4*)(Bl + l * 256 + ch * 16) = *(const u32x4*)(XBCC + (size_t)(t0 + l) * 1536 + 1024 + g * 128 + ch * 8); }
        for (int i = c.tid; i < 8 * 128; i += NTHR) { const int r = i >> 7, l = i & 127; const size_t o = ((size_t)bc * 16 + g * 8 + r) * 128;
            wl[i] = fexp(ACUM[o + 127] - ACUM[o + l]) * DT[o + l]; }
        __syncthreads();
#define SSD1_STAGE(r_) { _Pragma("unroll") for (int q_ = 0; q_ < 2; ++q_) { const int i_ = c.tid + q_ * NTHR, l_ = i_ >> 3, ch_ = i_ & 7; \
            const u32x4 v_ = *(const u32x4*)(XBCC + (size_t)(t0 + l_) * 1536 + (g * 8 + (r_)) * 64 + ch_ * 8); const float w_ = wl[(r_) * 128 + l_]; \
            u32x4 o_; o_.x = cvtpk(bflo(v_.x) * w_, bfhi(v_.x) * w_); o_.y = cvtpk(bflo(v_.y) * w_, bfhi(v_.y) * w_); o_.z = cvtpk(bflo(v_.z) * w_, bfhi(v_.z) * w_); o_.w = cvtpk(bflo(v_.w) * w_, bfhi(v_.w) * w_); \
            *(LAS u32x4*)(Xl + ((r_) & 1) * 16384 + l_ * 128 + ch_ * 16) = o_; } }
        SSD1_STAGE(0);
        __syncthreads();
        for (int r = 0; r < 8; ++r) {
            if (r + 1 < 8) SSD1_STAGE(r + 1);
            const LAS unsigned char* xb = Xl + (r & 1) * 16384 + (pt * 32 + col) * 2; const LAS unsigned char* bb = Bl + (nt * 32 + col) * 2;
            f32x16 acc = zero16();
#pragma unroll
            for (int ks = 0; ks < 8; ++ks) {
                bf16x8v af, bf;
#pragma unroll
                for (int j = 0; j < 8; ++j) { const int l = 16 * ks + 8 * hh + j; af[j] = *(const LAS short*)(xb + l * 128); bf[j] = *(const LAS short*)(bb + l * 256); }
                acc = MFMA32(af, bf, acc);
            }
            float* o = STATES + (((size_t)bc * 16 + g * 8 + r) * 64 + pt * 32) * 128 + nt * 32 + col;
#pragma unroll
            for (int rr = 0; rr < 16; ++rr) o[(size_t)((rr & 3) + 8 * (rr >> 2) + 4 * hh) * 128] = acc[rr];
            __syncthreads();
        }
#undef SSD1_STAGE
    }
    __syncthreads();
}

#define TABH_SRC(r_) ((r_) < 16384 ? IN_U + (size_t)(r_) * D : IN_V + (size_t)((r_) - 16384) * D)
#define TABH_FINISH(rowv, r_) { if ((r_) < 16384) fp8_row_finish<SLICED_PEER != 0>(rowv, WSP(unsigned char, WS_UB), (r_), WSP(float, WS_SCU) + (r_), c.lane); \
        else fp8_row_finish<(SLICED_PEER != 0) && (V_INT8 != 0)>(rowv, WSP(unsigned char, WS_VB), (r_) - 16384, WSP(float, WS_SCV) + ((r_) - 16384), c.lane); }
#define TABH_TICK() { if (kTicks) { if (tabr < 2 * 16384) { TABH_FINISH(tabv, tabr); } tabr += c.ngw; if (tabr < 2 * 16384) fp8_row_load(tabv, TABH_SRC(tabr), c.lane); } }
template <int PV = 0>
__device__ __forceinline__ void step_ssd2_fast(const Ctx& c) {
    constexpr bool kTicks = (HIDE_TABLES != 0) && PV == 0;
    const bf16_t* XBCC = WSP(bf16_t, WS_XBCC); const bf16_t* PROJ = WSP(bf16_t, WS_PROJ); const bf16_t* PREVB = WSP(bf16_t, WS_PREVB);
    const float* DT = WSP(float, WS_DT); const float* ACUM = WSP(float, WS_ACUM); bf16_t* YCAT = WSP(bf16_t, WS_ACT); float* SSP = WSP(float, WS_SSP);
    const int lane = c.lane, col = lane & 31, hh = lane >> 5;
    LAS unsigned char* Xw = c.lds + c.wave * 16384;
    LAS float* ac = (LAS float*)(c.lds + 131072 + c.wave * 1024); LAS float* dl = ac + 128;
    LAS unsigned char* Gl = c.lds + 139264;
    f32x4 tabv[8]; int tabr = c.gw;
    if (kTicks && tabr < 2 * 16384) fp8_row_load(tabv, TABH_SRC(tabr), c.lane);
    for (int item = blockIdx.x; item < NB * NCH * 2; item += gridDim.x) {
        const int bc = item >> 1, g = item & 1, t0 = bc * 128, hd = g * 8 + c.wave; const size_t ih = (size_t)bc * 16 + hd;
        __syncthreads();
#pragma unroll 1
        for (int tile = c.wave; tile < ((PV & 1) ? 0 : 10); tile += 8) {
            const int lt_ = tile < 1 ? 0 : tile < 3 ? 1 : tile < 6 ? 2 : 3, st_ = tile - (lt_ * (lt_ + 1)) / 2;
            bf16x8v cg[8], bg[8];
            const bf16_t* cp = XBCC + (size_t)(t0 + lt_ * 32 + col) * 1536 + 1280 + g * 128 + hh * 8;
            const bf16_t* bp = XBCC + (size_t)(t0 + st_ * 32 + col) * 1536 + 1024 + g * 128 + hh * 8;
#pragma unroll
            for (int ks = 0; ks < 8; ++ks) { cg[ks] = ld_frag16(cp + ks * 16); bg[ks] = ld_frag16(bp + ks * 16); }
            f32x16 gt = zero16();
#pragma unroll
            for (int ks = 0; ks < 8; ++ks) gt = MFMA32(bg[ks], cg[ks], gt);
            const u32x4 o0 = {cvtpk(gt[0], gt[1]), cvtpk(gt[2], gt[3]), cvtpk(gt[4], gt[5]), cvtpk(gt[6], gt[7])};
            const u32x4 o1 = {cvtpk(gt[8], gt[9]), cvtpk(gt[10], gt[11]), cvtpk(gt[12], gt[13]), cvtpk(gt[14], gt[15])};
            *(LAS u32x4*)(Gl + tile * 2048 + lane * 32) = o0; *(LAS u32x4*)(Gl + tile * 2048 + lane * 32 + 16) = o1;
        }
#pragma unroll 4
        for (int i = lane; i < ((PV & 16) ? 0 : 128 * 8); i += 64) { const int srow = i >> 3, ch = i & 7;
            *(LAS u32x4*)(Xw + srow * 128 + ch * 16) = *(const u32x4*)(XBCC + (size_t)(t0 + srow) * 1536 + hd * 64 + ch * 8); }
        ac[lane] = ACUM[ih * 128 + lane]; ac[lane + 64] = ACUM[ih * 128 + 64 + lane]; dl[lane] = DT[ih * 128 + lane]; dl[lane + 64] = DT[ih * 128 + 64 + lane];
        asm volatile("s_waitcnt vmcnt(0) lgkmcnt(0)" ::: "memory");
        __syncthreads();
        const float dsk = IN_DSKIP[hd];
        bf16x8v pf0[8], pf1[8];
        { const bf16_t* pp0 = PREVB + (ih * 64 + col) * 128 + hh * 8; const bf16_t* pp1 = pp0 + 32 * 128;
#pragma unroll
          for (int ks = 0; ks < 8; ++ks) { if (PV & 32) { pf0[ks] = (bf16x8v){0,0,0,0,0,0,0,0}; pf1[ks] = pf0[ks]; } else { pf0[ks] = ld_frag16(pp0 + ks * 16); pf1[ks] = ld_frag16(pp1 + ks * 16); } } }
#pragma unroll 1
        for (int lt = 3; lt >= 0; --lt) {
            const int l = lt * 32 + col, t = t0 + l;
            bf16x8v cf[8];
            const bf16_t* cp = XBCC + (size_t)t * 1536 + 1280 + g * 128 + hh * 8;
#pragma unroll
            for (int ks = 0; ks < 8; ++ks) { if (PV & 4) cf[ks] = (bf16x8v){0,0,0,0,0,0,0,0}; else cf[ks] = ld_frag16(cp + ks * 16); }
            const int zr = lt * 32 + (lane >> 3), zc = lane & 7;
            u32x4 zq[4];
#pragma unroll
            for (int k = 0; k < 4; ++k) zq[k] = *(const u32x4*)(PROJ + (size_t)(t0 + zr + 8 * k) * DINP + Z_OFF + hd * 64 + zc * 8);
            TABH_TICK();
            f32x16 acc[2]; acc[0] = zero16(); acc[1] = zero16();
#pragma unroll
            for (int ks = 0; ks < 8; ++ks) { acc[0] = MFMA32(pf0[ks], cf[ks], acc[0]); acc[1] = MFMA32(pf1[ks], cf[ks], acc[1]); }
            const float al = ac[l], el = fexp(al);
#pragma unroll
            for (int p2 = 0; p2 < 2; ++p2)
#pragma unroll
                for (int r = 0; r < 16; ++r) acc[p2][r] *= el;
#pragma unroll 1
            for (int st = 0; st <= ((PV & 2) ? -1 : lt); ++st) {
                const LAS unsigned char* gp = Gl + ((lt * (lt + 1)) / 2 + st) * 2048 + lane * 32;
                const u32x4 g0 = *(const LAS u32x4*)gp, g1 = *(const LAS u32x4*)(gp + 16);
                if (st == 0 || st == lt || (lt == 3 && st == 1)) { TABH_TICK(); }
                f32x16 gt;
#pragma unroll
                for (int i = 0; i < 4; ++i) { gt[2 * i] = bflo(g0[i]); gt[2 * i + 1] = bfhi(g0[i]); gt[8 + 2 * i] = bflo(g1[i]); gt[8 + 2 * i + 1] = bfhi(g1[i]); }
#pragma unroll
                for (int g4 = 0; g4 < 4; ++g4) {
                    const int sl0 = 8 * g4 + 4 * hh;
                    const f32x4 as = *(const LAS f32x4*)(ac + st * 32 + sl0), ds = *(const LAS f32x4*)(dl + st * 32 + sl0);
#pragma unroll
                    for (int e = 0; e < 4; ++e) {
                        const bool ok = (st < lt) || (sl0 + e <= col);
                        gt[4 * g4 + e] = ok ? gt[4 * g4 + e] * fexp(al - as[e]) * ds[e] : 0.f;
                    }
                }
                const bf16x8v w0 = acc_frag(gt, 0), w1 = acc_frag(gt, 1);
#pragma unroll
                for (int p2 = 0; p2 < 2; ++p2) {
                    const LAS unsigned char* xb = Xw + (p2 * 32 + col) * 2 + (st * 32 + 4 * hh) * 128;
                    bf16x8v x0, x1;
#pragma unroll
                    for (int j = 0; j < 8; ++j) { const int srow = 8 * (j >> 2) + (j & 3); x0[j] = *(const LAS short*)(xb + srow * 128); x1[j] = *(const LAS short*)(xb + (16 + srow) * 128); }
                    acc[p2] = MFMA32(x0, w0, acc[p2]); acc[p2] = MFMA32(x1, w1, acc[p2]);
                }
            }
            TABH_TICK();
            float ss = 0.f;
            u32x2 xq[2][4], z2[2][4];
#pragma unroll
            for (int p2 = 0; p2 < 2; ++p2)
#pragma unroll
                for (int g4 = 0; g4 < 4; ++g4) xq[p2][g4] = *(const LAS u32x2*)(Xw + l * 128 + (p2 * 32 + 8 * g4 + 4 * hh) * 2);
            asm volatile("s_waitcnt lgkmcnt(0)" ::: "memory");
#pragma unroll
            for (int k = 0; k < 4; ++k) *(LAS u32x4*)(Xw + (zr + 8 * k) * 128 + zc * 16) = zq[k];
            asm volatile("s_waitcnt lgkmcnt(0)" ::: "memory");
#pragma unroll
            for (int p2 = 0; p2 < 2; ++p2)
#pragma unroll
                for (int g4 = 0; g4 < 4; ++g4) z2[p2][g4] = *(const LAS u32x2*)(Xw + l * 128 + (p2 * 32 + 8 * g4 + 4 * hh) * 2);
            asm volatile("s_waitcnt lgkmcnt(0)" ::: "memory");
#pragma unroll
            for (int p2 = 0; p2 < 2; ++p2)
#pragma unroll
                for (int g4 = 0; g4 < 4; ++g4) {
                    const u32x2 xw = xq[p2][g4], zz = z2[p2][g4];
                    const float y0 = (acc[p2][4 * g4 + 0] + dsk * bflo(xw.x)) * silu_f(bflo(zz.x)), y1 = (acc[p2][4 * g4 + 1] + dsk * bfhi(xw.x)) * silu_f(bfhi(zz.x));
                    const float y2 = (acc[p2][4 * g4 + 2] + dsk * bflo(xw.y)) * silu_f(bflo(zz.y)), y3 = (acc[p2][4 * g4 + 3] + dsk * bfhi(xw.y)) * silu_f(bfhi(zz.y));
                    ss += (y0 * y0 + y1 * y1) + (y2 * y2 + y3 * y3);
                    *(LAS u32x2*)(Xw + l * 128 + (p2 * 32 + 8 * g4 + 4 * hh) * 2) = (u32x2){cvtpk(y0, y1), cvtpk(y2, y3)};
                }
            asm volatile("s_waitcnt lgkmcnt(0)" ::: "memory");
#pragma unroll
            for (int k = 0; k < 4; ++k) { const u32x4 yq = *(const LAS u32x4*)(Xw + (zr + 8 * k) * 128 + zc * 16); *(u32x4*)(YCAT + (size_t)(t0 + zr + 8 * k) * D + hd * 64 + zc * 8) = yq; }
            ss += __shfl_xor(ss, 32);
            if (hh == 0) SSP[(size_t)t * 32 + hd] = ss;
        }
    }
    if (kTicks) { while (tabr < 2 * 16384) { TABH_TICK(); } }
    __syncthreads();
}

__device__ __forceinline__ void step_att_fast(const Ctx& c) {
    const bf16_t* PROJ = WSP(bf16_t, WS_PROJ); bf16_t* YCAT = WSP(bf16_t, WS_ACT); float* SSP = WSP(float, WS_SSP);
    const int lane = c.lane, col = lane & 31, hh = lane >> 5;
    LAS unsigned char* Kl = c.lds;
    LAS unsigned char* Vt = c.lds + 256 * 144;
    const float NEG = -__builtin_huge_valf();
    for (int item = blockIdx.x; item < NB * NCH * 2; item += gridDim.x) {
        const int kvh = item & 1, nblk = (item >> 1) & 31, b = item >> 6, tq0 = b * SEQ + nblk * 128, tk0 = tq0 - 128;
        __syncthreads();
        for (int i = c.tid; i < 256 * 8; i += NTHR) {
            const int kj = i >> 3, ch = i & 7;
            if (nblk > 0 || kj >= 128) {
                const bf16_t* src = PROJ + (size_t)(tk0 + kj) * DINP + kvh * 64 + ch * 8;
                *(LAS u32x4*)(Kl + kj * 144 + ch * 16) = *(const u32x4*)(src + K_OFF);
                const u32x4 v = *(const u32x4*)(src + V_OFF);
                LAS unsigned char* vp = Vt + (ch * 8) * 520 + kj * 2;
                *(LAS unsigned short*)(vp + 0 * 520) = (unsigned short)(v.x & 0xffff); *(LAS unsigned short*)(vp + 1 * 520) = (unsigned short)(v.x >> 16);
                *(LAS unsigned short*)(vp + 2 * 520) = (unsigned short)(v.y & 0xffff); *(LAS unsigned short*)(vp + 3 * 520) = (unsigned short)(v.y >> 16);
                *(LAS unsigned short*)(vp + 4 * 520) = (unsigned short)(v.z & 0xffff); *(LAS unsigned short*)(vp + 5 * 520) = (unsigned short)(v.z >> 16);
                *(LAS unsigned short*)(vp + 6 * 520) = (unsigned short)(v.w & 0xffff); *(LAS unsigned short*)(vp + 7 * 520) = (unsigned short)(v.w >> 16);
            }
        }
        __syncthreads();
        const int hd = kvh * 8 + c.wave; const float sink = IN_SINKS[hd];
        for (int qt = 0; qt < 4; ++qt) {
            const int tq = tq0 + qt * 32 + col;
            bf16x8v qf[4];
#pragma unroll
            for (int ks = 0; ks < 4; ++ks) qf[ks] = ld_frag16(PROJ + (size_t)tq * DINP + Q_OFF + hd * 64 + ks * 16 + hh * 8);
            f32x16 S[5]; float m = sink;
#pragma unroll
            for (int jj = 0; jj < 5; ++jj) {
                const int j = qt + jj;
                if (nblk == 0 && j < 4) {
#pragma unroll
                    for (int r = 0; r < 16; ++r) S[jj][r] = NEG;
                } else {
                    f32x16 a = zero16();
#pragma unroll
                    for (int ks = 0; ks < 4; ++ks) a = MFMA32(lds_frag16(Kl + (j * 32 + col) * 144 + ks * 32 + hh * 16), qf[ks], a);
#pragma unroll
                    for (int r = 0; r < 16; ++r) {
                        const int kl = (r & 3) + 8 * (r >> 2) + 4 * hh;
                        float sv = a[r] * 0.125f;
                        if (jj == 0) sv = (kl > col) ? sv : NEG;
                        if (jj == 4) sv = (kl <= col) ? sv : NEG;
                        S[jj][r] = sv; m = fmaxf(m, sv);
                    }
                }
            }
            m = fmaxf(m, __shfl_xor(m, 32));
            float lsum = 0.f;
#pragma unroll
            for (int jj = 0; jj < 5; ++jj)
#pragma unroll
                for (int r = 0; r < 16; ++r) { const float p = fexp(S[jj][r] - m); S[jj][r] = p; lsum += p; }
            lsum += __shfl_xor(lsum, 32); lsum += fexp(sink - m);
            f32x16 O[2]; O[0] = zero16(); O[1] = zero16();
#pragma unroll
            for (int jj = 0; jj < 5; ++jj) {
                const int j = qt + jj;
                if (!(nblk == 0 && j < 4)) {
#pragma unroll
                    for (int ks2 = 0; ks2 < 2; ++ks2) {
                        const bf16x8v pf = acc_frag(S[jj], ks2);
#pragma unroll
                        for (int d2 = 0; d2 < 2; ++d2) {
                            const LAS unsigned char* vp = Vt + (d2 * 32 + col) * 520 + (j * 32 + 16 * ks2 + 4 * hh) * 2;
                            const u32x2 v0 = *(const LAS u32x2*)vp, v1 = *(const LAS u32x2*)(vp + 16);
                            O[d2] = MFMA32(__builtin_bit_cast(bf16x8v, ((u32x4){v0.x, v0.y, v1.x, v1.y})), pf, O[d2]);
                        }
                    }
                }
            }
            const float inv = 1.f / lsum; float ss = 0.f;
#pragma unroll
            for (int d2 = 0; d2 < 2; ++d2)
#pragma unroll
                for (int g4 = 0; g4 < 4; ++g4) {
                    const float o0 = O[d2][4 * g4] * inv, o1 = O[d2][4 * g4 + 1] * inv, o2 = O[d2][4 * g4 + 2] * inv, o3 = O[d2][4 * g4 + 3] * inv;
                    ss += (o0 * o0 + o1 * o1) + (o2 * o2 + o3 * o3);
                    *(u32x2*)(YCAT + (size_t)tq * D + 1024 + hd * 64 + d2 * 32 + 8 * g4 + 4 * hh) = (u32x2){cvtpk(o0, o1), cvtpk(o2, o3)};
                }
            ss += __shfl_xor(ss, 32);
            if (hh == 0) SSP[(size_t)tq * 32 + 16 + hd] = ss;
        }
    }
    __syncthreads();
}

__device__ __forceinline__ void step_rs(const Ctx& c) {
    const float* SSP = WSP(float, WS_SSP); float* RS = WSP(float, WS_RS);
    for (int t = c.gt; t < T; t += c.ngt) {
        float s1 = 0.f, s2 = 0.f;
#pragma unroll
        for (int j = 0; j < 4; ++j) { const f32x4 a = *(const f32x4*)(SSP + (size_t)t * 32 + 4 * j), b = *(const f32x4*)(SSP + (size_t)t * 32 + 16 + 4 * j);
            s1 += (a.x + a.y) + (a.z + a.w); s2 += (b.x + b.y) + (b.z + b.w); }
        const float r1 = rsqrtf(s1 * (1.f / 1024.f) + EPS), r2 = rsqrtf(s2 * (1.f / 1024.f) + EPS);
        RS[2 * t] = r1 / r2; RS[2 * t + 1] = r2;
    }
}

__device__ __forceinline__ void step_ln1(const Ctx& c) {
    const float* MOD = WSP(float, WS_MOD); bf16_t* H2 = WSP(bf16_t, WS_ACT); const bf16_t* GB = WSP(bf16_t, WS_R1B); bf16_t* X1B = WSP(bf16_t, WS_X1B); unsigned char* H2Q = WSP(unsigned char, WS_H2Q); float* HS = WSP(float, WS_HS);
    f32x4 xc[8], xn[8]; u32x2 gc[8], gn[8];
    int t = c.gw;
#define LN1_LOAD(xa, ga, tok) { _Pragma("unroll") for (int j_ = 0; j_ < 8; ++j_) { xa[j_] = *(const f32x4*)(IN_X + (size_t)(tok) * D + j_ * 256 + c.lane * 4); ga[j_] = *(const u32x2*)(GB + (size_t)(tok) * D + j_ * 256 + c.lane * 4); } }
    if (t < T) LN1_LOAD(xc, gc, t);
    for (; t < T; t += c.ngw) {
        const int tn = t + c.ngw;
        if (tn < T) LN1_LOAD(xn, gn, tn);
        const int b = t >> 12;
        f32x4 v[8]; float s = 0.f;
#pragma unroll
        for (int j = 0; j < 8; ++j) { v[j] = xc[j] * ALPHA + (f32x4){bflo(gc[j].x), bfhi(gc[j].x), bflo(gc[j].y), bfhi(gc[j].y)}; s += (v[j].x + v[j].y) + (v[j].z + v[j].w); }
        const float mean = wave_sum_all(s) * (1.f / D); float s2 = 0.f;
#pragma unroll
        for (int j = 0; j < 8; ++j) { v[j] = v[j] - mean; s2 += (v[j].x * v[j].x + v[j].y * v[j].y) + (v[j].z * v[j].z + v[j].w * v[j].w); }
        const float rstd = rsqrtf(wave_sum_all(s2) * (1.f / D) + EPS);
        const float* sh = MOD + b * NMOD + 3 * D; const float* sc = MOD + b * NMOD + 4 * D; float hmax = 0.f;
#pragma unroll
        for (int j = 0; j < 8; ++j) {
            const int col = j * 256 + c.lane * 4;
            const f32x4 g = *(const f32x4*)(IN_LN1G + col), bb = *(const f32x4*)(IN_LN1B + col), s_ = *(const f32x4*)(sc + col), h_ = *(const f32x4*)(sh + col);
            const f32x4 x1 = v[j] * rstd * g + bb;
            *(u32x2*)(X1B + (size_t)t * D + col) = (u32x2){cvtpk(x1.x, x1.y), cvtpk(x1.z, x1.w)};
            const f32x4 h2v = x1 * (s_ + 1.f) + h_;
            if (!(I8_GEMM3 && FAST_GEMM)) *(u32x2*)(H2 + (size_t)t * D + col) = (u32x2){cvtpk(h2v.x, h2v.y), cvtpk(h2v.z, h2v.w)};
            v[j] = h2v; hmax = fmaxf(hmax, fmaxf(fmaxf(fabsf(h2v.x), fabsf(h2v.y)), fmaxf(fabsf(h2v.z), fabsf(h2v.w))));
        }
        {
            hmax = DPPMAX(hmax, 0xB1); hmax = DPPMAX(hmax, 0x4E); hmax = DPPMAX(hmax, 0x141); hmax = DPPMAX(hmax, 0x140);
            const unsigned a0 = __builtin_amdgcn_readlane(__float_as_uint(hmax), 0), a1 = __builtin_amdgcn_readlane(__float_as_uint(hmax), 16);
            const unsigned a2 = __builtin_amdgcn_readlane(__float_as_uint(hmax), 32), a3 = __builtin_amdgcn_readlane(__float_as_uint(hmax), 48);
            const unsigned m01 = a0 > a1 ? a0 : a1, m23 = a2 > a3 ? a2 : a3; const float am = __uint_as_float(m01 > m23 ? m01 : m23);
            const float inv = am > 0.f ? 127.f / am : 0.f;
#pragma unroll
            for (int j = 0; j < 8; ++j) *(unsigned*)(H2Q + (size_t)t * D + j * 256 + c.lane * 4) = pack_i8x4(v[j] * inv);
            if (c.lane == 0) HS[t] = am * (1.f / 127.f);
        }
#pragma unroll
        for (int j = 0; j < 8; ++j) { xc[j] = xn[j]; gc[j] = gn[j]; }
    }
#undef LN1_LOAD
}

__device__ __forceinline__ void argmax_bfly(float& bv, int& bi) {
#pragma unroll
    for (int off = 32; off >= 1; off >>= 1) {
        const float ov = __shfl_xor(bv, off); const int oi = __shfl_xor(bi, off);
        if (ov > bv || (ov == bv && oi < bi)) { bv = ov; bi = oi; }
    }
}
__device__ __forceinline__ void step_topk_simple(const Ctx& c) {
    const bf16_t* Q = WSP(bf16_t, WS_PROJ); const bf16_t* KEYS = WSP(bf16_t, WS_KEYS); int* EXPERT = WSP(int, WS_EXP); float* GATE = WSP(float, WS_GATE);
    const int lane = c.lane; const float NEG = -__builtin_huge_valf();
    for (int item = c.gw; item < T * 8; item += c.ngw) {
        const int t = item >> 3, h = item & 7;
        const bf16_t* qrow = Q + (size_t)t * D + h * 256;
        float tv[2] = {0.f, 0.f}; int ti[2] = {0, 0};
#pragma unroll
        for (int cc = 0; cc < 2; ++cc) {
            float v0 = 0.f, v1 = 0.f;
            const bf16_t* k0 = KEYS + ((size_t)(h * 2 + cc) * 128 + lane) * 128; const bf16_t* k1 = k0 + 64 * 128;
            for (int d = 0; d < 128; d += 8) { const u32x4 qv = *(const u32x4*)(qrow + cc * 128 + d); v0 += dot8(qv, *(const u32x4*)(k0 + d)); v1 += dot8(qv, *(const u32x4*)(k1 + d)); }
            for (int r = 0; r < 16; ++r) {
                float bv = v0; int bi = lane; if (v1 > bv) { bv = v1; bi = lane + 64; }
                argmax_bfly(bv, bi);
                if (lane == r) { tv[cc] = bv; ti[cc] = bi; }
                if (bi == lane) v0 = NEG; if (bi == lane + 64) v1 = NEG;
            }
        }
        float cv[4]; const int ci0 = lane * 4;
#pragma unroll
        for (int q = 0; q < 4; ++q) { const int ci = ci0 + q; cv[q] = __shfl(tv[0], ci >> 4) + __shfl(tv[1], ci & 15); }
        float bestv = 0.f; int bestp = 0;
        for (int r = 0; r < 16; ++r) {
            float bv = cv[0]; int bi = ci0;
#pragma unroll
            for (int q = 1; q < 4; ++q) if (cv[q] > bv) { bv = cv[q]; bi = ci0 + q; }
            argmax_bfly(bv, bi);
            if (lane == r) { bestv = bv; bestp = bi; }
#pragma unroll
            for (int q = 0; q < 4; ++q) if (bi == ci0 + q) cv[q] = NEG;
        }
        const float mx = __shfl(bestv, 0);
        const float e = lane < 16 ? fexp(bestv - mx) : 0.f; const float ssum = wave_sum(e);
        const int e0 = __shfl(ti[0], bestp >> 4), e1 = __shfl(ti[1], bestp & 15);
        if (lane < 16) { EXPERT[(size_t)item * 16 + lane] = e0 * 128 + e1; GATE[(size_t)item * 16 + lane] = e / ssum; }
    }
}

#define TK_CE(a, b) { const int t_ = max(a, b); b = min(a, b); a = t_; }
__device__ __forceinline__ int tk_mono(float x) { int b = __float_as_int(x); return b ^ ((b >> 31) & 0x7fffffff); }
__device__ __forceinline__ float tk_val(int key, int mask) { int b = key & ~mask; b ^= (b >> 31) & 0x7fffffff; return __int_as_float(b); }
__device__ __forceinline__ void tk_sort16(int (&k)[16]) {
#pragma unroll
    for (int size = 2; size <= 16; size <<= 1)
#pragma unroll
        for (int stride = size >> 1; stride > 0; stride >>= 1)
#pragma unroll
            for (int i = 0; i < 16; ++i) { const int j = i ^ stride; if (j > i) { if ((i & size) == 0) TK_CE(k[i], k[j]) else TK_CE(k[j], k[i]) } }
}
__device__ __forceinline__ void tk_clean16(int (&k)[16]) {
#pragma unroll
    for (int stride = 8; stride > 0; stride >>= 1)
#pragma unroll
        for (int i = 0; i < 16; ++i) { const int j = i ^ stride; if (j > i) TK_CE(k[i], k[j]) }
}
__device__ __forceinline__ void tk_merge16(int (&a)[16], const int (&b)[16]) {
#pragma unroll
    for (int i = 0; i < 16; ++i) a[i] = max(a[i], b[15 - i]);
    tk_clean16(a);
}
__device__ __forceinline__ void topk_groups(const Ctx& c, const int h, const int grp_first, const int grp_end, const int grp_step) {
    const bf16_t* Q = WSP(bf16_t, WS_PROJ); const bf16_t* KEYS = WSP(bf16_t, WS_KEYS); int* EXPERT = WSP(int, WS_EXP); float* GATE = WSP(float, WS_GATE);
    const int lane = c.lane, col = lane & 31, hh = lane >> 5;
    constexpr int KP = 272;
    LAS unsigned char* kl = c.lds;
    LAS int* tab = (LAS int*)(c.lds + 256 * KP) + c.wave * (32 * 33);
    __syncthreads();
    for (int i = c.tid; i < 256 * 16; i += NTHR) { const int r = i >> 4, ch = i & 15;
        *(LAS u32x4*)(kl + r * KP + ch * 16) = *(const u32x4*)(KEYS + ((size_t)h * 256 + r) * 128 + ch * 8); }
    __syncthreads();
    const int INTMIN = (int)0x80000000;
    for (int grp = grp_first; grp < grp_end; grp += grp_step) {
        const int t0 = grp * 32;
        int top[2][16];
#pragma unroll
        for (int cc = 0; cc < 2; ++cc) {
            bf16x8v qf[8];
            const bf16_t* qp = Q + (size_t)(t0 + col) * D + h * 256 + cc * 128 + hh * 8;
#pragma unroll
            for (int ks = 0; ks < 8; ++ks) qf[ks] = __builtin_bit_cast(bf16x8v, *(const u32x4*)(qp + ks * 16));
            int k[4][16];
#pragma unroll
            for (int nt = 0; nt < 4; ++nt) {
                f32x16 acc;
#pragma unroll
                for (int r = 0; r < 16; ++r) acc[r] = 0.f;
#pragma unroll
                for (int ks = 0; ks < 8; ++ks) {
                    const bf16x8v af = __builtin_bit_cast(bf16x8v, *(const LAS u32x4*)(kl + (cc * 128 + nt * 32 + col) * KP + ks * 32 + hh * 16));
                    acc = __builtin_amdgcn_mfma_f32_32x32x16_bf16(af, qf[ks], acc, 0, 0, 0);
                }
#pragma unroll
                for (int r = 0; r < 16; ++r) k[nt][r] = (tk_mono(acc[r]) & ~127) | (nt * 32 + (r & 3) + 8 * (r >> 2) + 4 * hh);
                tk_sort16(k[nt]);
            }
            tk_merge16(k[0], k[1]); tk_merge16(k[2], k[3]); tk_merge16(k[0], k[2]);
            int p[16];
#pragma unroll
            for (int i = 0; i < 16; ++i) p[i] = __shfl_xor(k[0][15 - i], 32);
#pragma unroll
            for (int i = 0; i < 16; ++i) k[0][i] = max(k[0][i], p[i]);
            tk_clean16(k[0]);
#pragma unroll
            for (int i = 0; i < 16; ++i) top[cc][i] = k[0][i];
        }
        if (hh == 0) {
#pragma unroll
            for (int i = 0; i < 16; ++i) { tab[col * 33 + i] = top[0][i] & 127; tab[col * 33 + 16 + i] = top[1][i] & 127; }
        }
        float va[16], vb[16];
#pragma unroll
        for (int i = 0; i < 16; ++i) { va[i] = tk_val(top[0][i], 127); vb[i] = tk_val(top[1][i], 127); }
#define TK_CAND(i, j) ((tk_mono(va[i] + vb[j]) & ~255) | ((i) * 16 + (j)))
        int m[16], l1[16], l3[16], l4[16];
#pragma unroll
        for (int j = 0; j < 16; ++j) m[j] = TK_CAND(0, j);
#pragma unroll
        for (int j = 0; j < 8; ++j) l1[j] = TK_CAND(1, j);
#pragma unroll
        for (int j = 8; j < 16; ++j) l1[j] = INTMIN;
        tk_merge16(m, l1);
        l3[0] = TK_CAND(2, 0); l3[1] = TK_CAND(2, 1); l3[2] = TK_CAND(2, 2); l3[3] = TK_CAND(2, 3); l3[4] = TK_CAND(2, 4);
        l3[5] = TK_CAND(3, 0); l3[6] = TK_CAND(3, 1); l3[7] = TK_CAND(3, 2); l3[8] = TK_CAND(3, 3);
        l3[9] = TK_CAND(4, 0); l3[10] = TK_CAND(4, 1); l3[11] = TK_CAND(4, 2);
        l3[12] = TK_CAND(5, 0); l3[13] = TK_CAND(5, 1); l3[14] = TK_CAND(6, 0); l3[15] = TK_CAND(6, 1);
        tk_sort16(l3); tk_merge16(m, l3);
        l4[0] = TK_CAND(7, 0); l4[1] = TK_CAND(7, 1);
#pragma unroll
        for (int i = 8; i < 16; ++i) l4[i - 6] = TK_CAND(i, 0);
#pragma unroll
        for (int i = 10; i < 16; ++i) l4[i] = INTMIN;
        tk_sort16(l4); tk_merge16(m, l4);
#undef TK_CAND
        float ev[16]; float ssum = 0.f; const float mx = tk_val(m[0], 255);
#pragma unroll
        for (int r = 0; r < 16; ++r) { ev[r] = fexp(tk_val(m[r], 255) - mx); ssum += ev[r]; }
        const float inv = 1.f / ssum;
#if SLICED_PEER
        const size_t ob = (size_t)(t0 + col) * 128 + 2 * h;
        if (hh == 0) {
            int eo[16];
#pragma unroll
            for (int r = 0; r < 16; ++r) { const int code = m[r] & 255; eo[r] = tab[col * 33 + (code >> 4)] * 128 + tab[col * 33 + 16 + (code & 15)]; }
#pragma unroll
            for (int g = 0; g < 8; ++g) *(u32x2*)(EXPERT + ob + g * 16) = (u32x2){(unsigned)eo[g], (unsigned)eo[g + 8]};
        } else {
#pragma unroll
            for (int g = 0; g < 8; ++g) *(f32x2*)(GATE + ob + g * 16) = (f32x2){ev[g] * inv, ev[g + 8] * inv};
        }
#else
        const size_t ob = ((size_t)(t0 + col) * 8 + h) * 16;
        if (hh == 0) {
            int eo[16];
#pragma unroll
            for (int r = 0; r < 16; ++r) { const int code = m[r] & 255; eo[r] = tab[col * 33 + (code >> 4)] * 128 + tab[col * 33 + 16 + (code & 15)]; }
#pragma unroll
            for (int q = 0; q < 4; ++q) *(u32x4*)(EXPERT + ob + 4 * q) = (u32x4){(unsigned)eo[4 * q], (unsigned)eo[4 * q + 1], (unsigned)eo[4 * q + 2], (unsigned)eo[4 * q + 3]};
        } else {
#pragma unroll
            for (int q = 0; q < 4; ++q) *(f32x4*)(GATE + ob + 4 * q) = (f32x4){ev[4 * q] * inv, ev[4 * q + 1] * inv, ev[4 * q + 2] * inv, ev[4 * q + 3] * inv};
        }
#endif
    }
    __syncthreads();
}

__device__ __forceinline__ void step_topk_fast(const Ctx& c) {
    const int nper = (int)gridDim.x >> 3;
    topk_groups(c, (int)blockIdx.x & 7, (int)(blockIdx.x >> 3) + nper * c.wave, T / 32, nper * NWAVES);
}

#define PEER_LOAD(buf, TAB, kbase) { _Pragma("unroll") for (int u_ = 0; u_ < 4; ++u_) { const int k_ = (kbase) + u_; \
        const int e_ = __builtin_amdgcn_readlane(k_ < 64 ? er0 : er1, k_ & 63); const unsigned char* rp_ = (TAB) + (size_t)e_ * D + lane * 16; \
        buf[u_][0] = *(const u32x4*)rp_; buf[u_][1] = *(const u32x4*)(rp_ + 1024); } }
#define PEER_DOT(buf, kbase) { _Pragma("unroll") for (int u_ = 0; u_ < 4; ++u_) { f32x2 a2_ = {0.f, 0.f}; \
        _Pragma("unroll") for (int j_ = 0; j_ < 2; ++j_) _Pragma("unroll") for (int q_ = 0; q_ < 4; ++q_) { const int w_ = (int)buf[u_][j_][q_]; \
            a2_ += __builtin_amdgcn_cvt_pk_f32_fp8(w_, false) * hh[j_ * 8 + q_ * 2]; a2_ += __builtin_amdgcn_cvt_pk_f32_fp8(w_, true) * hh[j_ * 8 + q_ * 2 + 1]; } \
        const float tot_ = lane63(wave_sum63(a2_.x + a2_.y)); const int k_ = (kbase) + u_; \
        if (k_ < 64) ar0 = (lane == k_) ? tot_ : ar0; else ar1 = (lane == k_ - 64) ? tot_ : ar1; } }
#define PEER_AXPY(buf, kbase) { _Pragma("unroll") for (int u_ = 0; u_ < 4; ++u_) { const int k_ = (kbase) + u_; \
        const float w1_ = __int_as_float(__builtin_amdgcn_readlane(__float_as_int(k_ < 64 ? wr0 : wr1), k_ & 63)); const f32x2 ww_ = {w1_, w1_}; \
        _Pragma("unroll") for (int j_ = 0; j_ < 2; ++j_) _Pragma("unroll") for (int q_ = 0; q_ < 4; ++q_) { const int w_ = (int)buf[u_][j_][q_]; \
            yy[j_ * 8 + q_ * 2] += __builtin_amdgcn_cvt_pk_f32_fp8(w_, false) * ww_; yy[j_ * 8 + q_ * 2 + 1] += __builtin_amdgcn_cvt_pk_f32_fp8(w_, true) * ww_; } } }
__device__ __forceinline__ void step_peer(const Ctx& c) {
    const bf16_t* H2 = WSP(bf16_t, WS_ACT); const unsigned char* U8 = WSP(unsigned char, WS_UB); const unsigned char* V8 = WSP(unsigned char, WS_VB);
    const float* SCU = WSP(float, WS_SCU); const float* SCV = WSP(float, WS_SCV);
    const int* EXPERT = WSP(int, WS_EXP); const float* GATE = WSP(float, WS_GATE); const float* MOD = WSP(float, WS_MOD);
    const int lane = c.lane;
    for (int t = c.gw; t < T; t += c.ngw) {
        const int er0 = EXPERT[(size_t)t * 128 + lane], er1 = EXPERT[(size_t)t * 128 + 64 + lane];
        const float gr0 = GATE[(size_t)t * 128 + lane], gr1 = GATE[(size_t)t * 128 + 64 + lane];
        const float su0 = SCU[er0], su1 = SCU[er1], sv0 = SCV[er0], sv1 = SCV[er1];
        f32x2 hh[16];
#pragma unroll
        for (int j = 0; j < 2; ++j)
#pragma unroll
            for (int q = 0; q < 2; ++q) { const u32x4 v = *(const u32x4*)(H2 + (size_t)t * D + j * 1024 + lane * 16 + q * 8);
                hh[j * 8 + q * 4 + 0] = (f32x2){bflo(v.x), bfhi(v.x)}; hh[j * 8 + q * 4 + 1] = (f32x2){bflo(v.y), bfhi(v.y)};
                hh[j * 8 + q * 4 + 2] = (f32x2){bflo(v.z), bfhi(v.z)}; hh[j * 8 + q * 4 + 3] = (f32x2){bflo(v.w), bfhi(v.w)}; }
        float ar0 = 0.f, ar1 = 0.f;
        u32x4 A[4][2], B[4][2];
        PEER_LOAD(A, U8, 0);
        for (int kb = 0; kb < 128; kb += 8) {
            PEER_LOAD(B, U8, kb + 4);
            PEER_DOT(A, kb);
            if (kb + 8 < 128) PEER_LOAD(A, U8, kb + 8) else PEER_LOAD(A, V8, 0);
            PEER_DOT(B, kb + 4);
        }
        const float wr0 = gr0 * gelu_f(ar0 * su0) * sv0, wr1 = gr1 * gelu_f(ar1 * su1) * sv1;
        f32x2 yy[16];
#pragma unroll
        for (int i = 0; i < 16; ++i) yy[i] = (f32x2){0.f, 0.f};
        for (int kb = 0; kb < 128; kb += 8) {
            PEER_LOAD(B, V8, kb + 4);
            PEER_AXPY(A, kb);
            if (kb + 8 < 128) PEER_LOAD(A, V8, kb + 8);
            PEER_AXPY(B, kb + 4);
        }
        const int b = t >> 12; float* row = c.out + (size_t)t * D; const float* g2 = MOD + b * NMOD + 5 * D;
        float s = 0.f;
#pragma unroll
        for (int j = 0; j < 2; ++j)
#pragma unroll
            for (int q = 0; q < 4; ++q) {
                const int col = j * 1024 + lane * 16 + q * 4; const f32x4 xv = *(const f32x4*)(row + col), gv = *(const f32x4*)(g2 + col);
                f32x2& y0 = yy[j * 8 + q * 2]; f32x2& y1 = yy[j * 8 + q * 2 + 1];
                y0.x = ALPHA * xv.x + gv.x * y0.x; y0.y = ALPHA * xv.y + gv.y * y0.y; y1.x = ALPHA * xv.z + gv.z * y1.x; y1.y = ALPHA * xv.w + gv.w * y1.y;
                s += (y0.x + y0.y) + (y1.x + y1.y);
            }
        const float mean = wave_sum(s) * (1.f / D); float s2 = 0.f;
#pragma unroll
        for (int i = 0; i < 16; ++i) { yy[i] = yy[i] - mean; s2 += yy[i].x * yy[i].x + yy[i].y * yy[i].y; }
        const float rstd = rsqrtf(wave_sum(s2) * (1.f / D) + EPS);
#pragma unroll
        for (int j = 0; j < 2; ++j)
#pragma unroll
            for (int q = 0; q < 4; ++q) {
                const int col = j * 1024 + lane * 16 + q * 4; const f32x4 g = *(const f32x4*)(IN_LN2G + col), bb = *(const f32x4*)(IN_LN2B + col);
                const f32x2 y0 = yy[j * 8 + q * 2], y1 = yy[j * 8 + q * 2 + 1];
                *(f32x4*)(row + col) = (f32x4){y0.x * rstd * g.x + bb.x, y0.y * rstd * g.y + bb.y, y1.x * rstd * g.z + bb.z, y1.y * rstd * g.w + bb.w};
            }
    }
}

struct XcdPlace { int nloc, nx, xrank, rank; };
__device__ __forceinline__ float reduce8(float v) { v += DPPF(v, 0xB1); v += DPPF(v, 0x4E); v += DPPF(v, 0x141); return v; }
struct Sel8 { unsigned long long m1, m2, m4; };
__device__ __forceinline__ float cnd(float a, float b, unsigned long long m) { float r; asm("v_cndmask_b32 %0, %1, %2, %3" : "=v"(r) : "v"(a), "v"(b), "s"(m)); return r; }
__device__ __forceinline__ float sel8(const Sel8& S, float p0, float p1, float p2, float p3, float p4, float p5, float p6, float p7) {
    const float a0 = cnd(p0, p1, S.m1), a1 = cnd(p2, p3, S.m1), a2 = cnd(p4, p5, S.m1), a3 = cnd(p6, p7, S.m1);
    return cnd(cnd(a0, a1, S.m2), cnd(a2, a3, S.m2), S.m4);
}
#define PS_GATHER(buf, ids, tabp) { _Pragma("unroll") for (int q_ = 0; q_ < 4; ++q_) { \
        buf[4 * q_ + 0] = *(const u32x4*)((tabp) + (ids[q_].x * 128u + c16)); buf[4 * q_ + 1] = *(const u32x4*)((tabp) + (ids[q_].y * 128u + c16)); \
        buf[4 * q_ + 2] = *(const u32x4*)((tabp) + (ids[q_].z * 128u + c16)); buf[4 * q_ + 3] = *(const u32x4*)((tabp) + (ids[q_].w * 128u + c16)); } }
#define PS_IDS(ids, tok) { _Pragma("unroll") for (int q_ = 0; q_ < 4; ++q_) ids[q_] = *(const u32x4*)(EP + (size_t)(tok) * 128 + g * 16 + q_ * 4); }
__device__ __forceinline__ int cndi(int a, int b, unsigned long long m) { int r; asm("v_cndmask_b32 %0, %1, %2, %3" : "=v"(r) : "v"(a), "v"(b), "s"(m)); return r; }
__device__ __forceinline__ int sel8i(const Sel8& S, int p0, int p1, int p2, int p3, int p4, int p5, int p6, int p7) {
    const int a0 = cndi(p0, p1, S.m1), a1 = cndi(p2, p3, S.m1), a2 = cndi(p4, p5, S.m1), a3 = cndi(p6, p7, S.m1);
    return cndi(cndi(a0, a1, S.m2), cndi(a2, a3, S.m2), S.m4);
}
#define DPPI(v, ctrl) __builtin_amdgcn_update_dpp(0, (v), (ctrl), 0xF, 0xF, true)
__device__ __forceinline__ int reduce8i(int v) { v += DPPI(v, 0xB1); v += DPPI(v, 0x4E); v += DPPI(v, 0x141); return v; }
#define PU_PROCESS(buf, tok) { \
        const u32x4 hq_ = *(const u32x4*)(H2Q + (size_t)(tok) * D + slice * 128 + c16); \
        int p_[16]; \
        _Pragma("unroll") for (int i_ = 0; i_ < 16; ++i_) { int a_ = __builtin_amdgcn_sdot4((int)buf[i_].x, (int)hq_.x, 0, false); \
            a_ = __builtin_amdgcn_sdot4((int)buf[i_].y, (int)hq_.y, a_, false); a_ = __builtin_amdgcn_sdot4((int)buf[i_].z, (int)hq_.z, a_, false); a_ = __builtin_amdgcn_sdot4((int)buf[i_].w, (int)hq_.w, a_, false); \
            p_[i_] = reduce8i(a_); } \
        const int lo_ = sel8i(SL, p_[0], p_[1], p_[2], p_[3], p_[4], p_[5], p_[6], p_[7]), hi_ = sel8i(SL, p_[8], p_[9], p_[10], p_[11], p_[12], p_[13], p_[14], p_[15]); \
        if (PART16) {   \
            PARTA[((size_t)slice * T + (tok)) * 64 + lane] = (int)((((unsigned)(lo_ + 32) >> 6) & 0xffffu) | ((unsigned)((hi_ + 32) >> 6) << 16)); \
        } else { int* o_ = PARTA + ((size_t)slice * T + (tok)) * 128 + g * 16 + c8; o_[0] = lo_; o_[8] = hi_; } }
__device__ __forceinline__ void step_peer_u(const Ctx& c, const XcdPlace& P) {
    const unsigned char* H2Q = WSP(unsigned char, WS_H2Q); const unsigned char* U8 = WSP(unsigned char, WS_UB); const int* EP = WSP(int, WS_EXP); int* PARTA = WSP(int, WS_PARTA);
    const int lane = c.lane, g = lane >> 3, c8 = lane & 7, wid = P.rank * NWAVES + c.wave, nw = P.nloc * NWAVES;
    const Sel8 SL{__ballot((c8 & 1) != 0), __ballot((c8 & 2) != 0), __ballot((c8 & 4) != 0)};
    const unsigned c16 = (unsigned)c8 * 16u;
    for (int slice = P.xrank; slice < 16; slice += P.nx) {
        const unsigned char* ub = U8 + (size_t)slice * 16384 * 128;
        u32x4 idn[4]; u32x4 A[16], B[16];
        int t = wid;
        if (t < T) { PS_IDS(idn, t); PS_GATHER(A, idn, ub); }
        if (t + nw < T) { PS_IDS(idn, t + nw); PS_GATHER(B, idn, ub); }
        for (; t < T; t += 2 * nw) {
            if (t + 2 * nw < T) PS_IDS(idn, t + 2 * nw);
            PU_PROCESS(A, t);
            if (t + 2 * nw < T) { PS_GATHER(A, idn, ub); }
            if (t + nw < T) {
                if (t + 3 * nw < T) PS_IDS(idn, t + 3 * nw);
                PU_PROCESS(B, t + nw);
                if (t + 3 * nw < T) { PS_GATHER(B, idn, ub); }
            }
        }
    }
}
#if V_INT8
__device__ __forceinline__ void step_peer_w(const Ctx& c) {
    const int* PARTA = WSP(int, WS_PARTA); const int* EP = WSP(int, WS_EXP); const float* G = WSP(float, WS_GATE); unsigned* W8 = WSP(unsigned, WS_W8);
    const float* SCU = WSP(float, WS_SCU); const float* SCV = WSP(float, WS_SCV); const float* HS = WSP(float, WS_HS); float* WSC = WSP(float, WS_WS);
    const int g = c.lane >> 3, c8 = c.lane & 7, i0 = g * 16 + c8, i1 = i0 + 8;
    for (int t = c.gw; t < T; t += c.ngw) {
        int a0 = 0, a1 = 0;
#if PART16
#pragma unroll
        for (int sl = 0; sl < 16; ++sl) { const int p = PARTA[((size_t)sl * T + t) * 64 + c.lane]; a0 += (int)(short)(p & 0xffff); a1 += p >> 16; }
        const float descale = 64.f;
#else
#pragma unroll
        for (int sl = 0; sl < 16; ++sl) { a0 += PARTA[((size_t)sl * T + t) * 128 + i0]; a1 += PARTA[((size_t)sl * T + t) * 128 + i1]; }
        const float descale = 1.f;
#endif
        const size_t base = (size_t)t * 128;
        const int e0 = EP[base + i0], e1 = EP[base + i1]; const float g0 = G[base + i0], g1 = G[base + i1], hs = HS[t] * descale;
        const float w0 = g0 * gelu_f((float)a0 * (SCU[e0] * hs)) * SCV[e0], w1 = g1 * gelu_f((float)a1 * (SCU[e1] * hs)) * SCV[e1];
        float am = fmaxf(fabsf(w0), fabsf(w1));
        am = DPPMAX(am, 0xB1); am = DPPMAX(am, 0x4E); am = DPPMAX(am, 0x141); am = DPPMAX(am, 0x140);
        const unsigned m0 = __builtin_amdgcn_readlane(__float_as_uint(am), 0), m1 = __builtin_amdgcn_readlane(__float_as_uint(am), 16), m2 = __builtin_amdgcn_readlane(__float_as_uint(am), 32), m3 = __builtin_amdgcn_readlane(__float_as_uint(am), 48);
        const unsigned m01 = m0 > m1 ? m0 : m1, m23 = m2 > m3 ? m2 : m3; am = __uint_as_float(m01 > m23 ? m01 : m23);
        const float inv = am > 0.f ? 127.f / am : 0.f;
        const int q0 = (int)__builtin_rintf(w0 * inv) & 0xff, q1 = (int)__builtin_rintf(w1 * inv) & 0xff;
        const int pk = q0 | (q1 << 8);
        const int b0 = DPPI(pk, 0x00), b1 = DPPI(pk, 0x55), b2 = DPPI(pk, 0xAA), b3 = DPPI(pk, 0xFF);
        const unsigned dlo = (unsigned)(b0 & 0xff) | ((unsigned)(b1 & 0xff) << 8) | ((unsigned)(b2 & 0xff) << 16) | ((unsigned)(b3 & 0xff) << 24);
        const unsigned dhi = ((unsigned)(b0 >> 8) & 0xff) | (((unsigned)(b1 >> 8) & 0xff) << 8) | (((unsigned)(b2 >> 8) & 0xff) << 16) | (((unsigned)(b3 >> 8) & 0xff) << 24);
        if ((c.lane & 3) == 0) { W8[(size_t)t * 32 + g * 4 + (c8 >> 2)] = dlo; W8[(size_t)t * 32 + g * 4 + 2 + (c8 >> 2)] = dhi; }
        if (c.lane == 0) WSC[t] = am * (1.f / 127.f);
    }
}
#else
__device__ __forceinline__ void step_peer_w(const Ctx& c) {
    const int* PARTA = WSP(int, WS_PARTA); const int* EP = WSP(int, WS_EXP); float* GW = WSP(float, WS_GATE); const float* SCU = WSP(float, WS_SCU); const float* SCV = WSP(float, WS_SCV); const float* HS = WSP(float, WS_HS);
    for (int idx = c.gt; idx < T * 128; idx += c.ngt) {
        int a = 0;
#pragma unroll
        for (int sl = 0; sl < 16; ++sl) a += PARTA[(size_t)sl * T * 128 + idx];
        const int e = EP[idx];
        GW[idx] = GW[idx] * gelu_f((float)a * (SCU[e] * HS[idx >> 7])) * SCV[e];
    }
}
#endif
#if V_INT8
#define PV_PROCESS(buf, tok) { \
        const u32x4 wq_ = *(const u32x4*)(W8 + (size_t)(tok) * 32 + g * 4); const float wsc_ = WSC[tok]; \
        int acc_[16]; _Pragma("unroll") for (int q_ = 0; q_ < 16; ++q_) acc_[q_] = 0; \
        _Pragma("unroll") for (int j_ = 0; j_ < 4; ++j_) { const int w4_ = (int)wq_[j_]; \
            _Pragma("unroll") for (int q_ = 0; q_ < 4; ++q_) { \
                const unsigned a_ = buf[4 * j_][q_], b_ = buf[4 * j_ + 1][q_], c_ = buf[4 * j_ + 2][q_], d_ = buf[4 * j_ + 3][q_]; \
                const unsigned tl_ = __builtin_amdgcn_perm(b_, a_, 0x05010400u), th_ = __builtin_amdgcn_perm(b_, a_, 0x07030602u); \
                const unsigned ul_ = __builtin_amdgcn_perm(d_, c_, 0x05010400u), uh_ = __builtin_amdgcn_perm(d_, c_, 0x07030602u); \
                acc_[4 * q_ + 0] = __builtin_amdgcn_sdot4((int)__builtin_amdgcn_perm(ul_, tl_, 0x05040100u), w4_, acc_[4 * q_ + 0], false); \
                acc_[4 * q_ + 1] = __builtin_amdgcn_sdot4((int)__builtin_amdgcn_perm(ul_, tl_, 0x07060302u), w4_, acc_[4 * q_ + 1], false); \
                acc_[4 * q_ + 2] = __builtin_amdgcn_sdot4((int)__builtin_amdgcn_perm(uh_, th_, 0x05040100u), w4_, acc_[4 * q_ + 2], false); \
                acc_[4 * q_ + 3] = __builtin_amdgcn_sdot4((int)__builtin_amdgcn_perm(uh_, th_, 0x07060302u), w4_, acc_[4 * q_ + 3], false); } } \
        int p_[16]; \
        _Pragma("unroll") for (int q_ = 0; q_ < 16; ++q_) p_[q_] = acc_[q_] + DPPI(acc_[q_], 0x128); \
        int q8_[8]; \
        _Pragma("unroll") for (int k_ = 0; k_ < 8; ++k_) { const auto r_ = __builtin_amdgcn_permlane16_swap((unsigned)p_[k_], (unsigned)p_[k_ + 8], false, false); q8_[k_] = (int)r_[0] + (int)r_[1]; } \
        int r4_[4]; \
        _Pragma("unroll") for (int k_ = 0; k_ < 4; ++k_) { const auto r_ = __builtin_amdgcn_permlane32_swap((unsigned)q8_[k_], (unsigned)q8_[k_ + 4], false, false); r4_[k_] = (int)r_[0] + (int)r_[1]; } \
        if ((lane & 8) == 0) *(u32x2*)(Y + (size_t)(tok) * D + slice * 128 + ocol) = (u32x2){cvtpk((float)r4_[0] * wsc_, (float)r4_[1] * wsc_), cvtpk((float)r4_[2] * wsc_, (float)r4_[3] * wsc_)}; }
#else
#define PV_PROCESS(buf, tok) { \
        f32x4 wv_[4]; _Pragma("unroll") for (int q_ = 0; q_ < 4; ++q_) wv_[q_] = *(const f32x4*)(GW + (size_t)(tok) * 128 + g * 16 + q_ * 4); \
        f32x2 acc_[8]; _Pragma("unroll") for (int q_ = 0; q_ < 8; ++q_) acc_[q_] = (f32x2){0.f, 0.f}; \
        _Pragma("unroll") for (int i_ = 0; i_ < 16; ++i_) { const float w1_ = wv_[i_ >> 2][i_ & 3]; const f32x2 ww_ = {w1_, w1_}; \
            _Pragma("unroll") for (int q_ = 0; q_ < 4; ++q_) { const int w_ = (int)buf[i_][q_]; acc_[2 * q_] += __builtin_amdgcn_cvt_pk_f32_fp8(w_, false) * ww_; acc_[2 * q_ + 1] += __builtin_amdgcn_cvt_pk_f32_fp8(w_, true) * ww_; } } \
        float p_[16]; \
        _Pragma("unroll") for (int q_ = 0; q_ < 8; ++q_) { p_[2 * q_] = acc_[q_].x + DPPF(acc_[q_].x, 0x128); p_[2 * q_ + 1] = acc_[q_].y + DPPF(acc_[q_].y, 0x128); } \
        float q8_[8]; \
        _Pragma("unroll") for (int k_ = 0; k_ < 8; ++k_) { const auto r_ = __builtin_amdgcn_permlane16_swap(__float_as_uint(p_[k_]), __float_as_uint(p_[k_ + 8]), false, false); q8_[k_] = __uint_as_float(r_[0]) + __uint_as_float(r_[1]); } \
        float r4_[4]; \
        _Pragma("unroll") for (int k_ = 0; k_ < 4; ++k_) { const auto r_ = __builtin_amdgcn_permlane32_swap(__float_as_uint(q8_[k_]), __float_as_uint(q8_[k_ + 4]), false, false); r4_[k_] = __uint_as_float(r_[0]) + __uint_as_float(r_[1]); } \
        if ((lane & 8) == 0) *(u32x2*)(Y + (size_t)(tok) * D + slice * 128 + ocol) = (u32x2){cvtpk(r4_[0], r4_[1]), cvtpk(r4_[2], r4_[3])}; }
#endif
__device__ __forceinline__ void step_peer_v(const Ctx& c, const XcdPlace& P) {
    const unsigned char* V8 = WSP(unsigned char, WS_VB); const int* EP = WSP(int, WS_EXP); const float* GW = WSP(float, WS_GATE); bf16_t* Y = WSP(bf16_t, WS_Y);
    const unsigned* W8 = WSP(unsigned, WS_W8); const float* WSC = WSP(float, WS_WS); (void)GW; (void)W8; (void)WSC;
    const int lane = c.lane, g = lane >> 3, c8 = lane & 7, wid = P.rank * NWAVES + c.wave, nw = P.nloc * NWAVES;
    const int ocol = c8 * 16 + 8 * ((lane >> 4) & 1) + 4 * (lane >> 5);
    const unsigned c16 = (unsigned)c8 * 16u;
    for (int slice = P.xrank; slice < 16; slice += P.nx) {
        const unsigned char* vb = V8 + (size_t)slice * 16384 * 128;
        u32x4 idn[4]; u32x4 A[16], B[16];
        int t = wid;
        if (t < T) { PS_IDS(idn, t); PS_GATHER(A, idn, vb); }
        if (t + nw < T) { PS_IDS(idn, t + nw); PS_GATHER(B, idn, vb); }
        for (; t < T; t += 2 * nw) {
            if (t + 2 * nw < T) PS_IDS(idn, t + 2 * nw);
            PV_PROCESS(A, t);
            if (t + 2 * nw < T) { PS_GATHER(A, idn, vb); }
            if (t + nw < T) {
                if (t + 3 * nw < T) PS_IDS(idn, t + 3 * nw);
                PV_PROCESS(B, t + nw);
                if (t + 3 * nw < T) { PS_GATHER(B, idn, vb); }
            }
        }
    }
}
__device__ __forceinline__ void step_ln2(const Ctx& c) {
    const float* MOD = WSP(float, WS_MOD); const bf16_t* Y = WSP(bf16_t, WS_Y); const bf16_t* X1B = WSP(bf16_t, WS_X1B);
    u32x2 xc[8], xn[8], yc[8], yn[8];
    int t = c.gw;
#define LN2_LOAD(xa, ya, tok) { _Pragma("unroll") for (int j_ = 0; j_ < 8; ++j_) { xa[j_] = *(const u32x2*)(X1B + (size_t)(tok) * D + j_ * 256 + c.lane * 4); ya[j_] = *(const u32x2*)(Y + (size_t)(tok) * D + j_ * 256 + c.lane * 4); } }
    if (t < T) LN2_LOAD(xc, yc, t);
    for (; t < T; t += c.ngw) {
        const int tn = t + c.ngw;
        if (tn < T) LN2_LOAD(xn, yn, tn);
        const int b = t >> 12; float* row = c.out + (size_t)t * D; const float* g2 = MOD + b * NMOD + 5 * D;
        f32x4 v[8]; float s = 0.f;
#pragma unroll
        for (int j = 0; j < 8; ++j) { const int col = j * 256 + c.lane * 4; const f32x4 gv = *(const f32x4*)(g2 + col); const u32x2 xw = xc[j], yw = yc[j];
            v[j] = (f32x4){ALPHA * bflo(xw.x) + gv.x * bflo(yw.x), ALPHA * bfhi(xw.x) + gv.y * bfhi(yw.x), ALPHA * bflo(xw.y) + gv.z * bflo(yw.y), ALPHA * bfhi(xw.y) + gv.w * bfhi(yw.y)};
            s += (v[j].x + v[j].y) + (v[j].z + v[j].w); }
        const float mean = wave_sum_all(s) * (1.f / D); float s2 = 0.f;
#pragma unroll
        for (int j = 0; j < 8; ++j) { v[j] = v[j] - mean; s2 += (v[j].x * v[j].x + v[j].y * v[j].y) + (v[j].z * v[j].z + v[j].w * v[j].w); }
        const float rstd = rsqrtf(wave_sum_all(s2) * (1.f / D) + EPS);
#pragma unroll
        for (int j = 0; j < 8; ++j) { const int col = j * 256 + c.lane * 4; const f32x4 gg = *(const f32x4*)(IN_LN2G + col), bb = *(const f32x4*)(IN_LN2B + col);
            *(f32x4*)(row + col) = v[j] * rstd * gg + bb; }
#pragma unroll
        for (int j = 0; j < 8; ++j) { xc[j] = xn[j]; yc[j] = yn[j]; }
    }
#undef LN2_LOAD
}

__device__ __forceinline__ void step_requant(const Ctx& c) {
    const bf16_t* YCAT = WSP(bf16_t, WS_ACT); const float* SSP = WSP(float, WS_SSP); unsigned char* A8 = WSP(unsigned char, WS_A8); float* SA2 = WSP(float, WS_SA2);
    for (int t = c.gw; t < T; t += c.ngw) {
        float s1 = 0.f, s2 = 0.f;
#pragma unroll
        for (int j = 0; j < 4; ++j) { const f32x4 a = *(const f32x4*)(SSP + (size_t)t * 32 + 4 * j), b = *(const f32x4*)(SSP + (size_t)t * 32 + 16 + 4 * j); s1 += (a.x + a.y) + (a.z + a.w); s2 += (b.x + b.y) + (b.z + b.w); }
        const float r1 = rsqrtf(s1 * (1.f / 1024.f) + EPS), r2 = rsqrtf(s2 * (1.f / 1024.f) + EPS);
        f32x4 v[8]; float am = 0.f;
#pragma unroll
        for (int j = 0; j < 8; ++j) { const u32x2 w = *(const u32x2*)(YCAT + (size_t)t * D + j * 256 + c.lane * 4); const float r = j < 4 ? r1 : r2;
            v[j] = (f32x4){bflo(w.x), bfhi(w.x), bflo(w.y), bfhi(w.y)} * r; am = fmaxf(am, fmaxf(fmaxf(fabsf(v[j].x), fabsf(v[j].y)), fmaxf(fabsf(v[j].z), fabsf(v[j].w)))); }
        am = DPPMAX(am, 0xB1); am = DPPMAX(am, 0x4E); am = DPPMAX(am, 0x141); am = DPPMAX(am, 0x140);
        const unsigned a0 = __builtin_amdgcn_readlane(__float_as_uint(am), 0), a1 = __builtin_amdgcn_readlane(__float_as_uint(am), 16), a2 = __builtin_amdgcn_readlane(__float_as_uint(am), 32), a3 = __builtin_amdgcn_readlane(__float_as_uint(am), 48);
        const unsigned m01 = a0 > a1 ? a0 : a1, m23 = a2 > a3 ? a2 : a3; am = __uint_as_float(m01 > m23 ? m01 : m23);
        const float inv = am > 0.f ? 127.f / am : 0.f;
#pragma unroll
        for (int j = 0; j < 8; ++j) *(unsigned*)(A8 + (size_t)t * D + j * 256 + c.lane * 4) = pack_i8x4(v[j] * inv);
        if (c.lane == 0) SA2[t] = am * (1.f / 127.f);
    }
}
__device__ __forceinline__ void step_wq8(const Ctx& c) {
    LAS float* scr = (LAS float*)(c.lds + c.wave * 16384);
    if (I8_GEMM3 && FAST_GEMM) { for (int it = c.gw; it < (D / 64) * (D / 32); it += c.ngw) transpose_item_i8<false>(IN_WQ, D, D, D, WSP(unsigned char, WS_WQ), WSP(unsigned, WS_CTL) + CW_AMXQ, WSP(float, WS_SWQ), scr, it, c.lane); }
    if (I8_GEMM2 && FAST_GEMM) { for (int it = c.gw; it < (D / 64) * (D / 32); it += c.ngw) transpose_item_i8<false, true>(IN_WOUT, D, D, D, WSP(unsigned char, WS_WOUT), WSP(unsigned, WS_CTL) + CW_AMXOUT, WSP(float, WS_SWOUT), scr, it, c.lane, IN_SSMG, IN_ATTG); }
    if (I8_GEMM1 && FAST_GEMM) { for (int it = c.gw; it < (D / 64) * (DINP / 32); it += c.ngw) transpose_item_i8<true>(IN_WIN, D, 3856, DINP, WSP(unsigned char, WS_WIN), WSP(unsigned, WS_CTL) + CW_AMXIN, WSP(float, WS_SWIN), scr, it, c.lane); }
}

#if TAB_PROBE
__device__ __forceinline__ void tabp_load_coal(f32x4 (&v)[8], const float* src, int lane) {
#pragma unroll
    for (int i = 0; i < 8; ++i) v[i] = *(const f32x4*)(src + i * 256 + lane * 4);
}
template <int ROWMAJOR>
__device__ __forceinline__ void tabp_finish_coal(const f32x4 (&v)[8], unsigned char* tab, int row, float* scale, int lane) {
    float am = 0.f;
#pragma unroll
    for (int i = 0; i < 8; ++i) am = fmaxf(am, fmaxf(fmaxf(fabsf(v[i].x), fabsf(v[i].y)), fmaxf(fabsf(v[i].z), fabsf(v[i].w))));
    am = DPPMAX(am, 0xB1); am = DPPMAX(am, 0x4E); am = DPPMAX(am, 0x141); am = DPPMAX(am, 0x140);
    { const unsigned a0 = __builtin_amdgcn_readlane(__float_as_uint(am), 0), a1 = __builtin_amdgcn_readlane(__float_as_uint(am), 16);
      const unsigned a2 = __builtin_amdgcn_readlane(__float_as_uint(am), 32), a3 = __builtin_amdgcn_readlane(__float_as_uint(am), 48);
      const unsigned m01 = a0 > a1 ? a0 : a1, m23 = a2 > a3 ? a2 : a3; am = __uint_as_float(m01 > m23 ? m01 : m23); }
    const float inv = am > 0.f ? 127.f / am : 0.f;
#pragma unroll
    for (int i = 0; i < 8; ++i) {
        const unsigned o = pack_i8x4(v[i] * inv);
        if (ROWMAJOR) *(unsigned*)(tab + (size_t)row * D + i * 256 + lane * 4) = o;
        else *(unsigned*)(tab + ((size_t)(2 * i) * 16384 + row) * 128 + ((unsigned)(lane >> 5) * (16384u * 128u) + (unsigned)(lane & 31) * 4u)) = o;
    }
    if (lane == 0) *scale = am / 127.f;
}
__device__ __forceinline__ void step_tab_probe(const Ctx& c) {
#define TABP_SRC(r_) ((r_) < 16384 ? IN_U + (size_t)(r_) * D : IN_V + (size_t)((r_) - 16384) * D)
    f32x4 cur[8], nxt[8];
    int r = c.gw;
#if TAB_PROBE == 1
    if (r < 2 * 16384) fp8_row_load(cur, TABP_SRC(r), c.lane);
    for (; r < 2 * 16384; r += c.ngw) {
        const int rn = r + c.ngw;
        if (rn < 2 * 16384) fp8_row_load(nxt, TABP_SRC(rn), c.lane);
        if (r < 16384) fp8_row_finish<true>(cur, WSP(unsigned char, WS_UB), r, WSP(float, WS_SCU) + r, c.lane);
        else fp8_row_finish<true>(cur, WSP(unsigned char, WS_VB), r - 16384, WSP(float, WS_SCV) + (r - 16384), c.lane);
#pragma unroll
        for (int i = 0; i < 8; ++i) cur[i] = nxt[i];
    }
#elif TAB_PROBE == 2 || TAB_PROBE == 3
    if (r < 2 * 16384) tabp_load_coal(cur, TABP_SRC(r), c.lane);
    for (; r < 2 * 16384; r += c.ngw) {
        const int rn = r + c.ngw;
        if (rn < 2 * 16384) tabp_load_coal(nxt, TABP_SRC(rn), c.lane);
        if (r < 16384) tabp_finish_coal<TAB_PROBE == 3>(cur, WSP(unsigned char, WS_UB), r, WSP(float, WS_SCU) + r, c.lane);
        else tabp_finish_coal<TAB_PROBE == 3>(cur, WSP(unsigned char, WS_VB), r - 16384, WSP(float, WS_SCV) + (r - 16384), c.lane);
#pragma unroll
        for (int i = 0; i < 8; ++i) cur[i] = nxt[i];
    }
#elif TAB_PROBE == 4
    float acc_ = 0.f;
    for (; r < 2 * 16384; r += c.ngw) { tabp_load_coal(cur, TABP_SRC(r), c.lane);
#pragma unroll
        for (int i = 0; i < 8; ++i) acc_ += (cur[i].x + cur[i].y) + (cur[i].z + cur[i].w); }
    if (acc_ == 1.2345e-30f) WSP(float, WS_SCU)[0] = acc_;
#endif
#undef TABP_SRC
}
#endif

constexpr int NSTEPS = 18;
__global__ void __launch_bounds__(NTHR, 2) fwd_kernel(Args a) {
    extern __shared__ __attribute__((aligned(16))) unsigned char lds_raw[];
    Ctx c;
#pragma unroll
    for (int i = 0; i < 22; ++i) c.in[i] = a.in[i];
    c.out = a.out; c.ws = a.ws; c.lds = (LAS unsigned char*)lds_raw;
    c.tid = threadIdx.x; c.lane = c.tid & 63; c.wave = __builtin_amdgcn_readfirstlane(c.tid >> 6);
    c.gw = blockIdx.x * NWAVES + c.wave; c.ngw = gridDim.x * NWAVES; c.gt = blockIdx.x * NTHR + c.tid; c.ngt = gridDim.x * NTHR;
    for (int u = c.tid; u < (LDS_BYTES - LDSCTL_OFF) / 4; u += NTHR) ((LAS unsigned*)(c.lds + LDSCTL_OFF))[u] = 0u;
    __syncthreads();
    const bool multi = (a.hi - a.lo) > 1;
    XcdBarrier bar; bar.bar = (unsigned*)(c.ws + WS_CTL); bar.x = 0; bar.st = (volatile LAS unsigned*)(c.lds + MISC_OFF);
    if (multi) bar = xcd_barrier_post((unsigned*)(c.ws + WS_CTL), (volatile LAS unsigned*)(c.lds + MISC_OFF));
#define STEP_IDS() { int tid_ = (int)threadIdx.x; asm volatile("" : "+v"(tid_)); c.tid = tid_; c.lane = tid_ & 63; c.gt = (int)blockIdx.x * NTHR + tid_; }
#define STEP(i, ...) if (a.lo <= (i) && (i) < a.hi) { STEP_IDS(); __VA_ARGS__; if ((REPEAT_MASK >> (i)) & 1) { xcd_barrier(bar); __VA_ARGS__; } if ((i) + 1 < a.hi) xcd_barrier(bar); }
    STEP(0, step_pro(c));
#if WQ_ONEPASS && I8_GEMM1 && I8_GEMM2 && I8_GEMM3 && FAST_GEMM
    STEP(1, step_h1(c));
#else
    STEP(1, { step_h1(c); step_wq8(c); });
#endif
#if FAST_GEMM
#define RUN_GEMM(EPI, MIDK, Aoff, Boff, N_, ...) { pg8::Gemm g{WSP(bf16_t, Aoff), WSP(bf16_t, Boff), T, N_, D}; pg8::StaticOrder S; S.init(T, N_, (int)gridDim.x, (int)blockIdx.x); \
        pg8::EpiA<EPI> E{EPI{__VA_ARGS__}}; pg8::gemm_phase<pg8::EpiA<EPI>, pg8::StaticOrder, false, true, MIDK>(c.lds, g, S, E); }
#else
#define RUN_GEMM(EPI, MIDK, Aoff, Boff, N_, ...) { EPI e{__VA_ARGS__}; gemm_simple<EPI, MIDK>(c, WSP(bf16_t, Aoff), WSP(bf16_t, Boff), T, N_, D, e); }
#endif
#if I8_GEMM1 && FAST_GEMM
    STEP(2, { pg8::Gemm g{WSP(bf16_t, WS_ACT), WSP(bf16_t, WS_WIN), T, DINP, D / 2}; pg8::StaticOrder S; S.init(T, DINP, (int)gridDim.x, (int)blockIdx.x);
        pg8::EpiA<Epi1Q, true> E{Epi1Q{WSP(bf16_t, WS_PROJ), WSP(float, WS_DTRAW), WSP(float, WS_SA1), WSP(float, WS_SWIN)}}; pg8::gemm_phase<pg8::EpiA<Epi1Q, true>, pg8::StaticOrder, false, true, false, true>(c.lds, g, S, E); });
#else
    STEP(2, RUN_GEMM(Epi1, false, WS_ACT, WS_WIN, DINP, WSP(bf16_t, WS_PROJ), WSP(float, WS_DTRAW)));
#endif
#if (FAST_MIX & 5) == 5
    STEP(3, { step_att_fast(c); step_conv_only(c); step_dta(c); });
#elif FAST_MIX & 1
    STEP(3, { step_conv_only(c); step_dta(c); });
#else
    STEP(3, step_conv(c));
#endif
#if FAST_MIX & 2
    STEP(4, step_ssd1_fast(c));
#else
    STEP(4, step_ssd1_simple(c));
#endif
#if (FAST_MIX & 5) == 5
#elif FAST_MIX & 4
    STEP(5, step_att_fast(c));
#else
    STEP(5, step_att_simple(c));
#endif
    STEP(6, step_scan(c));
#if FAST_MIX & 8
    STEP(8, step_ssd2_fast<0>(c));
#else
    STEP(7, step_cb_simple(c));
    STEP(8, step_ssd2_simple(c));
#endif
#if I8_GEMM2 && FAST_GEMM
    STEP(9, step_requant(c));
    STEP(10, { pg8::Gemm g{WSP(bf16_t, WS_A8), WSP(bf16_t, WS_WOUT), T, D, D / 2}; pg8::StaticOrder S; S.init(T, D, (int)gridDim.x, (int)blockIdx.x);
        pg8::EpiA<Epi2Q, true> E{Epi2Q{WSP(float, WS_MOD), WSP(float, WS_SA2), WSP(float, WS_SWOUT), WSP(bf16_t, WS_R1B)}}; pg8::gemm_phase<pg8::EpiA<Epi2Q, true>, pg8::StaticOrder, false, true, false, true>(c.lds, g, S, E); });
#else
    STEP(10, RUN_GEMM(Epi2, true, WS_ACT, WS_WOUT, D, IN_X, WSP(float, WS_MOD), WSP(float, WS_SSP), WSP(bf16_t, WS_R1B)));
#endif
    STEP(11, step_ln1(c));
#if I8_GEMM3 && FAST_GEMM && FUSE_TOPK && FAST_TOPK
    STEP(12, { pg8::Gemm g{WSP(bf16_t, WS_H2Q), WSP(bf16_t, WS_WQ), T, D, D / 2}; pg8::StaticOrder S; S.init(T, D, (int)gridDim.x, (int)blockIdx.x);
        pg8::EpiA<Epi3Q, true> E{Epi3Q{WSP(bf16_t, WS_PROJ), WSP(float, WS_HS), WSP(float, WS_SWQ)}}; pg8::gemm_phase<pg8::EpiA<Epi3Q, true>, pg8::StaticOrder, false, true, false, true>(c.lds, g, S, E);
        asm volatile("s_waitcnt vmcnt(0)" ::: "memory"); __syncthreads();
        pg8::Unit u; for (int i = 0; S.next(i, u); ++i) topk_groups(c, u.pn, u.pm * 8 + c.wave, u.pm * 8 + c.wave + 1, 1); });
#else
#if I8_GEMM3 && FAST_GEMM
    STEP(12, { pg8::Gemm g{WSP(bf16_t, WS_H2Q), WSP(bf16_t, WS_WQ), T, D, D / 2}; pg8::StaticOrder S; S.init(T, D, (int)gridDim.x, (int)blockIdx.x);
        pg8::EpiA<Epi3Q, true> E{Epi3Q{WSP(bf16_t, WS_PROJ), WSP(float, WS_HS), WSP(float, WS_SWQ)}}; pg8::gemm_phase<pg8::EpiA<Epi3Q, true>, pg8::StaticOrder, false, true, false, true>(c.lds, g, S, E); });
#else
    STEP(12, RUN_GEMM(Epi3, false, WS_ACT, WS_WQ, D, WSP(bf16_t, WS_PROJ)));
#endif
#if FAST_TOPK
    STEP(13, step_topk_fast(c));
#else
    STEP(13, step_topk_simple(c));
#endif
#endif
#if SLICED_PEER
    XcdPlace P; P.nloc = (int)gridDim.x; P.nx = 1; P.xrank = 0; P.rank = (int)blockIdx.x;
    if (multi && a.lo <= 14 && 14 < a.hi) {
        unsigned* bw = (unsigned*)(c.ws + WS_CTL); const unsigned myx = xb_xcc_id();
        LAS unsigned* pl = (LAS unsigned*)(c.lds + LDSCTL_OFF + 16);
        if (c.tid == 0) pl[0] = xb_add(bw + 16384 + 64 * myx, 1u);
        __syncthreads();
        int nx = 0, xr = 0, nl = 0;
#pragma unroll
        for (int j = 0; j < 16; ++j) { const int cj = (int)xb_ld(&bw[XB_XCNT(j)]); if (cj > 0) { if (j < (int)myx) ++xr; ++nx; } if (j == (int)myx) nl = cj; }
        if (nl > 0 && nx > 0) { P.nloc = nl; P.nx = nx; P.xrank = xr; P.rank = (int)pl[0]; }
    }
    STEP(14, step_peer_u(c, P));
    STEP(15, step_peer_w(c));
    STEP(16, step_peer_v(c, P));
#if SSD2_PROBE
    STEP(17, { step_ln2(c); xcd_barrier(bar); step_ssd2_fast<SSD2_PROBE>(c); });
#elif TAB_PROBE
    STEP(17, { step_ln2(c); xcd_barrier(bar); step_tab_probe(c); });
#else
    STEP(17, step_ln2(c));
#endif
#else
    STEP(14, step_peer(c));
#endif
#undef STEP
}
}

extern "C" void kernel_launch(void* const* d_in, const int* in_sizes, int n_in, void* d_out, int out_size, void* d_ws, size_t ws_size, hipStream_t stream) {
    static int grid = 0;
    if (grid == 0) {
        if (n_in != 22 || in_sizes[0] != T * D || out_size != T * D || ws_size < WS_END) {
            fprintf(stderr, "kernel_launch: unexpected problem (n_in %d, in0 %d, out %d, ws %zu < %zu); nothing launched\n", n_in, n_in > 0 ? in_sizes[0] : -1, out_size, ws_size, (size_t)WS_END);
            grid = -1; return;
        }
        int dev = 0, cus = 0;
        if (hipGetDevice(&dev) != hipSuccess || hipDeviceGetAttribute(&cus, hipDeviceAttributeMultiprocessorCount, dev) != hipSuccess) { grid = -1; return; }
        if (hipFuncSetAttribute((const void*)fwd_kernel, hipFuncAttributeMaxDynamicSharedMemorySize, LDS_BYTES) != hipSuccess) { fprintf(stderr, "kernel_launch: hipFuncSetAttribute failed\n"); grid = -1; return; }
        int per_cu = 0;
        if (hipOccupancyMaxActiveBlocksPerMultiprocessor(&per_cu, (const void*)fwd_kernel, NTHR, LDS_BYTES) != hipSuccess || per_cu < 1) fprintf(stderr, "kernel_launch: occupancy query reports %d blocks per CU\n", per_cu);
        (void)hipGetLastError();
        grid = cus > 0 ? cus : 256;
    }
    if (grid < 0) return;
    (void)hipMemsetAsync((char*)d_ws + WS_CTL, 0, CTL_ZERO_BYTES, stream);
    Args a{};
    for (int i = 0; i < 22; ++i) a.in[i] = (const float*)d_in[i];
    a.out = (float*)d_out; a.ws = (unsigned char*)d_ws;
#if ONE_LAUNCH
    a.lo = 0; a.hi = NSTEPS;
    hipLaunchKernelGGL(fwd_kernel, dim3(grid), dim3(NTHR), LDS_BYTES, stream, a);
#else
    for (int i = 0; i < NSTEPS; ++i) { a.lo = i; a.hi = i + 1; hipLaunchKernelGGL(fwd_kernel, dim3(grid), dim3(NTHR), LDS_BYTES, stream, a); }
#endif
}
```

```cpp
#include <hip/hip_runtime.h>
#include <cstdio>
#include <cstdint>

#ifndef ONE_LAUNCH
#define ONE_LAUNCH 1
#endif
#ifndef FAST_GEMM
#define FAST_GEMM 1
#endif
#ifndef FAST_TOPK
#define FAST_TOPK 1
#endif
#ifndef FAST_MIX
#define FAST_MIX 15
#endif
#ifndef SLICED_PEER
#define SLICED_PEER 1
#endif
#ifndef PRO_REPEAT
#define PRO_REPEAT 0
#endif
#ifndef V_INT8
#define V_INT8 1
#endif
#ifndef HIDE_TABLES
#define HIDE_TABLES 1
#endif
#ifndef I8_GEMM3
#define I8_GEMM3 1
#endif
#ifndef I8_GEMM1
#define I8_GEMM1 1
#endif
#ifndef I8_GEMM2
#define I8_GEMM2 1
#endif
#ifndef U_INT4
#define U_INT4 1
#endif
#ifndef PART16
#define PART16 1
#endif
#ifndef FUSE_TOPK
#define FUSE_TOPK 1
#endif
#ifndef WQ_ONEPASS
#define WQ_ONEPASS 1
#endif
#ifndef TAB_PROBE
#define TAB_PROBE 0
#endif
#ifndef SSD2_PROBE
#define SSD2_PROBE 0
#endif
#ifndef REPEAT_MASK
#define REPEAT_MASK 0
#endif

#define LAS __attribute__((address_space(3)))
typedef unsigned short bf16_t;
typedef float f32x4 __attribute__((ext_vector_type(4)));
typedef unsigned u32x4 __attribute__((ext_vector_type(4)));
typedef unsigned u32x2 __attribute__((ext_vector_type(2)));

namespace {
constexpr int NB = 4, SEQ = 4096, T = NB * SEQ, D = 2048;
constexpr int NH = 16, NCH = SEQ / 128;
constexpr int DINP = 4096;
constexpr int Z_OFF = 0, XBC_OFF = 1024, Q_OFF = 2560, K_OFF = 3584, V_OFF = 3712, DT_OFF = 3840;
constexpr int NMOD = 6 * D;
constexpr float ALPHA = 1.189207115002721f;
constexpr float EPS = 1e-5f;
constexpr int NTHR = 512, NWAVES = 8;

constexpr size_t MiB = 1u << 20;
constexpr size_t WS_CTL = 0, CTL_ZERO_BYTES = 1 * MiB;
constexpr size_t WS_MOD = 512 * 1024;
constexpr size_t WS_KEYS = 1 * MiB;
constexpr size_t WS_DTRAW = 2 * MiB;
constexpr size_t WS_DT = 3 * MiB;
constexpr size_t WS_ACUM = 4 * MiB;
constexpr size_t WS_SSP = 5 * MiB;
constexpr size_t WS_RS = 7 * MiB;
constexpr size_t WS_SCU = 7 * MiB + 256 * 1024, WS_SCV = 7 * MiB + 512 * 1024;
constexpr size_t WS_EXP = 8 * MiB;
constexpr size_t WS_GATE = 16 * MiB;
constexpr size_t WS_WIN = 24 * MiB;
constexpr size_t WS_WOUT = 40 * MiB;
constexpr size_t WS_WQ = 48 * MiB;
constexpr size_t WS_UB = 56 * MiB;
constexpr size_t WS_VB = 120 * MiB;
constexpr size_t WS_ACT = 184 * MiB;
constexpr size_t WS_PROJ = 248 * MiB;
constexpr size_t WS_XBCC = 376 * MiB;
constexpr size_t WS_STATES = 424 * MiB;
constexpr size_t WS_PREVB = 488 * MiB;
constexpr size_t WS_H2Q = 504 * MiB;
constexpr size_t WS_W8 = 5 * MiB;
constexpr size_t WS_WS = 7 * MiB + 128 * 1024;
constexpr size_t WS_SWQ = 7 * MiB + 64 * 1024, WS_SWIN = 7 * MiB + 80 * 1024, WS_SA1 = 7 * MiB + 320 * 1024;
constexpr int CW_AMXQ = 32768, CW_AMXIN = 36864;
constexpr size_t WS_A8 = WS_XBCC;
constexpr size_t WS_SA2 = 7 * MiB + 384 * 1024, WS_SWOUT = 7 * MiB + 96 * 1024;
constexpr int CW_AMXOUT = 40960;
constexpr size_t WS_HS = 7 * MiB;
constexpr size_t WS_END = 536 * MiB;
constexpr size_t WS_H2N = WS_STATES;
constexpr size_t WS_R1B = WS_PROJ, WS_X1B = WS_PROJ + 64 * MiB, WS_Q = WS_PROJ, WS_PARTA = WS_XBCC, WS_Y = WS_ACT;

constexpr int RING_BYTES = 131072;
constexpr int LDSCTL_OFF = 163840 - 64, MISC_OFF = LDSCTL_OFF;
constexpr int LDS_BYTES = 163840;

__device__ __forceinline__ float bf2f(unsigned v) { return __uint_as_float(v << 16); }
__device__ __forceinline__ float bflo(unsigned w) { return __uint_as_float(w << 16); }
__device__ __forceinline__ float bfhi(unsigned w) { return __uint_as_float(w & 0xffff0000u); }
__device__ __forceinline__ unsigned f2bf(float f) { unsigned u = __float_as_uint(f); return (u + 0x7fffu + ((u >> 16) & 1u)) >> 16; }
__device__ __forceinline__ unsigned pk2(float lo, float hi) { return f2bf(lo) | (f2bf(hi) << 16); }
typedef __bf16 bf16x2n __attribute__((ext_vector_type(2)));
typedef float f32x2n __attribute__((ext_vector_type(2)));
__device__ __forceinline__ unsigned cvtpk(float lo, float hi) { const bf16x2n r = __builtin_convertvector((f32x2n){lo, hi}, bf16x2n); return __builtin_bit_cast(unsigned, r); }
__device__ __forceinline__ float fexp(float x) { return __builtin_amdgcn_exp2f(x * 1.4426950408889634f); }
__device__ __forceinline__ float silu_f(float x) { return x * __builtin_amdgcn_rcpf(1.f + fexp(-x)); }
__device__ __forceinline__ float softplus_f(float x) { return x > 20.f ? x : log1pf(expf(x)); }
__device__ __forceinline__ float gelu_f(float x) { return 0.5f * x * (1.f + erff(x * 0.70710678118654752f)); }
__device__ __forceinline__ float wave_sum(float v) {
#pragma unroll
    for (int o = 1; o < 64; o <<= 1) v += __shfl_xor(v, o);
    return v;
}
__device__ __forceinline__ float dot8(u32x4 a, u32x4 b) {
    float s = bflo(a.x) * bflo(b.x); s += bfhi(a.x) * bfhi(b.x);
    s += bflo(a.y) * bflo(b.y); s += bfhi(a.y) * bfhi(b.y);
    s += bflo(a.z) * bflo(b.z); s += bfhi(a.z) * bfhi(b.z);
    s += bflo(a.w) * bflo(b.w); s += bfhi(a.w) * bfhi(b.w);
    return s;
}
__device__ __forceinline__ int win_src_col(int n) { return n < 2560 ? n : (n < 3840 ? n + 16 : (n < 3856 ? n - 1280 : -1)); }

#define XB_TMO      128
#define XB_XCNT(j)  (256  + 64 * (j))
#define XB_XSUB(j)  (1280 + 64 * (j))
#define XB_XGEN(j)  (2304 + 64 * (j))
#define XB_TOP      3328
#define XB_TOPGEN   3392
#define XCD_BAR_WORDS 3456
#define XB_SPIN_CAP (1u << 18)
__device__ __forceinline__ unsigned xb_ld(unsigned* p)              { return __hip_atomic_load(p, __ATOMIC_RELAXED, __HIP_MEMORY_SCOPE_AGENT); }
__device__ __forceinline__ unsigned xb_add(unsigned* p, unsigned v) { return __hip_atomic_fetch_add(p, v, __ATOMIC_RELAXED, __HIP_MEMORY_SCOPE_AGENT); }
__device__ __forceinline__ unsigned xb_xcc_id() { return (unsigned)__builtin_amdgcn_s_getreg((3 << 11) | 20) & 0xFu; }
#define XB_SPIN(cond, bar) do { unsigned _sp = 0; while (cond) { __builtin_amdgcn_s_sleep(1); \
    if ((++_sp & 255u) == 0u) { if (xb_ld(&(bar)[XB_TMO])) break; if (_sp > XB_SPIN_CAP) { atomicAdd(&(bar)[XB_TMO], 1u); break; } } } } while (0)
struct XcdBarrier { unsigned* bar; unsigned x; volatile LAS unsigned* st; };
__device__ __forceinline__ XcdBarrier xcd_barrier_post(unsigned* bar, volatile LAS unsigned* st) {
    XcdBarrier b; b.bar = bar; b.x = xb_xcc_id(); b.st = st;
    if (threadIdx.x == 0) (void)xb_add(&bar[XB_XCNT(b.x)], 1u);
    return b;
}
__device__ __forceinline__ void xcd_barrier_complete(unsigned* bar, unsigned x, unsigned& nloc, unsigned& nx) {
    const unsigned G = gridDim.x * gridDim.y * gridDim.z;
    unsigned sum, cnt, mine, sp = 0u;
    for (;;) {
        sum = 0u; cnt = 0u; mine = 0u;
#pragma unroll
        for (unsigned j = 0; j < 16; ++j) { const unsigned c = xb_ld(&bar[XB_XCNT(j)]); sum += c; cnt += (c > 0u) ? 1u : 0u; mine = (j == x) ? c : mine; }
        if (sum == G) break;
        __builtin_amdgcn_s_sleep(1);
        if ((++sp & 255u) == 0u) { if (xb_ld(&bar[XB_TMO])) break; if (sp > XB_SPIN_CAP) { atomicAdd(&bar[XB_TMO], 1u); break; } }
    }
    nloc = mine > 0u ? mine : 1u; nx = cnt > 0u ? cnt : 1u;
}
__device__ __forceinline__ void xcd_barrier(const XcdBarrier& b) {
    asm volatile("s_waitcnt vmcnt(0)" ::: "memory");
    __syncthreads();
    if (threadIdx.x == 0) {
        unsigned* bar = b.bar;
        __builtin_amdgcn_s_waitcnt(0);
        unsigned nloc = b.st[0], nx = b.st[1];
        if (nloc == 0u) { xcd_barrier_complete(bar, b.x, nloc, nx); b.st[0] = nloc; b.st[1] = nx; }
        const unsigned old = xb_add(&bar[XB_XSUB(b.x)], 1u);
        const unsigned gen = old / nloc;
        if (old + 1u == (gen + 1u) * nloc) {
            __builtin_amdgcn_fence(__ATOMIC_RELEASE, "agent");
            asm volatile("s_waitcnt vmcnt(0)" ::: "memory");
            const unsigned og = xb_add(&bar[XB_TOP], 1u);
            const unsigned tg = og / nx;
            if (og + 1u == (tg + 1u) * nx) xb_add(&bar[XB_TOPGEN], 1u);
            else XB_SPIN(xb_ld(&bar[XB_TOPGEN]) == tg, bar);
            __builtin_amdgcn_fence(__ATOMIC_ACQUIRE, "agent");
            xb_add(&bar[XB_XGEN(b.x)], 1u);
            asm volatile("s_waitcnt vmcnt(0)" ::: "memory");
        } else {
            XB_SPIN(xb_ld(&bar[XB_XGEN(b.x)]) == gen, bar);
            __builtin_amdgcn_fence(__ATOMIC_ACQUIRE, "agent");
            asm volatile("s_waitcnt vmcnt(0)" ::: "memory");
        }
    }
    __syncthreads();
}

struct Args { const float* in[22]; float* out; unsigned char* ws; int lo, hi; };
struct Ctx {
    const float* in[22]; float* out; unsigned char* ws; LAS unsigned char* lds;
    int tid, lane, wave, gw, ngw, gt, ngt;
};
#define IN_X c.in[0]
#define IN_C c.in[1]
#define IN_WADA c.in[2]
#define IN_BADA c.in[3]
#define IN_WIN c.in[4]
#define IN_CONVW c.in[5]
#define IN_CONVB c.in[6]
#define IN_DTBIAS c.in[7]
#define IN_ALOG c.in[8]
#define IN_DSKIP c.in[9]
#define IN_SSMG c.in[10]
#define IN_SINKS c.in[11]
#define IN_ATTG c.in[12]
#define IN_WOUT c.in[13]
#define IN_LN1G c.in[14]
#define IN_LN1B c.in[15]
#define IN_WQ c.in[16]
#define IN_KEYS c.in[17]
#define IN_U c.in[18]
#define IN_V c.in[19]
#define IN_LN2G c.in[20]
#define IN_LN2B c.in[21]
#define WSP(type, off) ((type*)(c.ws + (off)))


typedef float f32x2 __attribute__((ext_vector_type(2)));
typedef short bf16x8v __attribute__((ext_vector_type(8)));
typedef float f32x16 __attribute__((ext_vector_type(16)));
#define DPPF(v, ctrl) __int_as_float(__builtin_amdgcn_update_dpp(0, __float_as_int(v), (ctrl), 0xF, 0xF, true))
__device__ __forceinline__ float row_sum16(float v) {
    v += DPPF(v, 0xB1); v += DPPF(v, 0x4E); v += DPPF(v, 0x141); v += DPPF(v, 0x140); return v;
}
__device__ __forceinline__ float wave_sum63(float v) {
    v = row_sum16(v);
    v += __int_as_float(__builtin_amdgcn_update_dpp(0, __float_as_int(v), 0x142, 0xA, 0xF, false));
    v += __int_as_float(__builtin_amdgcn_update_dpp(0, __float_as_int(v), 0x143, 0xC, 0xF, false));
    return v;
}
__device__ __forceinline__ float lane63(float v) { return __int_as_float(__builtin_amdgcn_readlane(__float_as_int(v), 63)); }
__device__ __forceinline__ float wave_sum_all(float v) { return lane63(wave_sum63(v)); }
__device__ __forceinline__ void fp8_row_load(f32x4 (&v)[8], const float* src, int lane) {
#pragma unroll
    for (int j = 0; j < 2; ++j)
#pragma unroll
        for (int q = 0; q < 4; ++q) v[j * 4 + q] = *(const f32x4*)(src + j * 1024 + lane * 16 + q * 4);
}
#define DPPMAX(v, ctrl) fmaxf(v, __int_as_float(__builtin_amdgcn_update_dpp(0, __float_as_int(v), (ctrl), 0xF, 0xF, true)))
__device__ __forceinline__ unsigned pack_i8x4(f32x4 x) {
    const float M = 12582912.f;
    const unsigned a = __float_as_uint(x.x + M), b = __float_as_uint(x.y + M), c = __float_as_uint(x.z + M), d = __float_as_uint(x.w + M);
    return __builtin_amdgcn_perm(b, a, 0x0c0c0400u) | __builtin_amdgcn_perm(d, c, 0x04000c0cu);
}
template <bool INT8>
__device__ __forceinline__ void fp8_row_finish(const f32x4 (&v)[8], unsigned char* tab, int row, float* scale, int lane) {
    float am = 0.f;
#pragma unroll
    for (int i = 0; i < 8; ++i) am = fmaxf(am, fmaxf(fmaxf(fabsf(v[i].x), fabsf(v[i].y)), fmaxf(fabsf(v[i].z), fabsf(v[i].w))));
    am = DPPMAX(am, 0xB1); am = DPPMAX(am, 0x4E); am = DPPMAX(am, 0x141); am = DPPMAX(am, 0x140);
    {
        const unsigned a0 = __builtin_amdgcn_readlane(__float_as_uint(am), 0), a1 = __builtin_amdgcn_readlane(__float_as_uint(am), 16);
        const unsigned a2 = __builtin_amdgcn_readlane(__float_as_uint(am), 32), a3 = __builtin_amdgcn_readlane(__float_as_uint(am), 48);
        const unsigned m01 = a0 > a1 ? a0 : a1, m23 = a2 > a3 ? a2 : a3; am = __uint_as_float(m01 > m23 ? m01 : m23);
    }
    const float top = INT8 ? 127.f : 448.f;
    const float inv = am > 0.f ? top / am : 0.f;
#pragma unroll
    for (int j = 0; j < 2; ++j) {
        u32x4 o;
#pragma unroll
        for (int q = 0; q < 4; ++q) { const f32x4 x = v[j * 4 + q] * inv;
            if (INT8) o[q] = pack_i8x4(x);
            else { int w = 0; w = __builtin_amdgcn_cvt_pk_fp8_f32(x.x, x.y, w, false); w = __builtin_amdgcn_cvt_pk_fp8_f32(x.z, x.w, w, true); o[q] = (unsigned)w; } }
#if SLICED_PEER
        *(u32x4*)(tab + ((size_t)(8 * j + (lane >> 3)) * 16384 + row) * 128 + (lane & 7) * 16) = o;
#else
        *(u32x4*)(tab + (size_t)row * D + j * 1024 + lane * 16) = o;
#endif
    }
    if (lane == 0) *scale = am / top;
}

__device__ __forceinline__ unsigned pack_i4x8(f32x4 a, f32x4 b, float inv) {
    const float M = 12582912.f;
    const unsigned q0 = __float_as_uint(a.x * inv + M) & 15u, q1 = __float_as_uint(a.y * inv + M) & 15u, q2 = __float_as_uint(a.z * inv + M) & 15u, q3 = __float_as_uint(a.w * inv + M) & 15u;
    const unsigned q4 = __float_as_uint(b.x * inv + M) & 15u, q5 = __float_as_uint(b.y * inv + M) & 15u, q6 = __float_as_uint(b.z * inv + M) & 15u, q7 = __float_as_uint(b.w * inv + M) & 15u;
    return q0 | (q1 << 4) | (q2 << 8) | (q3 << 12) | (q4 << 16) | (q5 << 20) | (q6 << 24) | (q7 << 28);
}
__device__ __forceinline__ void u4_row_finish(const f32x4 (&v)[8], unsigned char* tab, int row, float* scale, int lane) {
    float am = 0.f;
#pragma unroll
    for (int i = 0; i < 8; ++i) am = fmaxf(am, fmaxf(fmaxf(fabsf(v[i].x), fabsf(v[i].y)), fmaxf(fabsf(v[i].z), fabsf(v[i].w))));
    am = DPPMAX(am, 0xB1); am = DPPMAX(am, 0x4E); am = DPPMAX(am, 0x141); am = DPPMAX(am, 0x140);
    {
        const unsigned a0 = __builtin_amdgcn_readlane(__float_as_uint(am), 0), a1 = __builtin_amdgcn_readlane(__float_as_uint(am), 16);
        const unsigned a2 = __builtin_amdgcn_readlane(__float_as_uint(am), 32), a3 = __builtin_amdgcn_readlane(__float_as_uint(am), 48);
        const unsigned m01 = a0 > a1 ? a0 : a1, m23 = a2 > a3 ? a2 : a3; am = __uint_as_float(m01 > m23 ? m01 : m23);
    }
    const float inv = am > 0.f ? 7.f / am : 0.f;
#pragma unroll
    for (int j = 0; j < 2; ++j) {
        const u32x2 o = {pack_i4x8(v[j * 4 + 0], v[j * 4 + 1], inv), pack_i4x8(v[j * 4 + 2], v[j * 4 + 3], inv)};
        *(u32x2*)(tab + ((size_t)(4 * j + (lane >> 4)) * 16384 + row) * 128 + (lane & 15) * 8) = o;
    }
    if (lane == 0) *scale = am * (1.f / 7.f);
}

template <bool WIN_MAP, bool GAINS = false>
__device__ __forceinline__ void colamax_items(const Ctx& c, const float* W, int Nsrc, unsigned* AMX, const float* g1 = nullptr, const float* g2 = nullptr) {
    const int nblk = (Nsrc + 255) / 256;
    for (int it = c.gw; it < 32 * nblk; it += c.ngw) {
        const int kb = it / nblk, nb = it % nblk, col = nb * 256 + c.lane * 4;
        if (col < Nsrc) {
            f32x4 m = {0.f, 0.f, 0.f, 0.f};
            const float* wp = W + (size_t)(kb * 64) * Nsrc + col;
#pragma unroll 16
            for (int kk = 0; kk < 64; ++kk) { f32x4 v = *(const f32x4*)(wp + (size_t)kk * Nsrc); if (GAINS) { const int k = kb * 64 + kk; v = v * (k < 1024 ? g1[k] : g2[k - 1024]); } m.x = fmaxf(m.x, fabsf(v.x)); m.y = fmaxf(m.y, fabsf(v.y)); m.z = fmaxf(m.z, fabsf(v.z)); m.w = fmaxf(m.w, fabsf(v.w)); }
#pragma unroll
            for (int j = 0; j < 4; ++j) { const int sc = col + j; const int dn = WIN_MAP ? (sc < 2560 ? sc : (sc < 2576 ? sc + 1280 : sc - 16)) : sc;
                atomicMax(AMX + dn, __float_as_uint(m[j])); }
        }
    }
}
template <bool WIN_MAP, bool GAINS = false>
__device__ __forceinline__ void transpose_item_i8(const float* W, int K, int Nsrc, int ND, unsigned char* WT, const unsigned* AMX, float* SW, LAS float* scr, int item, int lane, const float* g1 = nullptr, const float* g2 = nullptr) {
    const int nblk = ND / 32, kb = item / nblk, nb = item % nblk, k0 = 64 * kb, n0 = 32 * nb;
    const int n = n0 + (lane & 31), sc = WIN_MAP ? win_src_col(n) : n;
    const float am = __uint_as_float(AMX[n]), inv = am > 0.f ? 127.f / am : 0.f;
    float tv[32];
    const float* wp = W + (size_t)(k0 + (lane >> 5)) * Nsrc + (sc >= 0 ? sc : 0);
#pragma unroll
    for (int i = 0; i < 32; ++i) tv[i] = wp[(size_t)(2 * i) * Nsrc];
#pragma unroll
    for (int i = 0; i < 32; ++i) { const int kk = k0 + 2 * i + (lane >> 5); float v = sc >= 0 ? tv[i] * inv : 0.f; if (GAINS) v *= (kk < 1024 ? g1[kk] : g2[kk - 1024]); scr[(2 * i + (lane >> 5)) * 33 + (lane & 31)] = v; }
    asm volatile("s_waitcnt lgkmcnt(0)" ::: "memory");
#pragma unroll
    for (int j = 0; j < 2; ++j) {
        const int ch = lane + 64 * j, nn = ch >> 2, kc = ch & 3; const LAS float* sp = scr + (16 * kc) * 33 + nn;
        u32x4 o;
#pragma unroll
        for (int q = 0; q < 4; ++q) o[q] = pack_i8x4((f32x4){sp[(4 * q) * 33], sp[(4 * q + 1) * 33], sp[(4 * q + 2) * 33], sp[(4 * q + 3) * 33]});
        *(u32x4*)(WT + (size_t)(n0 + nn) * K + k0 + 16 * kc) = o;
    }
    if (kb == 0 && lane < 32) SW[n] = am * (1.f / 127.f);
    asm volatile("s_waitcnt lgkmcnt(0)" ::: "memory");
}
template <int MODE>
__device__ __forceinline__ void wquant_block(const Ctx& c, const float* W, int Nsrc, int nb, unsigned char* WT, float* SW, const float* g1, const float* g2) {
    constexpr int PITCH = 4112;
    LAS unsigned char* Lb = c.lds;
    LAS float* red = (LAS float*)(c.lds + 32 * PITCH);
    const int n = c.lane & 31, half = c.lane >> 5, n0 = nb * 32, dn = n0 + n, sc = MODE == 0 ? win_src_col(dn) : dn;
    const float* wp = W + (size_t)(c.wave * 256 + 2 * half) * Nsrc + (sc >= 0 ? sc : 0);
    float am = 0.f;
#pragma unroll 1
    for (int it0 = 0; it0 < 64; it0 += 8) {
        float v0[8], v1[8];
#pragma unroll
        for (int u = 0; u < 8; ++u) { const float* p = wp + (size_t)(4 * (it0 + u)) * Nsrc; v0[u] = p[0]; v1[u] = p[Nsrc]; }
#pragma unroll
        for (int u = 0; u < 8; ++u) {
            const int k = c.wave * 256 + 4 * (it0 + u) + 2 * half;
            float a = sc >= 0 ? v0[u] : 0.f, b = sc >= 0 ? v1[u] : 0.f;
            if (MODE == 1) { a *= (k < 1024 ? g1[k] : g2[k - 1024]); b *= (k + 1 < 1024 ? g1[k + 1] : g2[k + 1 - 1024]); }
            am = fmaxf(am, fmaxf(fabsf(a), fabsf(b)));
            *(LAS unsigned*)(Lb + n * PITCH + k * 2) = cvtpk(a, b);
        }
    }
    red[(c.wave * 2 + half) * 32 + n] = am;
    __syncthreads();
    if (c.tid < 32) {
        float m = 0.f;
#pragma unroll
        for (int j = 0; j < 16; ++j) m = fmaxf(m, red[j * 32 + c.tid]);
        red[512 + c.tid] = m > 0.f ? 127.f / m : 0.f; SW[n0 + c.tid] = m * (1.f / 127.f);
    }
    __syncthreads();
#pragma unroll 2
    for (int i = 0; i < 8; ++i) {
        const int id = i * NTHR + c.tid, nn = id >> 7, kc = id & 127; const float inv = red[512 + nn];
        const u32x4 r0 = *(const LAS u32x4*)(Lb + nn * PITCH + kc * 32), r1 = *(const LAS u32x4*)(Lb + nn * PITCH + kc * 32 + 16);
        u32x4 o;
        o.x = pack_i8x4((f32x4){bflo(r0.x), bfhi(r0.x), bflo(r0.y), bfhi(r0.y)} * inv); o.y = pack_i8x4((f32x4){bflo(r0.z), bfhi(r0.z), bflo(r0.w), bfhi(r0.w)} * inv);
        o.z = pack_i8x4((f32x4){bflo(r1.x), bfhi(r1.x), bflo(r1.y), bfhi(r1.y)} * inv); o.w = pack_i8x4((f32x4){bflo(r1.z), bfhi(r1.z), bflo(r1.w), bfhi(r1.w)} * inv);
        *(u32x4*)(WT + (size_t)(n0 + nn) * D + kc * 16) = o;
    }
    __syncthreads();
}
template <int MODE>
__device__ __forceinline__ void transpose_item(const float* W, int K, int Nsrc, int ND, bf16_t* WT, LAS float* scr, int item, int lane, const float* g1, const float* g2) {
    const int nblk = ND / 32, kb = item / nblk, nb = item % nblk, k0 = 64 * kb, n0 = 32 * nb;
    const int n = n0 + (lane & 31), sc = MODE == 0 ? win_src_col(n) : n;
    float tv[32];
    const float* wp = W + (size_t)(k0 + (lane >> 5)) * Nsrc + (sc >= 0 ? sc : 0);
#pragma unroll
    for (int i = 0; i < 32; ++i) tv[i] = wp[(size_t)(2 * i) * Nsrc];
#pragma unroll
    for (int i = 0; i < 32; ++i) {
        const int kk = 2 * i + (lane >> 5);
        float v = sc >= 0 ? tv[i] : 0.f;
        if (MODE == 1) v *= (k0 + kk < 1024) ? g1[k0 + kk] : g2[k0 + kk - 1024];
        scr[kk * 33 + (lane & 31)] = v;
    }
    asm volatile("s_waitcnt lgkmcnt(0)" ::: "memory");
    const int cch = lane & 7;
#pragma unroll
    for (int j = 0; j < 4; ++j) {
        const int nn = (lane >> 3) + 8 * j; const LAS float* s = scr + (8 * cch) * 33 + nn;
        u32x4 o; o.x = pk2(s[0 * 33], s[1 * 33]); o.y = pk2(s[2 * 33], s[3 * 33]); o.z = pk2(s[4 * 33], s[5 * 33]); o.w = pk2(s[6 * 33], s[7 * 33]);
        *(u32x4*)(WT + (size_t)(n0 + nn) * K + k0 + 8 * cch) = o;
    }
    asm volatile("s_waitcnt lgkmcnt(0)" ::: "memory");
}
__device__ __forceinline__ void cvt_f32_bf16(const Ctx& c, const float* src, bf16_t* dst, size_t n8) {
    for (size_t i = (size_t)c.gt; i < n8; i += (size_t)c.ngt) {
        const f32x4 a = ((const f32x4*)src)[2 * i], b = ((const f32x4*)src)[2 * i + 1];
        u32x4 o; o.x = pk2(a.x, a.y); o.y = pk2(a.z, a.w); o.z = pk2(b.x, b.y); o.w = pk2(b.z, b.w);
        ((u32x4*)dst)[i] = o;
    }
}
__device__ __forceinline__ void step_pro(const Ctx& c) {
    float* MOD = WSP(float, WS_MOD);
    for (int rep_ = 0; rep_ < 1 + ((PRO_REPEAT >> 0) & 1); ++rep_) {
    {
        LAS float* sl = (LAS float*)c.lds;
        LAS float* red = (LAS float*)(c.lds + 32768);
        for (int i = c.tid; i < 4 * D; i += NTHR) sl[i] = silu_f(IN_C[i]);
        __syncthreads();
        for (int cb = blockIdx.x; cb < NMOD / 48; cb += gridDim.x) {
            const int rsub = c.lane / 12, cq = c.lane % 12; const bool act = c.lane < 60;
            const float* wp = IN_WADA + (size_t)(c.wave * 256) * NMOD + cb * 48 + cq * 4;
            f32x4 a0 = {0.f, 0.f, 0.f, 0.f}, a1 = a0, a2 = a0, a3 = a0;
#pragma unroll 1
            for (int it0 = 0; it0 < 56; it0 += 8) {
                f32x4 wv[8];
#pragma unroll
                for (int u = 0; u < 8; ++u) { const int r = (it0 + u) * 5 + rsub; wv[u] = (act && r < 256) ? *(const f32x4*)(wp + (size_t)r * NMOD) : (f32x4){0.f, 0.f, 0.f, 0.f}; }
#pragma unroll
                for (int u = 0; u < 8; ++u) { const int r = (it0 + u) * 5 + rsub, k = c.wave * 256 + (r < 256 ? r : 255);
                    a0 += wv[u] * sl[k]; a1 += wv[u] * sl[D + k]; a2 += wv[u] * sl[2 * D + k]; a3 += wv[u] * sl[3 * D + k]; }
            }
            if (act) { LAS f32x4* o = (LAS f32x4*)(red + (c.wave * 60 + c.lane) * 16); o[0] = a0; o[1] = a1; o[2] = a2; o[3] = a3; }
            __syncthreads();
            if (c.tid < 192) {
                const int bb = c.tid / 48, j = c.tid % 48, q = j >> 2, e = j & 3;
                float sum = IN_BADA[cb * 48 + j];
#pragma unroll
                for (int w = 0; w < 8; ++w)
#pragma unroll
                    for (int rs = 0; rs < 5; ++rs) sum += red[(w * 60 + rs * 12 + q) * 16 + bb * 4 + e];
                MOD[bb * NMOD + cb * 48 + j] = sum;
            }
            __syncthreads();
        }
    }
    }
    for (int rep_ = 0; rep_ < 1 + ((PRO_REPEAT >> 1) & 1); ++rep_) {
    LAS float* scr = (LAS float*)(c.lds + c.wave * 16384);
    constexpr int I_IN = (D / 64) * (DINP / 32), I_SQ = (D / 64) * (D / 32);
    for (int it = c.gw; it < I_IN + 2 * I_SQ; it += c.ngw) {
        int r = it;
        if (r < I_IN) { if (!(I8_GEMM1 && FAST_GEMM)) transpose_item<0>(IN_WIN, D, 3856, DINP, WSP(bf16_t, WS_WIN), scr, r, c.lane, nullptr, nullptr); continue; } r -= I_IN;
        if (r < I_SQ) { if (!(I8_GEMM2 && FAST_GEMM)) transpose_item<1>(IN_WOUT, D, D, D, WSP(bf16_t, WS_WOUT), scr, r, c.lane, IN_SSMG, IN_ATTG); continue; } r -= I_SQ;
        if (!I8_GEMM3) transpose_item<2>(IN_WQ, D, D, D, WSP(bf16_t, WS_WQ), scr, r, c.lane, nullptr, nullptr);
    }
#if WQ_ONEPASS && I8_GEMM1 && I8_GEMM2 && I8_GEMM3 && FAST_GEMM
    __syncthreads();
    for (int it = blockIdx.x; it < 256; it += gridDim.x) {
        if (it < 128) wquant_block<0>(c, IN_WIN, 3856, it, WSP(unsigned char, WS_WIN), WSP(float, WS_SWIN), nullptr, nullptr);
        else if (it < 192) wquant_block<1>(c, IN_WOUT, D, it - 128, WSP(unsigned char, WS_WOUT), WSP(float, WS_SWOUT), IN_SSMG, IN_ATTG);
        else wquant_block<2>(c, IN_WQ, D, it - 192, WSP(unsigned char, WS_WQ), WSP(float, WS_SWQ), nullptr, nullptr);
    }
#else
    if (I8_GEMM3) colamax_items<false>(c, IN_WQ, D, WSP(unsigned, WS_CTL) + CW_AMXQ);
    if (I8_GEMM1 && FAST_GEMM) colamax_items<true>(c, IN_WIN, 3856, WSP(unsigned, WS_CTL) + CW_AMXIN);
    if (I8_GEMM2 && FAST_GEMM) colamax_items<false, true>(c, IN_WOUT, D, WSP(unsigned, WS_CTL) + CW_AMXOUT, IN_SSMG, IN_ATTG);
#endif
    }
    for (int rep_ = 0; rep_ < (HIDE_TABLES ? 0 : 1) + ((PRO_REPEAT >> 2) & 1); ++rep_) {
    {
#define TAB_SRC(r_) ((r_) < 16384 ? IN_U + (size_t)(r_) * D : IN_V + (size_t)((r_) - 16384) * D)
        f32x4 cur[8], nxt[8];
        int r = c.gw;
        if (r < 2 * 16384) fp8_row_load(cur, TAB_SRC(r), c.lane);
        for (; r < 2 * 16384; r += c.ngw) {
            const int rn = r + c.ngw;
            if (rn < 2 * 16384) fp8_row_load(nxt, TAB_SRC(rn), c.lane);
            if (r < 16384) { if (U_INT4) u4_row_finish(cur, WSP(unsigned char, WS_UB), r, WSP(float, WS_SCU) + r, c.lane); else fp8_row_finish<SLICED_PEER != 0>(cur, WSP(unsigned char, WS_UB), r, WSP(float, WS_SCU) + r, c.lane); }
            else fp8_row_finish<(SLICED_PEER != 0) && (V_INT8 != 0)>(cur, WSP(unsigned char, WS_VB), r - 16384, WSP(float, WS_SCV) + (r - 16384), c.lane);
#pragma unroll
            for (int i = 0; i < 8; ++i) cur[i] = nxt[i];
        }
#undef TAB_SRC
    }
    }
    cvt_f32_bf16(c, IN_KEYS, WSP(bf16_t, WS_KEYS), (size_t)8 * 2 * 128 * 128 / 8);
}

__device__ __forceinline__ void step_h1(const Ctx& c) {
    const float* MOD = WSP(float, WS_MOD); bf16_t* H1 = WSP(bf16_t, WS_ACT);
    for (int t = c.gw; t < T; t += c.ngw) {
        const int b = t >> 12; const float* xr = IN_X + (size_t)t * D; const float* sh = MOD + b * NMOD; const float* sc = sh + D;
#if I8_GEMM1 && FAST_GEMM
        f32x4 hv[8]; float hmax = 0.f;
#pragma unroll
        for (int j = 0; j < 8; ++j) {
            const int col = j * 256 + c.lane * 4;
            const f32x4 xv = *(const f32x4*)(xr + col), s = *(const f32x4*)(sc + col), h = *(const f32x4*)(sh + col);
            hv[j] = xv * (s + 1.f) + h; hmax = fmaxf(hmax, fmaxf(fmaxf(fabsf(hv[j].x), fabsf(hv[j].y)), fmaxf(fabsf(hv[j].z), fabsf(hv[j].w))));
        }
        hmax = DPPMAX(hmax, 0xB1); hmax = DPPMAX(hmax, 0x4E); hmax = DPPMAX(hmax, 0x141); hmax = DPPMAX(hmax, 0x140);
        const unsigned a0 = __builtin_amdgcn_readlane(__float_as_uint(hmax), 0), a1 = __builtin_amdgcn_readlane(__float_as_uint(hmax), 16), a2 = __builtin_amdgcn_readlane(__float_as_uint(hmax), 32), a3 = __builtin_amdgcn_readlane(__float_as_uint(hmax), 48);
        const unsigned m01 = a0 > a1 ? a0 : a1, m23 = a2 > a3 ? a2 : a3; const float am = __uint_as_float(m01 > m23 ? m01 : m23), inv = am > 0.f ? 127.f / am : 0.f;
#pragma unroll
        for (int j = 0; j < 8; ++j) *(unsigned*)((unsigned char*)H1 + (size_t)t * D + j * 256 + c.lane * 4) = pack_i8x4(hv[j] * inv);
        if (c.lane == 0) WSP(float, WS_SA1)[t] = am * (1.f / 127.f);
#else
#pragma unroll
        for (int j = 0; j < 8; ++j) {
            const int col = j * 256 + c.lane * 4;
            const f32x4 xv = *(const f32x4*)(xr + col), s = *(const f32x4*)(sc + col), h = *(const f32x4*)(sh + col);
            u32x2 o; o.x = pk2(xv.x * (1.f + s.x) + h.x, xv.y * (1.f + s.y) + h.y); o.y = pk2(xv.z * (1.f + s.z) + h.z, xv.w * (1.f + s.w) + h.w);
            *(u32x2*)(H1 + (size_t)t * D + col) = o;
        }
#endif
    }
}

struct Epi1 {
    bf16_t* proj; float* dtraw;
    __device__ __forceinline__ float rho(int) const { return 1.f; }
    __device__ __forceinline__ float rowscale(int) const { return 1.f; }
    __device__ __forceinline__ void store8s(int row, int col, const float (&v)[8], float) const { store8(row, col, v); }
    __device__ __forceinline__ void store8(int row, int col, const float (&v)[8]) const {
        u32x4 o; o.x = pk2(v[0], v[1]); o.y = pk2(v[2], v[3]); o.z = pk2(v[4], v[5]); o.w = pk2(v[6], v[7]);
        *(u32x4*)(proj + (size_t)row * DINP + col) = o;
        if (col >= DT_OFF && col < DT_OFF + 16) {
            float* d = dtraw + (size_t)row * 16 + (col - DT_OFF);
            *(f32x4*)d = (f32x4){v[0], v[1], v[2], v[3]}; *(f32x4*)(d + 4) = (f32x4){v[4], v[5], v[6], v[7]};
        }
    }
};
struct Epi2 {
    const float* x; const float* mod; const float* ssp; bf16_t* r1;
    __device__ __forceinline__ void rs_pair(int row, float& r_ssd, float& r_att) const {
        float s1 = 0.f, s2 = 0.f;
#pragma unroll
        for (int j = 0; j < 4; ++j) { const f32x4 a = *(const f32x4*)(ssp + (size_t)row * 32 + 4 * j), b = *(const f32x4*)(ssp + (size_t)row * 32 + 16 + 4 * j);
            s1 += (a.x + a.y) + (a.z + a.w); s2 += (b.x + b.y) + (b.z + b.w); }
        r_ssd = rsqrtf(s1 * (1.f / 1024.f) + EPS); r_att = rsqrtf(s2 * (1.f / 1024.f) + EPS);
    }
    __device__ __forceinline__ float rho(int row) const { float a, b; rs_pair(row, a, b); return a / b; }
    __device__ __forceinline__ float rowscale(int row) const { float a, b; rs_pair(row, a, b); return b; }
    __device__ __forceinline__ void store8s(int row, int col, const float (&v)[8], float ra) const {
        const int b = row >> 12;
        const float* g = mod + b * NMOD + 2 * D + col;
        const f32x4 g0 = *(const f32x4*)g, g1 = *(const f32x4*)(g + 4);
        u32x4 o;
        o.x = cvtpk(g0.x * (ra * v[0]), g0.y * (ra * v[1])); o.y = cvtpk(g0.z * (ra * v[2]), g0.w * (ra * v[3]));
        o.z = cvtpk(g1.x * (ra * v[4]), g1.y * (ra * v[5])); o.w = cvtpk(g1.z * (ra * v[6]), g1.w * (ra * v[7]));
        *(u32x4*)(r1 + (size_t)row * D + col) = o;
    }
    __device__ __forceinline__ void store8(int row, int col, const float (&v)[8]) const { store8s(row, col, v, rowscale(row)); }
};
struct Epi3 {
    bf16_t* q;
    __device__ __forceinline__ float rho(int) const { return 1.f; }
    __device__ __forceinline__ float rowscale(int) const { return 1.f; }
    __device__ __forceinline__ void store8s(int row, int col, const float (&v)[8], float) const { store8(row, col, v); }
    __device__ __forceinline__ void store8(int row, int col, const float (&v)[8]) const {
        u32x4 o; o.x = pk2(v[0], v[1]); o.y = pk2(v[2], v[3]); o.z = pk2(v[4], v[5]); o.w = pk2(v[6], v[7]);
        *(u32x4*)(q + (size_t)row * D + col) = o;
    }
};

struct Epi1Q {
    bf16_t* proj; float* dtraw; const float* sa; const float* sw;
    __device__ __forceinline__ float rho(int) const { return 1.f; }
    __device__ __forceinline__ float rowscale(int row) const { return sa[row]; }
    __device__ __forceinline__ void store8s(int row, int col, const float (&v)[8], float rsc) const {
        const f32x4 s0 = *(const f32x4*)(sw + col) * rsc, s1 = *(const f32x4*)(sw + col + 4) * rsc;
        const float r0 = v[0] * s0.x, r1 = v[1] * s0.y, r2 = v[2] * s0.z, r3 = v[3] * s0.w, r4 = v[4] * s1.x, r5 = v[5] * s1.y, r6 = v[6] * s1.z, r7 = v[7] * s1.w;
        u32x4 o; o.x = cvtpk(r0, r1); o.y = cvtpk(r2, r3); o.z = cvtpk(r4, r5); o.w = cvtpk(r6, r7);
        *(u32x4*)(proj + (size_t)row * DINP + col) = o;
        if (col >= DT_OFF && col < DT_OFF + 16) { float* d = dtraw + (size_t)row * 16 + (col - DT_OFF); *(f32x4*)d = (f32x4){r0, r1, r2, r3}; *(f32x4*)(d + 4) = (f32x4){r4, r5, r6, r7}; }
    }
    __device__ __forceinline__ void store8(int row, int col, const float (&v)[8]) const { store8s(row, col, v, rowscale(row)); }
};
struct Epi2Q {
    const float* mod; const float* sa; const float* sw; bf16_t* r1;
    __device__ __forceinline__ float rho(int) const { return 1.f; }
    __device__ __forceinline__ float rowscale(int row) const { return sa[row]; }
    __device__ __forceinline__ void store8s(int row, int col, const float (&v)[8], float rsc) const {
        const int b = row >> 12; const float* g = mod + b * NMOD + 2 * D + col;
        const f32x4 s0 = *(const f32x4*)(sw + col) * *(const f32x4*)g * rsc, s1 = *(const f32x4*)(sw + col + 4) * *(const f32x4*)(g + 4) * rsc;
        u32x4 o; o.x = cvtpk(v[0] * s0.x, v[1] * s0.y); o.y = cvtpk(v[2] * s0.z, v[3] * s0.w); o.z = cvtpk(v[4] * s1.x, v[5] * s1.y); o.w = cvtpk(v[6] * s1.z, v[7] * s1.w);
        *(u32x4*)(r1 + (size_t)row * D + col) = o;
    }
    __device__ __forceinline__ void store8(int row, int col, const float (&v)[8]) const { store8s(row, col, v, rowscale(row)); }
};
struct Epi3Q {
    bf16_t* q; const float* hs; const float* swq;
    __device__ __forceinline__ float rho(int) const { return 1.f; }
    __device__ __forceinline__ float rowscale(int row) const { return hs[row]; }
    __device__ __forceinline__ void store8s(int row, int col, const float (&v)[8], float rsc) const {
        const f32x4 s0 = *(const f32x4*)(swq + col) * rsc, s1 = *(const f32x4*)(swq + col + 4) * rsc;
        u32x4 o; o.x = cvtpk(v[0] * s0.x, v[1] * s0.y); o.y = cvtpk(v[2] * s0.z, v[3] * s0.w); o.z = cvtpk(v[4] * s1.x, v[5] * s1.y); o.w = cvtpk(v[6] * s1.z, v[7] * s1.w);
        *(u32x4*)(q + (size_t)row * D + col) = o;
    }
    __device__ __forceinline__ void store8(int row, int col, const float (&v)[8]) const { store8s(row, col, v, rowscale(row)); }
};
template <class Epi, bool MIDK>
__device__ __forceinline__ void gemm_simple(const Ctx& c, const bf16_t* A, const bf16_t* Bt, int M, int N, int K, const Epi& E) {
    LAS float* As = (LAS float*)c.lds;
    LAS float* Bs = As + 32 * 132;
    const int tid = c.tid, ty = tid >> 4, tx = tid & 15, lr = tid >> 2, lk = (tid & 3) * 8;
    const int nTn = N / 128, ntile = (M / 128) * nTn;
    for (int tile = blockIdx.x; tile < ntile; tile += gridDim.x) {
        const int tm = tile / nTn, tn = tile % nTn;
        float acc[4][8];
#pragma unroll
        for (int i = 0; i < 4; ++i)
#pragma unroll
            for (int j = 0; j < 8; ++j) acc[i][j] = 0.f;
        const bf16_t* Ap = A + (size_t)(tm * 128 + lr) * K + lk;
        const bf16_t* Bp = Bt + (size_t)(tn * 128 + lr) * K + lk;
        for (int k0 = 0; k0 < K; k0 += 32) {
            if (MIDK && k0 == K / 2) {
#pragma unroll
                for (int i = 0; i < 4; ++i) { const float r = E.rho(tm * 128 + ty * 4 + i);
#pragma unroll
                    for (int j = 0; j < 8; ++j) acc[i][j] *= r; }
            }
            const u32x4 av = *(const u32x4*)(Ap + k0), bv = *(const u32x4*)(Bp + k0);
            __syncthreads();
            As[(lk + 0) * 132 + lr] = bflo(av.x); As[(lk + 1) * 132 + lr] = bfhi(av.x); As[(lk + 2) * 132 + lr] = bflo(av.y); As[(lk + 3) * 132 + lr] = bfhi(av.y);
            As[(lk + 4) * 132 + lr] = bflo(av.z); As[(lk + 5) * 132 + lr] = bfhi(av.z); As[(lk + 6) * 132 + lr] = bflo(av.w); As[(lk + 7) * 132 + lr] = bfhi(av.w);
            Bs[(lk + 0) * 132 + lr] = bflo(bv.x); Bs[(lk + 1) * 132 + lr] = bfhi(bv.x); Bs[(lk + 2) * 132 + lr] = bflo(bv.y); Bs[(lk + 3) * 132 + lr] = bfhi(bv.y);
            Bs[(lk + 4) * 132 + lr] = bflo(bv.z); Bs[(lk + 5) * 132 + lr] = bfhi(bv.z); Bs[(lk + 6) * 132 + lr] = bflo(bv.w); Bs[(lk + 7) * 132 + lr] = bfhi(bv.w);
            __syncthreads();
#pragma unroll 8
            for (int k = 0; k < 32; ++k) {
                const f32x4 a = *(const LAS f32x4*)(As + k * 132 + ty * 4);
                const f32x4 b0 = *(const LAS f32x4*)(Bs + k * 132 + tx * 8), b1 = *(const LAS f32x4*)(Bs + k * 132 + tx * 8 + 4);
                const float aa[4] = {a.x, a.y, a.z, a.w}; const float bb[8] = {b0.x, b0.y, b0.z, b0.w, b1.x, b1.y, b1.z, b1.w};
#pragma unroll
                for (int i = 0; i < 4; ++i)
#pragma unroll
                    for (int j = 0; j < 8; ++j) acc[i][j] += aa[i] * bb[j];
            }
        }
#pragma unroll
        for (int i = 0; i < 4; ++i) E.store8(tm * 128 + ty * 4 + i, tn * 128 + tx * 8, acc[i]);
    }
    __syncthreads();
}

namespace pg8 {
#define PG8_LAS __attribute__((address_space(3)))
typedef unsigned short bf16_t;
typedef short bf16x8 __attribute__((ext_vector_type(8)));
typedef float f32x4 __attribute__((ext_vector_type(4)));
typedef unsigned u32x4 __attribute__((ext_vector_type(4)));
constexpr int BM = 256, BK = 64, HALF = 128, HTB = HALF * BK * 2  , STAGE_BYTES = 8 * HTB, NXCD = 8, WGM = 8;

__host__ __device__ __forceinline__ int lds_byte(int r, int c) { const int st = (r >> 4) * 2 + (c >> 5), rr = r & 15, cc = c & 31, ob = rr * 64 + cc * 2; return st * 1024 + (ob ^ (((ob >> 9) & 1) << 5)); }
__host__ __device__ __forceinline__ void stage_rc(int b, int& R, int& C) { const int st = b / 1024, sb = b % 1024, swz = sb ^ (((sb >> 9) & 1) << 5); R = (st >> 1) * 16 + swz / 64; C = (st & 1) * 32 + (swz % 64) / 2; }
__host__ __device__ __forceinline__ int perm32(int rho) { const int n = rho >> 4, i = rho & 15; return 8 * (i >> 2) + 4 * n + (i & 3); }

struct Unit { int pm, pn; };
struct Gemm { const bf16_t* A; const bf16_t* Bt; int M, N, K; };

struct StaticOrder {
    int nM, nN, nwg, G, c;
    __host__ __device__ void init(int M, int N, int G_, int c_) { nM = M / BM; nN = N / BM; nwg = nM * nN; G = G_; c = c_; }
    __host__ __device__ bool next(int i, Unit& u) const {
        const long L = (long)i * G + c; if (L >= nwg) return false;
        int wgid = (int)L; { const int q = nwg / NXCD, r = nwg % NXCD, xcd = wgid % NXCD, off = wgid / NXCD; wgid = (xcd < r ? xcd * (q + 1) : r * (q + 1) + (xcd - r) * q) + off; }
        const int nig = WGM * nN, gid = wgid / nig, fm = gid * WGM, gsz = (nM - fm) < WGM ? (nM - fm) : WGM;
        u.pm = fm + ((wgid % nig) % gsz); u.pn = (wgid % nig) / gsz; return true;
    }
    __device__ __forceinline__ void a_ready(const Unit&) const {}
    __device__ __forceinline__ void done(const Unit&) const {}
};


template <class E, bool I8 = false> struct EpiA {
    static constexpr bool PERM = true, AFTER_DRAIN = false; E e;
    __device__ __forceinline__ void operator()(const f32x4 (&acc)[2][2][4][2], const Unit& u, int wr, int wc, int fr, int fq) const {
#pragma unroll
        for (int ai = 0; ai < 2; ++ai)
#pragma unroll
            for (int m = 0; m < 4; ++m) {
                const int row = u.pm * BM + ai * HALF + wr * 64 + m * 16 + fr; const float rsc = e.rowscale(row);
#pragma unroll
                for (int bj = 0; bj < 2; ++bj) {
                    const f32x4 v0 = acc[ai][bj][m][0], v1 = acc[ai][bj][m][1];
                    float v[8];
                    if constexpr (I8) {
#pragma unroll
                        for (int j = 0; j < 4; ++j) { v[j] = (float)__float_as_int(v0[j]); v[4 + j] = (float)__float_as_int(v1[j]); }
                    } else {
#pragma unroll
                        for (int j = 0; j < 4; ++j) { v[j] = v0[j]; v[4 + j] = v1[j]; }
                    }
                    e.store8s(row, u.pn * BM + bj * HALF + wc * 32 + 8 * fq, v, rsc);
                }
                if (m & 1) asm volatile("" ::: "memory");
            }
    }
    __device__ __forceinline__ void midk(f32x4 (&acc)[2][2][4][2], const Unit& u, int wr, int fr) const {
#pragma unroll
        for (int ai = 0; ai < 2; ++ai)
#pragma unroll
            for (int m = 0; m < 4; ++m) {
                const float r = e.rho(u.pm * BM + ai * HALF + wr * 64 + m * 16 + fr);
#pragma unroll
                for (int bj = 0; bj < 2; ++bj)
#pragma unroll
                    for (int n = 0; n < 2; ++n) acc[ai][bj][m][n] = acc[ai][bj][m][n] * r;
            }
    }
};
typedef int i32x4 __attribute__((ext_vector_type(4)));
template <class Epi, class Sched, bool ALIGN_EPI = false, bool SP2 = false, bool MIDK = false, bool I8 = false>
__device__ __forceinline__ void gemm_phase(PG8_LAS unsigned char* lds, const Gemm g, const Sched& S, const Epi& E) {
    const int tid = threadIdx.x, wid = __builtin_amdgcn_readfirstlane(tid >> 6), lane = tid & 63, wr = wid >> 2, wc = wid & 3, fr = lane & 15, fq = lane >> 4;
    const int K = g.K, nt = K / BK;
    unsigned voffA[2], voffB[2];
#pragma unroll
    for (int i = 0; i < 2; ++i) { int R, C; stage_rc(tid * 16 + i * 8192, R, C); const int Rb = Epi::PERM ? ((R & ~31) + perm32(R & 31)) : R;
        voffA[i] = (unsigned)(R * K + C) * 2u; voffB[i] = (unsigned)(Rb * K + C) * 2u; }
    const size_t kstep = (size_t)(BK * 2);
    const size_t hstep = (size_t)HALF * K * 2;
    const size_t tstep = 2 * hstep;
    const unsigned ldsw = (unsigned)wid * 1024u;
    const int aoff = lds_byte(wr * 64 + fr, fq * 8), boff = lds_byte(wc * 32 + fr, fq * 8);
#define PG8_SA(b, h) (((b) * 2 + (h)) * HTB)
#define PG8_SB(b, h) ((4 + (b) * 2 + (h)) * HTB)
#define PG8_STAGE(bufoff, gbase, voff) do { _Pragma("unroll") for (int _i = 0; _i < 2; ++_i) \
        __builtin_amdgcn_global_load_lds((const unsigned*)((const char*)(gbase) + (voff)[_i]), (PG8_LAS unsigned*)(lds + (bufoff) + ldsw + _i * 8192), 16, 0, 0); } while (0)
#define PG8_LDA(dst, b, h) do { _Pragma("unroll") for (int m = 0; m < 4; ++m) _Pragma("unroll") for (int k = 0; k < 2; ++k) dst[m][k] = *(const PG8_LAS bf16x8*)(lds + PG8_SA(b, h) + aoff + m * 2048 + k * 1024); } while (0)
#define PG8_LDB(dst, b, h) do { _Pragma("unroll") for (int n = 0; n < 2; ++n) _Pragma("unroll") for (int k = 0; k < 2; ++k) dst[n][k] = *(const PG8_LAS bf16x8*)(lds + PG8_SB(b, h) + boff + n * 2048 + k * 1024); } while (0)
#define PG8_MMA(ai, bj, At, Bt) do { __builtin_amdgcn_s_setprio(1); _Pragma("unroll") for (int m = 0; m < 4; ++m) _Pragma("unroll") for (int n = 0; n < 2; ++n) _Pragma("unroll") for (int k = 0; k < 2; ++k) { \
        if constexpr (I8) acc[ai][bj][m][n] = __builtin_bit_cast(f32x4, __builtin_amdgcn_mfma_i32_16x16x64_i8(__builtin_bit_cast(i32x4, Bt[n][k]), __builtin_bit_cast(i32x4, At[m][k]), __builtin_bit_cast(i32x4, acc[ai][bj][m][n]), 0, 0, 0)); \
        else acc[ai][bj][m][n] = __builtin_amdgcn_mfma_f32_16x16x32_bf16(Bt[n][k], At[m][k], acc[ai][bj][m][n], 0, 0, 0); } __builtin_amdgcn_s_setprio(0); } while (0)
#define PG8_WAIT_V(n) asm volatile("s_waitcnt vmcnt(" #n ")" ::: "memory")
#define PG8_WAIT_L(n) asm volatile("s_waitcnt lgkmcnt(" #n ")" ::: "memory")
#define PG8_BAR __builtin_amdgcn_s_barrier()
#define PG8_SCHED __builtin_amdgcn_sched_barrier(0)
    Unit cur, nxt; int ui = 0;
    if (!S.next(0, cur)) return;
    f32x4 acc[2][2][4][2];
#pragma unroll
    for (int a = 0; a < 2; ++a)
#pragma unroll
        for (int b = 0; b < 2; ++b)
#pragma unroll
            for (int m = 0; m < 4; ++m)
#pragma unroll
                for (int n = 0; n < 2; ++n) acc[a][b][m][n] = (f32x4){0.f, 0.f, 0.f, 0.f};
    bf16x8 At[4][2], B0[2][2], B1[2][2];
    const char* cA = (const char*)g.A + (size_t)cur.pm * tstep; const char* cB = (const char*)g.Bt + (size_t)cur.pn * tstep;
    S.a_ready(cur);
    if constexpr (SP2) {
        PG8_STAGE(PG8_SB(0, 0), cB, voffB); PG8_STAGE(PG8_SB(0, 1), cB + hstep, voffB); PG8_STAGE(PG8_SA(0, 0), cA, voffA); PG8_STAGE(PG8_SA(0, 1), cA + hstep, voffA);
        if (wr == 1) PG8_BAR;
        PG8_WAIT_V(2); PG8_BAR;
        PG8_STAGE(PG8_SB(1, 0), cB + kstep, voffB); PG8_STAGE(PG8_SA(1, 0), cA + kstep, voffA); PG8_STAGE(PG8_SB(1, 1), cB + hstep + kstep, voffB);
        PG8_WAIT_V(6); PG8_BAR;
    } else {
        PG8_STAGE(PG8_SB(0, 0), cB, voffB); PG8_STAGE(PG8_SA(0, 0), cA, voffA); PG8_STAGE(PG8_SB(0, 1), cB + hstep, voffB); PG8_STAGE(PG8_SA(0, 1), cA + hstep, voffA);
        if (wr == 1) PG8_BAR;
        PG8_WAIT_V(4); PG8_BAR;
        PG8_STAGE(PG8_SB(1, 0), cB + kstep, voffB); PG8_STAGE(PG8_SA(1, 0), cA + kstep, voffA); PG8_STAGE(PG8_SB(1, 1), cB + hstep + kstep, voffB);
        PG8_WAIT_V(6); PG8_BAR;
    }
    for (;;) {
        const bool has_next = S.next(ui + 1, nxt);
        const char* nA = has_next ? (const char*)g.A + (size_t)nxt.pm * tstep : cA; const char* nB = has_next ? (const char*)g.Bt + (size_t)nxt.pn * tstep : cB;
        for (int t = 0; t < nt; t += 2) {
            const bool last = (t == nt - 2);
            if constexpr (MIDK) { if (t == nt / 2) E.midk(acc, cur, wr, fr); }
            const char* a1 = cA + (size_t)(t + 1) * kstep;
            const char* a2 = last ? nA : cA + (size_t)(t + 2) * kstep; const char* b2 = last ? nB : cB + (size_t)(t + 2) * kstep;
            const char* a3 = a2 + kstep; const char* b3 = b2 + kstep;
            if (last && has_next) S.a_ready(nxt);
            if constexpr (SP2) {
            PG8_LDB(B0, 0, 0); PG8_LDB(B1, 0, 1); PG8_SCHED; PG8_LDA(At, 0, 0); PG8_STAGE(PG8_SA(1, 1), a1 + hstep, voffA);
            PG8_WAIT_V(8); PG8_WAIT_L(0); PG8_BAR; PG8_MMA(0, 0, At, B0); PG8_MMA(0, 1, At, B1); PG8_BAR; PG8_SCHED;
            PG8_LDA(At, 0, 1); PG8_STAGE(PG8_SB(0, 0), b2, voffB); PG8_STAGE(PG8_SB(0, 1), b2 + hstep, voffB); PG8_STAGE(PG8_SA(0, 0), a2, voffA);
            PG8_WAIT_V(8); PG8_WAIT_L(0); PG8_BAR; PG8_MMA(1, 0, At, B0); PG8_MMA(1, 1, At, B1); PG8_BAR; PG8_SCHED;
            PG8_LDB(B0, 1, 0); PG8_LDB(B1, 1, 1); PG8_SCHED; PG8_LDA(At, 1, 0); PG8_STAGE(PG8_SA(0, 1), a2 + hstep, voffA);
            PG8_WAIT_V(8); PG8_WAIT_L(0); PG8_BAR; PG8_MMA(0, 0, At, B0); PG8_MMA(0, 1, At, B1); PG8_BAR; PG8_SCHED;
            PG8_LDA(At, 1, 1); PG8_STAGE(PG8_SB(1, 0), b3, voffB); PG8_STAGE(PG8_SB(1, 1), b3 + hstep, voffB); PG8_STAGE(PG8_SA(1, 0), a3, voffA);
            PG8_WAIT_V(8); PG8_WAIT_L(0); PG8_BAR; PG8_MMA(1, 0, At, B0); PG8_MMA(1, 1, At, B1); PG8_BAR; PG8_SCHED;
            } else {
            PG8_LDB(B0, 0, 0); PG8_SCHED; PG8_LDA(At, 0, 0); PG8_STAGE(PG8_SA(1, 1), a1 + hstep, voffA);
            PG8_WAIT_L(8); PG8_BAR; PG8_WAIT_L(0); PG8_MMA(0, 0, At, B0); PG8_BAR; PG8_SCHED;
            PG8_LDB(B1, 0, 1); PG8_STAGE(PG8_SB(0, 0), b2, voffB);
            PG8_BAR; PG8_WAIT_L(0); PG8_MMA(0, 1, At, B1); PG8_BAR;
            PG8_LDA(At, 0, 1); PG8_STAGE(PG8_SA(0, 0), a2, voffA);
            PG8_BAR; PG8_WAIT_L(0); PG8_MMA(1, 0, At, B0); PG8_BAR; PG8_SCHED;
            PG8_STAGE(PG8_SB(0, 1), b2 + hstep, voffB);
            PG8_WAIT_V(6); PG8_BAR; PG8_MMA(1, 1, At, B1); PG8_BAR;
            PG8_LDB(B0, 1, 0); PG8_SCHED; PG8_LDA(At, 1, 0); PG8_STAGE(PG8_SA(0, 1), a2 + hstep, voffA);
            PG8_WAIT_L(8); PG8_BAR; PG8_WAIT_L(0); PG8_MMA(0, 0, At, B0); PG8_BAR; PG8_SCHED;
            PG8_LDB(B1, 1, 1); PG8_STAGE(PG8_SB(1, 0), b3, voffB);
            PG8_BAR; PG8_WAIT_L(0); PG8_MMA(0, 1, At, B1); PG8_BAR;
            PG8_LDA(At, 1, 1); PG8_STAGE(PG8_SA(1, 0), a3, voffA);
            PG8_BAR; PG8_WAIT_L(0); PG8_MMA(1, 0, At, B0); PG8_BAR; PG8_SCHED;
            PG8_STAGE(PG8_SB(1, 1), b3 + hstep, voffB);
            PG8_WAIT_V(6); PG8_BAR; PG8_MMA(1, 1, At, B1); PG8_BAR;
            }
        }
        if constexpr (ALIGN_EPI) { if (wr == 0) PG8_BAR; }
        if constexpr (!Epi::AFTER_DRAIN) { E(acc, cur, wr, wc, fr, fq); S.done(cur); }
        if (!has_next) break;
#pragma unroll
        for (int a = 0; a < 2; ++a)
#pragma unroll
            for (int b = 0; b < 2; ++b)
#pragma unroll
                for (int m = 0; m < 4; ++m)
#pragma unroll
                    for (int n = 0; n < 2; ++n) acc[a][b][m][n] = (f32x4){0.f, 0.f, 0.f, 0.f};
        cur = nxt; cA = nA; cB = nB; ++ui;
        if constexpr (ALIGN_EPI) { if (wr == 1) PG8_BAR; }
    }
    PG8_WAIT_V(0);
    if constexpr (!ALIGN_EPI) { if (wr == 0) PG8_BAR; }
    PG8_BAR;
    if constexpr (Epi::AFTER_DRAIN) { E.fused(acc, cur, wr, wc, fr, fq, lds, wid, lane); S.done(cur); }
#undef PG8_SA
#undef PG8_SB
#undef PG8_STAGE
#undef PG8_LDA
#undef PG8_LDB
#undef PG8_MMA
#undef PG8_WAIT_V
#undef PG8_WAIT_L
#undef PG8_BAR
#undef PG8_SCHED
}
}

__device__ __forceinline__ void step_conv(const Ctx& c) {
    const bf16_t* PROJ = WSP(bf16_t, WS_PROJ); bf16_t* XBCC = WSP(bf16_t, WS_XBCC);
    for (int idx = c.gt; idx < T * 768; idx += c.ngt) {
        const int t = idx / 768, ch = (idx % 768) * 2, pos = t & (SEQ - 1);
        float a0 = IN_CONVB[ch], a1 = IN_CONVB[ch + 1];
#pragma unroll
        for (int j = 0; j < 4; ++j) {
            if (pos - 3 + j >= 0) {
                const unsigned v = *(const unsigned*)(PROJ + (size_t)(t - 3 + j) * DINP + XBC_OFF + ch);
                a0 += IN_CONVW[j * 1536 + ch] * bflo(v); a1 += IN_CONVW[j * 1536 + ch + 1] * bfhi(v);
            }
        }
        *(unsigned*)(XBCC + (size_t)t * 1536 + ch) = pk2(silu_f(a0), silu_f(a1));
    }
    const float* DTRAW = WSP(float, WS_DTRAW); float* DT = WSP(float, WS_DT); float* ACUM = WSP(float, WS_ACUM);
    for (int idx = c.gt; idx < NB * NCH * NH; idx += c.ngt) {
        const int h = idx % NH, bc = idx / NH, t0 = bc * 128;
        const float A = -expf(IN_ALOG[h]), bias = IN_DTBIAS[h]; float cum = 0.f;
        for (int l = 0; l < 128; ++l) {
            const float dtv = softplus_f(DTRAW[(size_t)(t0 + l) * 16 + h] + bias); cum += dtv * A;
            DT[(size_t)idx * 128 + l] = dtv; ACUM[(size_t)idx * 128 + l] = cum;
        }
    }
}

__device__ __forceinline__ void step_ssd1_simple(const Ctx& c) {
    const bf16_t* XBCC = WSP(bf16_t, WS_XBCC); const float* DT = WSP(float, WS_DT); const float* ACUM = WSP(float, WS_ACUM); float* STATES = WSP(float, WS_STATES);
    LAS float* wl = (LAS float*)c.lds;
    for (int item = blockIdx.x; item < NB * NCH * NH; item += gridDim.x) {
        const int bc = item / NH, h = item % NH, g = h >> 3, t0 = bc * 128;
        __syncthreads();
        if (c.tid < 128) { const float aend = ACUM[(size_t)item * 128 + 127]; wl[c.tid] = fexp(aend - ACUM[(size_t)item * 128 + c.tid]) * DT[(size_t)item * 128 + c.tid]; }
        __syncthreads();
        const int p = c.tid >> 3, n0 = (c.tid & 7) * 16;
        float acc[16];
#pragma unroll
        for (int j = 0; j < 16; ++j) acc[j] = 0.f;
        for (int l = 0; l < 128; ++l) {
            const bf16_t* row = XBCC + (size_t)(t0 + l) * 1536;
            const float xv = bf2f(row[h * 64 + p]) * wl[l];
            const u32x4 b0 = *(const u32x4*)(row + 1024 + g * 128 + n0), b1 = *(const u32x4*)(row + 1024 + g * 128 + n0 + 8);
            acc[0] += xv * bflo(b0.x); acc[1] += xv * bfhi(b0.x); acc[2] += xv * bflo(b0.y); acc[3] += xv * bfhi(b0.y);
            acc[4] += xv * bflo(b0.z); acc[5] += xv * bfhi(b0.z); acc[6] += xv * bflo(b0.w); acc[7] += xv * bfhi(b0.w);
            acc[8] += xv * bflo(b1.x); acc[9] += xv * bfhi(b1.x); acc[10] += xv * bflo(b1.y); acc[11] += xv * bfhi(b1.y);
            acc[12] += xv * bflo(b1.z); acc[13] += xv * bfhi(b1.z); acc[14] += xv * bflo(b1.w); acc[15] += xv * bfhi(b1.w);
        }
        float* o = STATES + ((size_t)item * 64 + p) * 128 + n0;
#pragma unroll
        for (int j = 0; j < 4; ++j) *(f32x4*)(o + 4 * j) = (f32x4){acc[4 * j], acc[4 * j + 1], acc[4 * j + 2], acc[4 * j + 3]};
    }
    __syncthreads();
}

__device__ __forceinline__ void step_scan(const Ctx& c) {
    const float* STATES = WSP(float, WS_STATES); const float* ACUM = WSP(float, WS_ACUM); bf16_t* PREVB = WSP(bf16_t, WS_PREVB);
    for (int idx = c.gt; idx < NB * NH * 64 * 32; idx += c.ngt) {
        const int n4 = idx & 31, p = (idx >> 5) & 63, h = (idx >> 11) & 15, b = idx >> 15;
        f32x4 carry_ = {0.f, 0.f, 0.f, 0.f};
        const unsigned so = (unsigned)(((b * NCH * NH + h) * 64 + p) * 128 + n4 * 4), ao = (unsigned)((b * NCH * NH + h) * 128 + 127);
#pragma unroll
        for (int half = 0; half < 2; ++half) {
            f32x4 st[16]; float dec[16];
#pragma unroll
            for (int j = 0; j < 16; ++j) { const int ch = half * 16 + j;
                st[j] = *(const f32x4*)((const char*)(STATES + (size_t)ch * (NH * 64 * 128)) + so * 4u); dec[j] = *(const float*)((const char*)(ACUM + (size_t)ch * (NH * 128)) + ao * 4u); }
            static_assert(NCH == 32, "two halves of 16 chunks");
            f32x4 hs = half == 0 ? (f32x4){0.f, 0.f, 0.f, 0.f} : carry_;
#pragma unroll
            for (int j = 0; j < 16; ++j) { const int ch = half * 16 + j;
                *(u32x2*)((char*)(PREVB + (size_t)ch * (NH * 64 * 128)) + so * 2u) = (u32x2){pk2(hs.x, hs.y), pk2(hs.z, hs.w)};
                hs = hs * fexp(dec[j]) + st[j]; }
            carry_ = hs;
        }
    }
}

__device__ __forceinline__ void step_cb_simple(const Ctx& c) {
    const bf16_t* XBCC = WSP(bf16_t, WS_XBCC); float* G = WSP(float, WS_STATES);
    for (int idx = c.gt; idx < NB * NCH * 2 * 128 * 128; idx += c.ngt) {
        const int s = idx & 127, l = (idx >> 7) & 127, g = (idx >> 14) & 1, bc = idx >> 15, t0 = bc * 128;
        const bf16_t* Cr = XBCC + (size_t)(t0 + l) * 1536 + 1280 + g * 128; const bf16_t* Br = XBCC + (size_t)(t0 + s) * 1536 + 1024 + g * 128;
        float sum = 0.f;
#pragma unroll 4
        for (int n = 0; n < 128; n += 8) sum += dot8(*(const u32x4*)(Cr + n), *(const u32x4*)(Br + n));
        G[idx] = sum;
    }
}

__device__ __forceinline__ void step_ssd2_simple(const Ctx& c) {
    const bf16_t* XBCC = WSP(bf16_t, WS_XBCC); const bf16_t* PROJ = WSP(bf16_t, WS_PROJ); const bf16_t* PREVB = WSP(bf16_t, WS_PREVB);
    const float* DT = WSP(float, WS_DT); const float* ACUM = WSP(float, WS_ACUM); const float* G = WSP(float, WS_STATES);
    bf16_t* YCAT = WSP(bf16_t, WS_ACT); float* SSP = WSP(float, WS_SSP);
    LAS float* ac = (LAS float*)c.lds; LAS float* dl = ac + 128;
    for (int item = blockIdx.x; item < NB * NCH * NH; item += gridDim.x) {
        const int bc = item / NH, h = item % NH, g = h >> 3, t0 = bc * 128;
        __syncthreads();
        if (c.tid < 128) { ac[c.tid] = ACUM[(size_t)item * 128 + c.tid]; dl[c.tid] = DT[(size_t)item * 128 + c.tid]; }
        __syncthreads();
        const int l = c.tid >> 2, p0 = (c.tid & 3) * 16, t = t0 + l;
        float acc[16];
#pragma unroll
        for (int j = 0; j < 16; ++j) acc[j] = 0.f;
        {
            const bf16_t* Cr = XBCC + (size_t)t * 1536 + 1280 + g * 128; const bf16_t* Pr = PREVB + ((size_t)item * 64 + p0) * 128;
            for (int n = 0; n < 128; n += 8) {
                const u32x4 cv = *(const u32x4*)(Cr + n);
#pragma unroll
                for (int j = 0; j < 16; ++j) acc[j] += dot8(cv, *(const u32x4*)(Pr + j * 128 + n));
            }
            const float el = fexp(ac[l]);
#pragma unroll
            for (int j = 0; j < 16; ++j) acc[j] *= el;
        }
        const float al = ac[l]; const float* Gr = G + ((size_t)(bc * 2 + g) * 128 + l) * 128;
        for (int s = 0; s <= l; ++s) {
            const float coef = Gr[s] * fexp(al - ac[s]) * dl[s];
            const bf16_t* xr = XBCC + (size_t)(t0 + s) * 1536 + h * 64 + p0;
            const u32x4 x0 = *(const u32x4*)xr, x1 = *(const u32x4*)(xr + 8);
            acc[0] += coef * bflo(x0.x); acc[1] += coef * bfhi(x0.x); acc[2] += coef * bflo(x0.y); acc[3] += coef * bfhi(x0.y);
            acc[4] += coef * bflo(x0.z); acc[5] += coef * bfhi(x0.z); acc[6] += coef * bflo(x0.w); acc[7] += coef * bfhi(x0.w);
            acc[8] += coef * bflo(x1.x); acc[9] += coef * bfhi(x1.x); acc[10] += coef * bflo(x1.y); acc[11] += coef * bfhi(x1.y);
            acc[12] += coef * bflo(x1.z); acc[13] += coef * bfhi(x1.z); acc[14] += coef * bflo(x1.w); acc[15] += coef * bfhi(x1.w);
        }
        {
            const bf16_t* xr = XBCC + (size_t)t * 1536 + h * 64 + p0; const bf16_t* zr = PROJ + (size_t)t * DINP + Z_OFF + h * 64 + p0;
            const float dsk = IN_DSKIP[h]; float ss = 0.f; unsigned ow[8];
#pragma unroll
            for (int j = 0; j < 16; j += 2) {
                const unsigned xw = *(const unsigned*)(xr + j), zw = *(const unsigned*)(zr + j);
                const float y0 = (acc[j] + dsk * bflo(xw)) * silu_f(bflo(zw)), y1 = (acc[j + 1] + dsk * bfhi(xw)) * silu_f(bfhi(zw));
                ss += y0 * y0 + y1 * y1; ow[j >> 1] = pk2(y0, y1);
            }
            bf16_t* o = YCAT + (size_t)t * D + h * 64 + p0;
            *(u32x4*)o = (u32x4){ow[0], ow[1], ow[2], ow[3]}; *(u32x4*)(o + 8) = (u32x4){ow[4], ow[5], ow[6], ow[7]};
            ss += __shfl_xor(ss, 1); ss += __shfl_xor(ss, 2);
            if ((c.tid & 3) == 0) SSP[(size_t)t * 32 + h] = ss;
        }
    }
    __syncthreads();
}

__device__ __forceinline__ void step_att_simple(const Ctx& c) {
    const bf16_t* PROJ = WSP(bf16_t, WS_PROJ); bf16_t* YCAT = WSP(bf16_t, WS_ACT); float* SSP = WSP(float, WS_SSP);
    for (int idx = c.gt; idx < T * 16; idx += c.ngt) {
        const int t = idx >> 4, hd = idx & 15, kvh = hd >> 3, pos = t & (SEQ - 1);
        float q[64], o[64];
        {
            const bf16_t* qr = PROJ + (size_t)t * DINP + Q_OFF + hd * 64;
#pragma unroll
            for (int d = 0; d < 64; d += 8) { const u32x4 v = *(const u32x4*)(qr + d);
                q[d] = 0.125f * bflo(v.x); q[d + 1] = 0.125f * bfhi(v.x); q[d + 2] = 0.125f * bflo(v.y); q[d + 3] = 0.125f * bfhi(v.y);
                q[d + 4] = 0.125f * bflo(v.z); q[d + 5] = 0.125f * bfhi(v.z); q[d + 6] = 0.125f * bflo(v.w); q[d + 7] = 0.125f * bfhi(v.w); }
        }
#pragma unroll
        for (int d = 0; d < 64; ++d) o[d] = 0.f;
        float m = IN_SINKS[hd], den = 1.f;
        const int j0 = pos - 127 > 0 ? pos - 127 : 0;
        for (int kp = j0; kp <= pos; ++kp) {
            const size_t tk = (size_t)(t - pos + kp);
            const bf16_t* kr = PROJ + tk * DINP + K_OFF + kvh * 64; const bf16_t* vr = PROJ + tk * DINP + V_OFF + kvh * 64;
            float s = 0.f;
#pragma unroll
            for (int d = 0; d < 64; d += 8) { const u32x4 v = *(const u32x4*)(kr + d);
                s += q[d] * bflo(v.x) + q[d + 1] * bfhi(v.x) + q[d + 2] * bflo(v.y) + q[d + 3] * bfhi(v.y) + q[d + 4] * bflo(v.z) + q[d + 5] * bfhi(v.z) + q[d + 6] * bflo(v.w) + q[d + 7] * bfhi(v.w); }
            if (s > m) { const float sc = fexp(m - s); den *= sc;
#pragma unroll
                for (int d = 0; d < 64; ++d) o[d] *= sc;
                m = s; }
            const float p = fexp(s - m); den += p;
#pragma unroll
            for (int d = 0; d < 64; d += 8) { const u32x4 v = *(const u32x4*)(vr + d);
                o[d] += p * bflo(v.x); o[d + 1] += p * bfhi(v.x); o[d + 2] += p * bflo(v.y); o[d + 3] += p * bfhi(v.y);
                o[d + 4] += p * bflo(v.z); o[d + 5] += p * bfhi(v.z); o[d + 6] += p * bflo(v.w); o[d + 7] += p * bfhi(v.w); }
        }
        const float inv = 1.f / den; float ss = 0.f;
        bf16_t* orow = YCAT + (size_t)t * D + 1024 + hd * 64;
#pragma unroll
        for (int d = 0; d < 64; d += 8) {
            float r[8];
#pragma unroll
            for (int e = 0; e < 8; ++e) { r[e] = o[d + e] * inv; ss += r[e] * r[e]; }
            *(u32x4*)(orow + d) = (u32x4){pk2(r[0], r[1]), pk2(r[2], r[3]), pk2(r[4], r[5]), pk2(r[6], r[7])};
        }
        SSP[(size_t)t * 32 + 16 + hd] = ss;
    }
}

__device__ __forceinline__ bf16x8v ld_frag16(const void* p) { return __builtin_bit_cast(bf16x8v, *(const u32x4*)p); }
__device__ __forceinline__ bf16x8v lds_frag16(const LAS unsigned char* p) { return __builtin_bit_cast(bf16x8v, *(const LAS u32x4*)p); }
__device__ __forceinline__ f32x16 zero16() { f32x16 z;
#pragma unroll
    for (int r = 0; r < 16; ++r) z[r] = 0.f;
    return z; }
#define MFMA32(a, b, c) __builtin_amdgcn_mfma_f32_32x32x16_bf16((a), (b), (c), 0, 0, 0)
__device__ __forceinline__ bf16x8v acc_frag(const f32x16& x, int ks2) {
    u32x4 w; w.x = cvtpk(x[8 * ks2 + 0], x[8 * ks2 + 1]); w.y = cvtpk(x[8 * ks2 + 2], x[8 * ks2 + 3]); w.z = cvtpk(x[8 * ks2 + 4], x[8 * ks2 + 5]); w.w = cvtpk(x[8 * ks2 + 6], x[8 * ks2 + 7]);
    return __builtin_bit_cast(bf16x8v, w);
}

__device__ __forceinline__ void step_dta(const Ctx& c) {
    const float* DTRAW = WSP(float, WS_DTRAW); float* DT = WSP(float, WS_DT); float* ACUM = WSP(float, WS_ACUM);
    for (int idx = c.gw; idx < NB * NCH * NH; idx += c.ngw) {
        const int h = idx % NH, bc = idx / NH, t0 = bc * 128, l0 = 2 * c.lane;
        const float A = -expf(IN_ALOG[h]), bias = IN_DTBIAS[h];
        const float d0 = softplus_f(DTRAW[(size_t)(t0 + l0) * 16 + h] + bias), d1 = softplus_f(DTRAW[(size_t)(t0 + l0 + 1) * 16 + h] + bias);
        const float a0 = d0 * A, a1 = d1 * A; float x = a0 + a1;
#pragma unroll
        for (int o = 1; o < 64; o <<= 1) { const float v = __shfl_up(x, o); if (c.lane >= o) x += v; }
        const float ex = x - (a0 + a1);
        *(f32x2*)(DT + (size_t)idx * 128 + l0) = (f32x2){d0, d1};
        *(f32x2*)(ACUM + (size_t)idx * 128 + l0) = (f32x2){ex + a0, ex + a0 + a1};
    }
}
__device__ __forceinline__ void step_conv_only(const Ctx& c) {
    const bf16_t* PROJ = WSP(bf16_t, WS_PROJ); bf16_t* XBCC = WSP(bf16_t, WS_XBCC);
    for (int idx = c.gt; idx < (T / 8) * 384; idx += c.ngt) {
        const int rb = idx / 384, ch = (idx % 384) * 4, t0 = rb * 8, pos0 = t0 & (SEQ - 1);
        f32x4 w[4];
#pragma unroll
        for (int j = 0; j < 4; ++j) w[j] = *(const f32x4*)(IN_CONVW + j * 1536 + ch);
        const f32x4 bias = *(const f32x4*)(IN_CONVB + ch);
        f32x4 xr[11];
#pragma unroll
        for (int i = 0; i < 11; ++i) {
            if (pos0 - 3 + i >= 0) { const u32x2 v = *(const u32x2*)(PROJ + (size_t)(t0 - 3 + i) * DINP + XBC_OFF + ch); xr[i] = (f32x4){bflo(v.x), bfhi(v.x), bflo(v.y), bfhi(v.y)}; }
            else xr[i] = (f32x4){0.f, 0.f, 0.f, 0.f};
        }
#pragma unroll
        for (int r = 0; r < 8; ++r) {
            const f32x4 a = bias + w[0] * xr[r] + w[1] * xr[r + 1] + w[2] * xr[r + 2] + w[3] * xr[r + 3];
            *(u32x2*)(XBCC + (size_t)(t0 + r) * 1536 + ch) = (u32x2){cvtpk(silu_f(a.x), silu_f(a.y)), cvtpk(silu_f(a.z), silu_f(a.w))};
        }
    }
}

__device__ __forceinline__ void step_ssd1_fast(const Ctx& c) {
    const bf16_t* XBCC = WSP(bf16_t, WS_XBCC); const float* DT = WSP(float, WS_DT); const float* ACUM = WSP(float, WS_ACUM); float* STATES = WSP(float, WS_STATES);
    LAS unsigned char* Bl = c.lds;
    LAS unsigned char* Xl = c.lds + 32768;
    LAS float* wl = (LAS float*)(c.lds + 65536);
    const int lane = c.lane, col = lane & 31, hh = lane >> 5, pt = c.wave >> 2, nt = c.wave & 3;
    for (int item = blockIdx.x; item < NB * NCH * 2; item += gridDim.x) {
        const int bc = item >> 1, g = item & 1, t0 = bc * 128;
        __syncthreads();
        for (int i = c.tid; i < 128 * 16; i += NTHR) { const int l = i >> 4, ch = i & 15;
            *(LAS u32x4*)(Bl + l * 256 + ch * 16) = *(const u32x4*)(XBCC + (size_t)(t0 + l) * 1536 + 1024 + g * 128 + ch * 8); }
        for (int i = c.tid; i < 8 * 128; i += NTHR) { const int r = i >> 7, l = i & 127; const size_t o = ((size_t)bc * 16 + g * 8 + r) * 128;
            wl[i] = fexp(ACUM[o + 127] - ACUM[o + l]) * DT[o + l]; }
        __syncthreads();
#define SSD1_STAGE(r_) { _Pragma("unroll") for (int q_ = 0; q_ < 2; ++q_) { const int i_ = c.tid + q_ * NTHR, l_ = i_ >> 3, ch_ = i_ & 7; \
            const u32x4 v_ = *(const u32x4*)(XBCC + (size_t)(t0 + l_) * 1536 + (g * 8 + (r_)) * 64 + ch_ * 8); const float w_ = wl[(r_) * 128 + l_]; \
            u32x4 o_; o_.x = cvtpk(bflo(v_.x) * w_, bfhi(v_.x) * w_); o_.y = cvtpk(bflo(v_.y) * w_, bfhi(v_.y) * w_); o_.z = cvtpk(bflo(v_.z) * w_, bfhi(v_.z) * w_); o_.w = cvtpk(bflo(v_.w) * w_, bfhi(v_.w) * w_); \
            *(LAS u32x4*)(Xl + ((r_) & 1) * 16384 + l_ * 128 + ch_ * 16) = o_; } }
        SSD1_STAGE(0);
        __syncthreads();
        for (int r = 0; r < 8; ++r) {
            if (r + 1 < 8) SSD1_STAGE(r + 1);
            const LAS unsigned char* xb = Xl + (r & 1) * 16384 + (pt * 32 + col) * 2; const LAS unsigned char* bb = Bl + (nt * 32 + col) * 2;
            f32x16 acc = zero16();
#pragma unroll
            for (int ks = 0; ks < 8; ++ks) {
                bf16x8v af, bf;
#pragma unroll
                for (int j = 0; j < 8; ++j) { const int l = 16 * ks + 8 * hh + j; af[j] = *(const LAS short*)(xb + l * 128); bf[j] = *(const LAS short*)(bb + l * 256); }
                acc = MFMA32(af, bf, acc);
            }
            float* o = STATES + (((size_t)bc * 16 + g * 8 + r) * 64 + pt * 32) * 128 + nt * 32 + col;
#pragma unroll
            for (int rr = 0; rr < 16; ++rr) o[(size_t)((rr & 3) + 8 * (rr >> 2) + 4 * hh) * 128] = acc[rr];
            __syncthreads();
        }
#undef SSD1_STAGE
    }
    __syncthreads();
}

#define TABH_SRC(r_) ((r_) < 16384 ? IN_U + (size_t)(r_) * D : IN_V + (size_t)((r_) - 16384) * D)
#define TABH_FINISH(rowv, r_) { if ((r_) < 16384) { if (U_INT4) u4_row_finish(rowv, WSP(unsigned char, WS_UB), (r_), WSP(float, WS_SCU) + (r_), c.lane); else fp8_row_finish<SLICED_PEER != 0>(rowv, WSP(unsigned char, WS_UB), (r_), WSP(float, WS_SCU) + (r_), c.lane); } \
        else fp8_row_finish<(SLICED_PEER != 0) && (V_INT8 != 0)>(rowv, WSP(unsigned char, WS_VB), (r_) - 16384, WSP(float, WS_SCV) + ((r_) - 16384), c.lane); }
#define TABH_TICK() { if (kTicks) { if (tabr < 2 * 16384) { TABH_FINISH(tabv, tabr); } tabr += c.ngw; if (tabr < 2 * 16384) fp8_row_load(tabv, TABH_SRC(tabr), c.lane); } }
template <int PV = 0>
__device__ __forceinline__ void step_ssd2_fast(const Ctx& c) {
    constexpr bool kTicks = (HIDE_TABLES != 0) && PV == 0;
    const bf16_t* XBCC = WSP(bf16_t, WS_XBCC); const bf16_t* PROJ = WSP(bf16_t, WS_PROJ); const bf16_t* PREVB = WSP(bf16_t, WS_PREVB);
    const float* DT = WSP(float, WS_DT); const float* ACUM = WSP(float, WS_ACUM); bf16_t* YCAT = WSP(bf16_t, WS_ACT); float* SSP = WSP(float, WS_SSP);
    const int lane = c.lane, col = lane & 31, hh = lane >> 5;
    LAS unsigned char* Xw = c.lds + c.wave * 16384;
    LAS float* ac = (LAS float*)(c.lds + 131072 + c.wave * 1024); LAS float* dl = ac + 128;
    LAS unsigned char* Gl = c.lds + 139264;
    f32x4 tabv[8]; int tabr = c.gw;
    if (kTicks && tabr < 2 * 16384) fp8_row_load(tabv, TABH_SRC(tabr), c.lane);
    for (int item = blockIdx.x; item < NB * NCH * 2; item += gridDim.x) {
        const int bc = item >> 1, g = item & 1, t0 = bc * 128, hd = g * 8 + c.wave; const size_t ih = (size_t)bc * 16 + hd;
        __syncthreads();
#pragma unroll 1
        for (int tile = c.wave; tile < ((PV & 1) ? 0 : 10); tile += 8) {
            const int lt_ = tile < 1 ? 0 : tile < 3 ? 1 : tile < 6 ? 2 : 3, st_ = tile - (lt_ * (lt_ + 1)) / 2;
            bf16x8v cg[8], bg[8];
            const bf16_t* cp = XBCC + (size_t)(t0 + lt_ * 32 + col) * 1536 + 1280 + g * 128 + hh * 8;
            const bf16_t* bp = XBCC + (size_t)(t0 + st_ * 32 + col) * 1536 + 1024 + g * 128 + hh * 8;
#pragma unroll
            for (int ks = 0; ks < 8; ++ks) { cg[ks] = ld_frag16(cp + ks * 16); bg[ks] = ld_frag16(bp + ks * 16); }
            f32x16 gt = zero16();
#pragma unroll
            for (int ks = 0; ks < 8; ++ks) gt = MFMA32(bg[ks], cg[ks], gt);
            const u32x4 o0 = {cvtpk(gt[0], gt[1]), cvtpk(gt[2], gt[3]), cvtpk(gt[4], gt[5]), cvtpk(gt[6], gt[7])};
            const u32x4 o1 = {cvtpk(gt[8], gt[9]), cvtpk(gt[10], gt[11]), cvtpk(gt[12], gt[13]), cvtpk(gt[14], gt[15])};
            *(LAS u32x4*)(Gl + tile * 2048 + lane * 32) = o0; *(LAS u32x4*)(Gl + tile * 2048 + lane * 32 + 16) = o1;
        }
#pragma unroll 4
        for (int i = lane; i < ((PV & 16) ? 0 : 128 * 8); i += 64) { const int srow = i >> 3, ch = i & 7;
            *(LAS u32x4*)(Xw + srow * 128 + ch * 16) = *(const u32x4*)(XBCC + (size_t)(t0 + srow) * 1536 + hd * 64 + ch * 8); }
        ac[lane] = ACUM[ih * 128 + lane]; ac[lane + 64] = ACUM[ih * 128 + 64 + lane]; dl[lane] = DT[ih * 128 + lane]; dl[lane + 64] = DT[ih * 128 + 64 + lane];
        asm volatile("s_waitcnt vmcnt(0) lgkmcnt(0)" ::: "memory");
        __syncthreads();
        const float dsk = IN_DSKIP[hd];
        bf16x8v pf0[8], pf1[8];
        { const bf16_t* pp0 = PREVB + (ih * 64 + col) * 128 + hh * 8; const bf16_t* pp1 = pp0 + 32 * 128;
#pragma unroll
          for (int ks = 0; ks < 8; ++ks) { if (PV & 32) { pf0[ks] = (bf16x8v){0,0,0,0,0,0,0,0}; pf1[ks] = pf0[ks]; } else { pf0[ks] = ld_frag16(pp0 + ks * 16); pf1[ks] = ld_frag16(pp1 + ks * 16); } } }
#pragma unroll 1
        for (int lt = 3; lt >= 0; --lt) {
            const int l = lt * 32 + col, t = t0 + l;
            bf16x8v cf[8];
            const bf16_t* cp = XBCC + (size_t)t * 1536 + 1280 + g * 128 + hh * 8;
#pragma unroll
            for (int ks = 0; ks < 8; ++ks) { if (PV & 4) cf[ks] = (bf16x8v){0,0,0,0,0,0,0,0}; else cf[ks] = ld_frag16(cp + ks * 16); }
            const int zr = lt * 32 + (lane >> 3), zc = lane & 7;
            u32x4 zq[4];
#pragma unroll
            for (int k = 0; k < 4; ++k) zq[k] = *(const u32x4*)(PROJ + (size_t)(t0 + zr + 8 * k) * DINP + Z_OFF + hd * 64 + zc * 8);
            TABH_TICK();
            f32x16 acc[2]; acc[0] = zero16(); acc[1] = zero16();
#pragma unroll
            for (int ks = 0; ks < 8; ++ks) { acc[0] = MFMA32(pf0[ks], cf[ks], acc[0]); acc[1] = MFMA32(pf1[ks], cf[ks], acc[1]); }
            const float al = ac[l], el = fexp(al);
#pragma unroll
            for (int p2 = 0; p2 < 2; ++p2)
#pragma unroll
                for (int r = 0; r < 16; ++r) acc[p2][r] *= el;
#pragma unroll 1
            for (int st = 0; st <= ((PV & 2) ? -1 : lt); ++st) {
                const LAS unsigned char* gp = Gl + ((lt * (lt + 1)) / 2 + st) * 2048 + lane * 32;
                const u32x4 g0 = *(const LAS u32x4*)gp, g1 = *(const LAS u32x4*)(gp + 16);
                if (st == 0 || st == lt || (lt == 3 && st == 1)) { TABH_TICK(); }
                f32x16 gt;
#pragma unroll
                for (int i = 0; i < 4; ++i) { gt[2 * i] = bflo(g0[i]); gt[2 * i + 1] = bfhi(g0[i]); gt[8 + 2 * i] = bflo(g1[i]); gt[8 + 2 * i + 1] = bfhi(g1[i]); }
#pragma unroll
                for (int g4 = 0; g4 < 4; ++g4) {
                    const int sl0 = 8 * g4 + 4 * hh;
                    const f32x4 as = *(const LAS f32x4*)(ac + st * 32 + sl0), ds = *(const LAS f32x4*)(dl + st * 32 + sl0);
#pragma unroll
                    for (int e = 0; e < 4; ++e) {
                        const bool ok = (st < lt) || (sl0 + e <= col);
                        gt[4 * g4 + e] = ok ? gt[4 * g4 + e] * fexp(al - as[e]) * ds[e] : 0.f;
                    }
                }
                const bf16x8v w0 = acc_frag(gt, 0), w1 = acc_frag(gt, 1);
#pragma unroll
                for (int p2 = 0; p2 < 2; ++p2) {
                    const LAS unsigned char* xb = Xw + (p2 * 32 + col) * 2 + (st * 32 + 4 * hh) * 128;
                    bf16x8v x0, x1;
#pragma unroll
                    for (int j = 0; j < 8; ++j) { const int srow = 8 * (j >> 2) + (j & 3); x0[j] = *(const LAS short*)(xb + srow * 128); x1[j] = *(const LAS short*)(xb + (16 + srow) * 128); }
                    acc[p2] = MFMA32(x0, w0, acc[p2]); acc[p2] = MFMA32(x1, w1, acc[p2]);
                }
            }
            TABH_TICK();
            float ss = 0.f;
            u32x2 xq[2][4], z2[2][4];
#pragma unroll
            for (int p2 = 0; p2 < 2; ++p2)
#pragma unroll
                for (int g4 = 0; g4 < 4; ++g4) xq[p2][g4] = *(const LAS u32x2*)(Xw + l * 128 + (p2 * 32 + 8 * g4 + 4 * hh) * 2);
            asm volatile("s_waitcnt lgkmcnt(0)" ::: "memory");
#pragma unroll
            for (int k = 0; k < 4; ++k) *(LAS u32x4*)(Xw + (zr + 8 * k) * 128 + zc * 16) = zq[k];
            asm volatile("s_waitcnt lgkmcnt(0)" ::: "memory");
#pragma unroll
            for (int p2 = 0; p2 < 2; ++p2)
#pragma unroll
                for (int g4 = 0; g4 < 4; ++g4) z2[p2][g4] = *(const LAS u32x2*)(Xw + l * 128 + (p2 * 32 + 8 * g4 + 4 * hh) * 2);
            asm volatile("s_waitcnt lgkmcnt(0)" ::: "memory");
#pragma unroll
            for (int p2 = 0; p2 < 2; ++p2)
#pragma unroll
                for (int g4 = 0; g4 < 4; ++g4) {
                    const u32x2 xw = xq[p2][g4], zz = z2[p2][g4];
                    const float y0 = (acc[p2][4 * g4 + 0] + dsk * bflo(xw.x)) * silu_f(bflo(zz.x)), y1 = (acc[p2][4 * g4 + 1] + dsk * bfhi(xw.x)) * silu_f(bfhi(zz.x));
                    const float y2 = (acc[p2][4 * g4 + 2] + dsk * bflo(xw.y)) * silu_f(bflo(zz.y)), y3 = (acc[p2][4 * g4 + 3] + dsk * bfhi(xw.y)) * silu_f(bfhi(zz.y));
                    ss += (y0 * y0 + y1 * y1) + (y2 * y2 + y3 * y3);
                    *(LAS u32x2*)(Xw + l * 128 + (p2 * 32 + 8 * g4 + 4 * hh) * 2) = (u32x2){cvtpk(y0, y1), cvtpk(y2, y3)};
                }
            asm volatile("s_waitcnt lgkmcnt(0)" ::: "memory");
#pragma unroll
            for (int k = 0; k < 4; ++k) { const u32x4 yq = *(const LAS u32x4*)(Xw + (zr + 8 * k) * 128 + zc * 16); *(u32x4*)(YCAT + (size_t)(t0 + zr + 8 * k) * D + hd * 64 + zc * 8) = yq; }
            ss += __shfl_xor(ss, 32);
            if (hh == 0) SSP[(size_t)t * 32 + hd] = ss;
        }
    }
    if (kTicks) { while (tabr < 2 * 16384) { TABH_TICK(); } }
    __syncthreads();
}

__device__ __forceinline__ void step_att_fast(const Ctx& c) {
    const bf16_t* PROJ = WSP(bf16_t, WS_PROJ); bf16_t* YCAT = WSP(bf16_t, WS_ACT); float* SSP = WSP(float, WS_SSP);
    const int lane = c.lane, col = lane & 31, hh = lane >> 5;
    LAS unsigned char* Kl = c.lds;
    LAS unsigned char* Vt = c.lds + 256 * 144;
    const float NEG = -__builtin_huge_valf();
    for (int item = blockIdx.x; item < NB * NCH * 2; item += gridDim.x) {
        const int kvh = item & 1, nblk = (item >> 1) & 31, b = item >> 6, tq0 = b * SEQ + nblk * 128, tk0 = tq0 - 128;
        __syncthreads();
        for (int i = c.tid; i < 256 * 8; i += NTHR) {
            const int kj = i >> 3, ch = i & 7;
            if (nblk > 0 || kj >= 128) {
                const bf16_t* src = PROJ + (size_t)(tk0 + kj) * DINP + kvh * 64 + ch * 8;
                *(LAS u32x4*)(Kl + kj * 144 + ch * 16) = *(const u32x4*)(src + K_OFF);
                const u32x4 v = *(const u32x4*)(src + V_OFF);
                LAS unsigned char* vp = Vt + (ch * 8) * 520 + kj * 2;
                *(LAS unsigned short*)(vp + 0 * 520) = (unsigned short)(v.x & 0xffff); *(LAS unsigned short*)(vp + 1 * 520) = (unsigned short)(v.x >> 16);
                *(LAS unsigned short*)(vp + 2 * 520) = (unsigned short)(v.y & 0xffff); *(LAS unsigned short*)(vp + 3 * 520) = (unsigned short)(v.y >> 16);
                *(LAS unsigned short*)(vp + 4 * 520) = (unsigned short)(v.z & 0xffff); *(LAS unsigned short*)(vp + 5 * 520) = (unsigned short)(v.z >> 16);
                *(LAS unsigned short*)(vp + 6 * 520) = (unsigned short)(v.w & 0xffff); *(LAS unsigned short*)(vp + 7 * 520) = (unsigned short)(v.w >> 16);
            }
        }
        __syncthreads();
        const int hd = kvh * 8 + c.wave; const float sink = IN_SINKS[hd];
        for (int qt = 0; qt < 4; ++qt) {
            const int tq = tq0 + qt * 32 + col;
            bf16x8v qf[4];
#pragma unroll
            for (int ks = 0; ks < 4; ++ks) qf[ks] = ld_frag16(PROJ + (size_t)tq * DINP + Q_OFF + hd * 64 + ks * 16 + hh * 8);
            f32x16 S[5]; float m = sink;
#pragma unroll
            for (int jj = 0; jj < 5; ++jj) {
                const int j = qt + jj;
                if (nblk == 0 && j < 4) {
#pragma unroll
                    for (int r = 0; r < 16; ++r) S[jj][r] = NEG;
                } else {
                    f32x16 a = zero16();
#pragma unroll
                    for (int ks = 0; ks < 4; ++ks) a = MFMA32(lds_frag16(Kl + (j * 32 + col) * 144 + ks * 32 + hh * 16), qf[ks], a);
#pragma unroll
                    for (int r = 0; r < 16; ++r) {
                        const int kl = (r & 3) + 8 * (r >> 2) + 4 * hh;
                        float sv = a[r] * 0.125f;
                        if (jj == 0) sv = (kl > col) ? sv : NEG;
                        if (jj == 4) sv = (kl <= col) ? sv : NEG;
                        S[jj][r] = sv; m = fmaxf(m, sv);
                    }
                }
            }
            m = fmaxf(m, __shfl_xor(m, 32));
            float lsum = 0.f;
#pragma unroll
            for (int jj = 0; jj < 5; ++jj)
#pragma unroll
                for (int r = 0; r < 16; ++r) { const float p = fexp(S[jj][r] - m); S[jj][r] = p; lsum += p; }
            lsum += __shfl_xor(lsum, 32); lsum += fexp(sink - m);
            f32x16 O[2]; O[0] = zero16(); O[1] = zero16();
#pragma unroll
            for (int jj = 0; jj < 5; ++jj) {
                const int j = qt + jj;
                if (!(nblk == 0 && j < 4)) {
#pragma unroll
                    for (int ks2 = 0; ks2 < 2; ++ks2) {
                        const bf16x8v pf = acc_frag(S[jj], ks2);
#pragma unroll
                        for (int d2 = 0; d2 < 2; ++d2) {
                            const LAS unsigned char* vp = Vt + (d2 * 32 + col) * 520 + (j * 32 + 16 * ks2 + 4 * hh) * 2;
                            const u32x2 v0 = *(const LAS u32x2*)vp, v1 = *(const LAS u32x2*)(vp + 16);
                            O[d2] = MFMA32(__builtin_bit_cast(bf16x8v, ((u32x4){v0.x, v0.y, v1.x, v1.y})), pf, O[d2]);
                        }
                    }
                }
            }
            const float inv = 1.f / lsum; float ss = 0.f;
#pragma unroll
            for (int d2 = 0; d2 < 2; ++d2)
#pragma unroll
                for (int g4 = 0; g4 < 4; ++g4) {
                    const float o0 = O[d2][4 * g4] * inv, o1 = O[d2][4 * g4 + 1] * inv, o2 = O[d2][4 * g4 + 2] * inv, o3 = O[d2][4 * g4 + 3] * inv;
                    ss += (o0 * o0 + o1 * o1) + (o2 * o2 + o3 * o3);
                    *(u32x2*)(YCAT + (size_t)tq * D + 1024 + hd * 64 + d2 * 32 + 8 * g4 + 4 * hh) = (u32x2){cvtpk(o0, o1), cvtpk(o2, o3)};
                }
            ss += __shfl_xor(ss, 32);
            if (hh == 0) SSP[(size_t)tq * 32 + 16 + hd] = ss;
        }
    }
    __syncthreads();
}

__device__ __forceinline__ void step_rs(const Ctx& c) {
    const float* SSP = WSP(float, WS_SSP); float* RS = WSP(float, WS_RS);
    for (int t = c.gt; t < T; t += c.ngt) {
        float s1 = 0.f, s2 = 0.f;
#pragma unroll
        for (int j = 0; j < 4; ++j) { const f32x4 a = *(const f32x4*)(SSP + (size_t)t * 32 + 4 * j), b = *(const f32x4*)(SSP + (size_t)t * 32 + 16 + 4 * j);
            s1 += (a.x + a.y) + (a.z + a.w); s2 += (b.x + b.y) + (b.z + b.w); }
        const float r1 = rsqrtf(s1 * (1.f / 1024.f) + EPS), r2 = rsqrtf(s2 * (1.f / 1024.f) + EPS);
        RS[2 * t] = r1 / r2; RS[2 * t + 1] = r2;
    }
}

__device__ __forceinline__ void step_ln1(const Ctx& c) {
    const float* MOD = WSP(float, WS_MOD); bf16_t* H2 = WSP(bf16_t, WS_ACT); const bf16_t* GB = WSP(bf16_t, WS_R1B); bf16_t* X1B = WSP(bf16_t, WS_X1B); unsigned char* H2Q = WSP(unsigned char, WS_H2Q); float* HS = WSP(float, WS_HS);
    f32x4 xc[8], xn[8]; u32x2 gc[8], gn[8];
    int t = c.gw;
#define LN1_LOAD(xa, ga, tok) { _Pragma("unroll") for (int j_ = 0; j_ < 8; ++j_) { xa[j_] = *(const f32x4*)(IN_X + (size_t)(tok) * D + j_ * 256 + c.lane * 4); ga[j_] = *(const u32x2*)(GB + (size_t)(tok) * D + j_ * 256 + c.lane * 4); } }
    if (t < T) LN1_LOAD(xc, gc, t);
    for (; t < T; t += c.ngw) {
        const int tn = t + c.ngw;
        if (tn < T) LN1_LOAD(xn, gn, tn);
        const int b = t >> 12;
        f32x4 v[8]; float s = 0.f;
#pragma unroll
        for (int j = 0; j < 8; ++j) { v[j] = xc[j] * ALPHA + (f32x4){bflo(gc[j].x), bfhi(gc[j].x), bflo(gc[j].y), bfhi(gc[j].y)}; s += (v[j].x + v[j].y) + (v[j].z + v[j].w); }
        const float mean = wave_sum_all(s) * (1.f / D); float s2 = 0.f;
#pragma unroll
        for (int j = 0; j < 8; ++j) { v[j] = v[j] - mean; s2 += (v[j].x * v[j].x + v[j].y * v[j].y) + (v[j].z * v[j].z + v[j].w * v[j].w); }
        const float rstd = rsqrtf(wave_sum_all(s2) * (1.f / D) + EPS);
        const float* sh = MOD + b * NMOD + 3 * D; const float* sc = MOD + b * NMOD + 4 * D; float hmax = 0.f;
#pragma unroll
        for (int j = 0; j < 8; ++j) {
            const int col = j * 256 + c.lane * 4;
            const f32x4 g = *(const f32x4*)(IN_LN1G + col), bb = *(const f32x4*)(IN_LN1B + col), s_ = *(const f32x4*)(sc + col), h_ = *(const f32x4*)(sh + col);
            const f32x4 x1 = v[j] * rstd * g + bb;
            *(u32x2*)(X1B + (size_t)t * D + col) = (u32x2){cvtpk(x1.x, x1.y), cvtpk(x1.z, x1.w)};
            const f32x4 h2v = x1 * (s_ + 1.f) + h_;
            if (!(I8_GEMM3 && FAST_GEMM)) *(u32x2*)(H2 + (size_t)t * D + col) = (u32x2){cvtpk(h2v.x, h2v.y), cvtpk(h2v.z, h2v.w)};
            v[j] = h2v; hmax = fmaxf(hmax, fmaxf(fmaxf(fabsf(h2v.x), fabsf(h2v.y)), fmaxf(fabsf(h2v.z), fabsf(h2v.w))));
        }
        {
            hmax = DPPMAX(hmax, 0xB1); hmax = DPPMAX(hmax, 0x4E); hmax = DPPMAX(hmax, 0x141); hmax = DPPMAX(hmax, 0x140);
            const unsigned a0 = __builtin_amdgcn_readlane(__float_as_uint(hmax), 0), a1 = __builtin_amdgcn_readlane(__float_as_uint(hmax), 16);
            const unsigned a2 = __builtin_amdgcn_readlane(__float_as_uint(hmax), 32), a3 = __builtin_amdgcn_readlane(__float_as_uint(hmax), 48);
            const unsigned m01 = a0 > a1 ? a0 : a1, m23 = a2 > a3 ? a2 : a3; const float am = __uint_as_float(m01 > m23 ? m01 : m23);
            const float QT = U_INT4 ? 119.f : 127.f;
            const float inv = am > 0.f ? QT / am : 0.f;
#pragma unroll
            for (int j = 0; j < 8; ++j) {
                *(unsigned*)(H2Q + (size_t)t * D + j * 256 + c.lane * 4) = pack_i8x4(v[j] * inv);
                if (U_INT4) {
                    const float M = 12582912.f;
                    const unsigned b0 = __float_as_uint(v[j].x * inv + M), b1 = __float_as_uint(v[j].y * inv + M), b2 = __float_as_uint(v[j].z * inv + M), b3 = __float_as_uint(v[j].w * inv + M);
                    const unsigned lo = (b0 & 15u) | ((b1 & 15u) << 4) | ((b2 & 15u) << 8) | ((b3 & 15u) << 12);
                    const unsigned hi = (((b0 + 8u) >> 4) & 15u) | ((((b1 + 8u) >> 4) & 15u) << 4) | ((((b2 + 8u) >> 4) & 15u) << 8) | ((((b3 + 8u) >> 4) & 15u) << 12);
                    *(unsigned*)(WSP(unsigned char, WS_H2N) + (size_t)t * D + j * 256 + c.lane * 4) = lo | (hi << 16);
                }
            }
            if (c.lane == 0) HS[t] = am * (1.f / QT);
        }
#pragma unroll
        for (int j = 0; j < 8; ++j) { xc[j] = xn[j]; gc[j] = gn[j]; }
    }
#undef LN1_LOAD
}

__device__ __forceinline__ void argmax_bfly(float& bv, int& bi) {
#pragma unroll
    for (int off = 32; off >= 1; off >>= 1) {
        const float ov = __shfl_xor(bv, off); const int oi = __shfl_xor(bi, off);
        if (ov > bv || (ov == bv && oi < bi)) { bv = ov; bi = oi; }
    }
}
__device__ __forceinline__ void step_topk_simple(const Ctx& c) {
    const bf16_t* Q = WSP(bf16_t, WS_PROJ); const bf16_t* KEYS = WSP(bf16_t, WS_KEYS); int* EXPERT = WSP(int, WS_EXP); float* GATE = WSP(float, WS_GATE);
    const int lane = c.lane; const float NEG = -__builtin_huge_valf();
    for (int item = c.gw; item < T * 8; item += c.ngw) {
        const int t = item >> 3, h = item & 7;
        const bf16_t* qrow = Q + (size_t)t * D + h * 256;
        float tv[2] = {0.f, 0.f}; int ti[2] = {0, 0};
#pragma unroll
        for (int cc = 0; cc < 2; ++cc) {
            float v0 = 0.f, v1 = 0.f;
            const bf16_t* k0 = KEYS + ((size_t)(h * 2 + cc) * 128 + lane) * 128; const bf16_t* k1 = k0 + 64 * 128;
            for (int d = 0; d < 128; d += 8) { const u32x4 qv = *(const u32x4*)(qrow + cc * 128 + d); v0 += dot8(qv, *(const u32x4*)(k0 + d)); v1 += dot8(qv, *(const u32x4*)(k1 + d)); }
            for (int r = 0; r < 16; ++r) {
                float bv = v0; int bi = lane; if (v1 > bv) { bv = v1; bi = lane + 64; }
                argmax_bfly(bv, bi);
                if (lane == r) { tv[cc] = bv; ti[cc] = bi; }
                if (bi == lane) v0 = NEG; if (bi == lane + 64) v1 = NEG;
            }
        }
        float cv[4]; const int ci0 = lane * 4;
#pragma unroll
        for (int q = 0; q < 4; ++q) { const int ci = ci0 + q; cv[q] = __shfl(tv[0], ci >> 4) + __shfl(tv[1], ci & 15); }
        float bestv = 0.f; int bestp = 0;
        for (int r = 0; r < 16; ++r) {
            float bv = cv[0]; int bi = ci0;
#pragma unroll
            for (int q = 1; q < 4; ++q) if (cv[q] > bv) { bv = cv[q]; bi = ci0 + q; }
            argmax_bfly(bv, bi);
            if (lane == r) { bestv = bv; bestp = bi; }
#pragma unroll
            for (int q = 0; q < 4; ++q) if (bi == ci0 + q) cv[q] = NEG;
        }
        const float mx = __shfl(bestv, 0);
        const float e = lane < 16 ? fexp(bestv - mx) : 0.f; const float ssum = wave_sum(e);
        const int e0 = __shfl(ti[0], bestp >> 4), e1 = __shfl(ti[1], bestp & 15);
        if (lane < 16) { EXPERT[(size_t)item * 16 + lane] = e0 * 128 + e1; GATE[(size_t)item * 16 + lane] = e / ssum; }
    }
}

#define TK_CE(a, b) { const int t_ = max(a, b); b = min(a, b); a = t_; }
__device__ __forceinline__ int tk_mono(float x) { int b = __float_as_int(x); return b ^ ((b >> 31) & 0x7fffffff); }
__device__ __forceinline__ float tk_val(int key, int mask) { int b = key & ~mask; b ^= (b >> 31) & 0x7fffffff; return __int_as_float(b); }
__device__ __forceinline__ void tk_sort16(int (&k)[16]) {
#pragma unroll
    for (int size = 2; size <= 16; size <<= 1)
#pragma unroll
        for (int stride = size >> 1; stride > 0; stride >>= 1)
#pragma unroll
            for (int i = 0; i < 16; ++i) { const int j = i ^ stride; if (j > i) { if ((i & size) == 0) TK_CE(k[i], k[j]) else TK_CE(k[j], k[i]) } }
}
__device__ __forceinline__ void tk_clean16(int (&k)[16]) {
#pragma unroll
    for (int stride = 8; stride > 0; stride >>= 1)
#pragma unroll
        for (int i = 0; i < 16; ++i) { const int j = i ^ stride; if (j > i) TK_CE(k[i], k[j]) }
}
__device__ __forceinline__ void tk_merge16(int (&a)[16], const int (&b)[16]) {
#pragma unroll
    for (int i = 0; i < 16; ++i) a[i] = max(a[i], b[15 - i]);
    tk_clean16(a);
}
__device__ __forceinline__ void topk_groups(const Ctx& c, const int h, const int grp_first, const int grp_end, const int grp_step) {
    const bf16_t* Q = WSP(bf16_t, WS_PROJ); const bf16_t* KEYS = WSP(bf16_t, WS_KEYS); int* EXPERT = WSP(int, WS_EXP); float* GATE = WSP(float, WS_GATE);
    const int lane = c.lane, col = lane & 31, hh = lane >> 5;
    constexpr int KP = 272;
    LAS unsigned char* kl = c.lds;
    LAS int* tab = (LAS int*)(c.lds + 256 * KP) + c.wave * (32 * 33);
    __syncthreads();
    for (int i = c.tid; i < 256 * 16; i += NTHR) { const int r = i >> 4, ch = i & 15;
        *(LAS u32x4*)(kl + r * KP + ch * 16) = *(const u32x4*)(KEYS + ((size_t)h * 256 + r) * 128 + ch * 8); }
    __syncthreads();
    const int INTMIN = (int)0x80000000;
    for (int grp = grp_first; grp < grp_end; grp += grp_step) {
        const int t0 = grp * 32;
        int top[2][16];
#pragma unroll
        for (int cc = 0; cc < 2; ++cc) {
            bf16x8v qf[8];
            const bf16_t* qp = Q + (size_t)(t0 + col) * D + h * 256 + cc * 128 + hh * 8;
#pragma unroll
            for (int ks = 0; ks < 8; ++ks) qf[ks] = __builtin_bit_cast(bf16x8v, *(const u32x4*)(qp + ks * 16));
            int k[4][16];
#pragma unroll
            for (int nt = 0; nt < 4; ++nt) {
                f32x16 acc;
#pragma unroll
                for (int r = 0; r < 16; ++r) acc[r] = 0.f;
#pragma unroll
                for (int ks = 0; ks < 8; ++ks) {
                    const bf16x8v af = __builtin_bit_cast(bf16x8v, *(const LAS u32x4*)(kl + (cc * 128 + nt * 32 + col) * KP + ks * 32 + hh * 16));
                    acc = __builtin_amdgcn_mfma_f32_32x32x16_bf16(af, qf[ks], acc, 0, 0, 0);
                }
#pragma unroll
                for (int r = 0; r < 16; ++r) k[nt][r] = (tk_mono(acc[r]) & ~127) | (nt * 32 + (r & 3) + 8 * (r >> 2) + 4 * hh);
                tk_sort16(k[nt]);
            }
            tk_merge16(k[0], k[1]); tk_merge16(k[2], k[3]); tk_merge16(k[0], k[2]);
            int p[16];
#pragma unroll
            for (int i = 0; i < 16; ++i) p[i] = __shfl_xor(k[0][15 - i], 32);
#pragma unroll
            for (int i = 0; i < 16; ++i) k[0][i] = max(k[0][i], p[i]);
            tk_clean16(k[0]);
#pragma unroll
            for (int i = 0; i < 16; ++i) top[cc][i] = k[0][i];
        }
        if (hh == 0) {
#pragma unroll
            for (int i = 0; i < 16; ++i) { tab[col * 33 + i] = top[0][i] & 127; tab[col * 33 + 16 + i] = top[1][i] & 127; }
        }
        float va[16], vb[16];
#pragma unroll
        for (int i = 0; i < 16; ++i) { va[i] = tk_val(top[0][i], 127); vb[i] = tk_val(top[1][i], 127); }
#define TK_CAND(i, j) ((tk_mono(va[i] + vb[j]) & ~255) | ((i) * 16 + (j)))
        int m[16], l1[16], l3[16], l4[16];
#pragma unroll
        for (int j = 0; j < 16; ++j) m[j] = TK_CAND(0, j);
#pragma unroll
        for (int j = 0; j < 8; ++j) l1[j] = TK_CAND(1, j);
#pragma unroll
        for (int j = 8; j < 16; ++j) l1[j] = INTMIN;
        tk_merge16(m, l1);
        l3[0] = TK_CAND(2, 0); l3[1] = TK_CAND(2, 1); l3[2] = TK_CAND(2, 2); l3[3] = TK_CAND(2, 3); l3[4] = TK_CAND(2, 4);
        l3[5] = TK_CAND(3, 0); l3[6] = TK_CAND(3, 1); l3[7] = TK_CAND(3, 2); l3[8] = TK_CAND(3, 3);
        l3[9] = TK_CAND(4, 0); l3[10] = TK_CAND(4, 1); l3[11] = TK_CAND(4, 2);
        l3[12] = TK_CAND(5, 0); l3[13] = TK_CAND(5, 1); l3[14] = TK_CAND(6, 0); l3[15] = TK_CAND(6, 1);
        tk_sort16(l3); tk_merge16(m, l3);
        l4[0] = TK_CAND(7, 0); l4[1] = TK_CAND(7, 1);
#pragma unroll
        for (int i = 8; i < 16; ++i) l4[i - 6] = TK_CAND(i, 0);
#pragma unroll
        for (int i = 10; i < 16; ++i) l4[i] = INTMIN;
        tk_sort16(l4); tk_merge16(m, l4);
#undef TK_CAND
        float ev[16]; float ssum = 0.f; const float mx = tk_val(m[0], 255);
#pragma unroll
        for (int r = 0; r < 16; ++r) { ev[r] = fexp(tk_val(m[r], 255) - mx); ssum += ev[r]; }
        const float inv = 1.f / ssum;
#if SLICED_PEER
        const size_t ob = (size_t)(t0 + col) * 128 + 2 * h;
        if (hh == 0) {
            int eo[16];
#pragma unroll
            for (int r = 0; r < 16; ++r) { const int code = m[r] & 255; eo[r] = tab[col * 33 + (code >> 4)] * 128 + tab[col * 33 + 16 + (code & 15)]; }
#pragma unroll
            for (int g = 0; g < 8; ++g) *(u32x2*)(EXPERT + ob + g * 16) = (u32x2){(unsigned)eo[g], (unsigned)eo[g + 8]};
        } else {
#pragma unroll
            for (int g = 0; g < 8; ++g) *(f32x2*)(GATE + ob + g * 16) = (f32x2){ev[g] * inv, ev[g + 8] * inv};
        }
#else
        const size_t ob = ((size_t)(t0 + col) * 8 + h) * 16;
        if (hh == 0) {
            int eo[16];
#pragma unroll
            for (int r = 0; r < 16; ++r) { const int code = m[r] & 255; eo[r] = tab[col * 33 + (code >> 4)] * 128 + tab[col * 33 + 16 + (code & 15)]; }
#pragma unroll
            for (int q = 0; q < 4; ++q) *(u32x4*)(EXPERT + ob + 4 * q) = (u32x4){(unsigned)eo[4 * q], (unsigned)eo[4 * q + 1], (unsigned)eo[4 * q + 2], (unsigned)eo[4 * q + 3]};
        } else {
#pragma unroll
            for (int q = 0; q < 4; ++q) *(f32x4*)(GATE + ob + 4 * q) = (f32x4){ev[4 * q] * inv, ev[4 * q + 1] * inv, ev[4 * q + 2] * inv, ev[4 * q + 3] * inv};
        }
#endif
    }
    __syncthreads();
}

__device__ __forceinline__ void step_topk_fast(const Ctx& c) {
    const int nper = (int)gridDim.x >> 3;
    topk_groups(c, (int)blockIdx.x & 7, (int)(blockIdx.x >> 3) + nper * c.wave, T / 32, nper * NWAVES);
}

#define PEER_LOAD(buf, TAB, kbase) { _Pragma("unroll") for (int u_ = 0; u_ < 4; ++u_) { const int k_ = (kbase) + u_; \
        const int e_ = __builtin_amdgcn_readlane(k_ < 64 ? er0 : er1, k_ & 63); const unsigned char* rp_ = (TAB) + (size_t)e_ * D + lane * 16; \
        buf[u_][0] = *(const u32x4*)rp_; buf[u_][1] = *(const u32x4*)(rp_ + 1024); } }
#define PEER_DOT(buf, kbase) { _Pragma("unroll") for (int u_ = 0; u_ < 4; ++u_) { f32x2 a2_ = {0.f, 0.f}; \
        _Pragma("unroll") for (int j_ = 0; j_ < 2; ++j_) _Pragma("unroll") for (int q_ = 0; q_ < 4; ++q_) { const int w_ = (int)buf[u_][j_][q_]; \
            a2_ += __builtin_amdgcn_cvt_pk_f32_fp8(w_, false) * hh[j_ * 8 + q_ * 2]; a2_ += __builtin_amdgcn_cvt_pk_f32_fp8(w_, true) * hh[j_ * 8 + q_ * 2 + 1]; } \
        const float tot_ = lane63(wave_sum63(a2_.x + a2_.y)); const int k_ = (kbase) + u_; \
        if (k_ < 64) ar0 = (lane == k_) ? tot_ : ar0; else ar1 = (lane == k_ - 64) ? tot_ : ar1; } }
#define PEER_AXPY(buf, kbase) { _Pragma("unroll") for (int u_ = 0; u_ < 4; ++u_) { const int k_ = (kbase) + u_; \
        const float w1_ = __int_as_float(__builtin_amdgcn_readlane(__float_as_int(k_ < 64 ? wr0 : wr1), k_ & 63)); const f32x2 ww_ = {w1_, w1_}; \
        _Pragma("unroll") for (int j_ = 0; j_ < 2; ++j_) _Pragma("unroll") for (int q_ = 0; q_ < 4; ++q_) { const int w_ = (int)buf[u_][j_][q_]; \
            yy[j_ * 8 + q_ * 2] += __builtin_amdgcn_cvt_pk_f32_fp8(w_, false) * ww_; yy[j_ * 8 + q_ * 2 + 1] += __builtin_amdgcn_cvt_pk_f32_fp8(w_, true) * ww_; } } }
__device__ __forceinline__ void step_peer(const Ctx& c) {
    const bf16_t* H2 = WSP(bf16_t, WS_ACT); const unsigned char* U8 = WSP(unsigned char, WS_UB); const unsigned char* V8 = WSP(unsigned char, WS_VB);
    const float* SCU = WSP(float, WS_SCU); const float* SCV = WSP(float, WS_SCV);
    const int* EXPERT = WSP(int, WS_EXP); const float* GATE = WSP(float, WS_GATE); const float* MOD = WSP(float, WS_MOD);
    const int lane = c.lane;
    for (int t = c.gw; t < T; t += c.ngw) {
        const int er0 = EXPERT[(size_t)t * 128 + lane], er1 = EXPERT[(size_t)t * 128 + 64 + lane];
        const float gr0 = GATE[(size_t)t * 128 + lane], gr1 = GATE[(size_t)t * 128 + 64 + lane];
        const float su0 = SCU[er0], su1 = SCU[er1], sv0 = SCV[er0], sv1 = SCV[er1];
        f32x2 hh[16];
#pragma unroll
        for (int j = 0; j < 2; ++j)
#pragma unroll
            for (int q = 0; q < 2; ++q) { const u32x4 v = *(const u32x4*)(H2 + (size_t)t * D + j * 1024 + lane * 16 + q * 8);
                hh[j * 8 + q * 4 + 0] = (f32x2){bflo(v.x), bfhi(v.x)}; hh[j * 8 + q * 4 + 1] = (f32x2){bflo(v.y), bfhi(v.y)};
                hh[j * 8 + q * 4 + 2] = (f32x2){bflo(v.z), bfhi(v.z)}; hh[j * 8 + q * 4 + 3] = (f32x2){bflo(v.w), bfhi(v.w)}; }
        float ar0 = 0.f, ar1 = 0.f;
        u32x4 A[4][2], B[4][2];
        PEER_LOAD(A, U8, 0);
        for (int kb = 0; kb < 128; kb += 8) {
            PEER_LOAD(B, U8, kb + 4);
            PEER_DOT(A, kb);
            if (kb + 8 < 128) PEER_LOAD(A, U8, kb + 8) else PEER_LOAD(A, V8, 0);
            PEER_DOT(B, kb + 4);
        }
        const float wr0 = gr0 * gelu_f(ar0 * su0) * sv0, wr1 = gr1 * gelu_f(ar1 * su1) * sv1;
        f32x2 yy[16];
#pragma unroll
        for (int i = 0; i < 16; ++i) yy[i] = (f32x2){0.f, 0.f};
        for (int kb = 0; kb < 128; kb += 8) {
            PEER_LOAD(B, V8, kb + 4);
            PEER_AXPY(A, kb);
            if (kb + 8 < 128) PEER_LOAD(A, V8, kb + 8);
            PEER_AXPY(B, kb + 4);
        }
        const int b = t >> 12; float* row = c.out + (size_t)t * D; const float* g2 = MOD + b * NMOD + 5 * D;
        float s = 0.f;
#pragma unroll
        for (int j = 0; j < 2; ++j)
#pragma unroll
            for (int q = 0; q < 4; ++q) {
                const int col = j * 1024 + lane * 16 + q * 4; const f32x4 xv = *(const f32x4*)(row + col), gv = *(const f32x4*)(g2 + col);
                f32x2& y0 = yy[j * 8 + q * 2]; f32x2& y1 = yy[j * 8 + q * 2 + 1];
                y0.x = ALPHA * xv.x + gv.x * y0.x; y0.y = ALPHA * xv.y + gv.y * y0.y; y1.x = ALPHA * xv.z + gv.z * y1.x; y1.y = ALPHA * xv.w + gv.w * y1.y;
                s += (y0.x + y0.y) + (y1.x + y1.y);
            }
        const float mean = wave_sum(s) * (1.f / D); float s2 = 0.f;
#pragma unroll
        for (int i = 0; i < 16; ++i) { yy[i] = yy[i] - mean; s2 += yy[i].x * yy[i].x + yy[i].y * yy[i].y; }
        const float rstd = rsqrtf(wave_sum(s2) * (1.f / D) + EPS);
#pragma unroll
        for (int j = 0; j < 2; ++j)
#pragma unroll
            for (int q = 0; q < 4; ++q) {
                const int col = j * 1024 + lane * 16 + q * 4; const f32x4 g = *(const f32x4*)(IN_LN2G + col), bb = *(const f32x4*)(IN_LN2B + col);
                const f32x2 y0 = yy[j * 8 + q * 2], y1 = yy[j * 8 + q * 2 + 1];
                *(f32x4*)(row + col) = (f32x4){y0.x * rstd * g.x + bb.x, y0.y * rstd * g.y + bb.y, y1.x * rstd * g.z + bb.z, y1.y * rstd * g.w + bb.w};
            }
    }
}

struct XcdPlace { int nloc, nx, xrank, rank; };
__device__ __forceinline__ float reduce8(float v) { v += DPPF(v, 0xB1); v += DPPF(v, 0x4E); v += DPPF(v, 0x141); return v; }
struct Sel8 { unsigned long long m1, m2, m4; };
__device__ __forceinline__ float cnd(float a, float b, unsigned long long m) { float r; asm("v_cndmask_b32 %0, %1, %2, %3" : "=v"(r) : "v"(a), "v"(b), "s"(m)); return r; }
__device__ __forceinline__ float sel8(const Sel8& S, float p0, float p1, float p2, float p3, float p4, float p5, float p6, float p7) {
    const float a0 = cnd(p0, p1, S.m1), a1 = cnd(p2, p3, S.m1), a2 = cnd(p4, p5, S.m1), a3 = cnd(p6, p7, S.m1);
    return cnd(cnd(a0, a1, S.m2), cnd(a2, a3, S.m2), S.m4);
}
#define PS_GATHER(buf, ids, tabp) { _Pragma("unroll") for (int q_ = 0; q_ < 4; ++q_) { \
        buf[4 * q_ + 0] = *(const u32x4*)((tabp) + (ids[q_].x * 128u + c16)); buf[4 * q_ + 1] = *(const u32x4*)((tabp) + (ids[q_].y * 128u + c16)); \
        buf[4 * q_ + 2] = *(const u32x4*)((tabp) + (ids[q_].z * 128u + c16)); buf[4 * q_ + 3] = *(const u32x4*)((tabp) + (ids[q_].w * 128u + c16)); } }
#define PS_IDS(ids, tok) { _Pragma("unroll") for (int q_ = 0; q_ < 4; ++q_) ids[q_] = *(const u32x4*)(EP + (size_t)(tok) * 128 + g * 16 + q_ * 4); }
__device__ __forceinline__ int cndi(int a, int b, unsigned long long m) { int r; asm("v_cndmask_b32 %0, %1, %2, %3" : "=v"(r) : "v"(a), "v"(b), "s"(m)); return r; }
__device__ __forceinline__ int sel8i(const Sel8& S, int p0, int p1, int p2, int p3, int p4, int p5, int p6, int p7) {
    const int a0 = cndi(p0, p1, S.m1), a1 = cndi(p2, p3, S.m1), a2 = cndi(p4, p5, S.m1), a3 = cndi(p6, p7, S.m1);
    return cndi(cndi(a0, a1, S.m2), cndi(a2, a3, S.m2), S.m4);
}
#define DPPI(v, ctrl) __builtin_amdgcn_update_dpp(0, (v), (ctrl), 0xF, 0xF, true)
__device__ __forceinline__ int reduce8i(int v) { v += DPPI(v, 0xB1); v += DPPI(v, 0x4E); v += DPPI(v, 0x141); return v; }
#if U_INT4
#define PU_PROCESS(buf, tok) { \
        const u32x4 ha_ = *(const u32x4*)(H2N + (size_t)(tok) * D + slice * 256 + c8 * 32), hb_ = *(const u32x4*)(H2N + (size_t)(tok) * D + slice * 256 + c8 * 32 + 16); \
        const int l0_ = (int)__builtin_amdgcn_perm(ha_.y, ha_.x, 0x05040100u), h0_ = (int)__builtin_amdgcn_perm(ha_.y, ha_.x, 0x07060302u); \
        const int l1_ = (int)__builtin_amdgcn_perm(ha_.w, ha_.z, 0x05040100u), h1_ = (int)__builtin_amdgcn_perm(ha_.w, ha_.z, 0x07060302u); \
        const int l2_ = (int)__builtin_amdgcn_perm(hb_.y, hb_.x, 0x05040100u), h2_ = (int)__builtin_amdgcn_perm(hb_.y, hb_.x, 0x07060302u); \
        const int l3_ = (int)__builtin_amdgcn_perm(hb_.w, hb_.z, 0x05040100u), h3_ = (int)__builtin_amdgcn_perm(hb_.w, hb_.z, 0x07060302u); \
        int p_[16]; \
        _Pragma("unroll") for (int i_ = 0; i_ < 16; ++i_) { \
            int al_ = __builtin_amdgcn_sdot8((int)buf[i_].x, l0_, 0, false); al_ = __builtin_amdgcn_sdot8((int)buf[i_].y, l1_, al_, false); \
            al_ = __builtin_amdgcn_sdot8((int)buf[i_].z, l2_, al_, false); al_ = __builtin_amdgcn_sdot8((int)buf[i_].w, l3_, al_, false); \
            int ah_ = __builtin_amdgcn_sdot8((int)buf[i_].x, h0_, 0, false); ah_ = __builtin_amdgcn_sdot8((int)buf[i_].y, h1_, ah_, false); \
            ah_ = __builtin_amdgcn_sdot8((int)buf[i_].z, h2_, ah_, false); ah_ = __builtin_amdgcn_sdot8((int)buf[i_].w, h3_, ah_, false); \
            p_[i_] = reduce8i(al_ + (ah_ << 4)); } \
        const int lo_ = sel8i(SL, p_[0], p_[1], p_[2], p_[3], p_[4], p_[5], p_[6], p_[7]), hi_ = sel8i(SL, p_[8], p_[9], p_[10], p_[11], p_[12], p_[13], p_[14], p_[15]); \
        PARTA[((size_t)slice * T + (tok)) * 64 + lane] = (int)((((unsigned)(lo_ + 4) >> 3) & 0xffffu) | ((unsigned)((hi_ + 4) >> 3) << 16)); }
constexpr int NSLU = 8;
#else
#define PU_PROCESS(buf, tok) { \
        const u32x4 hq_ = *(const u32x4*)(H2Q + (size_t)(tok) * D + slice * 128 + c16); \
        int p_[16]; \
        _Pragma("unroll") for (int i_ = 0; i_ < 16; ++i_) { int a_ = __builtin_amdgcn_sdot4((int)buf[i_].x, (int)hq_.x, 0, false); \
            a_ = __builtin_amdgcn_sdot4((int)buf[i_].y, (int)hq_.y, a_, false); a_ = __builtin_amdgcn_sdot4((int)buf[i_].z, (int)hq_.z, a_, false); a_ = __builtin_amdgcn_sdot4((int)buf[i_].w, (int)hq_.w, a_, false); \
            p_[i_] = reduce8i(a_); } \
        const int lo_ = sel8i(SL, p_[0], p_[1], p_[2], p_[3], p_[4], p_[5], p_[6], p_[7]), hi_ = sel8i(SL, p_[8], p_[9], p_[10], p_[11], p_[12], p_[13], p_[14], p_[15]); \
        if (PART16) {   \
            PARTA[((size_t)slice * T + (tok)) * 64 + lane] = (int)((((unsigned)(lo_ + 32) >> 6) & 0xffffu) | ((unsigned)((hi_ + 32) >> 6) << 16)); \
        } else { int* o_ = PARTA + ((size_t)slice * T + (tok)) * 128 + g * 16 + c8; o_[0] = lo_; o_[8] = hi_; } }
constexpr int NSLU = 16;
#endif
__device__ __forceinline__ void step_peer_u(const Ctx& c, const XcdPlace& P) {
    const unsigned char* H2Q = WSP(unsigned char, WS_H2Q); const unsigned char* H2N = WSP(unsigned char, WS_H2N); const unsigned char* U8 = WSP(unsigned char, WS_UB); const int* EP = WSP(int, WS_EXP); int* PARTA = WSP(int, WS_PARTA);
    (void)H2Q; (void)H2N;
    const int lane = c.lane, g = lane >> 3, c8 = lane & 7, wid = P.rank * NWAVES + c.wave, nw = P.nloc * NWAVES;
    const Sel8 SL{__ballot((c8 & 1) != 0), __ballot((c8 & 2) != 0), __ballot((c8 & 4) != 0)};
    const unsigned c16 = (unsigned)c8 * 16u;
    for (int slice = P.xrank; slice < NSLU; slice += P.nx) {
        const unsigned char* ub = U8 + (size_t)slice * 16384 * 128;
        u32x4 idn[4]; u32x4 A[16], B[16];
        int t = wid;
        if (t < T) { PS_IDS(idn, t); PS_GATHER(A, idn, ub); }
        if (t + nw < T) { PS_IDS(idn, t + nw); PS_GATHER(B, idn, ub); }
        for (; t < T; t += 2 * nw) {
            if (t + 2 * nw < T) PS_IDS(idn, t + 2 * nw);
            PU_PROCESS(A, t);
            if (t + 2 * nw < T) { PS_GATHER(A, idn, ub); }
            if (t + nw < T) {
                if (t + 3 * nw < T) PS_IDS(idn, t + 3 * nw);
                PU_PROCESS(B, t + nw);
                if (t + 3 * nw < T) { PS_GATHER(B, idn, ub); }
            }
        }
    }
}
#if V_INT8
__device__ __forceinline__ void step_peer_w(const Ctx& c) {
    const int* PARTA = WSP(int, WS_PARTA); const int* EP = WSP(int, WS_EXP); const float* G = WSP(float, WS_GATE); unsigned* W8 = WSP(unsigned, WS_W8);
    const float* SCU = WSP(float, WS_SCU); const float* SCV = WSP(float, WS_SCV); const float* HS = WSP(float, WS_HS); float* WSC = WSP(float, WS_WS);
    const int g = c.lane >> 3, c8 = c.lane & 7, i0 = g * 16 + c8, i1 = i0 + 8;
    for (int t = c.gw; t < T; t += c.ngw) {
        int a0 = 0, a1 = 0;
#if PART16
#pragma unroll
        for (int sl = 0; sl < NSLU; ++sl) { const int p = PARTA[((size_t)sl * T + t) * 64 + c.lane]; a0 += (int)(short)(p & 0xffff); a1 += p >> 16; }
        const float descale = U_INT4 ? 8.f : 64.f;
#else
#pragma unroll
        for (int sl = 0; sl < 16; ++sl) { a0 += PARTA[((size_t)sl * T + t) * 128 + i0]; a1 += PARTA[((size_t)sl * T + t) * 128 + i1]; }
        const float descale = 1.f;
#endif
        const size_t base = (size_t)t * 128;
        const int e0 = EP[base + i0], e1 = EP[base + i1]; const float g0 = G[base + i0], g1 = G[base + i1], hs = HS[t] * descale;
        const float w0 = g0 * gelu_f((float)a0 * (SCU[e0] * hs)) * SCV[e0], w1 = g1 * gelu_f((float)a1 * (SCU[e1] * hs)) * SCV[e1];
        float am = fmaxf(fabsf(w0), fabsf(w1));
        am = DPPMAX(am, 0xB1); am = DPPMAX(am, 0x4E); am = DPPMAX(am, 0x141); am = DPPMAX(am, 0x140);
        const unsigned m0 = __builtin_amdgcn_readlane(__float_as_uint(am), 0), m1 = __builtin_amdgcn_readlane(__float_as_uint(am), 16), m2 = __builtin_amdgcn_readlane(__float_as_uint(am), 32), m3 = __builtin_amdgcn_readlane(__float_as_uint(am), 48);
        const unsigned m01 = m0 > m1 ? m0 : m1, m23 = m2 > m3 ? m2 : m3; am = __uint_as_float(m01 > m23 ? m01 : m23);
        const float inv = am > 0.f ? 127.f / am : 0.f;
        const int q0 = (int)__builtin_rintf(w0 * inv) & 0xff, q1 = (int)__builtin_rintf(w1 * inv) & 0xff;
        const int pk = q0 | (q1 << 8);
        const int b0 = DPPI(pk, 0x00), b1 = DPPI(pk, 0x55), b2 = DPPI(pk, 0xAA), b3 = DPPI(pk, 0xFF);
        const unsigned dlo = (unsigned)(b0 & 0xff) | ((unsigned)(b1 & 0xff) << 8) | ((unsigned)(b2 & 0xff) << 16) | ((unsigned)(b3 & 0xff) << 24);
        const unsigned dhi = ((unsigned)(b0 >> 8) & 0xff) | (((unsigned)(b1 >> 8) & 0xff) << 8) | (((unsigned)(b2 >> 8) & 0xff) << 16) | (((unsigned)(b3 >> 8) & 0xff) << 24);
        if ((c.lane & 3) == 0) { W8[(size_t)t * 32 + g * 4 + (c8 >> 2)] = dlo; W8[(size_t)t * 32 + g * 4 + 2 + (c8 >> 2)] = dhi; }
        if (c.lane == 0) WSC[t] = am * (1.f / 127.f);
    }
}
#else
__device__ __forceinline__ void step_peer_w(const Ctx& c) {
    const int* PARTA = WSP(int, WS_PARTA); const int* EP = WSP(int, WS_EXP); float* GW = WSP(float, WS_GATE); const float* SCU = WSP(float, WS_SCU); const float* SCV = WSP(float, WS_SCV); const float* HS = WSP(float, WS_HS);
    for (int idx = c.gt; idx < T * 128; idx += c.ngt) {
        int a = 0;
#pragma unroll
        for (int sl = 0; sl < 16; ++sl) a += PARTA[(size_t)sl * T * 128 + idx];
        const int e = EP[idx];
        GW[idx] = GW[idx] * gelu_f((float)a * (SCU[e] * HS[idx >> 7])) * SCV[e];
    }
}
#endif
#if V_INT8
#define PV_PROCESS(buf, tok) { \
        const u32x4 wq_ = *(const u32x4*)(W8 + (size_t)(tok) * 32 + g * 4); const float wsc_ = WSC[tok]; \
        int acc_[16]; _Pragma("unroll") for (int q_ = 0; q_ < 16; ++q_) acc_[q_] = 0; \
        _Pragma("unroll") for (int j_ = 0; j_ < 4; ++j_) { const int w4_ = (int)wq_[j_]; \
            _Pragma("unroll") for (int q_ = 0; q_ < 4; ++q_) { \
                const unsigned a_ = buf[4 * j_][q_], b_ = buf[4 * j_ + 1][q_], c_ = buf[4 * j_ + 2][q_], d_ = buf[4 * j_ + 3][q_]; \
                const unsigned tl_ = __builtin_amdgcn_perm(b_, a_, 0x05010400u), th_ = __builtin_amdgcn_perm(b_, a_, 0x07030602u); \
                const unsigned ul_ = __builtin_amdgcn_perm(d_, c_, 0x05010400u), uh_ = __builtin_amdgcn_perm(d_, c_, 0x07030602u); \
                acc_[4 * q_ + 0] = __builtin_amdgcn_sdot4((int)__builtin_amdgcn_perm(ul_, tl_, 0x05040100u), w4_, acc_[4 * q_ + 0], false); \
                acc_[4 * q_ + 1] = __builtin_amdgcn_sdot4((int)__builtin_amdgcn_perm(ul_, tl_, 0x07060302u), w4_, acc_[4 * q_ + 1], false); \
                acc_[4 * q_ + 2] = __builtin_amdgcn_sdot4((int)__builtin_amdgcn_perm(uh_, th_, 0x05040100u), w4_, acc_[4 * q_ + 2], false); \
                acc_[4 * q_ + 3] = __builtin_amdgcn_sdot4((int)__builtin_amdgcn_perm(uh_, th_, 0x07060302u), w4_, acc_[4 * q_ + 3], false); } } \
        int p_[16]; \
        _Pragma("unroll") for (int q_ = 0; q_ < 16; ++q_) p_[q_] = acc_[q_] + DPPI(acc_[q_], 0x128); \
        int q8_[8]; \
        _Pragma("unroll") for (int k_ = 0; k_ < 8; ++k_) { const auto r_ = __builtin_amdgcn_permlane16_swap((unsigned)p_[k_], (unsigned)p_[k_ + 8], false, false); q8_[k_] = (int)r_[0] + (int)r_[1]; } \
        int r4_[4]; \
        _Pragma("unroll") for (int k_ = 0; k_ < 4; ++k_) { const auto r_ = __builtin_amdgcn_permlane32_swap((unsigned)q8_[k_], (unsigned)q8_[k_ + 4], false, false); r4_[k_] = (int)r_[0] + (int)r_[1]; } \
        if ((lane & 8) == 0) *(u32x2*)(Y + (size_t)(tok) * D + slice * 128 + ocol) = (u32x2){cvtpk((float)r4_[0] * wsc_, (float)r4_[1] * wsc_), cvtpk((float)r4_[2] * wsc_, (float)r4_[3] * wsc_)}; }
#else
#define PV_PROCESS(buf, tok) { \
        f32x4 wv_[4]; _Pragma("unroll") for (int q_ = 0; q_ < 4; ++q_) wv_[q_] = *(const f32x4*)(GW + (size_t)(tok) * 128 + g * 16 + q_ * 4); \
        f32x2 acc_[8]; _Pragma("unroll") for (int q_ = 0; q_ < 8; ++q_) acc_[q_] = (f32x2){0.f, 0.f}; \
        _Pragma("unroll") for (int i_ = 0; i_ < 16; ++i_) { const float w1_ = wv_[i_ >> 2][i_ & 3]; const f32x2 ww_ = {w1_, w1_}; \
            _Pragma("unroll") for (int q_ = 0; q_ < 4; ++q_) { const int w_ = (int)buf[i_][q_]; acc_[2 * q_] += __builtin_amdgcn_cvt_pk_f32_fp8(w_, false) * ww_; acc_[2 * q_ + 1] += __builtin_amdgcn_cvt_pk_f32_fp8(w_, true) * ww_; } } \
        float p_[16]; \
        _Pragma("unroll") for (int q_ = 0; q_ < 8; ++q_) { p_[2 * q_] = acc_[q_].x + DPPF(acc_[q_].x, 0x128); p_[2 * q_ + 1] = acc_[q_].y + DPPF(acc_[q_].y, 0x128); } \
        float q8_[8]; \
        _Pragma("unroll") for (int k_ = 0; k_ < 8; ++k_) { const auto r_ = __builtin_amdgcn_permlane16_swap(__float_as_uint(p_[k_]), __float_as_uint(p_[k_ + 8]), false, false); q8_[k_] = __uint_as_float(r_[0]) + __uint_as_float(r_[1]); } \
        float r4_[4]; \
        _Pragma("unroll") for (int k_ = 0; k_ < 4; ++k_) { const auto r_ = __builtin_amdgcn_permlane32_swap(__float_as_uint(q8_[k_]), __float_as_uint(q8_[k_ + 4]), false, false); r4_[k_] = __uint_as_float(r_[0]) + __uint_as_float(r_[1]); } \
        if ((lane & 8) == 0) *(u32x2*)(Y + (size_t)(tok) * D + slice * 128 + ocol) = (u32x2){cvtpk(r4_[0], r4_[1]), cvtpk(r4_[2], r4_[3])}; }
#endif
__device__ __forceinline__ void step_peer_v(const Ctx& c, const XcdPlace& P) {
    const unsigned char* V8 = WSP(unsigned char, WS_VB); const int* EP = WSP(int, WS_EXP); const float* GW = WSP(float, WS_GATE); bf16_t* Y = WSP(bf16_t, WS_Y);
    const unsigned* W8 = WSP(unsigned, WS_W8); const float* WSC = WSP(float, WS_WS); (void)GW; (void)W8; (void)WSC;
    const int lane = c.lane, g = lane >> 3, c8 = lane & 7, wid = P.rank * NWAVES + c.wave, nw = P.nloc * NWAVES;
    const int ocol = c8 * 16 + 8 * ((lane >> 4) & 1) + 4 * (lane >> 5);
    const unsigned c16 = (unsigned)c8 * 16u;
    for (int slice = P.xrank; slice < 16; slice += P.nx) {
        const unsigned char* vb = V8 + (size_t)slice * 16384 * 128;
        u32x4 idn[4]; u32x4 A[16], B[16];
        int t = wid;
        if (t < T) { PS_IDS(idn, t); PS_GATHER(A, idn, vb); }
        if (t + nw < T) { PS_IDS(idn, t + nw); PS_GATHER(B, idn, vb); }
        for (; t < T; t += 2 * nw) {
            if (t + 2 * nw < T) PS_IDS(idn, t + 2 * nw);
            PV_PROCESS(A, t);
            if (t + 2 * nw < T) { PS_GATHER(A, idn, vb); }
            if (t + nw < T) {
                if (t + 3 * nw < T) PS_IDS(idn, t + 3 * nw);
                PV_PROCESS(B, t + nw);
                if (t + 3 * nw < T) { PS_GATHER(B, idn, vb); }
            }
        }
    }
}
__device__ __forceinline__ void step_ln2(const Ctx& c) {
    const float* MOD = WSP(float, WS_MOD); const bf16_t* Y = WSP(bf16_t, WS_Y); const bf16_t* X1B = WSP(bf16_t, WS_X1B);
    u32x2 xc[8], xn[8], yc[8], yn[8];
    int t = c.gw;
#define LN2_LOAD(xa, ya, tok) { _Pragma("unroll") for (int j_ = 0; j_ < 8; ++j_) { xa[j_] = *(const u32x2*)(X1B + (size_t)(tok) * D + j_ * 256 + c.lane * 4); ya[j_] = *(const u32x2*)(Y + (size_t)(tok) * D + j_ * 256 + c.lane * 4); } }
    if (t < T) LN2_LOAD(xc, yc, t);
    for (; t < T; t += c.ngw) {
        const int tn = t + c.ngw;
        if (tn < T) LN2_LOAD(xn, yn, tn);
        const int b = t >> 12; float* row = c.out + (size_t)t * D; const float* g2 = MOD + b * NMOD + 5 * D;
        f32x4 v[8]; float s = 0.f;
#pragma unroll
        for (int j = 0; j < 8; ++j) { const int col = j * 256 + c.lane * 4; const f32x4 gv = *(const f32x4*)(g2 + col); const u32x2 xw = xc[j], yw = yc[j];
            v[j] = (f32x4){ALPHA * bflo(xw.x) + gv.x * bflo(yw.x), ALPHA * bfhi(xw.x) + gv.y * bfhi(yw.x), ALPHA * bflo(xw.y) + gv.z * bflo(yw.y), ALPHA * bfhi(xw.y) + gv.w * bfhi(yw.y)};
            s += (v[j].x + v[j].y) + (v[j].z + v[j].w); }
        const float mean = wave_sum_all(s) * (1.f / D); float s2 = 0.f;
#pragma unroll
        for (int j = 0; j < 8; ++j) { v[j] = v[j] - mean; s2 += (v[j].x * v[j].x + v[j].y * v[j].y) + (v[j].z * v[j].z + v[j].w * v[j].w); }
        const float rstd = rsqrtf(wave_sum_all(s2) * (1.f / D) + EPS);
#pragma unroll
        for (int j = 0; j < 8; ++j) { const int col = j * 256 + c.lane * 4; const f32x4 gg = *(const f32x4*)(IN_LN2G + col), bb = *(const f32x4*)(IN_LN2B + col);
            *(f32x4*)(row + col) = v[j] * rstd * gg + bb; }
#pragma unroll
        for (int j = 0; j < 8; ++j) { xc[j] = xn[j]; yc[j] = yn[j]; }
    }
#undef LN2_LOAD
}

__device__ __forceinline__ void step_requant(const Ctx& c) {
    const bf16_t* YCAT = WSP(bf16_t, WS_ACT); const float* SSP = WSP(float, WS_SSP); unsigned char* A8 = WSP(unsigned char, WS_A8); float* SA2 = WSP(float, WS_SA2);
    for (int t = c.gw; t < T; t += c.ngw) {
        float s1 = 0.f, s2 = 0.f;
#pragma unroll
        for (int j = 0; j < 4; ++j) { const f32x4 a = *(const f32x4*)(SSP + (size_t)t * 32 + 4 * j), b = *(const f32x4*)(SSP + (size_t)t * 32 + 16 + 4 * j); s1 += (a.x + a.y) + (a.z + a.w); s2 += (b.x + b.y) + (b.z + b.w); }
        const float r1 = rsqrtf(s1 * (1.f / 1024.f) + EPS), r2 = rsqrtf(s2 * (1.f / 1024.f) + EPS);
        f32x4 v[8]; float am = 0.f;
#pragma unroll
        for (int j = 0; j < 8; ++j) { const u32x2 w = *(const u32x2*)(YCAT + (size_t)t * D + j * 256 + c.lane * 4); const float r = j < 4 ? r1 : r2;
            v[j] = (f32x4){bflo(w.x), bfhi(w.x), bflo(w.y), bfhi(w.y)} * r; am = fmaxf(am, fmaxf(fmaxf(fabsf(v[j].x), fabsf(v[j].y)), fmaxf(fabsf(v[j].z), fabsf(v[j].w)))); }
        am = DPPMAX(am, 0xB1); am = DPPMAX(am, 0x4E); am = DPPMAX(am, 0x141); am = DPPMAX(am, 0x140);
        const unsigned a0 = __builtin_amdgcn_readlane(__float_as_uint(am), 0), a1 = __builtin_amdgcn_readlane(__float_as_uint(am), 16), a2 = __builtin_amdgcn_readlane(__float_as_uint(am), 32), a3 = __builtin_amdgcn_readlane(__float_as_uint(am), 48);
        const unsigned m01 = a0 > a1 ? a0 : a1, m23 = a2 > a3 ? a2 : a3; am = __uint_as_float(m01 > m23 ? m01 : m23);
        const float inv = am > 0.f ? 127.f / am : 0.f;
#pragma unroll
        for (int j = 0; j < 8; ++j) *(unsigned*)(A8 + (size_t)t * D + j * 256 + c.lane * 4) = pack_i8x4(v[j] * inv);
        if (c.lane == 0) SA2[t] = am * (1.f / 127.f);
    }
}
__device__ __forceinline__ void step_wq8(const Ctx& c) {
    LAS float* scr = (LAS float*)(c.lds + c.wave * 16384);
    if (I8_GEMM3 && FAST_GEMM) { for (int it = c.gw; it < (D / 64) * (D / 32); it += c.ngw) transpose_item_i8<false>(IN_WQ, D, D, D, WSP(unsigned char, WS_WQ), WSP(unsigned, WS_CTL) + CW_AMXQ, WSP(float, WS_SWQ), scr, it, c.lane); }
    if (I8_GEMM2 && FAST_GEMM) { for (int it = c.gw; it < (D / 64) * (D / 32); it += c.ngw) transpose_item_i8<false, true>(IN_WOUT, D, D, D, WSP(unsigned char, WS_WOUT), WSP(unsigned, WS_CTL) + CW_AMXOUT, WSP(float, WS_SWOUT), scr, it, c.lane, IN_SSMG, IN_ATTG); }
    if (I8_GEMM1 && FAST_GEMM) { for (int it = c.gw; it < (D / 64) * (DINP / 32); it += c.ngw) transpose_item_i8<true>(IN_WIN, D, 3856, DINP, WSP(unsigned char, WS_WIN), WSP(unsigned, WS_CTL) + CW_AMXIN, WSP(float, WS_SWIN), scr, it, c.lane); }
}

#if TAB_PROBE
__device__ __forceinline__ void tabp_load_coal(f32x4 (&v)[8], const float* src, int lane) {
#pragma unroll
    for (int i = 0; i < 8; ++i) v[i] = *(const f32x4*)(src + i * 256 + lane * 4);
}
template <int ROWMAJOR>
__device__ __forceinline__ void tabp_finish_coal(const f32x4 (&v)[8], unsigned char* tab, int row, float* scale, int lane) {
    float am = 0.f;
#pragma unroll
    for (int i = 0; i < 8; ++i) am = fmaxf(am, fmaxf(fmaxf(fabsf(v[i].x), fabsf(v[i].y)), fmaxf(fabsf(v[i].z), fabsf(v[i].w))));
    am = DPPMAX(am, 0xB1); am = DPPMAX(am, 0x4E); am = DPPMAX(am, 0x141); am = DPPMAX(am, 0x140);
    { const unsigned a0 = __builtin_amdgcn_readlane(__float_as_uint(am), 0), a1 = __builtin_amdgcn_readlane(__float_as_uint(am), 16);
      const unsigned a2 = __builtin_amdgcn_readlane(__float_as_uint(am), 32), a3 = __builtin_amdgcn_readlane(__float_as_uint(am), 48);
      const unsigned m01 = a0 > a1 ? a0 : a1, m23 = a2 > a3 ? a2 : a3; am = __uint_as_float(m01 > m23 ? m01 : m23); }
    const float inv = am > 0.f ? 127.f / am : 0.f;
#pragma unroll
    for (int i = 0; i < 8; ++i) {
        const unsigned o = pack_i8x4(v[i] * inv);
        if (ROWMAJOR) *(unsigned*)(tab + (size_t)row * D + i * 256 + lane * 4) = o;
        else *(unsigned*)(tab + ((size_t)(2 * i) * 16384 + row) * 128 + ((unsigned)(lane >> 5) * (16384u * 128u) + (unsigned)(lane & 31) * 4u)) = o;
    }
    if (lane == 0) *scale = am / 127.f;
}
__device__ __forceinline__ void step_tab_probe(const Ctx& c) {
#define TABP_SRC(r_) ((r_) < 16384 ? IN_U + (size_t)(r_) * D : IN_V + (size_t)((r_) - 16384) * D)
    f32x4 cur[8], nxt[8];
    int r = c.gw;
#if TAB_PROBE == 1
    if (r < 2 * 16384) fp8_row_load(cur, TABP_SRC(r), c.lane);
    for (; r < 2 * 16384; r += c.ngw) {
        const int rn = r + c.ngw;
        if (rn < 2 * 16384) fp8_row_load(nxt, TABP_SRC(rn), c.lane);
        if (r < 16384) fp8_row_finish<true>(cur, WSP(unsigned char, WS_UB), r, WSP(float, WS_SCU) + r, c.lane);
        else fp8_row_finish<true>(cur, WSP(unsigned char, WS_VB), r - 16384, WSP(float, WS_SCV) + (r - 16384), c.lane);
#pragma unroll
        for (int i = 0; i < 8; ++i) cur[i] = nxt[i];
    }
#elif TAB_PROBE == 2 || TAB_PROBE == 3
    if (r < 2 * 16384) tabp_load_coal(cur, TABP_SRC(r), c.lane);
    for (; r < 2 * 16384; r += c.ngw) {
        const int rn = r + c.ngw;
        if (rn < 2 * 16384) tabp_load_coal(nxt, TABP_SRC(rn), c.lane);
        if (r < 16384) tabp_finish_coal<TAB_PROBE == 3>(cur, WSP(unsigned char, WS_UB), r, WSP(float, WS_SCU) + r, c.lane);
        else tabp_finish_coal<TAB_PROBE == 3>(cur, WSP(unsigned char, WS_VB), r - 16384, WSP(float, WS_SCV) + (r - 16384), c.lane);
#pragma unroll
        for (int i = 0; i < 8; ++i) cur[i] = nxt[i];
    }
#elif TAB_PROBE == 4
    float acc_ = 0.f;
    for (; r < 2 * 16384; r += c.ngw) { tabp_load_coal(cur, TABP_SRC(r), c.lane);
#pragma unroll
        for (int i = 0; i < 8; ++i) acc_ += (cur[i].x + cur[i].y) + (cur[i].z + cur[i].w); }
    if (acc_ == 1.2345e-30f) WSP(float, WS_SCU)[0] = acc_;
#endif
#undef TABP_SRC
}
#endif

constexpr int NSTEPS = 18;
__global__ void __launch_bounds__(NTHR, 2) fwd_kernel(Args a) {
    extern __shared__ __attribute__((aligned(16))) unsigned char lds_raw[];
    Ctx c;
#pragma unroll
    for (int i = 0; i < 22; ++i) c.in[i] = a.in[i];
    c.out = a.out; c.ws = a.ws; c.lds = (LAS unsigned char*)lds_raw;
    c.tid = threadIdx.x; c.lane = c.tid & 63; c.wave = __builtin_amdgcn_readfirstlane(c.tid >> 6);
    c.gw = blockIdx.x * NWAVES + c.wave; c.ngw = gridDim.x * NWAVES; c.gt = blockIdx.x * NTHR + c.tid; c.ngt = gridDim.x * NTHR;
    for (int u = c.tid; u < (LDS_BYTES - LDSCTL_OFF) / 4; u += NTHR) ((LAS unsigned*)(c.lds + LDSCTL_OFF))[u] = 0u;
    __syncthreads();
    const bool multi = (a.hi - a.lo) > 1;
    XcdBarrier bar; bar.bar = (unsigned*)(c.ws + WS_CTL); bar.x = 0; bar.st = (volatile LAS unsigned*)(c.lds + MISC_OFF);
    if (multi) bar = xcd_barrier_post((unsigned*)(c.ws + WS_CTL), (volatile LAS unsigned*)(c.lds + MISC_OFF));
#define STEP_IDS() { int tid_ = (int)threadIdx.x; asm volatile("" : "+v"(tid_)); c.tid = tid_; c.lane = tid_ & 63; c.gt = (int)blockIdx.x * NTHR + tid_; }
#define STEP(i, ...) if (a.lo <= (i) && (i) < a.hi) { STEP_IDS(); __VA_ARGS__; if ((REPEAT_MASK >> (i)) & 1) { xcd_barrier(bar); __VA_ARGS__; } if ((i) + 1 < a.hi) xcd_barrier(bar); }
    STEP(0, step_pro(c));
#if WQ_ONEPASS && I8_GEMM1 && I8_GEMM2 && I8_GEMM3 && FAST_GEMM
    STEP(1, step_h1(c));
#else
    STEP(1, { step_h1(c); step_wq8(c); });
#endif
#if FAST_GEMM
#define RUN_GEMM(EPI, MIDK, Aoff, Boff, N_, ...) { pg8::Gemm g{WSP(bf16_t, Aoff), WSP(bf16_t, Boff), T, N_, D}; pg8::StaticOrder S; S.init(T, N_, (int)gridDim.x, (int)blockIdx.x); \
        pg8::EpiA<EPI> E{EPI{__VA_ARGS__}}; pg8::gemm_phase<pg8::EpiA<EPI>, pg8::StaticOrder, false, true, MIDK>(c.lds, g, S, E); }
#else
#define RUN_GEMM(EPI, MIDK, Aoff, Boff, N_, ...) { EPI e{__VA_ARGS__}; gemm_simple<EPI, MIDK>(c, WSP(bf16_t, Aoff), WSP(bf16_t, Boff), T, N_, D, e); }
#endif
#if I8_GEMM1 && FAST_GEMM
    STEP(2, { pg8::Gemm g{WSP(bf16_t, WS_ACT), WSP(bf16_t, WS_WIN), T, DINP, D / 2}; pg8::StaticOrder S; S.init(T, DINP, (int)gridDim.x, (int)blockIdx.x);
        pg8::EpiA<Epi1Q, true> E{Epi1Q{WSP(bf16_t, WS_PROJ), WSP(float, WS_DTRAW), WSP(float, WS_SA1), WSP(float, WS_SWIN)}}; pg8::gemm_phase<pg8::EpiA<Epi1Q, true>, pg8::StaticOrder, false, true, false, true>(c.lds, g, S, E); });
#else
    STEP(2, RUN_GEMM(Epi1, false, WS_ACT, WS_WIN, DINP, WSP(bf16_t, WS_PROJ), WSP(float, WS_DTRAW)));
#endif
#if (FAST_MIX & 5) == 5
    STEP(3, { step_att_fast(c); step_conv_only(c); step_dta(c); });
#elif FAST_MIX & 1
    STEP(3, { step_conv_only(c); step_dta(c); });
#else
    STEP(3, step_conv(c));
#endif
#if FAST_MIX & 2
    STEP(4, step_ssd1_fast(c));
#else
    STEP(4, step_ssd1_simple(c));
#endif
#if (FAST_MIX & 5) == 5
#elif FAST_MIX & 4
    STEP(5, step_att_fast(c));
#else
    STEP(5, step_att_simple(c));
#endif
    STEP(6, step_scan(c));
#if FAST_MIX & 8
    STEP(8, step_ssd2_fast<0>(c));
#else
    STEP(7, step_cb_simple(c));
    STEP(8, step_ssd2_simple(c));
#endif
#if I8_GEMM2 && FAST_GEMM
    STEP(9, step_requant(c));
    STEP(10, { pg8::Gemm g{WSP(bf16_t, WS_A8), WSP(bf16_t, WS_WOUT), T, D, D / 2}; pg8::StaticOrder S; S.init(T, D, (int)gridDim.x, (int)blockIdx.x);
        pg8::EpiA<Epi2Q, true> E{Epi2Q{WSP(float, WS_MOD), WSP(float, WS_SA2), WSP(float, WS_SWOUT), WSP(bf16_t, WS_R1B)}}; pg8::gemm_phase<pg8::EpiA<Epi2Q, true>, pg8::StaticOrder, false, true, false, true>(c.lds, g, S, E); });
#else
    STEP(10, RUN_GEMM(Epi2, true, WS_ACT, WS_WOUT, D, IN_X, WSP(float, WS_MOD), WSP(float, WS_SSP), WSP(bf16_t, WS_R1B)));
#endif
    STEP(11, step_ln1(c));
#if I8_GEMM3 && FAST_GEMM && FUSE_TOPK && FAST_TOPK
    STEP(12, { pg8::Gemm g{WSP(bf16_t, WS_H2Q), WSP(bf16_t, WS_WQ), T, D, D / 2}; pg8::StaticOrder S; S.init(T, D, (int)gridDim.x, (int)blockIdx.x);
        pg8::EpiA<Epi3Q, true> E{Epi3Q{WSP(bf16_t, WS_PROJ), WSP(float, WS_HS), WSP(float, WS_SWQ)}}; pg8::gemm_phase<pg8::EpiA<Epi3Q, true>, pg8::StaticOrder, false, true, false, true>(c.lds, g, S, E);
        asm volatile("s_waitcnt vmcnt(0)" ::: "memory"); __syncthreads();
        pg8::Unit u; for (int i = 0; S.next(i, u); ++i) topk_groups(c, u.pn, u.pm * 8 + c.wave, u.pm * 8 + c.wave + 1, 1); });
#else
#if I8_GEMM3 && FAST_GEMM
    STEP(12, { pg8::Gemm g{WSP(bf16_t, WS_H2Q), WSP(bf16_t, WS_WQ), T, D, D / 2}; pg8::StaticOrder S; S.init(T, D, (int)gridDim.x, (int)blockIdx.x);
        pg8::EpiA<Epi3Q, true> E{Epi3Q{WSP(bf16_t, WS_PROJ), WSP(float, WS_HS), WSP(float, WS_SWQ)}}; pg8::gemm_phase<pg8::EpiA<Epi3Q, true>, pg8::StaticOrder, false, true, false, true>(c.lds, g, S, E); });
#else
    STEP(12, RUN_GEMM(Epi3, false, WS_ACT, WS_WQ, D, WSP(bf16_t, WS_PROJ)));
#endif
#if FAST_TOPK
    STEP(13, step_topk_fast(c));
#else
    STEP(13, step_topk_simple(c));
#endif
#endif
#if SLICED_PEER
    XcdPlace P; P.nloc = (int)gridDim.x; P.nx = 1; P.xrank = 0; P.rank = (int)blockIdx.x;
    if (multi && a.lo <= 14 && 14 < a.hi) {
        unsigned* bw = (unsigned*)(c.ws + WS_CTL); const unsigned myx = xb_xcc_id();
        LAS unsigned* pl = (LAS unsigned*)(c.lds + LDSCTL_OFF + 16);
        if (c.tid == 0) pl[0] = xb_add(bw + 16384 + 64 * myx, 1u);
        __syncthreads();
        int nx = 0, xr = 0, nl = 0;
#pragma unroll
        for (int j = 0; j < 16; ++j) { const int cj = (int)xb_ld(&bw[XB_XCNT(j)]); if (cj > 0) { if (j < (int)myx) ++xr; ++nx; } if (j == (int)myx) nl = cj; }
        if (nl > 0 && nx > 0) { P.nloc = nl; P.nx = nx; P.xrank = xr; P.rank = (int)pl[0]; }
    }
    STEP(14, step_peer_u(c, P));
    STEP(15, step_peer_w(c));
    STEP(16, step_peer_v(c, P));
#if SSD2_PROBE
    STEP(17, { step_ln2(c); xcd_barrier(bar); step_ssd2_fast<SSD2_PROBE>(c); });
#elif TAB_PROBE
    STEP(17, { step_ln2(c); xcd_barrier(bar); step_tab_probe(c); });
#else
    STEP(17, step_ln2(c));
#endif
#else
    STEP(14, step_peer(c));
#endif
#undef STEP
}
}

extern "C" void kernel_launch(void* const* d_in, const int* in_sizes, int n_in, void* d_out, int out_size, void* d_ws, size_t ws_size, hipStream_t stream) {
    static int grid = 0;
    if (grid == 0) {
        if (n_in != 22 || in_sizes[0] != T * D || out_size != T * D || ws_size < WS_END) {
            fprintf(stderr, "kernel_launch: unexpected problem (n_in %d, in0 %d, out %d, ws %zu < %zu); nothing launched\n", n_in, n_in > 0 ? in_sizes[0] : -1, out_size, ws_size, (size_t)WS_END);
            grid = -1; return;
        }
        int dev = 0, cus = 0;
        if (hipGetDevice(&dev) != hipSuccess || hipDeviceGetAttribute(&cus, hipDeviceAttributeMultiprocessorCount, dev) != hipSuccess) { grid = -1; return; }
        if (hipFuncSetAttribute((const void*)fwd_kernel, hipFuncAttributeMaxDynamicSharedMemorySize, LDS_BYTES) != hipSuccess) { fprintf(stderr, "kernel_launch: hipFuncSetAttribute failed\n"); grid = -1; return; }
        int per_cu = 0;
        if (hipOccupancyMaxActiveBlocksPerMultiprocessor(&per_cu, (const void*)fwd_kernel, NTHR, LDS_BYTES) != hipSuccess || per_cu < 1) fprintf(stderr, "kernel_launch: occupancy query reports %d blocks per CU\n", per_cu);
        (void)hipGetLastError();
        grid = cus > 0 ? cus : 256;
    }
    if (grid < 0) return;
    (void)hipMemsetAsync((char*)d_ws + WS_CTL, 0, CTL_ZERO_BYTES, stream);
    Args a{};
    for (int i = 0; i < 22; ++i) a.in[i] = (const float*)d_in[i];
    a.out = (float*)d_out; a.ws = (unsigned char*)d_ws;
#if ONE_LAUNCH
    a.lo = 0; a.hi = NSTEPS;
    hipLaunchKernelGGL(fwd_kernel, dim3(grid), dim3(NTHR), LDS_BYTES, stream, a);
#else
    for (int i = 0; i < NSTEPS; ++i) { a.lo = i; a.hi = i + 1; hipLaunchKernelGGL(fwd_kernel, dim3(grid), dim3(NTHR), LDS_BYTES, stream, a); }
#endif
}
```

```cpp
#include <hip/hip_runtime.h>
#include <cstdio>
#include <cstdint>

#ifndef ONE_LAUNCH
#define ONE_LAUNCH 1
#endif
#ifndef FAST_GEMM
#define FAST_GEMM 1
#endif
#ifndef FAST_TOPK
#define FAST_TOPK 1
#endif
#ifndef FAST_MIX
#define FAST_MIX 15
#endif
#ifndef SLICED_PEER
#define SLICED_PEER 1
#endif
#ifndef PRO_REPEAT
#define PRO_REPEAT 0
#endif
#ifndef V_INT8
#define V_INT8 1
#endif
#ifndef HIDE_TABLES
#define HIDE_TABLES 1
#endif
#ifndef I8_GEMM3
#define I8_GEMM3 1
#endif
#ifndef I8_GEMM1
#define I8_GEMM1 1
#endif
#ifndef I8_GEMM2
#define I8_GEMM2 1
#endif
#ifndef U_INT4
#define U_INT4 1
#endif
#ifndef V_INT4
#define V_INT4 1
#endif
#ifndef PART16
#define PART16 1
#endif
#ifndef FUSE_TOPK
#define FUSE_TOPK 1
#endif
#ifndef WQ_ONEPASS
#define WQ_ONEPASS 1
#endif
#ifndef TAB_PROBE
#define TAB_PROBE 0
#endif
#ifndef SSD2_PROBE
#define SSD2_PROBE 0
#endif
#ifndef REPEAT_MASK
#define REPEAT_MASK 0
#endif

#define LAS __attribute__((address_space(3)))
typedef unsigned short bf16_t;
typedef float f32x4 __attribute__((ext_vector_type(4)));
typedef unsigned u32x4 __attribute__((ext_vector_type(4)));
typedef unsigned u32x2 __attribute__((ext_vector_type(2)));

namespace {
constexpr int NB = 4, SEQ = 4096, T = NB * SEQ, D = 2048;
constexpr int NH = 16, NCH = SEQ / 128;
constexpr int DINP = 4096;
constexpr int Z_OFF = 0, XBC_OFF = 1024, Q_OFF = 2560, K_OFF = 3584, V_OFF = 3712, DT_OFF = 3840;
constexpr int NMOD = 6 * D;
constexpr float ALPHA = 1.189207115002721f;
constexpr float EPS = 1e-5f;
constexpr int NTHR = 512, NWAVES = 8;

constexpr size_t MiB = 1u << 20;
constexpr size_t WS_CTL = 0, CTL_ZERO_BYTES = 1 * MiB;
constexpr size_t WS_MOD = 512 * 1024;
constexpr size_t WS_KEYS = 1 * MiB;
constexpr size_t WS_DTRAW = 2 * MiB;
constexpr size_t WS_DT = 3 * MiB;
constexpr size_t WS_ACUM = 4 * MiB;
constexpr size_t WS_SSP = 5 * MiB;
constexpr size_t WS_RS = 7 * MiB;
constexpr size_t WS_SCU = 7 * MiB + 256 * 1024, WS_SCV = 7 * MiB + 512 * 1024;
constexpr size_t WS_EXP = 8 * MiB;
constexpr size_t WS_GATE = 16 * MiB;
constexpr size_t WS_WIN = 24 * MiB;
constexpr size_t WS_WOUT = 40 * MiB;
constexpr size_t WS_WQ = 48 * MiB;
constexpr size_t WS_UB = 56 * MiB;
constexpr size_t WS_VB = 120 * MiB;
constexpr size_t WS_ACT = 184 * MiB;
constexpr size_t WS_PROJ = 248 * MiB;
constexpr size_t WS_XBCC = 376 * MiB;
constexpr size_t WS_STATES = 424 * MiB;
constexpr size_t WS_PREVB = 488 * MiB;
constexpr size_t WS_H2Q = 504 * MiB;
constexpr size_t WS_W8 = 5 * MiB;
constexpr size_t WS_WS = 7 * MiB + 128 * 1024;
constexpr size_t WS_SWQ = 7 * MiB + 64 * 1024, WS_SWIN = 7 * MiB + 80 * 1024, WS_SA1 = 7 * MiB + 320 * 1024;
constexpr int CW_AMXQ = 32768, CW_AMXIN = 36864;
constexpr size_t WS_A8 = WS_XBCC;
constexpr size_t WS_SA2 = 7 * MiB + 384 * 1024, WS_SWOUT = 7 * MiB + 96 * 1024;
constexpr int CW_AMXOUT = 40960;
constexpr size_t WS_HS = 7 * MiB;
constexpr size_t WS_END = 536 * MiB;
constexpr size_t WS_EP16 = WS_STATES + 32 * MiB;
constexpr size_t WS_H2N = WS_STATES;
constexpr size_t WS_R1B = WS_PROJ, WS_X1B = WS_PROJ + 64 * MiB, WS_Q = WS_PROJ, WS_PARTA = WS_XBCC, WS_Y = WS_ACT;

constexpr int RING_BYTES = 131072;
constexpr int LDSCTL_OFF = 163840 - 64, MISC_OFF = LDSCTL_OFF;
constexpr int LDS_BYTES = 163840;

__device__ __forceinline__ float bf2f(unsigned v) { return __uint_as_float(v << 16); }
__device__ __forceinline__ float bflo(unsigned w) { return __uint_as_float(w << 16); }
__device__ __forceinline__ float bfhi(unsigned w) { return __uint_as_float(w & 0xffff0000u); }
__device__ __forceinline__ unsigned f2bf(float f) { unsigned u = __float_as_uint(f); return (u + 0x7fffu + ((u >> 16) & 1u)) >> 16; }
__device__ __forceinline__ unsigned pk2(float lo, float hi) { return f2bf(lo) | (f2bf(hi) << 16); }
typedef __bf16 bf16x2n __attribute__((ext_vector_type(2)));
typedef float f32x2n __attribute__((ext_vector_type(2)));
__device__ __forceinline__ unsigned cvtpk(float lo, float hi) { const bf16x2n r = __builtin_convertvector((f32x2n){lo, hi}, bf16x2n); return __builtin_bit_cast(unsigned, r); }
__device__ __forceinline__ float fexp(float x) { return __builtin_amdgcn_exp2f(x * 1.4426950408889634f); }
__device__ __forceinline__ float silu_f(float x) { return x * __builtin_amdgcn_rcpf(1.f + fexp(-x)); }
__device__ __forceinline__ float softplus_f(float x) { return x > 20.f ? x : log1pf(expf(x)); }
__device__ __forceinline__ float gelu_f(float x) { return 0.5f * x * (1.f + erff(x * 0.70710678118654752f)); }
__device__ __forceinline__ float wave_sum(float v) {
#pragma unroll
    for (int o = 1; o < 64; o <<= 1) v += __shfl_xor(v, o);
    return v;
}
__device__ __forceinline__ float dot8(u32x4 a, u32x4 b) {
    float s = bflo(a.x) * bflo(b.x); s += bfhi(a.x) * bfhi(b.x);
    s += bflo(a.y) * bflo(b.y); s += bfhi(a.y) * bfhi(b.y);
    s += bflo(a.z) * bflo(b.z); s += bfhi(a.z) * bfhi(b.z);
    s += bflo(a.w) * bflo(b.w); s += bfhi(a.w) * bfhi(b.w);
    return s;
}
__device__ __forceinline__ int win_src_col(int n) { return n < 2560 ? n : (n < 3840 ? n + 16 : (n < 3856 ? n - 1280 : -1)); }

#define XB_TMO      128
#define XB_XCNT(j)  (256  + 64 * (j))
#define XB_XSUB(j)  (1280 + 64 * (j))
#define XB_XGEN(j)  (2304 + 64 * (j))
#define XB_TOP      3328
#define XB_TOPGEN   3392
#define XCD_BAR_WORDS 3456
#define XB_SPIN_CAP (1u << 18)
__device__ __forceinline__ unsigned xb_ld(unsigned* p)              { return __hip_atomic_load(p, __ATOMIC_RELAXED, __HIP_MEMORY_SCOPE_AGENT); }
__device__ __forceinline__ unsigned xb_add(unsigned* p, unsigned v) { return __hip_atomic_fetch_add(p, v, __ATOMIC_RELAXED, __HIP_MEMORY_SCOPE_AGENT); }
__device__ __forceinline__ unsigned xb_xcc_id() { return (unsigned)__builtin_amdgcn_s_getreg((3 << 11) | 20) & 0xFu; }
#define XB_SPIN(cond, bar) do { unsigned _sp = 0; while (cond) { __builtin_amdgcn_s_sleep(1); \
    if ((++_sp & 255u) == 0u) { if (xb_ld(&(bar)[XB_TMO])) break; if (_sp > XB_SPIN_CAP) { atomicAdd(&(bar)[XB_TMO], 1u); break; } } } } while (0)
struct XcdBarrier { unsigned* bar; unsigned x; volatile LAS unsigned* st; };
__device__ __forceinline__ XcdBarrier xcd_barrier_post(unsigned* bar, volatile LAS unsigned* st) {
    XcdBarrier b; b.bar = bar; b.x = xb_xcc_id(); b.st = st;
    if (threadIdx.x == 0) (void)xb_add(&bar[XB_XCNT(b.x)], 1u);
    return b;
}
__device__ __forceinline__ void xcd_barrier_complete(unsigned* bar, unsigned x, unsigned& nloc, unsigned& nx) {
    const unsigned G = gridDim.x * gridDim.y * gridDim.z;
    unsigned sum, cnt, mine, sp = 0u;
    for (;;) {
        sum = 0u; cnt = 0u; mine = 0u;
#pragma unroll
        for (unsigned j = 0; j < 16; ++j) { const unsigned c = xb_ld(&bar[XB_XCNT(j)]); sum += c; cnt += (c > 0u) ? 1u : 0u; mine = (j == x) ? c : mine; }
        if (sum == G) break;
        __builtin_amdgcn_s_sleep(1);
        if ((++sp & 255u) == 0u) { if (xb_ld(&bar[XB_TMO])) break; if (sp > XB_SPIN_CAP) { atomicAdd(&bar[XB_TMO], 1u); break; } }
    }
    nloc = mine > 0u ? mine : 1u; nx = cnt > 0u ? cnt : 1u;
}
__device__ __forceinline__ void xcd_barrier(const XcdBarrier& b) {
    asm volatile("s_waitcnt vmcnt(0)" ::: "memory");
    __syncthreads();
    if (threadIdx.x == 0) {
        unsigned* bar = b.bar;
        __builtin_amdgcn_s_waitcnt(0);
        unsigned nloc = b.st[0], nx = b.st[1];
        if (nloc == 0u) { xcd_barrier_complete(bar, b.x, nloc, nx); b.st[0] = nloc; b.st[1] = nx; }
        const unsigned old = xb_add(&bar[XB_XSUB(b.x)], 1u);
        const unsigned gen = old / nloc;
        if (old + 1u == (gen + 1u) * nloc) {
            __builtin_amdgcn_fence(__ATOMIC_RELEASE, "agent");
            asm volatile("s_waitcnt vmcnt(0)" ::: "memory");
            const unsigned og = xb_add(&bar[XB_TOP], 1u);
            const unsigned tg = og / nx;
            if (og + 1u == (tg + 1u) * nx) xb_add(&bar[XB_TOPGEN], 1u);
            else XB_SPIN(xb_ld(&bar[XB_TOPGEN]) == tg, bar);
            __builtin_amdgcn_fence(__ATOMIC_ACQUIRE, "agent");
            xb_add(&bar[XB_XGEN(b.x)], 1u);
            asm volatile("s_waitcnt vmcnt(0)" ::: "memory");
        } else {
            XB_SPIN(xb_ld(&bar[XB_XGEN(b.x)]) == gen, bar);
            __builtin_amdgcn_fence(__ATOMIC_ACQUIRE, "agent");
            asm volatile("s_waitcnt vmcnt(0)" ::: "memory");
        }
    }
    __syncthreads();
}

struct Args { const float* in[22]; float* out; unsigned char* ws; int lo, hi; };
struct Ctx {
    const float* in[22]; float* out; unsigned char* ws; LAS unsigned char* lds;
    int tid, lane, wave, gw, ngw, gt, ngt;
};
#define IN_X c.in[0]
#define IN_C c.in[1]
#define IN_WADA c.in[2]
#define IN_BADA c.in[3]
#define IN_WIN c.in[4]
#define IN_CONVW c.in[5]
#define IN_CONVB c.in[6]
#define IN_DTBIAS c.in[7]
#define IN_ALOG c.in[8]
#define IN_DSKIP c.in[9]
#define IN_SSMG c.in[10]
#define IN_SINKS c.in[11]
#define IN_ATTG c.in[12]
#define IN_WOUT c.in[13]
#define IN_LN1G c.in[14]
#define IN_LN1B c.in[15]
#define IN_WQ c.in[16]
#define IN_KEYS c.in[17]
#define IN_U c.in[18]
#define IN_V c.in[19]
#define IN_LN2G c.in[20]
#define IN_LN2B c.in[21]
#define WSP(type, off) ((type*)(c.ws + (off)))


typedef float f32x2 __attribute__((ext_vector_type(2)));
typedef short bf16x8v __attribute__((ext_vector_type(8)));
typedef float f32x16 __attribute__((ext_vector_type(16)));
#define DPPF(v, ctrl) __int_as_float(__builtin_amdgcn_update_dpp(0, __float_as_int(v), (ctrl), 0xF, 0xF, true))
__device__ __forceinline__ float row_sum16(float v) {
    v += DPPF(v, 0xB1); v += DPPF(v, 0x4E); v += DPPF(v, 0x141); v += DPPF(v, 0x140); return v;
}
__device__ __forceinline__ float wave_sum63(float v) {
    v = row_sum16(v);
    v += __int_as_float(__builtin_amdgcn_update_dpp(0, __float_as_int(v), 0x142, 0xA, 0xF, false));
    v += __int_as_float(__builtin_amdgcn_update_dpp(0, __float_as_int(v), 0x143, 0xC, 0xF, false));
    return v;
}
__device__ __forceinline__ float lane63(float v) { return __int_as_float(__builtin_amdgcn_readlane(__float_as_int(v), 63)); }
__device__ __forceinline__ float wave_sum_all(float v) { return lane63(wave_sum63(v)); }
__device__ __forceinline__ void fp8_row_load(f32x4 (&v)[8], const float* src, int lane) {
#pragma unroll
    for (int j = 0; j < 2; ++j)
#pragma unroll
        for (int q = 0; q < 4; ++q) v[j * 4 + q] = *(const f32x4*)(src + j * 1024 + lane * 16 + q * 4);
}
#define DPPMAX(v, ctrl) fmaxf(v, __int_as_float(__builtin_amdgcn_update_dpp(0, __float_as_int(v), (ctrl), 0xF, 0xF, true)))
__device__ __forceinline__ unsigned pack_i8x4(f32x4 x) {
    const float M = 12582912.f;
    const unsigned a = __float_as_uint(x.x + M), b = __float_as_uint(x.y + M), c = __float_as_uint(x.z + M), d = __float_as_uint(x.w + M);
    return __builtin_amdgcn_perm(b, a, 0x0c0c0400u) | __builtin_amdgcn_perm(d, c, 0x04000c0cu);
}
template <bool INT8>
__device__ __forceinline__ void fp8_row_finish(const f32x4 (&v)[8], unsigned char* tab, int row, float* scale, int lane) {
    float am = 0.f;
#pragma unroll
    for (int i = 0; i < 8; ++i) am = fmaxf(am, fmaxf(fmaxf(fabsf(v[i].x), fabsf(v[i].y)), fmaxf(fabsf(v[i].z), fabsf(v[i].w))));
    am = DPPMAX(am, 0xB1); am = DPPMAX(am, 0x4E); am = DPPMAX(am, 0x141); am = DPPMAX(am, 0x140);
    {
        const unsigned a0 = __builtin_amdgcn_readlane(__float_as_uint(am), 0), a1 = __builtin_amdgcn_readlane(__float_as_uint(am), 16);
        const unsigned a2 = __builtin_amdgcn_readlane(__float_as_uint(am), 32), a3 = __builtin_amdgcn_readlane(__float_as_uint(am), 48);
        const unsigned m01 = a0 > a1 ? a0 : a1, m23 = a2 > a3 ? a2 : a3; am = __uint_as_float(m01 > m23 ? m01 : m23);
    }
    const float top = INT8 ? 127.f : 448.f;
    const float inv = am > 0.f ? top / am : 0.f;
#pragma unroll
    for (int j = 0; j < 2; ++j) {
        u32x4 o;
#pragma unroll
        for (int q = 0; q < 4; ++q) { const f32x4 x = v[j * 4 + q] * inv;
            if (INT8) o[q] = pack_i8x4(x);
            else { int w = 0; w = __builtin_amdgcn_cvt_pk_fp8_f32(x.x, x.y, w, false); w = __builtin_amdgcn_cvt_pk_fp8_f32(x.z, x.w, w, true); o[q] = (unsigned)w; } }
#if SLICED_PEER
        *(u32x4*)(tab + ((size_t)(8 * j + (lane >> 3)) * 16384 + row) * 128 + (lane & 7) * 16) = o;
#else
        *(u32x4*)(tab + (size_t)row * D + j * 1024 + lane * 16) = o;
#endif
    }
    if (lane == 0) *scale = am / top;
}

__device__ __forceinline__ unsigned i4nib(float x) { return __float_as_uint(__builtin_amdgcn_fmed3f(x, -7.f, 7.f) + 12582912.f) & 15u; }
__device__ __forceinline__ unsigned pack_i4x8(f32x4 a, f32x4 b, float inv) {
    return i4nib(a.x * inv) | (i4nib(a.y * inv) << 4) | (i4nib(a.z * inv) << 8) | (i4nib(a.w * inv) << 12) | (i4nib(b.x * inv) << 16) | (i4nib(b.y * inv) << 20) | (i4nib(b.z * inv) << 24) | (i4nib(b.w * inv) << 28);
}
__device__ __forceinline__ void u4_row_finish(const f32x4 (&v)[8], unsigned char* tab, int row, float* scale, int lane) {
    float am = 0.f;
#pragma unroll
    for (int i = 0; i < 8; ++i) am = fmaxf(am, fmaxf(fmaxf(fabsf(v[i].x), fabsf(v[i].y)), fmaxf(fabsf(v[i].z), fabsf(v[i].w))));
    am = DPPMAX(am, 0xB1); am = DPPMAX(am, 0x4E); am = DPPMAX(am, 0x141); am = DPPMAX(am, 0x140);
    {
        const unsigned a0 = __builtin_amdgcn_readlane(__float_as_uint(am), 0), a1 = __builtin_amdgcn_readlane(__float_as_uint(am), 16);
        const unsigned a2 = __builtin_amdgcn_readlane(__float_as_uint(am), 32), a3 = __builtin_amdgcn_readlane(__float_as_uint(am), 48);
        const unsigned m01 = a0 > a1 ? a0 : a1, m23 = a2 > a3 ? a2 : a3; am = __uint_as_float(m01 > m23 ? m01 : m23);
    }
    am *= 0.75f;
    const float inv = am > 0.f ? 7.f / am : 0.f;
#pragma unroll
    for (int j = 0; j < 2; ++j) {
        const u32x2 o = {pack_i4x8(v[j * 4 + 0], v[j * 4 + 1], inv), pack_i4x8(v[j * 4 + 2], v[j * 4 + 3], inv)};
        *(u32x2*)(tab + ((size_t)(4 * j + (lane >> 4)) * 16384 + row) * 128 + (lane & 15) * 8) = o;
    }
    if (lane == 0) *scale = am * (1.f / 7.f);
}

template <bool WIN_MAP, bool GAINS = false>
__device__ __forceinline__ void colamax_items(const Ctx& c, const float* W, int Nsrc, unsigned* AMX, const float* g1 = nullptr, const float* g2 = nullptr) {
    const int nblk = (Nsrc + 255) / 256;
    for (int it = c.gw; it < 32 * nblk; it += c.ngw) {
        const int kb = it / nblk, nb = it % nblk, col = nb * 256 + c.lane * 4;
        if (col < Nsrc) {
            f32x4 m = {0.f, 0.f, 0.f, 0.f};
            const float* wp = W + (size_t)(kb * 64) * Nsrc + col;
#pragma unroll 16
            for (int kk = 0; kk < 64; ++kk) { f32x4 v = *(const f32x4*)(wp + (size_t)kk * Nsrc); if (GAINS) { const int k = kb * 64 + kk; v = v * (k < 1024 ? g1[k] : g2[k - 1024]); } m.x = fmaxf(m.x, fabsf(v.x)); m.y = fmaxf(m.y, fabsf(v.y)); m.z = fmaxf(m.z, fabsf(v.z)); m.w = fmaxf(m.w, fabsf(v.w)); }
#pragma unroll
            for (int j = 0; j < 4; ++j) { const int sc = col + j; const int dn = WIN_MAP ? (sc < 2560 ? sc : (sc < 2576 ? sc + 1280 : sc - 16)) : sc;
                atomicMax(AMX + dn, __float_as_uint(m[j])); }
        }
    }
}
template <bool WIN_MAP, bool GAINS = false>
__device__ __forceinline__ void transpose_item_i8(const float* W, int K, int Nsrc, int ND, unsigned char* WT, const unsigned* AMX, float* SW, LAS float* scr, int item, int lane, const float* g1 = nullptr, const float* g2 = nullptr) {
    const int nblk = ND / 32, kb = item / nblk, nb = item % nblk, k0 = 64 * kb, n0 = 32 * nb;
    const int n = n0 + (lane & 31), sc = WIN_MAP ? win_src_col(n) : n;
    const float am = __uint_as_float(AMX[n]), inv = am > 0.f ? 127.f / am : 0.f;
    float tv[32];
    const float* wp = W + (size_t)(k0 + (lane >> 5)) * Nsrc + (sc >= 0 ? sc : 0);
#pragma unroll
    for (int i = 0; i < 32; ++i) tv[i] = wp[(size_t)(2 * i) * Nsrc];
#pragma unroll
    for (int i = 0; i < 32; ++i) { const int kk = k0 + 2 * i + (lane >> 5); float v = sc >= 0 ? tv[i] * inv : 0.f; if (GAINS) v *= (kk < 1024 ? g1[kk] : g2[kk - 1024]); scr[(2 * i + (lane >> 5)) * 33 + (lane & 31)] = v; }
    asm volatile("s_waitcnt lgkmcnt(0)" ::: "memory");
#pragma unroll
    for (int j = 0; j < 2; ++j) {
        const int ch = lane + 64 * j, nn = ch >> 2, kc = ch & 3; const LAS float* sp = scr + (16 * kc) * 33 + nn;
        u32x4 o;
#pragma unroll
        for (int q = 0; q < 4; ++q) o[q] = pack_i8x4((f32x4){sp[(4 * q) * 33], sp[(4 * q + 1) * 33], sp[(4 * q + 2) * 33], sp[(4 * q + 3) * 33]});
        *(u32x4*)(WT + (size_t)(n0 + nn) * K + k0 + 16 * kc) = o;
    }
    if (kb == 0 && lane < 32) SW[n] = am * (1.f / 127.f);
    asm volatile("s_waitcnt lgkmcnt(0)" ::: "memory");
}
template <int MODE>
__device__ __forceinline__ void wquant_block(const Ctx& c, const float* W, int Nsrc, int nb, unsigned char* WT, float* SW, const float* g1, const float* g2) {
    constexpr int PITCH = 4112;
    LAS unsigned char* Lb = c.lds;
    LAS float* red = (LAS float*)(c.lds + 32 * PITCH);
    const int n = c.lane & 31, half = c.lane >> 5, n0 = nb * 32, dn = n0 + n, sc = MODE == 0 ? win_src_col(dn) : dn;
    const float* wp = W + (size_t)(c.wave * 256 + 2 * half) * Nsrc + (sc >= 0 ? sc : 0);
    float am = 0.f;
#pragma unroll 1
    for (int it0 = 0; it0 < 64; it0 += 8) {
        float v0[8], v1[8];
#pragma unroll
        for (int u = 0; u < 8; ++u) { const float* p = wp + (size_t)(4 * (it0 + u)) * Nsrc; v0[u] = p[0]; v1[u] = p[Nsrc]; }
#pragma unroll
        for (int u = 0; u < 8; ++u) {
            const int k = c.wave * 256 + 4 * (it0 + u) + 2 * half;
            float a = sc >= 0 ? v0[u] : 0.f, b = sc >= 0 ? v1[u] : 0.f;
            if (MODE == 1) { a *= (k < 1024 ? g1[k] : g2[k - 1024]); b *= (k + 1 < 1024 ? g1[k + 1] : g2[k + 1 - 1024]); }
            am = fmaxf(am, fmaxf(fabsf(a), fabsf(b)));
            *(LAS unsigned*)(Lb + n * PITCH + k * 2) = cvtpk(a, b);
        }
    }
    red[(c.wave * 2 + half) * 32 + n] = am;
    __syncthreads();
    if (c.tid < 32) {
        float m = 0.f;
#pragma unroll
        for (int j = 0; j < 16; ++j) m = fmaxf(m, red[j * 32 + c.tid]);
        red[512 + c.tid] = m > 0.f ? 127.f / m : 0.f; SW[n0 + c.tid] = m * (1.f / 127.f);
    }
    __syncthreads();
#pragma unroll 2
    for (int i = 0; i < 8; ++i) {
        const int id = i * NTHR + c.tid, nn = id >> 7, kc = id & 127; const float inv = red[512 + nn];
        const u32x4 r0 = *(const LAS u32x4*)(Lb + nn * PITCH + kc * 32), r1 = *(const LAS u32x4*)(Lb + nn * PITCH + kc * 32 + 16);
        u32x4 o;
        o.x = pack_i8x4((f32x4){bflo(r0.x), bfhi(r0.x), bflo(r0.y), bfhi(r0.y)} * inv); o.y = pack_i8x4((f32x4){bflo(r0.z), bfhi(r0.z), bflo(r0.w), bfhi(r0.w)} * inv);
        o.z = pack_i8x4((f32x4){bflo(r1.x), bfhi(r1.x), bflo(r1.y), bfhi(r1.y)} * inv); o.w = pack_i8x4((f32x4){bflo(r1.z), bfhi(r1.z), bflo(r1.w), bfhi(r1.w)} * inv);
        *(u32x4*)(WT + (size_t)(n0 + nn) * D + kc * 16) = o;
    }
    __syncthreads();
}
template <int MODE>
__device__ __forceinline__ void transpose_item(const float* W, int K, int Nsrc, int ND, bf16_t* WT, LAS float* scr, int item, int lane, const float* g1, const float* g2) {
    const int nblk = ND / 32, kb = item / nblk, nb = item % nblk, k0 = 64 * kb, n0 = 32 * nb;
    const int n = n0 + (lane & 31), sc = MODE == 0 ? win_src_col(n) : n;
    float tv[32];
    const float* wp = W + (size_t)(k0 + (lane >> 5)) * Nsrc + (sc >= 0 ? sc : 0);
#pragma unroll
    for (int i = 0; i < 32; ++i) tv[i] = wp[(size_t)(2 * i) * Nsrc];
#pragma unroll
    for (int i = 0; i < 32; ++i) {
        const int kk = 2 * i + (lane >> 5);
        float v = sc >= 0 ? tv[i] : 0.f;
        if (MODE == 1) v *= (k0 + kk < 1024) ? g1[k0 + kk] : g2[k0 + kk - 1024];
        scr[kk * 33 + (lane & 31)] = v;
    }
    asm volatile("s_waitcnt lgkmcnt(0)" ::: "memory");
    const int cch = lane & 7;
#pragma unroll
    for (int j = 0; j < 4; ++j) {
        const int nn = (lane >> 3) + 8 * j; const LAS float* s = scr + (8 * cch) * 33 + nn;
        u32x4 o; o.x = pk2(s[0 * 33], s[1 * 33]); o.y = pk2(s[2 * 33], s[3 * 33]); o.z = pk2(s[4 * 33], s[5 * 33]); o.w = pk2(s[6 * 33], s[7 * 33]);
        *(u32x4*)(WT + (size_t)(n0 + nn) * K + k0 + 8 * cch) = o;
    }
    asm volatile("s_waitcnt lgkmcnt(0)" ::: "memory");
}
__device__ __forceinline__ void cvt_f32_bf16(const Ctx& c, const float* src, bf16_t* dst, size_t n8) {
    for (size_t i = (size_t)c.gt; i < n8; i += (size_t)c.ngt) {
        const f32x4 a = ((const f32x4*)src)[2 * i], b = ((const f32x4*)src)[2 * i + 1];
        u32x4 o; o.x = pk2(a.x, a.y); o.y = pk2(a.z, a.w); o.z = pk2(b.x, b.y); o.w = pk2(b.z, b.w);
        ((u32x4*)dst)[i] = o;
    }
}
__device__ __forceinline__ void step_pro(const Ctx& c) {
    float* MOD = WSP(float, WS_MOD);
    for (int rep_ = 0; rep_ < 1 + ((PRO_REPEAT >> 0) & 1); ++rep_) {
    {
        LAS float* sl = (LAS float*)c.lds;
        LAS float* red = (LAS float*)(c.lds + 32768);
        for (int i = c.tid; i < 4 * D; i += NTHR) sl[i] = silu_f(IN_C[i]);
        __syncthreads();
        for (int cb = blockIdx.x; cb < NMOD / 48; cb += gridDim.x) {
            const int rsub = c.lane / 12, cq = c.lane % 12; const bool act = c.lane < 60;
            const float* wp = IN_WADA + (size_t)(c.wave * 256) * NMOD + cb * 48 + cq * 4;
            f32x4 a0 = {0.f, 0.f, 0.f, 0.f}, a1 = a0, a2 = a0, a3 = a0;
#pragma unroll 1
            for (int it0 = 0; it0 < 56; it0 += 8) {
                f32x4 wv[8];
#pragma unroll
                for (int u = 0; u < 8; ++u) { const int r = (it0 + u) * 5 + rsub; wv[u] = (act && r < 256) ? *(const f32x4*)(wp + (size_t)r * NMOD) : (f32x4){0.f, 0.f, 0.f, 0.f}; }
#pragma unroll
                for (int u = 0; u < 8; ++u) { const int r = (it0 + u) * 5 + rsub, k = c.wave * 256 + (r < 256 ? r : 255);
                    a0 += wv[u] * sl[k]; a1 += wv[u] * sl[D + k]; a2 += wv[u] * sl[2 * D + k]; a3 += wv[u] * sl[3 * D + k]; }
            }
            if (act) { LAS f32x4* o = (LAS f32x4*)(red + (c.wave * 60 + c.lane) * 16); o[0] = a0; o[1] = a1; o[2] = a2; o[3] = a3; }
            __syncthreads();
            if (c.tid < 192) {
                const int bb = c.tid / 48, j = c.tid % 48, q = j >> 2, e = j & 3;
                float sum = IN_BADA[cb * 48 + j];
#pragma unroll
                for (int w = 0; w < 8; ++w)
#pragma unroll
                    for (int rs = 0; rs < 5; ++rs) sum += red[(w * 60 + rs * 12 + q) * 16 + bb * 4 + e];
                MOD[bb * NMOD + cb * 48 + j] = sum;
            }
            __syncthreads();
        }
    }
    }
    for (int rep_ = 0; rep_ < 1 + ((PRO_REPEAT >> 1) & 1); ++rep_) {
    LAS float* scr = (LAS float*)(c.lds + c.wave * 16384);
    constexpr int I_IN = (D / 64) * (DINP / 32), I_SQ = (D / 64) * (D / 32);
    for (int it = c.gw; it < I_IN + 2 * I_SQ; it += c.ngw) {
        int r = it;
        if (r < I_IN) { if (!(I8_GEMM1 && FAST_GEMM)) transpose_item<0>(IN_WIN, D, 3856, DINP, WSP(bf16_t, WS_WIN), scr, r, c.lane, nullptr, nullptr); continue; } r -= I_IN;
        if (r < I_SQ) { if (!(I8_GEMM2 && FAST_GEMM)) transpose_item<1>(IN_WOUT, D, D, D, WSP(bf16_t, WS_WOUT), scr, r, c.lane, IN_SSMG, IN_ATTG); continue; } r -= I_SQ;
        if (!I8_GEMM3) transpose_item<2>(IN_WQ, D, D, D, WSP(bf16_t, WS_WQ), scr, r, c.lane, nullptr, nullptr);
    }
#if WQ_ONEPASS && I8_GEMM1 && I8_GEMM2 && I8_GEMM3 && FAST_GEMM
    __syncthreads();
    for (int it = blockIdx.x; it < 256; it += gridDim.x) {
        if (it < 128) wquant_block<0>(c, IN_WIN, 3856, it, WSP(unsigned char, WS_WIN), WSP(float, WS_SWIN), nullptr, nullptr);
        else if (it < 192) wquant_block<1>(c, IN_WOUT, D, it - 128, WSP(unsigned char, WS_WOUT), WSP(float, WS_SWOUT), IN_SSMG, IN_ATTG);
        else wquant_block<2>(c, IN_WQ, D, it - 192, WSP(unsigned char, WS_WQ), WSP(float, WS_SWQ), nullptr, nullptr);
    }
#else
    if (I8_GEMM3) colamax_items<false>(c, IN_WQ, D, WSP(unsigned, WS_CTL) + CW_AMXQ);
    if (I8_GEMM1 && FAST_GEMM) colamax_items<true>(c, IN_WIN, 3856, WSP(unsigned, WS_CTL) + CW_AMXIN);
    if (I8_GEMM2 && FAST_GEMM) colamax_items<false, true>(c, IN_WOUT, D, WSP(unsigned, WS_CTL) + CW_AMXOUT, IN_SSMG, IN_ATTG);
#endif
    }
    for (int rep_ = 0; rep_ < (HIDE_TABLES ? 0 : 1) + ((PRO_REPEAT >> 2) & 1); ++rep_) {
    {
#define TAB_SRC(r_) ((r_) < 16384 ? IN_U + (size_t)(r_) * D : IN_V + (size_t)((r_) - 16384) * D)
        f32x4 cur[8], nxt[8];
        int r = c.gw;
        if (r < 2 * 16384) fp8_row_load(cur, TAB_SRC(r), c.lane);
        for (; r < 2 * 16384; r += c.ngw) {
            const int rn = r + c.ngw;
            if (rn < 2 * 16384) fp8_row_load(nxt, TAB_SRC(rn), c.lane);
            if (r < 16384) { if (U_INT4) u4_row_finish(cur, WSP(unsigned char, WS_UB), r, WSP(float, WS_SCU) + r, c.lane); else fp8_row_finish<SLICED_PEER != 0>(cur, WSP(unsigned char, WS_UB), r, WSP(float, WS_SCU) + r, c.lane); }
            else if (V_INT4 && U_INT4) u4_row_finish(cur, WSP(unsigned char, WS_VB), r - 16384, WSP(float, WS_SCV) + (r - 16384), c.lane);
            else fp8_row_finish<(SLICED_PEER != 0) && (V_INT8 != 0)>(cur, WSP(unsigned char, WS_VB), r - 16384, WSP(float, WS_SCV) + (r - 16384), c.lane);
#pragma unroll
            for (int i = 0; i < 8; ++i) cur[i] = nxt[i];
        }
#undef TAB_SRC
    }
    }
    cvt_f32_bf16(c, IN_KEYS, WSP(bf16_t, WS_KEYS), (size_t)8 * 2 * 128 * 128 / 8);
}

__device__ __forceinline__ void step_h1(const Ctx& c) {
    const float* MOD = WSP(float, WS_MOD); bf16_t* H1 = WSP(bf16_t, WS_ACT);
    for (int t = c.gw; t < T; t += c.ngw) {
        const int b = t >> 12; const float* xr = IN_X + (size_t)t * D; const float* sh = MOD + b * NMOD; const float* sc = sh + D;
#if I8_GEMM1 && FAST_GEMM
        f32x4 hv[8]; float hmax = 0.f;
#pragma unroll
        for (int j = 0; j < 8; ++j) {
            const int col = j * 256 + c.lane * 4;
            const f32x4 xv = *(const f32x4*)(xr + col), s = *(const f32x4*)(sc + col), h = *(const f32x4*)(sh + col);
            hv[j] = xv * (s + 1.f) + h; hmax = fmaxf(hmax, fmaxf(fmaxf(fabsf(hv[j].x), fabsf(hv[j].y)), fmaxf(fabsf(hv[j].z), fabsf(hv[j].w))));
        }
        hmax = DPPMAX(hmax, 0xB1); hmax = DPPMAX(hmax, 0x4E); hmax = DPPMAX(hmax, 0x141); hmax = DPPMAX(hmax, 0x140);
        const unsigned a0 = __builtin_amdgcn_readlane(__float_as_uint(hmax), 0), a1 = __builtin_amdgcn_readlane(__float_as_uint(hmax), 16), a2 = __builtin_amdgcn_readlane(__float_as_uint(hmax), 32), a3 = __builtin_amdgcn_readlane(__float_as_uint(hmax), 48);
        const unsigned m01 = a0 > a1 ? a0 : a1, m23 = a2 > a3 ? a2 : a3; const float am = __uint_as_float(m01 > m23 ? m01 : m23), inv = am > 0.f ? 127.f / am : 0.f;
#pragma unroll
        for (int j = 0; j < 8; ++j) *(unsigned*)((unsigned char*)H1 + (size_t)t * D + j * 256 + c.lane * 4) = pack_i8x4(hv[j] * inv);
        if (c.lane == 0) WSP(float, WS_SA1)[t] = am * (1.f / 127.f);
#else
#pragma unroll
        for (int j = 0; j < 8; ++j) {
            const int col = j * 256 + c.lane * 4;
            const f32x4 xv = *(const f32x4*)(xr + col), s = *(const f32x4*)(sc + col), h = *(const f32x4*)(sh + col);
            u32x2 o; o.x = pk2(xv.x * (1.f + s.x) + h.x, xv.y * (1.f + s.y) + h.y); o.y = pk2(xv.z * (1.f + s.z) + h.z, xv.w * (1.f + s.w) + h.w);
            *(u32x2*)(H1 + (size_t)t * D + col) = o;
        }
#endif
    }
}

struct Epi1 {
    bf16_t* proj; float* dtraw;
    __device__ __forceinline__ float rho(int) const { return 1.f; }
    __device__ __forceinline__ float rowscale(int) const { return 1.f; }
    __device__ __forceinline__ void store8s(int row, int col, const float (&v)[8], float) const { store8(row, col, v); }
    __device__ __forceinline__ void store8(int row, int col, const float (&v)[8]) const {
        u32x4 o; o.x = pk2(v[0], v[1]); o.y = pk2(v[2], v[3]); o.z = pk2(v[4], v[5]); o.w = pk2(v[6], v[7]);
        *(u32x4*)(proj + (size_t)row * DINP + col) = o;
        if (col >= DT_OFF && col < DT_OFF + 16) {
            float* d = dtraw + (size_t)row * 16 + (col - DT_OFF);
            *(f32x4*)d = (f32x4){v[0], v[1], v[2], v[3]}; *(f32x4*)(d + 4) = (f32x4){v[4], v[5], v[6], v[7]};
        }
    }
};
struct Epi2 {
    const float* x; const float* mod; const float* ssp; bf16_t* r1;
    __device__ __forceinline__ void rs_pair(int row, float& r_ssd, float& r_att) const {
        float s1 = 0.f, s2 = 0.f;
#pragma unroll
        for (int j = 0; j < 4; ++j) { const f32x4 a = *(const f32x4*)(ssp + (size_t)row * 32 + 4 * j), b = *(const f32x4*)(ssp + (size_t)row * 32 + 16 + 4 * j);
            s1 += (a.x + a.y) + (a.z + a.w); s2 += (b.x + b.y) + (b.z + b.w); }
        r_ssd = rsqrtf(s1 * (1.f / 1024.f) + EPS); r_att = rsqrtf(s2 * (1.f / 1024.f) + EPS);
    }
    __device__ __forceinline__ float rho(int row) const { float a, b; rs_pair(row, a, b); return a / b; }
    __device__ __forceinline__ float rowscale(int row) const { float a, b; rs_pair(row, a, b); return b; }
    __device__ __forceinline__ void store8s(int row, int col, const float (&v)[8], float ra) const {
        const int b = row >> 12;
        const float* g = mod + b * NMOD + 2 * D + col;
        const f32x4 g0 = *(const f32x4*)g, g1 = *(const f32x4*)(g + 4);
        u32x4 o;
        o.x = cvtpk(g0.x * (ra * v[0]), g0.y * (ra * v[1])); o.y = cvtpk(g0.z * (ra * v[2]), g0.w * (ra * v[3]));
        o.z = cvtpk(g1.x * (ra * v[4]), g1.y * (ra * v[5])); o.w = cvtpk(g1.z * (ra * v[6]), g1.w * (ra * v[7]));
        *(u32x4*)(r1 + (size_t)row * D + col) = o;
    }
    __device__ __forceinline__ void store8(int row, int col, const float (&v)[8]) const { store8s(row, col, v, rowscale(row)); }
};
struct Epi3 {
    bf16_t* q;
    __device__ __forceinline__ float rho(int) const { return 1.f; }
    __device__ __forceinline__ float rowscale(int) const { return 1.f; }
    __device__ __forceinline__ void store8s(int row, int col, const float (&v)[8], float) const { store8(row, col, v); }
    __device__ __forceinline__ void store8(int row, int col, const float (&v)[8]) const {
        u32x4 o; o.x = pk2(v[0], v[1]); o.y = pk2(v[2], v[3]); o.z = pk2(v[4], v[5]); o.w = pk2(v[6], v[7]);
        *(u32x4*)(q + (size_t)row * D + col) = o;
    }
};

struct Epi1Q {
    bf16_t* proj; float* dtraw; const float* sa; const float* sw;
    __device__ __forceinline__ float rho(int) const { return 1.f; }
    __device__ __forceinline__ float rowscale(int row) const { return sa[row]; }
    __device__ __forceinline__ void store8s(int row, int col, const float (&v)[8], float rsc) const {
        const f32x4 s0 = *(const f32x4*)(sw + col) * rsc, s1 = *(const f32x4*)(sw + col + 4) * rsc;
        const float r0 = v[0] * s0.x, r1 = v[1] * s0.y, r2 = v[2] * s0.z, r3 = v[3] * s0.w, r4 = v[4] * s1.x, r5 = v[5] * s1.y, r6 = v[6] * s1.z, r7 = v[7] * s1.w;
        u32x4 o; o.x = cvtpk(r0, r1); o.y = cvtpk(r2, r3); o.z = cvtpk(r4, r5); o.w = cvtpk(r6, r7);
        *(u32x4*)(proj + (size_t)row * DINP + col) = o;
        if (col >= DT_OFF && col < DT_OFF + 16) { float* d = dtraw + (size_t)row * 16 + (col - DT_OFF); *(f32x4*)d = (f32x4){r0, r1, r2, r3}; *(f32x4*)(d + 4) = (f32x4){r4, r5, r6, r7}; }
    }
    __device__ __forceinline__ void store8(int row, int col, const float (&v)[8]) const { store8s(row, col, v, rowscale(row)); }
    __device__ __forceinline__ void colscales(int, int col, f32x4& s0, f32x4& s1) const { s0 = *(const f32x4*)(sw + col); s1 = *(const f32x4*)(sw + col + 4); }
    __device__ __forceinline__ void store8p(int row, int col, const float (&v)[8], const f32x4& c0, const f32x4& c1, float rsc) const {
        const f32x4 s0 = c0 * rsc, s1 = c1 * rsc;
        const float r0 = v[0] * s0.x, r1 = v[1] * s0.y, r2 = v[2] * s0.z, r3 = v[3] * s0.w, r4 = v[4] * s1.x, r5 = v[5] * s1.y, r6 = v[6] * s1.z, r7 = v[7] * s1.w;
        u32x4 o; o.x = cvtpk(r0, r1); o.y = cvtpk(r2, r3); o.z = cvtpk(r4, r5); o.w = cvtpk(r6, r7);
        *(u32x4*)(proj + (size_t)row * DINP + col) = o;
        if (col >= DT_OFF && col < DT_OFF + 16) { float* d = dtraw + (size_t)row * 16 + (col - DT_OFF); *(f32x4*)d = (f32x4){r0, r1, r2, r3}; *(f32x4*)(d + 4) = (f32x4){r4, r5, r6, r7}; }
    }
};
struct Epi2Q {
    const float* mod; const float* sa; const float* sw; bf16_t* r1;
    __device__ __forceinline__ float rho(int) const { return 1.f; }
    __device__ __forceinline__ float rowscale(int row) const { return sa[row]; }
    __device__ __forceinline__ void store8s(int row, int col, const float (&v)[8], float rsc) const {
        const int b = row >> 12; const float* g = mod + b * NMOD + 2 * D + col;
        const f32x4 s0 = *(const f32x4*)(sw + col) * *(const f32x4*)g * rsc, s1 = *(const f32x4*)(sw + col + 4) * *(const f32x4*)(g + 4) * rsc;
        u32x4 o; o.x = cvtpk(v[0] * s0.x, v[1] * s0.y); o.y = cvtpk(v[2] * s0.z, v[3] * s0.w); o.z = cvtpk(v[4] * s1.x, v[5] * s1.y); o.w = cvtpk(v[6] * s1.z, v[7] * s1.w);
        *(u32x4*)(r1 + (size_t)row * D + col) = o;
    }
    __device__ __forceinline__ void store8(int row, int col, const float (&v)[8]) const { store8s(row, col, v, rowscale(row)); }
    __device__ __forceinline__ void colscales(int row, int col, f32x4& s0, f32x4& s1) const {
        const float* g = mod + (row >> 12) * NMOD + 2 * D + col; s0 = *(const f32x4*)(sw + col) * *(const f32x4*)g; s1 = *(const f32x4*)(sw + col + 4) * *(const f32x4*)(g + 4); }
    __device__ __forceinline__ void store8p(int row, int col, const float (&v)[8], const f32x4& c0, const f32x4& c1, float rsc) const {
        const f32x4 s0 = c0 * rsc, s1 = c1 * rsc;
        u32x4 o; o.x = cvtpk(v[0] * s0.x, v[1] * s0.y); o.y = cvtpk(v[2] * s0.z, v[3] * s0.w); o.z = cvtpk(v[4] * s1.x, v[5] * s1.y); o.w = cvtpk(v[6] * s1.z, v[7] * s1.w);
        *(u32x4*)(r1 + (size_t)row * D + col) = o;
    }
};
struct Epi3Q {
    bf16_t* q; const float* hs; const float* swq;
    __device__ __forceinline__ float rho(int) const { return 1.f; }
    __device__ __forceinline__ float rowscale(int row) const { return hs[row]; }
    __device__ __forceinline__ void store8s(int row, int col, const float (&v)[8], float rsc) const {
        const f32x4 s0 = *(const f32x4*)(swq + col) * rsc, s1 = *(const f32x4*)(swq + col + 4) * rsc;
        u32x4 o; o.x = cvtpk(v[0] * s0.x, v[1] * s0.y); o.y = cvtpk(v[2] * s0.z, v[3] * s0.w); o.z = cvtpk(v[4] * s1.x, v[5] * s1.y); o.w = cvtpk(v[6] * s1.z, v[7] * s1.w);
        *(u32x4*)(q + (size_t)row * D + col) = o;
    }
    __device__ __forceinline__ void store8(int row, int col, const float (&v)[8]) const { store8s(row, col, v, rowscale(row)); }
    __device__ __forceinline__ void colscales(int, int col, f32x4& s0, f32x4& s1) const { s0 = *(const f32x4*)(swq + col); s1 = *(const f32x4*)(swq + col + 4); }
    __device__ __forceinline__ void store8p(int row, int col, const float (&v)[8], const f32x4& c0, const f32x4& c1, float rsc) const {
        const f32x4 s0 = c0 * rsc, s1 = c1 * rsc;
        u32x4 o; o.x = cvtpk(v[0] * s0.x, v[1] * s0.y); o.y = cvtpk(v[2] * s0.z, v[3] * s0.w); o.z = cvtpk(v[4] * s1.x, v[5] * s1.y); o.w = cvtpk(v[6] * s1.z, v[7] * s1.w);
        *(u32x4*)(q + (size_t)row * D + col) = o;
    }
};
template <class Epi, bool MIDK>
__device__ __forceinline__ void gemm_simple(const Ctx& c, const bf16_t* A, const bf16_t* Bt, int M, int N, int K, const Epi& E) {
    LAS float* As = (LAS float*)c.lds;
    LAS float* Bs = As + 32 * 132;
    const int tid = c.tid, ty = tid >> 4, tx = tid & 15, lr = tid >> 2, lk = (tid & 3) * 8;
    const int nTn = N / 128, ntile = (M / 128) * nTn;
    for (int tile = blockIdx.x; tile < ntile; tile += gridDim.x) {
        const int tm = tile / nTn, tn = tile % nTn;
        float acc[4][8];
#pragma unroll
        for (int i = 0; i < 4; ++i)
#pragma unroll
            for (int j = 0; j < 8; ++j) acc[i][j] = 0.f;
        const bf16_t* Ap = A + (size_t)(tm * 128 + lr) * K + lk;
        const bf16_t* Bp = Bt + (size_t)(tn * 128 + lr) * K + lk;
        for (int k0 = 0; k0 < K; k0 += 32) {
            if (MIDK && k0 == K / 2) {
#pragma unroll
                for (int i = 0; i < 4; ++i) { const float r = E.rho(tm * 128 + ty * 4 + i);
#pragma unroll
                    for (int j = 0; j < 8; ++j) acc[i][j] *= r; }
            }
            const u32x4 av = *(const u32x4*)(Ap + k0), bv = *(const u32x4*)(Bp + k0);
            __syncthreads();
            As[(lk + 0) * 132 + lr] = bflo(av.x); As[(lk + 1) * 132 + lr] = bfhi(av.x); As[(lk + 2) * 132 + lr] = bflo(av.y); As[(lk + 3) * 132 + lr] = bfhi(av.y);
            As[(lk + 4) * 132 + lr] = bflo(av.z); As[(lk + 5) * 132 + lr] = bfhi(av.z); As[(lk + 6) * 132 + lr] = bflo(av.w); As[(lk + 7) * 132 + lr] = bfhi(av.w);
            Bs[(lk + 0) * 132 + lr] = bflo(bv.x); Bs[(lk + 1) * 132 + lr] = bfhi(bv.x); Bs[(lk + 2) * 132 + lr] = bflo(bv.y); Bs[(lk + 3) * 132 + lr] = bfhi(bv.y);
            Bs[(lk + 4) * 132 + lr] = bflo(bv.z); Bs[(lk + 5) * 132 + lr] = bfhi(bv.z); Bs[(lk + 6) * 132 + lr] = bflo(bv.w); Bs[(lk + 7) * 132 + lr] = bfhi(bv.w);
            __syncthreads();
#pragma unroll 8
            for (int k = 0; k < 32; ++k) {
                const f32x4 a = *(const LAS f32x4*)(As + k * 132 + ty * 4);
                const f32x4 b0 = *(const LAS f32x4*)(Bs + k * 132 + tx * 8), b1 = *(const LAS f32x4*)(Bs + k * 132 + tx * 8 + 4);
                const float aa[4] = {a.x, a.y, a.z, a.w}; const float bb[8] = {b0.x, b0.y, b0.z, b0.w, b1.x, b1.y, b1.z, b1.w};
#pragma unroll
                for (int i = 0; i < 4; ++i)
#pragma unroll
                    for (int j = 0; j < 8; ++j) acc[i][j] += aa[i] * bb[j];
            }
        }
#pragma unroll
        for (int i = 0; i < 4; ++i) E.store8(tm * 128 + ty * 4 + i, tn * 128 + tx * 8, acc[i]);
    }
    __syncthreads();
}

namespace pg8 {
#define PG8_LAS __attribute__((address_space(3)))
typedef unsigned short bf16_t;
typedef short bf16x8 __attribute__((ext_vector_type(8)));
typedef float f32x4 __attribute__((ext_vector_type(4)));
typedef unsigned u32x4 __attribute__((ext_vector_type(4)));
constexpr int BM = 256, BK = 64, HALF = 128, HTB = HALF * BK * 2  , STAGE_BYTES = 8 * HTB, NXCD = 8, WGM = 8;

__host__ __device__ __forceinline__ int lds_byte(int r, int c) { const int st = (r >> 4) * 2 + (c >> 5), rr = r & 15, cc = c & 31, ob = rr * 64 + cc * 2; return st * 1024 + (ob ^ (((ob >> 9) & 1) << 5)); }
__host__ __device__ __forceinline__ void stage_rc(int b, int& R, int& C) { const int st = b / 1024, sb = b % 1024, swz = sb ^ (((sb >> 9) & 1) << 5); R = (st >> 1) * 16 + swz / 64; C = (st & 1) * 32 + (swz % 64) / 2; }
__host__ __device__ __forceinline__ int perm32(int rho) { const int n = rho >> 4, i = rho & 15; return 8 * (i >> 2) + 4 * n + (i & 3); }

struct Unit { int pm, pn; };
struct Gemm { const bf16_t* A; const bf16_t* Bt; int M, N, K; };

struct StaticOrder {
    int nM, nN, nwg, G, c;
    __host__ __device__ void init(int M, int N, int G_, int c_) { nM = M / BM; nN = N / BM; nwg = nM * nN; G = G_; c = c_; }
    __host__ __device__ bool next(int i, Unit& u) const {
        const long L = (long)i * G + c; if (L >= nwg) return false;
        int wgid = (int)L; { const int q = nwg / NXCD, r = nwg % NXCD, xcd = wgid % NXCD, off = wgid / NXCD; wgid = (xcd < r ? xcd * (q + 1) : r * (q + 1) + (xcd - r) * q) + off; }
        const int nig = WGM * nN, gid = wgid / nig, fm = gid * WGM, gsz = (nM - fm) < WGM ? (nM - fm) : WGM;
        u.pm = fm + ((wgid % nig) % gsz); u.pn = (wgid % nig) / gsz; return true;
    }
    __device__ __forceinline__ void a_ready(const Unit&) const {}
    __device__ __forceinline__ void done(const Unit&) const {}
};


template <class E, bool I8 = false> struct EpiA {
    static constexpr bool PERM = true, AFTER_DRAIN = false; E e;
    __device__ __forceinline__ void operator()(const f32x4 (&acc)[2][2][4][2], const Unit& u, int wr, int wc, int fr, int fq) const {
        if constexpr (I8) {
            f32x4 cs[2][2]; float rs[2][4];
#pragma unroll
            for (int bj = 0; bj < 2; ++bj) e.colscales(u.pm * BM, u.pn * BM + bj * HALF + wc * 32 + 8 * fq, cs[bj][0], cs[bj][1]);
#pragma unroll
            for (int ai = 0; ai < 2; ++ai)
#pragma unroll
                for (int m = 0; m < 4; ++m) rs[ai][m] = e.rowscale(u.pm * BM + ai * HALF + wr * 64 + m * 16 + fr);
#pragma unroll
            for (int ai = 0; ai < 2; ++ai)
#pragma unroll
                for (int m = 0; m < 4; ++m) {
                    const int row = u.pm * BM + ai * HALF + wr * 64 + m * 16 + fr;
#pragma unroll
                    for (int bj = 0; bj < 2; ++bj) {
                        const f32x4 v0 = acc[ai][bj][m][0], v1 = acc[ai][bj][m][1];
                        float v[8];
#pragma unroll
                        for (int j = 0; j < 4; ++j) { v[j] = (float)__float_as_int(v0[j]); v[4 + j] = (float)__float_as_int(v1[j]); }
                        e.store8p(row, u.pn * BM + bj * HALF + wc * 32 + 8 * fq, v, cs[bj][0], cs[bj][1], rs[ai][m]);
                    }
                }
            return;
        }
#pragma unroll
        for (int ai = 0; ai < 2; ++ai)
#pragma unroll
            for (int m = 0; m < 4; ++m) {
                const int row = u.pm * BM + ai * HALF + wr * 64 + m * 16 + fr; const float rsc = e.rowscale(row);
#pragma unroll
                for (int bj = 0; bj < 2; ++bj) {
                    const f32x4 v0 = acc[ai][bj][m][0], v1 = acc[ai][bj][m][1];
                    float v[8];
#pragma unroll
                    for (int j = 0; j < 4; ++j) { v[j] = v0[j]; v[4 + j] = v1[j]; }
                    e.store8s(row, u.pn * BM + bj * HALF + wc * 32 + 8 * fq, v, rsc);
                }
                if (m & 1) asm volatile("" ::: "memory");
            }
    }
    __device__ __forceinline__ void midk(f32x4 (&acc)[2][2][4][2], const Unit& u, int wr, int fr) const {
#pragma unroll
        for (int ai = 0; ai < 2; ++ai)
#pragma unroll
            for (int m = 0; m < 4; ++m) {
                const float r = e.rho(u.pm * BM + ai * HALF + wr * 64 + m * 16 + fr);
#pragma unroll
                for (int bj = 0; bj < 2; ++bj)
#pragma unroll
                    for (int n = 0; n < 2; ++n) acc[ai][bj][m][n] = acc[ai][bj][m][n] * r;
            }
    }
};
typedef int i32x4 __attribute__((ext_vector_type(4)));
template <class Epi, class Sched, bool ALIGN_EPI = false, bool SP2 = false, bool MIDK = false, bool I8 = false>
__device__ __forceinline__ void gemm_phase(PG8_LAS unsigned char* lds, const Gemm g, const Sched& S, const Epi& E) {
    const int tid = threadIdx.x, wid = __builtin_amdgcn_readfirstlane(tid >> 6), lane = tid & 63, wr = wid >> 2, wc = wid & 3, fr = lane & 15, fq = lane >> 4;
    const int K = g.K, nt = K / BK;
    unsigned voffA[2], voffB[2];
#pragma unroll
    for (int i = 0; i < 2; ++i) { int R, C; stage_rc(tid * 16 + i * 8192, R, C); const int Rb = Epi::PERM ? ((R & ~31) + perm32(R & 31)) : R;
        voffA[i] = (unsigned)(R * K + C) * 2u; voffB[i] = (unsigned)(Rb * K + C) * 2u; }
    const size_t kstep = (size_t)(BK * 2);
    const size_t hstep = (size_t)HALF * K * 2;
    const size_t tstep = 2 * hstep;
    const unsigned ldsw = (unsigned)wid * 1024u;
    const int aoff = lds_byte(wr * 64 + fr, fq * 8), boff = lds_byte(wc * 32 + fr, fq * 8);
#define PG8_SA(b, h) (((b) * 2 + (h)) * HTB)
#define PG8_SB(b, h) ((4 + (b) * 2 + (h)) * HTB)
#define PG8_STAGE(bufoff, gbase, voff) do { _Pragma("unroll") for (int _i = 0; _i < 2; ++_i) \
        __builtin_amdgcn_global_load_lds((const unsigned*)((const char*)(gbase) + (voff)[_i]), (PG8_LAS unsigned*)(lds + (bufoff) + ldsw + _i * 8192), 16, 0, 0); } while (0)
#define PG8_LDA(dst, b, h) do { _Pragma("unroll") for (int m = 0; m < 4; ++m) _Pragma("unroll") for (int k = 0; k < 2; ++k) dst[m][k] = *(const PG8_LAS bf16x8*)(lds + PG8_SA(b, h) + aoff + m * 2048 + k * 1024); } while (0)
#define PG8_LDB(dst, b, h) do { _Pragma("unroll") for (int n = 0; n < 2; ++n) _Pragma("unroll") for (int k = 0; k < 2; ++k) dst[n][k] = *(const PG8_LAS bf16x8*)(lds + PG8_SB(b, h) + boff + n * 2048 + k * 1024); } while (0)
#define PG8_MMA(ai, bj, At, Bt) do { __builtin_amdgcn_s_setprio(1); _Pragma("unroll") for (int m = 0; m < 4; ++m) _Pragma("unroll") for (int n = 0; n < 2; ++n) _Pragma("unroll") for (int k = 0; k < 2; ++k) { \
        if constexpr (I8) acc[ai][bj][m][n] = __builtin_bit_cast(f32x4, __builtin_amdgcn_mfma_i32_16x16x64_i8(__builtin_bit_cast(i32x4, Bt[n][k]), __builtin_bit_cast(i32x4, At[m][k]), __builtin_bit_cast(i32x4, acc[ai][bj][m][n]), 0, 0, 0)); \
        else acc[ai][bj][m][n] = __builtin_amdgcn_mfma_f32_16x16x32_bf16(Bt[n][k], At[m][k], acc[ai][bj][m][n], 0, 0, 0); } __builtin_amdgcn_s_setprio(0); } while (0)
#define PG8_WAIT_V(n) asm volatile("s_waitcnt vmcnt(" #n ")" ::: "memory")
#define PG8_WAIT_L(n) asm volatile("s_waitcnt lgkmcnt(" #n ")" ::: "memory")
#define PG8_BAR __builtin_amdgcn_s_barrier()
#define PG8_SCHED __builtin_amdgcn_sched_barrier(0)
    Unit cur, nxt; int ui = 0;
    if (!S.next(0, cur)) return;
    f32x4 acc[2][2][4][2];
#pragma unroll
    for (int a = 0; a < 2; ++a)
#pragma unroll
        for (int b = 0; b < 2; ++b)
#pragma unroll
            for (int m = 0; m < 4; ++m)
#pragma unroll
                for (int n = 0; n < 2; ++n) acc[a][b][m][n] = (f32x4){0.f, 0.f, 0.f, 0.f};
    bf16x8 At[4][2], B0[2][2], B1[2][2];
    const char* cA = (const char*)g.A + (size_t)cur.pm * tstep; const char* cB = (const char*)g.Bt + (size_t)cur.pn * tstep;
    S.a_ready(cur);
    if constexpr (SP2) {
        PG8_STAGE(PG8_SB(0, 0), cB, voffB); PG8_STAGE(PG8_SB(0, 1), cB + hstep, voffB); PG8_STAGE(PG8_SA(0, 0), cA, voffA); PG8_STAGE(PG8_SA(0, 1), cA + hstep, voffA);
        if (wr == 1) PG8_BAR;
        PG8_WAIT_V(2); PG8_BAR;
        PG8_STAGE(PG8_SB(1, 0), cB + kstep, voffB); PG8_STAGE(PG8_SA(1, 0), cA + kstep, voffA); PG8_STAGE(PG8_SB(1, 1), cB + hstep + kstep, voffB);
        PG8_WAIT_V(6); PG8_BAR;
    } else {
        PG8_STAGE(PG8_SB(0, 0), cB, voffB); PG8_STAGE(PG8_SA(0, 0), cA, voffA); PG8_STAGE(PG8_SB(0, 1), cB + hstep, voffB); PG8_STAGE(PG8_SA(0, 1), cA + hstep, voffA);
        if (wr == 1) PG8_BAR;
        PG8_WAIT_V(4); PG8_BAR;
        PG8_STAGE(PG8_SB(1, 0), cB + kstep, voffB); PG8_STAGE(PG8_SA(1, 0), cA + kstep, voffA); PG8_STAGE(PG8_SB(1, 1), cB + hstep + kstep, voffB);
        PG8_WAIT_V(6); PG8_BAR;
    }
    for (;;) {
        const bool has_next = S.next(ui + 1, nxt);
        const char* nA = has_next ? (const char*)g.A + (size_t)nxt.pm * tstep : cA; const char* nB = has_next ? (const char*)g.Bt + (size_t)nxt.pn * tstep : cB;
        for (int t = 0; t < nt; t += 2) {
            const bool last = (t == nt - 2);
            if constexpr (MIDK) { if (t == nt / 2) E.midk(acc, cur, wr, fr); }
            const char* a1 = cA + (size_t)(t + 1) * kstep;
            const char* a2 = last ? nA : cA + (size_t)(t + 2) * kstep; const char* b2 = last ? nB : cB + (size_t)(t + 2) * kstep;
            const char* a3 = a2 + kstep; const char* b3 = b2 + kstep;
            if (last && has_next) S.a_ready(nxt);
            if constexpr (SP2) {
            PG8_LDB(B0, 0, 0); PG8_LDB(B1, 0, 1); PG8_SCHED; PG8_LDA(At, 0, 0); PG8_STAGE(PG8_SA(1, 1), a1 + hstep, voffA);
            PG8_WAIT_V(8); PG8_WAIT_L(0); PG8_BAR; PG8_MMA(0, 0, At, B0); PG8_MMA(0, 1, At, B1); PG8_BAR; PG8_SCHED;
            PG8_LDA(At, 0, 1); PG8_STAGE(PG8_SB(0, 0), b2, voffB); PG8_STAGE(PG8_SB(0, 1), b2 + hstep, voffB); PG8_STAGE(PG8_SA(0, 0), a2, voffA);
            PG8_WAIT_V(8); PG8_WAIT_L(0); PG8_BAR; PG8_MMA(1, 0, At, B0); PG8_MMA(1, 1, At, B1); PG8_BAR; PG8_SCHED;
            PG8_LDB(B0, 1, 0); PG8_LDB(B1, 1, 1); PG8_SCHED; PG8_LDA(At, 1, 0); PG8_STAGE(PG8_SA(0, 1), a2 + hstep, voffA);
            PG8_WAIT_V(8); PG8_WAIT_L(0); PG8_BAR; PG8_MMA(0, 0, At, B0); PG8_MMA(0, 1, At, B1); PG8_BAR; PG8_SCHED;
            PG8_LDA(At, 1, 1); PG8_STAGE(PG8_SB(1, 0), b3, voffB); PG8_STAGE(PG8_SB(1, 1), b3 + hstep, voffB); PG8_STAGE(PG8_SA(1, 0), a3, voffA);
            PG8_WAIT_V(8); PG8_WAIT_L(0); PG8_BAR; PG8_MMA(1, 0, At, B0); PG8_MMA(1, 1, At, B1); PG8_BAR; PG8_SCHED;
            } else {
            PG8_LDB(B0, 0, 0); PG8_SCHED; PG8_LDA(At, 0, 0); PG8_STAGE(PG8_SA(1, 1), a1 + hstep, voffA);
            PG8_WAIT_L(8); PG8_BAR; PG8_WAIT_L(0); PG8_MMA(0, 0, At, B0); PG8_BAR; PG8_SCHED;
            PG8_LDB(B1, 0, 1); PG8_STAGE(PG8_SB(0, 0), b2, voffB);
            PG8_BAR; PG8_WAIT_L(0); PG8_MMA(0, 1, At, B1); PG8_BAR;
            PG8_LDA(At, 0, 1); PG8_STAGE(PG8_SA(0, 0), a2, voffA);
            PG8_BAR; PG8_WAIT_L(0); PG8_MMA(1, 0, At, B0); PG8_BAR; PG8_SCHED;
            PG8_STAGE(PG8_SB(0, 1), b2 + hstep, voffB);
            PG8_WAIT_V(6); PG8_BAR; PG8_MMA(1, 1, At, B1); PG8_BAR;
            PG8_LDB(B0, 1, 0); PG8_SCHED; PG8_LDA(At, 1, 0); PG8_STAGE(PG8_SA(0, 1), a2 + hstep, voffA);
            PG8_WAIT_L(8); PG8_BAR; PG8_WAIT_L(0); PG8_MMA(0, 0, At, B0); PG8_BAR; PG8_SCHED;
            PG8_LDB(B1, 1, 1); PG8_STAGE(PG8_SB(1, 0), b3, voffB);
            PG8_BAR; PG8_WAIT_L(0); PG8_MMA(0, 1, At, B1); PG8_BAR;
            PG8_LDA(At, 1, 1); PG8_STAGE(PG8_SA(1, 0), a3, voffA);
            PG8_BAR; PG8_WAIT_L(0); PG8_MMA(1, 0, At, B0); PG8_BAR; PG8_SCHED;
            PG8_STAGE(PG8_SB(1, 1), b3 + hstep, voffB);
            PG8_WAIT_V(6); PG8_BAR; PG8_MMA(1, 1, At, B1); PG8_BAR;
            }
        }
        if constexpr (ALIGN_EPI) { if (wr == 0) PG8_BAR; }
        if constexpr (!Epi::AFTER_DRAIN) { E(acc, cur, wr, wc, fr, fq); S.done(cur); }
        if (!has_next) break;
#pragma unroll
        for (int a = 0; a < 2; ++a)
#pragma unroll
            for (int b = 0; b < 2; ++b)
#pragma unroll
                for (int m = 0; m < 4; ++m)
#pragma unroll
                    for (int n = 0; n < 2; ++n) acc[a][b][m][n] = (f32x4){0.f, 0.f, 0.f, 0.f};
        cur = nxt; cA = nA; cB = nB; ++ui;
        if constexpr (ALIGN_EPI) { if (wr == 1) PG8_BAR; }
    }
    PG8_WAIT_V(0);
    if constexpr (!ALIGN_EPI) { if (wr == 0) PG8_BAR; }
    PG8_BAR;
    if constexpr (Epi::AFTER_DRAIN) { E.fused(acc, cur, wr, wc, fr, fq, lds, wid, lane); S.done(cur); }
#undef PG8_SA
#undef PG8_SB
#undef PG8_STAGE
#undef PG8_LDA
#undef PG8_LDB
#undef PG8_MMA
#undef PG8_WAIT_V
#undef PG8_WAIT_L
#undef PG8_BAR
#undef PG8_SCHED
}
}

__device__ __forceinline__ void step_conv(const Ctx& c) {
    const bf16_t* PROJ = WSP(bf16_t, WS_PROJ); bf16_t* XBCC = WSP(bf16_t, WS_XBCC);
    for (int idx = c.gt; idx < T * 768; idx += c.ngt) {
        const int t = idx / 768, ch = (idx % 768) * 2, pos = t & (SEQ - 1);
        float a0 = IN_CONVB[ch], a1 = IN_CONVB[ch + 1];
#pragma unroll
        for (int j = 0; j < 4; ++j) {
            if (pos - 3 + j >= 0) {
                const unsigned v = *(const unsigned*)(PROJ + (size_t)(t - 3 + j) * DINP + XBC_OFF + ch);
                a0 += IN_CONVW[j * 1536 + ch] * bflo(v); a1 += IN_CONVW[j * 1536 + ch + 1] * bfhi(v);
            }
        }
        *(unsigned*)(XBCC + (size_t)t * 1536 + ch) = pk2(silu_f(a0), silu_f(a1));
    }
    const float* DTRAW = WSP(float, WS_DTRAW); float* DT = WSP(float, WS_DT); float* ACUM = WSP(float, WS_ACUM);
    for (int idx = c.gt; idx < NB * NCH * NH; idx += c.ngt) {
        const int h = idx % NH, bc = idx / NH, t0 = bc * 128;
        const float A = -expf(IN_ALOG[h]), bias = IN_DTBIAS[h]; float cum = 0.f;
        for (int l = 0; l < 128; ++l) {
            const float dtv = softplus_f(DTRAW[(size_t)(t0 + l) * 16 + h] + bias); cum += dtv * A;
            DT[(size_t)idx * 128 + l] = dtv; ACUM[(size_t)idx * 128 + l] = cum;
        }
    }
}

__device__ __forceinline__ void step_ssd1_simple(const Ctx& c) {
    const bf16_t* XBCC = WSP(bf16_t, WS_XBCC); const float* DT = WSP(float, WS_DT); const float* ACUM = WSP(float, WS_ACUM); float* STATES = WSP(float, WS_STATES);
    LAS float* wl = (LAS float*)c.lds;
    for (int item = blockIdx.x; item < NB * NCH * NH; item += gridDim.x) {
        const int bc = item / NH, h = item % NH, g = h >> 3, t0 = bc * 128;
        __syncthreads();
        if (c.tid < 128) { const float aend = ACUM[(size_t)item * 128 + 127]; wl[c.tid] = fexp(aend - ACUM[(size_t)item * 128 + c.tid]) * DT[(size_t)item * 128 + c.tid]; }
        __syncthreads();
        const int p = c.tid >> 3, n0 = (c.tid & 7) * 16;
        float acc[16];
#pragma unroll
        for (int j = 0; j < 16; ++j) acc[j] = 0.f;
        for (int l = 0; l < 128; ++l) {
            const bf16_t* row = XBCC + (size_t)(t0 + l) * 1536;
            const float xv = bf2f(row[h * 64 + p]) * wl[l];
            const u32x4 b0 = *(const u32x4*)(row + 1024 + g * 128 + n0), b1 = *(const u32x4*)(row + 1024 + g * 128 + n0 + 8);
            acc[0] += xv * bflo(b0.x); acc[1] += xv * bfhi(b0.x); acc[2] += xv * bflo(b0.y); acc[3] += xv * bfhi(b0.y);
            acc[4] += xv * bflo(b0.z); acc[5] += xv * bfhi(b0.z); acc[6] += xv * bflo(b0.w); acc[7] += xv * bfhi(b0.w);
            acc[8] += xv * bflo(b1.x); acc[9] += xv * bfhi(b1.x); acc[10] += xv * bflo(b1.y); acc[11] += xv * bfhi(b1.y);
            acc[12] += xv * bflo(b1.z); acc[13] += xv * bfhi(b1.z); acc[14] += xv * bflo(b1.w); acc[15] += xv * bfhi(b1.w);
        }
        float* o = STATES + ((size_t)item * 64 + p) * 128 + n0;
#pragma unroll
        for (int j = 0; j < 4; ++j) *(f32x4*)(o + 4 * j) = (f32x4){acc[4 * j], acc[4 * j + 1], acc[4 * j + 2], acc[4 * j + 3]};
    }
    __syncthreads();
}

__device__ __forceinline__ void step_scan(const Ctx& c) {
    const float* STATES = WSP(float, WS_STATES); const float* ACUM = WSP(float, WS_ACUM); bf16_t* PREVB = WSP(bf16_t, WS_PREVB);
    for (int idx = c.gt; idx < NB * NH * 64 * 32; idx += c.ngt) {
        const int n4 = idx & 31, p = (idx >> 5) & 63, h = (idx >> 11) & 15, b = idx >> 15;
        f32x4 carry_ = {0.f, 0.f, 0.f, 0.f};
        const unsigned so = (unsigned)(((b * NCH * NH + h) * 64 + p) * 128 + n4 * 4), ao = (unsigned)((b * NCH * NH + h) * 128 + 127);
#pragma unroll
        for (int half = 0; half < 2; ++half) {
            f32x4 st[16]; float dec[16];
#pragma unroll
            for (int j = 0; j < 16; ++j) { const int ch = half * 16 + j;
                st[j] = *(const f32x4*)((const char*)(STATES + (size_t)ch * (NH * 64 * 128)) + so * 4u); dec[j] = *(const float*)((const char*)(ACUM + (size_t)ch * (NH * 128)) + ao * 4u); }
            static_assert(NCH == 32, "two halves of 16 chunks");
            f32x4 hs = half == 0 ? (f32x4){0.f, 0.f, 0.f, 0.f} : carry_;
#pragma unroll
            for (int j = 0; j < 16; ++j) { const int ch = half * 16 + j;
                *(u32x2*)((char*)(PREVB + (size_t)ch * (NH * 64 * 128)) + so * 2u) = (u32x2){pk2(hs.x, hs.y), pk2(hs.z, hs.w)};
                hs = hs * fexp(dec[j]) + st[j]; }
            carry_ = hs;
        }
    }
}

__device__ __forceinline__ void step_cb_simple(const Ctx& c) {
    const bf16_t* XBCC = WSP(bf16_t, WS_XBCC); float* G = WSP(float, WS_STATES);
    for (int idx = c.gt; idx < NB * NCH * 2 * 128 * 128; idx += c.ngt) {
        const int s = idx & 127, l = (idx >> 7) & 127, g = (idx >> 14) & 1, bc = idx >> 15, t0 = bc * 128;
        const bf16_t* Cr = XBCC + (size_t)(t0 + l) * 1536 + 1280 + g * 128; const bf16_t* Br = XBCC + (size_t)(t0 + s) * 1536 + 1024 + g * 128;
        float sum = 0.f;
#pragma unroll 4
        for (int n = 0; n < 128; n += 8) sum += dot8(*(const u32x4*)(Cr + n), *(const u32x4*)(Br + n));
        G[idx] = sum;
    }
}

__device__ __forceinline__ void step_ssd2_simple(const Ctx& c) {
    const bf16_t* XBCC = WSP(bf16_t, WS_XBCC); const bf16_t* PROJ = WSP(bf16_t, WS_PROJ); const bf16_t* PREVB = WSP(bf16_t, WS_PREVB);
    const float* DT = WSP(float, WS_DT); const float* ACUM = WSP(float, WS_ACUM); const float* G = WSP(float, WS_STATES);
    bf16_t* YCAT = WSP(bf16_t, WS_ACT); float* SSP = WSP(float, WS_SSP);
    LAS float* ac = (LAS float*)c.lds; LAS float* dl = ac + 128;
    for (int item = blockIdx.x; item < NB * NCH * NH; item += gridDim.x) {
        const int bc = item / NH, h = item % NH, g = h >> 3, t0 = bc * 128;
        __syncthreads();
        if (c.tid < 128) { ac[c.tid] = ACUM[(size_t)item * 128 + c.tid]; dl[c.tid] = DT[(size_t)item * 128 + c.tid]; }
        __syncthreads();
        const int l = c.tid >> 2, p0 = (c.tid & 3) * 16, t = t0 + l;
        float acc[16];
#pragma unroll
        for (int j = 0; j < 16; ++j) acc[j] = 0.f;
        {
            const bf16_t* Cr = XBCC + (size_t)t * 1536 + 1280 + g * 128; const bf16_t* Pr = PREVB + ((size_t)item * 64 + p0) * 128;
            for (int n = 0; n < 128; n += 8) {
                const u32x4 cv = *(const u32x4*)(Cr + n);
#pragma unroll
                for (int j = 0; j < 16; ++j) acc[j] += dot8(cv, *(const u32x4*)(Pr + j * 128 + n));
            }
            const float el = fexp(ac[l]);
#pragma unroll
            for (int j = 0; j < 16; ++j) acc[j] *= el;
        }
        const float al = ac[l]; const float* Gr = G + ((size_t)(bc * 2 + g) * 128 + l) * 128;
        for (int s = 0; s <= l; ++s) {
            const float coef = Gr[s] * fexp(al - ac[s]) * dl[s];
            const bf16_t* xr = XBCC + (size_t)(t0 + s) * 1536 + h * 64 + p0;
            const u32x4 x0 = *(const u32x4*)xr, x1 = *(const u32x4*)(xr + 8);
            acc[0] += coef * bflo(x0.x); acc[1] += coef * bfhi(x0.x); acc[2] += coef * bflo(x0.y); acc[3] += coef * bfhi(x0.y);
            acc[4] += coef * bflo(x0.z); acc[5] += coef * bfhi(x0.z); acc[6] += coef * bflo(x0.w); acc[7] += coef * bfhi(x0.w);
            acc[8] += coef * bflo(x1.x); acc[9] += coef * bfhi(x1.x); acc[10] += coef * bflo(x1.y); acc[11] += coef * bfhi(x1.y);
            acc[12] += coef * bflo(x1.z); acc[13] += coef * bfhi(x1.z); acc[14] += coef * bflo(x1.w); acc[15] += coef * bfhi(x1.w);
        }
        {
            const bf16_t* xr = XBCC + (size_t)t * 1536 + h * 64 + p0; const bf16_t* zr = PROJ + (size_t)t * DINP + Z_OFF + h * 64 + p0;
            const float dsk = IN_DSKIP[h]; float ss = 0.f; unsigned ow[8];
#pragma unroll
            for (int j = 0; j < 16; j += 2) {
                const unsigned xw = *(const unsigned*)(xr + j), zw = *(const unsigned*)(zr + j);
                const float y0 = (acc[j] + dsk * bflo(xw)) * silu_f(bflo(zw)), y1 = (acc[j + 1] + dsk * bfhi(xw)) * silu_f(bfhi(zw));
                ss += y0 * y0 + y1 * y1; ow[j >> 1] = pk2(y0, y1);
            }
            bf16_t* o = YCAT + (size_t)t * D + h * 64 + p0;
            *(u32x4*)o = (u32x4){ow[0], ow[1], ow[2], ow[3]}; *(u32x4*)(o + 8) = (u32x4){ow[4], ow[5], ow[6], ow[7]};
            ss += __shfl_xor(ss, 1); ss += __shfl_xor(ss, 2);
            if ((c.tid & 3) == 0) SSP[(size_t)t * 32 + h] = ss;
        }
    }
    __syncthreads();
}

__device__ __forceinline__ void step_att_simple(const Ctx& c) {
    const bf16_t* PROJ = WSP(bf16_t, WS_PROJ); bf16_t* YCAT = WSP(bf16_t, WS_ACT); float* SSP = WSP(float, WS_SSP);
    for (int idx = c.gt; idx < T * 16; idx += c.ngt) {
        const int t = idx >> 4, hd = idx & 15, kvh = hd >> 3, pos = t & (SEQ - 1);
        float q[64], o[64];
        {
            const bf16_t* qr = PROJ + (size_t)t * DINP + Q_OFF + hd * 64;
#pragma unroll
            for (int d = 0; d < 64; d += 8) { const u32x4 v = *(const u32x4*)(qr + d);
                q[d] = 0.125f * bflo(v.x); q[d + 1] = 0.125f * bfhi(v.x); q[d + 2] = 0.125f * bflo(v.y); q[d + 3] = 0.125f * bfhi(v.y);
                q[d + 4] = 0.125f * bflo(v.z); q[d + 5] = 0.125f * bfhi(v.z); q[d + 6] = 0.125f * bflo(v.w); q[d + 7] = 0.125f * bfhi(v.w); }
        }
#pragma unroll
        for (int d = 0; d < 64; ++d) o[d] = 0.f;
        float m = IN_SINKS[hd], den = 1.f;
        const int j0 = pos - 127 > 0 ? pos - 127 : 0;
        for (int kp = j0; kp <= pos; ++kp) {
            const size_t tk = (size_t)(t - pos + kp);
            const bf16_t* kr = PROJ + tk * DINP + K_OFF + kvh * 64; const bf16_t* vr = PROJ + tk * DINP + V_OFF + kvh * 64;
            float s = 0.f;
#pragma unroll
            for (int d = 0; d < 64; d += 8) { const u32x4 v = *(const u32x4*)(kr + d);
                s += q[d] * bflo(v.x) + q[d + 1] * bfhi(v.x) + q[d + 2] * bflo(v.y) + q[d + 3] * bfhi(v.y) + q[d + 4] * bflo(v.z) + q[d + 5] * bfhi(v.z) + q[d + 6] * bflo(v.w) + q[d + 7] * bfhi(v.w); }
            if (s > m) { const float sc = fexp(m - s); den *= sc;
#pragma unroll
                for (int d = 0; d < 64; ++d) o[d] *= sc;
                m = s; }
            const float p = fexp(s - m); den += p;
#pragma unroll
            for (int d = 0; d < 64; d += 8) { const u32x4 v = *(const u32x4*)(vr + d);
                o[d] += p * bflo(v.x); o[d + 1] += p * bfhi(v.x); o[d + 2] += p * bflo(v.y); o[d + 3] += p * bfhi(v.y);
                o[d + 4] += p * bflo(v.z); o[d + 5] += p * bfhi(v.z); o[d + 6] += p * bflo(v.w); o[d + 7] += p * bfhi(v.w); }
        }
        const float inv = 1.f / den; float ss = 0.f;
        bf16_t* orow = YCAT + (size_t)t * D + 1024 + hd * 64;
#pragma unroll
        for (int d = 0; d < 64; d += 8) {
            float r[8];
#pragma unroll
            for (int e = 0; e < 8; ++e) { r[e] = o[d + e] * inv; ss += r[e] * r[e]; }
            *(u32x4*)(orow + d) = (u32x4){pk2(r[0], r[1]), pk2(r[2], r[3]), pk2(r[4], r[5]), pk2(r[6], r[7])};
        }
        SSP[(size_t)t * 32 + 16 + hd] = ss;
    }
}

__device__ __forceinline__ bf16x8v ld_frag16(const void* p) { return __builtin_bit_cast(bf16x8v, *(const u32x4*)p); }
__device__ __forceinline__ bf16x8v lds_frag16(const LAS unsigned char* p) { return __builtin_bit_cast(bf16x8v, *(const LAS u32x4*)p); }
__device__ __forceinline__ f32x16 zero16() { f32x16 z;
#pragma unroll
    for (int r = 0; r < 16; ++r) z[r] = 0.f;
    return z; }
#define MFMA32(a, b, c) __builtin_amdgcn_mfma_f32_32x32x16_bf16((a), (b), (c), 0, 0, 0)
__device__ __forceinline__ bf16x8v acc_frag(const f32x16& x, int ks2) {
    u32x4 w; w.x = cvtpk(x[8 * ks2 + 0], x[8 * ks2 + 1]); w.y = cvtpk(x[8 * ks2 + 2], x[8 * ks2 + 3]); w.z = cvtpk(x[8 * ks2 + 4], x[8 * ks2 + 5]); w.w = cvtpk(x[8 * ks2 + 6], x[8 * ks2 + 7]);
    return __builtin_bit_cast(bf16x8v, w);
}

__device__ __forceinline__ void step_dta(const Ctx& c) {
    const float* DTRAW = WSP(float, WS_DTRAW); float* DT = WSP(float, WS_DT); float* ACUM = WSP(float, WS_ACUM);
    for (int idx = c.gw; idx < NB * NCH * NH; idx += c.ngw) {
        const int h = idx % NH, bc = idx / NH, t0 = bc * 128, l0 = 2 * c.lane;
        const float A = -expf(IN_ALOG[h]), bias = IN_DTBIAS[h];
        const float d0 = softplus_f(DTRAW[(size_t)(t0 + l0) * 16 + h] + bias), d1 = softplus_f(DTRAW[(size_t)(t0 + l0 + 1) * 16 + h] + bias);
        const float a0 = d0 * A, a1 = d1 * A; float x = a0 + a1;
#pragma unroll
        for (int o = 1; o < 64; o <<= 1) { const float v = __shfl_up(x, o); if (c.lane >= o) x += v; }
        const float ex = x - (a0 + a1);
        *(f32x2*)(DT + (size_t)idx * 128 + l0) = (f32x2){d0, d1};
        *(f32x2*)(ACUM + (size_t)idx * 128 + l0) = (f32x2){ex + a0, ex + a0 + a1};
    }
}
__device__ __forceinline__ void step_conv_only(const Ctx& c) {
    const bf16_t* PROJ = WSP(bf16_t, WS_PROJ); bf16_t* XBCC = WSP(bf16_t, WS_XBCC);
    for (int idx = c.gt; idx < (T / 8) * 384; idx += c.ngt) {
        const int rb = idx / 384, ch = (idx % 384) * 4, t0 = rb * 8, pos0 = t0 & (SEQ - 1);
        f32x4 w[4];
#pragma unroll
        for (int j = 0; j < 4; ++j) w[j] = *(const f32x4*)(IN_CONVW + j * 1536 + ch);
        const f32x4 bias = *(const f32x4*)(IN_CONVB + ch);
        f32x4 xr[11];
#pragma unroll
        for (int i = 0; i < 11; ++i) {
            if (pos0 - 3 + i >= 0) { const u32x2 v = *(const u32x2*)(PROJ + (size_t)(t0 - 3 + i) * DINP + XBC_OFF + ch); xr[i] = (f32x4){bflo(v.x), bfhi(v.x), bflo(v.y), bfhi(v.y)}; }
            else xr[i] = (f32x4){0.f, 0.f, 0.f, 0.f};
        }
#pragma unroll
        for (int r = 0; r < 8; ++r) {
            const f32x4 a = bias + w[0] * xr[r] + w[1] * xr[r + 1] + w[2] * xr[r + 2] + w[3] * xr[r + 3];
            *(u32x2*)(XBCC + (size_t)(t0 + r) * 1536 + ch) = (u32x2){cvtpk(silu_f(a.x), silu_f(a.y)), cvtpk(silu_f(a.z), silu_f(a.w))};
        }
    }
}

__device__ __forceinline__ void step_ssd1_fast(const Ctx& c) {
    const bf16_t* XBCC = WSP(bf16_t, WS_XBCC); const float* DT = WSP(float, WS_DT); const float* ACUM = WSP(float, WS_ACUM); float* STATES = WSP(float, WS_STATES);
    LAS unsigned char* Bl = c.lds;
    LAS unsigned char* Xl = c.lds + 32768;
    LAS float* wl = (LAS float*)(c.lds + 65536);
    const int lane = c.lane, col = lane & 31, hh = lane >> 5, pt = c.wave >> 2, nt = c.wave & 3;
    for (int item = blockIdx.x; item < NB * NCH * 2; item += gridDim.x) {
        const int bc = item >> 1, g = item & 1, t0 = bc * 128;
        __syncthreads();
        for (int i = c.tid; i < 128 * 16; i += NTHR) { const int l = i >> 4, ch = i & 15;
            *(LAS u32x4*)(Bl + l * 256 + ch * 16) = *(const u32x4*)(XBCC + (size_t)(t0 + l) * 1536 + 1024 + g * 128 + ch * 8); }
        for (int i = c.tid; i < 8 * 128; i += NTHR) { const int r = i >> 7, l = i & 127; const size_t o = ((size_t)bc * 16 + g * 8 + r) * 128;
            wl[i] = fexp(ACUM[o + 127] - ACUM[o + l]) * DT[o + l]; }
        __syncthreads();
#define SSD1_STAGE(r_) { _Pragma("unroll") for (int q_ = 0; q_ < 2; ++q_) { const int i_ = c.tid + q_ * NTHR, l_ = i_ >> 3, ch_ = i_ & 7; \
            const u32x4 v_ = *(const u32x4*)(XBCC + (size_t)(t0 + l_) * 1536 + (g * 8 + (r_)) * 64 + ch_ * 8); const float w_ = wl[(r_) * 128 + l_]; \
            u32x4 o_; o_.x = cvtpk(bflo(v_.x) * w_, bfhi(v_.x) * w_); o_.y = cvtpk(bflo(v_.y) * w_, bfhi(v_.y) * w_); o_.z = cvtpk(bflo(v_.z) * w_, bfhi(v_.z) * w_); o_.w = cvtpk(bflo(v_.w) * w_, bfhi(v_.w) * w_); \
            *(LAS u32x4*)(Xl + ((r_) & 1) * 16384 + l_ * 128 + ch_ * 16) = o_; } }
        SSD1_STAGE(0);
        __syncthreads();
        for (int r = 0; r < 8; ++r) {
            if (r + 1 < 8) SSD1_STAGE(r + 1);
            const LAS unsigned char* xb = Xl + (r & 1) * 16384 + (pt * 32 + col) * 2; const LAS unsigned char* bb = Bl + (nt * 32 + col) * 2;
            f32x16 acc = zero16();
#pragma unroll
            for (int ks = 0; ks < 8; ++ks) {
                bf16x8v af, bf;
#pragma unroll
                for (int j = 0; j < 8; ++j) { const int l = 16 * ks + 8 * hh + j; af[j] = *(const LAS short*)(xb + l * 128); bf[j] = *(const LAS short*)(bb + l * 256); }
                acc = MFMA32(af, bf, acc);
            }
            float* o = STATES + (((size_t)bc * 16 + g * 8 + r) * 64 + pt * 32) * 128 + nt * 32 + col;
#pragma unroll
            for (int rr = 0; rr < 16; ++rr) o[(size_t)((rr & 3) + 8 * (rr >> 2) + 4 * hh) * 128] = acc[rr];
            __syncthreads();
        }
#undef SSD1_STAGE
    }
    __syncthreads();
}

#define TABH_SRC(r_) ((r_) < 16384 ? IN_U + (size_t)(r_) * D : IN_V + (size_t)((r_) - 16384) * D)
#define TABH_FINISH(rowv, r_) { if ((r_) < 16384) { if (U_INT4) u4_row_finish(rowv, WSP(unsigned char, WS_UB), (r_), WSP(float, WS_SCU) + (r_), c.lane); else fp8_row_finish<SLICED_PEER != 0>(rowv, WSP(unsigned char, WS_UB), (r_), WSP(float, WS_SCU) + (r_), c.lane); } \
        else if (V_INT4 && U_INT4) u4_row_finish(rowv, WSP(unsigned char, WS_VB), (r_) - 16384, WSP(float, WS_SCV) + ((r_) - 16384), c.lane); \
        else fp8_row_finish<(SLICED_PEER != 0) && (V_INT8 != 0)>(rowv, WSP(unsigned char, WS_VB), (r_) - 16384, WSP(float, WS_SCV) + ((r_) - 16384), c.lane); }
#define TABH_TICK() { if (kTicks) { if (tabr < 2 * 16384) { TABH_FINISH(tabv, tabr); } tabr += c.ngw; if (tabr < 2 * 16384) fp8_row_load(tabv, TABH_SRC(tabr), c.lane); } }
template <int PV = 0>
__device__ __forceinline__ void step_ssd2_fast(const Ctx& c) {
    constexpr bool kTicks = (HIDE_TABLES != 0) && PV == 0;
    const bf16_t* XBCC = WSP(bf16_t, WS_XBCC); const bf16_t* PROJ = WSP(bf16_t, WS_PROJ); const bf16_t* PREVB = WSP(bf16_t, WS_PREVB);
    const float* DT = WSP(float, WS_DT); const float* ACUM = WSP(float, WS_ACUM); bf16_t* YCAT = WSP(bf16_t, WS_ACT); float* SSP = WSP(float, WS_SSP);
    const int lane = c.lane, col = lane & 31, hh = lane >> 5;
    LAS unsigned char* Xw = c.lds + c.wave * 16384;
    LAS float* ac = (LAS float*)(c.lds + 131072 + c.wave * 1024); LAS float* dl = ac + 128;
    LAS unsigned char* Gl = c.lds + 139264;
    f32x4 tabv[8]; int tabr = c.gw;
    if (kTicks && tabr < 2 * 16384) fp8_row_load(tabv, TABH_SRC(tabr), c.lane);
    for (int item = blockIdx.x; item < NB * NCH * 2; item += gridDim.x) {
        const int bc = item >> 1, g = item & 1, t0 = bc * 128, hd = g * 8 + c.wave; const size_t ih = (size_t)bc * 16 + hd;
        __syncthreads();
#pragma unroll 1
        for (int tile = c.wave; tile < ((PV & 1) ? 0 : 10); tile += 8) {
            const int lt_ = tile < 1 ? 0 : tile < 3 ? 1 : tile < 6 ? 2 : 3, st_ = tile - (lt_ * (lt_ + 1)) / 2;
            bf16x8v cg[8], bg[8];
            const bf16_t* cp = XBCC + (size_t)(t0 + lt_ * 32 + col) * 1536 + 1280 + g * 128 + hh * 8;
            const bf16_t* bp = XBCC + (size_t)(t0 + st_ * 32 + col) * 1536 + 1024 + g * 128 + hh * 8;
#pragma unroll
            for (int ks = 0; ks < 8; ++ks) { cg[ks] = ld_frag16(cp + ks * 16); bg[ks] = ld_frag16(bp + ks * 16); }
            f32x16 gt = zero16();
#pragma unroll
            for (int ks = 0; ks < 8; ++ks) gt = MFMA32(bg[ks], cg[ks], gt);
            const u32x4 o0 = {cvtpk(gt[0], gt[1]), cvtpk(gt[2], gt[3]), cvtpk(gt[4], gt[5]), cvtpk(gt[6], gt[7])};
            const u32x4 o1 = {cvtpk(gt[8], gt[9]), cvtpk(gt[10], gt[11]), cvtpk(gt[12], gt[13]), cvtpk(gt[14], gt[15])};
            *(LAS u32x4*)(Gl + tile * 2048 + lane * 32) = o0; *(LAS u32x4*)(Gl + tile * 2048 + lane * 32 + 16) = o1;
        }
#pragma unroll 4
        for (int i = lane; i < ((PV & 16) ? 0 : 128 * 8); i += 64) { const int srow = i >> 3, ch = i & 7;
            *(LAS u32x4*)(Xw + srow * 128 + ch * 16) = *(const u32x4*)(XBCC + (size_t)(t0 + srow) * 1536 + hd * 64 + ch * 8); }
        ac[lane] = ACUM[ih * 128 + lane]; ac[lane + 64] = ACUM[ih * 128 + 64 + lane]; dl[lane] = DT[ih * 128 + lane]; dl[lane + 64] = DT[ih * 128 + 64 + lane];
        asm volatile("s_waitcnt vmcnt(0) lgkmcnt(0)" ::: "memory");
        __syncthreads();
        const float dsk = IN_DSKIP[hd];
        bf16x8v pf0[8], pf1[8];
        { const bf16_t* pp0 = PREVB + (ih * 64 + col) * 128 + hh * 8; const bf16_t* pp1 = pp0 + 32 * 128;
#pragma unroll
          for (int ks = 0; ks < 8; ++ks) { if (PV & 32) { pf0[ks] = (bf16x8v){0,0,0,0,0,0,0,0}; pf1[ks] = pf0[ks]; } else { pf0[ks] = ld_frag16(pp0 + ks * 16); pf1[ks] = ld_frag16(pp1 + ks * 16); } } }
#pragma unroll 1
        for (int lt = 3; lt >= 0; --lt) {
            const int l = lt * 32 + col, t = t0 + l;
            bf16x8v cf[8];
            const bf16_t* cp = XBCC + (size_t)t * 1536 + 1280 + g * 128 + hh * 8;
#pragma unroll
            for (int ks = 0; ks < 8; ++ks) { if (PV & 4) cf[ks] = (bf16x8v){0,0,0,0,0,0,0,0}; else cf[ks] = ld_frag16(cp + ks * 16); }
            const int zr = lt * 32 + (lane >> 3), zc = lane & 7;
            u32x4 zq[4];
#pragma unroll
            for (int k = 0; k < 4; ++k) zq[k] = *(const u32x4*)(PROJ + (size_t)(t0 + zr + 8 * k) * DINP + Z_OFF + hd * 64 + zc * 8);
            TABH_TICK();
            f32x16 acc[2]; acc[0] = zero16(); acc[1] = zero16();
#pragma unroll
            for (int ks = 0; ks < 8; ++ks) { acc[0] = MFMA32(pf0[ks], cf[ks], acc[0]); acc[1] = MFMA32(pf1[ks], cf[ks], acc[1]); }
            const float al = ac[l], el = fexp(al);
#pragma unroll
            for (int p2 = 0; p2 < 2; ++p2)
#pragma unroll
                for (int r = 0; r < 16; ++r) acc[p2][r] *= el;
#pragma unroll 1
            for (int st = 0; st <= ((PV & 2) ? -1 : lt); ++st) {
                const LAS unsigned char* gp = Gl + ((lt * (lt + 1)) / 2 + st) * 2048 + lane * 32;
                const u32x4 g0 = *(const LAS u32x4*)gp, g1 = *(const LAS u32x4*)(gp + 16);
                if (st == 0 || st == lt || (lt == 3 && st == 1)) { TABH_TICK(); }
                f32x16 gt;
#pragma unroll
                for (int i = 0; i < 4; ++i) { gt[2 * i] = bflo(g0[i]); gt[2 * i + 1] = bfhi(g0[i]); gt[8 + 2 * i] = bflo(g1[i]); gt[8 + 2 * i + 1] = bfhi(g1[i]); }
#pragma unroll
                for (int g4 = 0; g4 < 4; ++g4) {
                    const int sl0 = 8 * g4 + 4 * hh;
                    const f32x4 as = *(const LAS f32x4*)(ac + st * 32 + sl0), ds = *(const LAS f32x4*)(dl + st * 32 + sl0);
#pragma unroll
                    for (int e = 0; e < 4; ++e) {
                        const bool ok = (st < lt) || (sl0 + e <= col);
                        gt[4 * g4 + e] = ok ? gt[4 * g4 + e] * fexp(al - as[e]) * ds[e] : 0.f;
                    }
                }
                const bf16x8v w0 = acc_frag(gt, 0), w1 = acc_frag(gt, 1);
#pragma unroll
                for (int p2 = 0; p2 < 2; ++p2) {
                    const LAS unsigned char* xb = Xw + (p2 * 32 + col) * 2 + (st * 32 + 4 * hh) * 128;
                    bf16x8v x0, x1;
#pragma unroll
                    for (int j = 0; j < 8; ++j) { const int srow = 8 * (j >> 2) + (j & 3); x0[j] = *(const LAS short*)(xb + srow * 128); x1[j] = *(const LAS short*)(xb + (16 + srow) * 128); }
                    acc[p2] = MFMA32(x0, w0, acc[p2]); acc[p2] = MFMA32(x1, w1, acc[p2]);
                }
            }
            TABH_TICK();
            float ss = 0.f;
            u32x2 xq[2][4], z2[2][4];
#pragma unroll
            for (int p2 = 0; p2 < 2; ++p2)
#pragma unroll
                for (int g4 = 0; g4 < 4; ++g4) xq[p2][g4] = *(const LAS u32x2*)(Xw + l * 128 + (p2 * 32 + 8 * g4 + 4 * hh) * 2);
            asm volatile("s_waitcnt lgkmcnt(0)" ::: "memory");
#pragma unroll
            for (int k = 0; k < 4; ++k) *(LAS u32x4*)(Xw + (zr + 8 * k) * 128 + zc * 16) = zq[k];
            asm volatile("s_waitcnt lgkmcnt(0)" ::: "memory");
#pragma unroll
            for (int p2 = 0; p2 < 2; ++p2)
#pragma unroll
                for (int g4 = 0; g4 < 4; ++g4) z2[p2][g4] = *(const LAS u32x2*)(Xw + l * 128 + (p2 * 32 + 8 * g4 + 4 * hh) * 2);
            asm volatile("s_waitcnt lgkmcnt(0)" ::: "memory");
#pragma unroll
            for (int p2 = 0; p2 < 2; ++p2)
#pragma unroll
                for (int g4 = 0; g4 < 4; ++g4) {
                    const u32x2 xw = xq[p2][g4], zz = z2[p2][g4];
                    const float y0 = (acc[p2][4 * g4 + 0] + dsk * bflo(xw.x)) * silu_f(bflo(zz.x)), y1 = (acc[p2][4 * g4 + 1] + dsk * bfhi(xw.x)) * silu_f(bfhi(zz.x));
                    const float y2 = (acc[p2][4 * g4 + 2] + dsk * bflo(xw.y)) * silu_f(bflo(zz.y)), y3 = (acc[p2][4 * g4 + 3] + dsk * bfhi(xw.y)) * silu_f(bfhi(zz.y));
                    ss += (y0 * y0 + y1 * y1) + (y2 * y2 + y3 * y3);
                    *(LAS u32x2*)(Xw + l * 128 + (p2 * 32 + 8 * g4 + 4 * hh) * 2) = (u32x2){cvtpk(y0, y1), cvtpk(y2, y3)};
                }
            asm volatile("s_waitcnt lgkmcnt(0)" ::: "memory");
#pragma unroll
            for (int k = 0; k < 4; ++k) { const u32x4 yq = *(const LAS u32x4*)(Xw + (zr + 8 * k) * 128 + zc * 16); *(u32x4*)(YCAT + (size_t)(t0 + zr + 8 * k) * D + hd * 64 + zc * 8) = yq; }
            ss += __shfl_xor(ss, 32);
            if (hh == 0) SSP[(size_t)t * 32 + hd] = ss;
        }
    }
    if (kTicks) { while (tabr < 2 * 16384) { TABH_TICK(); } }
    __syncthreads();
}

__device__ __forceinline__ void step_att_fast(const Ctx& c) {
    const bf16_t* PROJ = WSP(bf16_t, WS_PROJ); bf16_t* YCAT = WSP(bf16_t, WS_ACT); float* SSP = WSP(float, WS_SSP);
    const int lane = c.lane, col = lane & 31, hh = lane >> 5;
    LAS unsigned char* Kl = c.lds;
    LAS unsigned char* Vt = c.lds + 256 * 144;
    const float NEG = -__builtin_huge_valf();
    for (int item = blockIdx.x; item < NB * NCH * 2; item += gridDim.x) {
        const int kvh = item & 1, nblk = (item >> 1) & 31, b = item >> 6, tq0 = b * SEQ + nblk * 128, tk0 = tq0 - 128;
        __syncthreads();
        for (int i = c.tid; i < 256 * 8; i += NTHR) {
            const int kj = i >> 3, ch = i & 7;
            if (nblk > 0 || kj >= 128) {
                const bf16_t* src = PROJ + (size_t)(tk0 + kj) * DINP + kvh * 64 + ch * 8;
                *(LAS u32x4*)(Kl + kj * 144 + ch * 16) = *(const u32x4*)(src + K_OFF);
                const u32x4 v = *(const u32x4*)(src + V_OFF);
                LAS unsigned char* vp = Vt + (ch * 8) * 520 + kj * 2;
                *(LAS unsigned short*)(vp + 0 * 520) = (unsigned short)(v.x & 0xffff); *(LAS unsigned short*)(vp + 1 * 520) = (unsigned short)(v.x >> 16);
                *(LAS unsigned short*)(vp + 2 * 520) = (unsigned short)(v.y & 0xffff); *(LAS unsigned short*)(vp + 3 * 520) = (unsigned short)(v.y >> 16);
                *(LAS unsigned short*)(vp + 4 * 520) = (unsigned short)(v.z & 0xffff); *(LAS unsigned short*)(vp + 5 * 520) = (unsigned short)(v.z >> 16);
                *(LAS unsigned short*)(vp + 6 * 520) = (unsigned short)(v.w & 0xffff); *(LAS unsigned short*)(vp + 7 * 520) = (unsigned short)(v.w >> 16);
            }
        }
        __syncthreads();
        const int hd = kvh * 8 + c.wave; const float sink = IN_SINKS[hd];
        for (int qt = 0; qt < 4; ++qt) {
            const int tq = tq0 + qt * 32 + col;
            bf16x8v qf[4];
#pragma unroll
            for (int ks = 0; ks < 4; ++ks) qf[ks] = ld_frag16(PROJ + (size_t)tq * DINP + Q_OFF + hd * 64 + ks * 16 + hh * 8);
            f32x16 S[5]; float m = sink;
#pragma unroll
            for (int jj = 0; jj < 5; ++jj) {
                const int j = qt + jj;
                if (nblk == 0 && j < 4) {
#pragma unroll
                    for (int r = 0; r < 16; ++r) S[jj][r] = NEG;
                } else {
                    f32x16 a = zero16();
#pragma unroll
                    for (int ks = 0; ks < 4; ++ks) a = MFMA32(lds_frag16(Kl + (j * 32 + col) * 144 + ks * 32 + hh * 16), qf[ks], a);
#pragma unroll
                    for (int r = 0; r < 16; ++r) {
                        const int kl = (r & 3) + 8 * (r >> 2) + 4 * hh;
                        float sv = a[r] * 0.125f;
                        if (jj == 0) sv = (kl > col) ? sv : NEG;
                        if (jj == 4) sv = (kl <= col) ? sv : NEG;
                        S[jj][r] = sv; m = fmaxf(m, sv);
                    }
                }
            }
            m = fmaxf(m, __shfl_xor(m, 32));
            float lsum = 0.f;
#pragma unroll
            for (int jj = 0; jj < 5; ++jj)
#pragma unroll
                for (int r = 0; r < 16; ++r) { const float p = fexp(S[jj][r] - m); S[jj][r] = p; lsum += p; }
            lsum += __shfl_xor(lsum, 32); lsum += fexp(sink - m);
            f32x16 O[2]; O[0] = zero16(); O[1] = zero16();
#pragma unroll
            for (int jj = 0; jj < 5; ++jj) {
                const int j = qt + jj;
                if (!(nblk == 0 && j < 4)) {
#pragma unroll
                    for (int ks2 = 0; ks2 < 2; ++ks2) {
                        const bf16x8v pf = acc_frag(S[jj], ks2);
#pragma unroll
                        for (int d2 = 0; d2 < 2; ++d2) {
                            const LAS unsigned char* vp = Vt + (d2 * 32 + col) * 520 + (j * 32 + 16 * ks2 + 4 * hh) * 2;
                            const u32x2 v0 = *(const LAS u32x2*)vp, v1 = *(const LAS u32x2*)(vp + 16);
                            O[d2] = MFMA32(__builtin_bit_cast(bf16x8v, ((u32x4){v0.x, v0.y, v1.x, v1.y})), pf, O[d2]);
                        }
                    }
                }
            }
            const float inv = 1.f / lsum; float ss = 0.f;
#pragma unroll
            for (int d2 = 0; d2 < 2; ++d2)
#pragma unroll
                for (int g4 = 0; g4 < 4; ++g4) {
                    const float o0 = O[d2][4 * g4] * inv, o1 = O[d2][4 * g4 + 1] * inv, o2 = O[d2][4 * g4 + 2] * inv, o3 = O[d2][4 * g4 + 3] * inv;
                    ss += (o0 * o0 + o1 * o1) + (o2 * o2 + o3 * o3);
                    *(u32x2*)(YCAT + (size_t)tq * D + 1024 + hd * 64 + d2 * 32 + 8 * g4 + 4 * hh) = (u32x2){cvtpk(o0, o1), cvtpk(o2, o3)};
                }
            ss += __shfl_xor(ss, 32);
            if (hh == 0) SSP[(size_t)tq * 32 + 16 + hd] = ss;
        }
    }
    __syncthreads();
}

__device__ __forceinline__ void step_rs(const Ctx& c) {
    const float* SSP = WSP(float, WS_SSP); float* RS = WSP(float, WS_RS);
    for (int t = c.gt; t < T; t += c.ngt) {
        float s1 = 0.f, s2 = 0.f;
#pragma unroll
        for (int j = 0; j < 4; ++j) { const f32x4 a = *(const f32x4*)(SSP + (size_t)t * 32 + 4 * j), b = *(const f32x4*)(SSP + (size_t)t * 32 + 16 + 4 * j);
            s1 += (a.x + a.y) + (a.z + a.w); s2 += (b.x + b.y) + (b.z + b.w); }
        const float r1 = rsqrtf(s1 * (1.f / 1024.f) + EPS), r2 = rsqrtf(s2 * (1.f / 1024.f) + EPS);
        RS[2 * t] = r1 / r2; RS[2 * t + 1] = r2;
    }
}

__device__ __forceinline__ void step_ln1(const Ctx& c) {
    const float* MOD = WSP(float, WS_MOD); bf16_t* H2 = WSP(bf16_t, WS_ACT); const bf16_t* GB = WSP(bf16_t, WS_R1B); bf16_t* X1B = WSP(bf16_t, WS_X1B); unsigned char* H2Q = WSP(unsigned char, WS_H2Q); float* HS = WSP(float, WS_HS);
    LAS float* Lg = (LAS float*)c.lds;
    for (int i = c.tid; i < 512; i += NTHR) { ((LAS f32x4*)Lg)[i] = ((const f32x4*)IN_LN1G)[i]; ((LAS f32x4*)Lg)[512 + i] = ((const f32x4*)IN_LN1B)[i]; }
    for (int i = c.tid; i < 4 * 1024; i += NTHR) { const int bq = i >> 10, r = i & 1023; ((LAS f32x4*)Lg)[1024 + i] = ((const f32x4*)(MOD + bq * NMOD + 3 * D))[r]; }
    __syncthreads();
    f32x4 xc[8], xn[8]; u32x2 gc[8], gn[8];
    int t = c.gw;
#define LN1_LOAD(xa, ga, tok) { _Pragma("unroll") for (int j_ = 0; j_ < 8; ++j_) { xa[j_] = *(const f32x4*)(IN_X + (size_t)(tok) * D + j_ * 256 + c.lane * 4); ga[j_] = *(const u32x2*)(GB + (size_t)(tok) * D + j_ * 256 + c.lane * 4); } }
    if (t < T) LN1_LOAD(xc, gc, t);
    for (; t < T; t += c.ngw) {
        const int tn = t + c.ngw;
        if (tn < T) LN1_LOAD(xn, gn, tn);
        const int b = t >> 12;
        f32x4 v[8]; float s = 0.f;
#pragma unroll
        for (int j = 0; j < 8; ++j) { v[j] = xc[j] * ALPHA + (f32x4){bflo(gc[j].x), bfhi(gc[j].x), bflo(gc[j].y), bfhi(gc[j].y)}; s += (v[j].x + v[j].y) + (v[j].z + v[j].w); }
        const float mean = wave_sum_all(s) * (1.f / D); float s2 = 0.f;
#pragma unroll
        for (int j = 0; j < 8; ++j) { v[j] = v[j] - mean; s2 += (v[j].x * v[j].x + v[j].y * v[j].y) + (v[j].z * v[j].z + v[j].w * v[j].w); }
        const float rstd = rsqrtf(wave_sum_all(s2) * (1.f / D) + EPS);
        const LAS float* sh = Lg + 4096 + b * 4096; const LAS float* sc = sh + 2048; float hmax = 0.f;
#pragma unroll
        for (int j = 0; j < 8; ++j) {
            const int col = j * 256 + c.lane * 4;
            const f32x4 g = *(const LAS f32x4*)(Lg + col), bb = *(const LAS f32x4*)(Lg + 2048 + col), s_ = *(const LAS f32x4*)(sc + col), h_ = *(const LAS f32x4*)(sh + col);
            const f32x4 x1 = v[j] * rstd * g + bb;
            *(u32x2*)(X1B + (size_t)t * D + col) = (u32x2){cvtpk(x1.x, x1.y), cvtpk(x1.z, x1.w)};
            const f32x4 h2v = x1 * (s_ + 1.f) + h_;
            if (!(I8_GEMM3 && FAST_GEMM)) *(u32x2*)(H2 + (size_t)t * D + col) = (u32x2){cvtpk(h2v.x, h2v.y), cvtpk(h2v.z, h2v.w)};
            v[j] = h2v; hmax = fmaxf(hmax, fmaxf(fmaxf(fabsf(h2v.x), fabsf(h2v.y)), fmaxf(fabsf(h2v.z), fabsf(h2v.w))));
        }
        {
            hmax = DPPMAX(hmax, 0xB1); hmax = DPPMAX(hmax, 0x4E); hmax = DPPMAX(hmax, 0x141); hmax = DPPMAX(hmax, 0x140);
            const unsigned a0 = __builtin_amdgcn_readlane(__float_as_uint(hmax), 0), a1 = __builtin_amdgcn_readlane(__float_as_uint(hmax), 16);
            const unsigned a2 = __builtin_amdgcn_readlane(__float_as_uint(hmax), 32), a3 = __builtin_amdgcn_readlane(__float_as_uint(hmax), 48);
            const unsigned m01 = a0 > a1 ? a0 : a1, m23 = a2 > a3 ? a2 : a3; const float am = __uint_as_float(m01 > m23 ? m01 : m23);
            const float QT = U_INT4 ? 119.f : 127.f;
            const float inv = am > 0.f ? QT / am : 0.f;
#pragma unroll
            for (int j = 0; j < 8; ++j) {
                *(unsigned*)(H2Q + (size_t)t * D + j * 256 + c.lane * 4) = pack_i8x4(v[j] * inv);
                if (U_INT4) {
                    const float M = 12582912.f;
                    const unsigned b0 = __float_as_uint(v[j].x * inv + M), b1 = __float_as_uint(v[j].y * inv + M), b2 = __float_as_uint(v[j].z * inv + M), b3 = __float_as_uint(v[j].w * inv + M);
                    const unsigned lo = (b0 & 15u) | ((b1 & 15u) << 4) | ((b2 & 15u) << 8) | ((b3 & 15u) << 12);
                    const unsigned hi = (((b0 + 8u) >> 4) & 15u) | ((((b1 + 8u) >> 4) & 15u) << 4) | ((((b2 + 8u) >> 4) & 15u) << 8) | ((((b3 + 8u) >> 4) & 15u) << 12);
                    *(unsigned*)(WSP(unsigned char, WS_H2N) + (size_t)t * D + j * 256 + c.lane * 4) = lo | (hi << 16);
                }
            }
            if (c.lane == 0) HS[t] = am * (1.f / QT);
        }
#pragma unroll
        for (int j = 0; j < 8; ++j) { xc[j] = xn[j]; gc[j] = gn[j]; }
    }
#undef LN1_LOAD
}

__device__ __forceinline__ void argmax_bfly(float& bv, int& bi) {
#pragma unroll
    for (int off = 32; off >= 1; off >>= 1) {
        const float ov = __shfl_xor(bv, off); const int oi = __shfl_xor(bi, off);
        if (ov > bv || (ov == bv && oi < bi)) { bv = ov; bi = oi; }
    }
}
__device__ __forceinline__ void step_topk_simple(const Ctx& c) {
    const bf16_t* Q = WSP(bf16_t, WS_PROJ); const bf16_t* KEYS = WSP(bf16_t, WS_KEYS); int* EXPERT = WSP(int, WS_EXP); float* GATE = WSP(float, WS_GATE);
    const int lane = c.lane; const float NEG = -__builtin_huge_valf();
    for (int item = c.gw; item < T * 8; item += c.ngw) {
        const int t = item >> 3, h = item & 7;
        const bf16_t* qrow = Q + (size_t)t * D + h * 256;
        float tv[2] = {0.f, 0.f}; int ti[2] = {0, 0};
#pragma unroll
        for (int cc = 0; cc < 2; ++cc) {
            float v0 = 0.f, v1 = 0.f;
            const bf16_t* k0 = KEYS + ((size_t)(h * 2 + cc) * 128 + lane) * 128; const bf16_t* k1 = k0 + 64 * 128;
            for (int d = 0; d < 128; d += 8) { const u32x4 qv = *(const u32x4*)(qrow + cc * 128 + d); v0 += dot8(qv, *(const u32x4*)(k0 + d)); v1 += dot8(qv, *(const u32x4*)(k1 + d)); }
            for (int r = 0; r < 16; ++r) {
                float bv = v0; int bi = lane; if (v1 > bv) { bv = v1; bi = lane + 64; }
                argmax_bfly(bv, bi);
                if (lane == r) { tv[cc] = bv; ti[cc] = bi; }
                if (bi == lane) v0 = NEG; if (bi == lane + 64) v1 = NEG;
            }
        }
        float cv[4]; const int ci0 = lane * 4;
#pragma unroll
        for (int q = 0; q < 4; ++q) { const int ci = ci0 + q; cv[q] = __shfl(tv[0], ci >> 4) + __shfl(tv[1], ci & 15); }
        float bestv = 0.f; int bestp = 0;
        for (int r = 0; r < 16; ++r) {
            float bv = cv[0]; int bi = ci0;
#pragma unroll
            for (int q = 1; q < 4; ++q) if (cv[q] > bv) { bv = cv[q]; bi = ci0 + q; }
            argmax_bfly(bv, bi);
            if (lane == r) { bestv = bv; bestp = bi; }
#pragma unroll
            for (int q = 0; q < 4; ++q) if (bi == ci0 + q) cv[q] = NEG;
        }
        const float mx = __shfl(bestv, 0);
        const float e = lane < 16 ? fexp(bestv - mx) : 0.f; const float ssum = wave_sum(e);
        const int e0 = __shfl(ti[0], bestp >> 4), e1 = __shfl(ti[1], bestp & 15);
        if (lane < 16) { EXPERT[(size_t)item * 16 + lane] = e0 * 128 + e1; GATE[(size_t)item * 16 + lane] = e / ssum; }
    }
}

#define TK_CE(a, b) { const int t_ = max(a, b); b = min(a, b); a = t_; }
__device__ __forceinline__ int tk_mono(float x) { int b = __float_as_int(x); return b ^ ((b >> 31) & 0x7fffffff); }
__device__ __forceinline__ float tk_val(int key, int mask) { int b = key & ~mask; b ^= (b >> 31) & 0x7fffffff; return __int_as_float(b); }
__device__ __forceinline__ void tk_sort16(int (&k)[16]) {
    TK_CE(k[0], k[13]) TK_CE(k[1], k[12]) TK_CE(k[2], k[15]) TK_CE(k[3], k[14]) TK_CE(k[4], k[8]) TK_CE(k[5], k[6]) TK_CE(k[7], k[11]) TK_CE(k[9], k[10])
    TK_CE(k[0], k[5]) TK_CE(k[1], k[7]) TK_CE(k[2], k[9]) TK_CE(k[3], k[4]) TK_CE(k[6], k[13]) TK_CE(k[8], k[14]) TK_CE(k[10], k[15]) TK_CE(k[11], k[12])
    TK_CE(k[0], k[1]) TK_CE(k[2], k[3]) TK_CE(k[4], k[5]) TK_CE(k[6], k[8]) TK_CE(k[7], k[9]) TK_CE(k[10], k[11]) TK_CE(k[12], k[13]) TK_CE(k[14], k[15])
    TK_CE(k[0], k[2]) TK_CE(k[1], k[3]) TK_CE(k[4], k[10]) TK_CE(k[5], k[11]) TK_CE(k[6], k[7]) TK_CE(k[8], k[9]) TK_CE(k[12], k[14]) TK_CE(k[13], k[15])
    TK_CE(k[1], k[2]) TK_CE(k[3], k[12]) TK_CE(k[4], k[6]) TK_CE(k[5], k[7]) TK_CE(k[8], k[10]) TK_CE(k[9], k[11]) TK_CE(k[13], k[14])
    TK_CE(k[1], k[4]) TK_CE(k[2], k[6]) TK_CE(k[5], k[8]) TK_CE(k[7], k[10]) TK_CE(k[9], k[13]) TK_CE(k[11], k[14])
    TK_CE(k[2], k[4]) TK_CE(k[3], k[6]) TK_CE(k[9], k[12]) TK_CE(k[11], k[13])
    TK_CE(k[3], k[5]) TK_CE(k[6], k[8]) TK_CE(k[7], k[9]) TK_CE(k[10], k[12])
    TK_CE(k[3], k[4]) TK_CE(k[5], k[6]) TK_CE(k[7], k[8]) TK_CE(k[9], k[10]) TK_CE(k[11], k[12])
    TK_CE(k[6], k[7]) TK_CE(k[8], k[9])
}
__device__ __forceinline__ void tk_clean16(int (&k)[16]) {
#pragma unroll
    for (int stride = 8; stride > 0; stride >>= 1)
#pragma unroll
        for (int i = 0; i < 16; ++i) { const int j = i ^ stride; if (j > i) TK_CE(k[i], k[j]) }
}
__device__ __forceinline__ void tk_merge16(int (&a)[16], const int (&b)[16]) {
#pragma unroll
    for (int i = 0; i < 16; ++i) a[i] = max(a[i], b[15 - i]);
    tk_clean16(a);
}
__device__ __forceinline__ void topk_groups(const Ctx& c, const int h, const int grp_first, const int grp_end, const int grp_step) {
    const bf16_t* Q = WSP(bf16_t, WS_PROJ); const bf16_t* KEYS = WSP(bf16_t, WS_KEYS); int* EXPERT = WSP(int, WS_EXP); float* GATE = WSP(float, WS_GATE);
    const int lane = c.lane, col = lane & 31, hh = lane >> 5;
    constexpr int KP = 272;
    LAS unsigned char* kl = c.lds;
    LAS int* tab = (LAS int*)(c.lds + 256 * KP) + c.wave * (32 * 33);
    __syncthreads();
    for (int i = c.tid; i < 256 * 16; i += NTHR) { const int r = i >> 4, ch = i & 15;
        *(LAS u32x4*)(kl + r * KP + ch * 16) = *(const u32x4*)(KEYS + ((size_t)h * 256 + r) * 128 + ch * 8); }
    __syncthreads();
    const int INTMIN = (int)0x80000000;
    for (int grp = grp_first; grp < grp_end; grp += grp_step) {
        const int t0 = grp * 32;
        int top[2][16];
#pragma unroll
        for (int cc = 0; cc < 2; ++cc) {
            bf16x8v qf[8];
            const bf16_t* qp = Q + (size_t)(t0 + col) * D + h * 256 + cc * 128 + hh * 8;
#pragma unroll
            for (int ks = 0; ks < 8; ++ks) qf[ks] = __builtin_bit_cast(bf16x8v, *(const u32x4*)(qp + ks * 16));
            int k[4][16];
#pragma unroll
            for (int nt = 0; nt < 4; ++nt) {
                f32x16 acc;
#pragma unroll
                for (int r = 0; r < 16; ++r) acc[r] = 0.f;
#pragma unroll
                for (int ks = 0; ks < 8; ++ks) {
                    const bf16x8v af = __builtin_bit_cast(bf16x8v, *(const LAS u32x4*)(kl + (cc * 128 + nt * 32 + col) * KP + ks * 32 + hh * 16));
                    acc = __builtin_amdgcn_mfma_f32_32x32x16_bf16(af, qf[ks], acc, 0, 0, 0);
                }
#pragma unroll
                for (int r = 0; r < 16; ++r) k[nt][r] = (tk_mono(acc[r]) & ~127) | (nt * 32 + (r & 3) + 8 * (r >> 2) + 4 * hh);
                tk_sort16(k[nt]);
            }
            tk_merge16(k[0], k[1]); tk_merge16(k[2], k[3]); tk_merge16(k[0], k[2]);
            int p[16];
#pragma unroll
            for (int i = 0; i < 16; ++i) p[i] = __shfl_xor(k[0][15 - i], 32);
#pragma unroll
            for (int i = 0; i < 16; ++i) k[0][i] = max(k[0][i], p[i]);
            tk_clean16(k[0]);
#pragma unroll
            for (int i = 0; i < 16; ++i) top[cc][i] = k[0][i];
        }
        if (hh == 0) {
#pragma unroll
            for (int i = 0; i < 16; ++i) { tab[col * 33 + i] = top[0][i] & 127; tab[col * 33 + 16 + i] = top[1][i] & 127; }
        }
        float va[16], vb[16];
#pragma unroll
        for (int i = 0; i < 16; ++i) { va[i] = tk_val(top[0][i], 127); vb[i] = tk_val(top[1][i], 127); }
#define TK_CAND(i, j) ((tk_mono(va[i] + vb[j]) & ~255) | ((i) * 16 + (j)))
        int m[16], l1[16], l3[16], l4[16];
#pragma unroll
        for (int j = 0; j < 16; ++j) m[j] = TK_CAND(0, j);
#pragma unroll
        for (int j = 0; j < 8; ++j) l1[j] = TK_CAND(1, j);
#pragma unroll
        for (int j = 8; j < 16; ++j) l1[j] = INTMIN;
        tk_merge16(m, l1);
        l3[0] = TK_CAND(2, 0); l3[1] = TK_CAND(2, 1); l3[2] = TK_CAND(2, 2); l3[3] = TK_CAND(2, 3); l3[4] = TK_CAND(2, 4);
        l3[5] = TK_CAND(3, 0); l3[6] = TK_CAND(3, 1); l3[7] = TK_CAND(3, 2); l3[8] = TK_CAND(3, 3);
        l3[9] = TK_CAND(4, 0); l3[10] = TK_CAND(4, 1); l3[11] = TK_CAND(4, 2);
        l3[12] = TK_CAND(5, 0); l3[13] = TK_CAND(5, 1); l3[14] = TK_CAND(6, 0); l3[15] = TK_CAND(6, 1);
        tk_sort16(l3); tk_merge16(m, l3);
        l4[0] = TK_CAND(7, 0); l4[1] = TK_CAND(7, 1);
#pragma unroll
        for (int i = 8; i < 16; ++i) l4[i - 6] = TK_CAND(i, 0);
#pragma unroll
        for (int i = 10; i < 16; ++i) l4[i] = INTMIN;
        tk_sort16(l4); tk_merge16(m, l4);
#undef TK_CAND
        float ev[16]; float ssum = 0.f; const float mx = tk_val(m[0], 255);
#pragma unroll
        for (int r = 0; r < 16; ++r) { ev[r] = fexp(tk_val(m[r], 255) - mx); ssum += ev[r]; }
        const float inv = 1.f / ssum;
#if SLICED_PEER
        const size_t ob = (size_t)(t0 + col) * 128 + 2 * h;
        if (hh == 0) {
            int eo[16];
#pragma unroll
            for (int r = 0; r < 16; ++r) { const int code = m[r] & 255; eo[r] = tab[col * 33 + (code >> 4)] * 128 + tab[col * 33 + 16 + (code & 15)]; }
#pragma unroll
            for (int g = 0; g < 8; ++g) *(u32x2*)(EXPERT + ob + g * 16) = (u32x2){(unsigned)eo[g], (unsigned)eo[g + 8]};
            {
                unsigned* E16 = WSP(unsigned, WS_EP16) + (size_t)(t0 + col) * 64 + h;
#pragma unroll
                for (int g = 0; g < 8; ++g) E16[g * 8] = (unsigned)eo[g] | ((unsigned)eo[g + 8] << 16);
            }
        } else {
#pragma unroll
            for (int g = 0; g < 8; ++g) *(f32x2*)(GATE + ob + g * 16) = (f32x2){ev[g] * inv, ev[g + 8] * inv};
        }
#else
        const size_t ob = ((size_t)(t0 + col) * 8 + h) * 16;
        if (hh == 0) {
            int eo[16];
#pragma unroll
            for (int r = 0; r < 16; ++r) { const int code = m[r] & 255; eo[r] = tab[col * 33 + (code >> 4)] * 128 + tab[col * 33 + 16 + (code & 15)]; }
#pragma unroll
            for (int q = 0; q < 4; ++q) *(u32x4*)(EXPERT + ob + 4 * q) = (u32x4){(unsigned)eo[4 * q], (unsigned)eo[4 * q + 1], (unsigned)eo[4 * q + 2], (unsigned)eo[4 * q + 3]};
        } else {
#pragma unroll
            for (int q = 0; q < 4; ++q) *(f32x4*)(GATE + ob + 4 * q) = (f32x4){ev[4 * q] * inv, ev[4 * q + 1] * inv, ev[4 * q + 2] * inv, ev[4 * q + 3] * inv};
        }
#endif
    }
    __syncthreads();
}

__device__ __forceinline__ void step_topk_fast(const Ctx& c) {
    const int nper = (int)gridDim.x >> 3;
    topk_groups(c, (int)blockIdx.x & 7, (int)(blockIdx.x >> 3) + nper * c.wave, T / 32, nper * NWAVES);
}

#define PEER_LOAD(buf, TAB, kbase) { _Pragma("unroll") for (int u_ = 0; u_ < 4; ++u_) { const int k_ = (kbase) + u_; \
        const int e_ = __builtin_amdgcn_readlane(k_ < 64 ? er0 : er1, k_ & 63); const unsigned char* rp_ = (TAB) + (size_t)e_ * D + lane * 16; \
        buf[u_][0] = *(const u32x4*)rp_; buf[u_][1] = *(const u32x4*)(rp_ + 1024); } }
#define PEER_DOT(buf, kbase) { _Pragma("unroll") for (int u_ = 0; u_ < 4; ++u_) { f32x2 a2_ = {0.f, 0.f}; \
        _Pragma("unroll") for (int j_ = 0; j_ < 2; ++j_) _Pragma("unroll") for (int q_ = 0; q_ < 4; ++q_) { const int w_ = (int)buf[u_][j_][q_]; \
            a2_ += __builtin_amdgcn_cvt_pk_f32_fp8(w_, false) * hh[j_ * 8 + q_ * 2]; a2_ += __builtin_amdgcn_cvt_pk_f32_fp8(w_, true) * hh[j_ * 8 + q_ * 2 + 1]; } \
        const float tot_ = lane63(wave_sum63(a2_.x + a2_.y)); const int k_ = (kbase) + u_; \
        if (k_ < 64) ar0 = (lane == k_) ? tot_ : ar0; else ar1 = (lane == k_ - 64) ? tot_ : ar1; } }
#define PEER_AXPY(buf, kbase) { _Pragma("unroll") for (int u_ = 0; u_ < 4; ++u_) { const int k_ = (kbase) + u_; \
        const float w1_ = __int_as_float(__builtin_amdgcn_readlane(__float_as_int(k_ < 64 ? wr0 : wr1), k_ & 63)); const f32x2 ww_ = {w1_, w1_}; \
        _Pragma("unroll") for (int j_ = 0; j_ < 2; ++j_) _Pragma("unroll") for (int q_ = 0; q_ < 4; ++q_) { const int w_ = (int)buf[u_][j_][q_]; \
            yy[j_ * 8 + q_ * 2] += __builtin_amdgcn_cvt_pk_f32_fp8(w_, false) * ww_; yy[j_ * 8 + q_ * 2 + 1] += __builtin_amdgcn_cvt_pk_f32_fp8(w_, true) * ww_; } } }
__device__ __forceinline__ void step_peer(const Ctx& c) {
    const bf16_t* H2 = WSP(bf16_t, WS_ACT); const unsigned char* U8 = WSP(unsigned char, WS_UB); const unsigned char* V8 = WSP(unsigned char, WS_VB);
    const float* SCU = WSP(float, WS_SCU); const float* SCV = WSP(float, WS_SCV);
    const int* EXPERT = WSP(int, WS_EXP); const float* GATE = WSP(float, WS_GATE); const float* MOD = WSP(float, WS_MOD);
    const int lane = c.lane;
    for (int t = c.gw; t < T; t += c.ngw) {
        const int er0 = EXPERT[(size_t)t * 128 + lane], er1 = EXPERT[(size_t)t * 128 + 64 + lane];
        const float gr0 = GATE[(size_t)t * 128 + lane], gr1 = GATE[(size_t)t * 128 + 64 + lane];
        const float su0 = SCU[er0], su1 = SCU[er1], sv0 = SCV[er0], sv1 = SCV[er1];
        f32x2 hh[16];
#pragma unroll
        for (int j = 0; j < 2; ++j)
#pragma unroll
            for (int q = 0; q < 2; ++q) { const u32x4 v = *(const u32x4*)(H2 + (size_t)t * D + j * 1024 + lane * 16 + q * 8);
                hh[j * 8 + q * 4 + 0] = (f32x2){bflo(v.x), bfhi(v.x)}; hh[j * 8 + q * 4 + 1] = (f32x2){bflo(v.y), bfhi(v.y)};
                hh[j * 8 + q * 4 + 2] = (f32x2){bflo(v.z), bfhi(v.z)}; hh[j * 8 + q * 4 + 3] = (f32x2){bflo(v.w), bfhi(v.w)}; }
        float ar0 = 0.f, ar1 = 0.f;
        u32x4 A[4][2], B[4][2];
        PEER_LOAD(A, U8, 0);
        for (int kb = 0; kb < 128; kb += 8) {
            PEER_LOAD(B, U8, kb + 4);
            PEER_DOT(A, kb);
            if (kb + 8 < 128) PEER_LOAD(A, U8, kb + 8) else PEER_LOAD(A, V8, 0);
            PEER_DOT(B, kb + 4);
        }
        const float wr0 = gr0 * gelu_f(ar0 * su0) * sv0, wr1 = gr1 * gelu_f(ar1 * su1) * sv1;
        f32x2 yy[16];
#pragma unroll
        for (int i = 0; i < 16; ++i) yy[i] = (f32x2){0.f, 0.f};
        for (int kb = 0; kb < 128; kb += 8) {
            PEER_LOAD(B, V8, kb + 4);
            PEER_AXPY(A, kb);
            if (kb + 8 < 128) PEER_LOAD(A, V8, kb + 8);
            PEER_AXPY(B, kb + 4);
        }
        const int b = t >> 12; float* row = c.out + (size_t)t * D; const float* g2 = MOD + b * NMOD + 5 * D;
        float s = 0.f;
#pragma unroll
        for (int j = 0; j < 2; ++j)
#pragma unroll
            for (int q = 0; q < 4; ++q) {
                const int col = j * 1024 + lane * 16 + q * 4; const f32x4 xv = *(const f32x4*)(row + col), gv = *(const f32x4*)(g2 + col);
                f32x2& y0 = yy[j * 8 + q * 2]; f32x2& y1 = yy[j * 8 + q * 2 + 1];
                y0.x = ALPHA * xv.x + gv.x * y0.x; y0.y = ALPHA * xv.y + gv.y * y0.y; y1.x = ALPHA * xv.z + gv.z * y1.x; y1.y = ALPHA * xv.w + gv.w * y1.y;
                s += (y0.x + y0.y) + (y1.x + y1.y);
            }
        const float mean = wave_sum(s) * (1.f / D); float s2 = 0.f;
#pragma unroll
        for (int i = 0; i < 16; ++i) { yy[i] = yy[i] - mean; s2 += yy[i].x * yy[i].x + yy[i].y * yy[i].y; }
        const float rstd = rsqrtf(wave_sum(s2) * (1.f / D) + EPS);
#pragma unroll
        for (int j = 0; j < 2; ++j)
#pragma unroll
            for (int q = 0; q < 4; ++q) {
                const int col = j * 1024 + lane * 16 + q * 4; const f32x4 g = *(const f32x4*)(IN_LN2G + col), bb = *(const f32x4*)(IN_LN2B + col);
                const f32x2 y0 = yy[j * 8 + q * 2], y1 = yy[j * 8 + q * 2 + 1];
                *(f32x4*)(row + col) = (f32x4){y0.x * rstd * g.x + bb.x, y0.y * rstd * g.y + bb.y, y1.x * rstd * g.z + bb.z, y1.y * rstd * g.w + bb.w};
            }
    }
}

struct XcdPlace { int nloc, nx, xrank, rank; };
__device__ __forceinline__ float reduce8(float v) { v += DPPF(v, 0xB1); v += DPPF(v, 0x4E); v += DPPF(v, 0x141); return v; }
struct Sel8 { unsigned long long m1, m2, m4; };
__device__ __forceinline__ float cnd(float a, float b, unsigned long long m) { float r; asm("v_cndmask_b32 %0, %1, %2, %3" : "=v"(r) : "v"(a), "v"(b), "s"(m)); return r; }
__device__ __forceinline__ float sel8(const Sel8& S, float p0, float p1, float p2, float p3, float p4, float p5, float p6, float p7) {
    const float a0 = cnd(p0, p1, S.m1), a1 = cnd(p2, p3, S.m1), a2 = cnd(p4, p5, S.m1), a3 = cnd(p6, p7, S.m1);
    return cnd(cnd(a0, a1, S.m2), cnd(a2, a3, S.m2), S.m4);
}
#define PS_GATHER(buf, ids, tabp) { _Pragma("unroll") for (int q_ = 0; q_ < 4; ++q_) { \
        buf[4 * q_ + 0] = *(const u32x4*)((tabp) + (ids[q_].x * 128u + c16)); buf[4 * q_ + 1] = *(const u32x4*)((tabp) + (ids[q_].y * 128u + c16)); \
        buf[4 * q_ + 2] = *(const u32x4*)((tabp) + (ids[q_].z * 128u + c16)); buf[4 * q_ + 3] = *(const u32x4*)((tabp) + (ids[q_].w * 128u + c16)); } }
#define PS_IDS(ids, tok) { _Pragma("unroll") for (int q_ = 0; q_ < 4; ++q_) ids[q_] = *(const u32x4*)(EP + (size_t)(tok) * 128 + g * 16 + q_ * 4); }
__device__ __forceinline__ int cndi(int a, int b, unsigned long long m) { int r; asm("v_cndmask_b32 %0, %1, %2, %3" : "=v"(r) : "v"(a), "v"(b), "s"(m)); return r; }
__device__ __forceinline__ int sel8i(const Sel8& S, int p0, int p1, int p2, int p3, int p4, int p5, int p6, int p7) {
    const int a0 = cndi(p0, p1, S.m1), a1 = cndi(p2, p3, S.m1), a2 = cndi(p4, p5, S.m1), a3 = cndi(p6, p7, S.m1);
    return cndi(cndi(a0, a1, S.m2), cndi(a2, a3, S.m2), S.m4);
}
#define DPPI(v, ctrl) __builtin_amdgcn_update_dpp(0, (v), (ctrl), 0xF, 0xF, true)
__device__ __forceinline__ int reduce8i(int v) { v += DPPI(v, 0xB1); v += DPPI(v, 0x4E); v += DPPI(v, 0x141); return v; }
#if U_INT4
#define PU_PROCESS(buf, tok) { \
        const u32x4 ha_ = *(const u32x4*)(H2N + (size_t)(tok) * D + slice * 256 + c8 * 32), hb_ = *(const u32x4*)(H2N + (size_t)(tok) * D + slice * 256 + c8 * 32 + 16); \
        const int l0_ = (int)__builtin_amdgcn_perm(ha_.y, ha_.x, 0x05040100u), h0_ = (int)__builtin_amdgcn_perm(ha_.y, ha_.x, 0x07060302u); \
        const int l1_ = (int)__builtin_amdgcn_perm(ha_.w, ha_.z, 0x05040100u), h1_ = (int)__builtin_amdgcn_perm(ha_.w, ha_.z, 0x07060302u); \
        const int l2_ = (int)__builtin_amdgcn_perm(hb_.y, hb_.x, 0x05040100u), h2_ = (int)__builtin_amdgcn_perm(hb_.y, hb_.x, 0x07060302u); \
        const int l3_ = (int)__builtin_amdgcn_perm(hb_.w, hb_.z, 0x05040100u), h3_ = (int)__builtin_amdgcn_perm(hb_.w, hb_.z, 0x07060302u); \
        int p_[16]; \
        _Pragma("unroll") for (int i_ = 0; i_ < 16; ++i_) { \
            int al_ = __builtin_amdgcn_sdot8((int)buf[i_].x, l0_, 0, false); al_ = __builtin_amdgcn_sdot8((int)buf[i_].y, l1_, al_, false); \
            al_ = __builtin_amdgcn_sdot8((int)buf[i_].z, l2_, al_, false); al_ = __builtin_amdgcn_sdot8((int)buf[i_].w, l3_, al_, false); \
            int ah_ = __builtin_amdgcn_sdot8((int)buf[i_].x, h0_, 0, false); ah_ = __builtin_amdgcn_sdot8((int)buf[i_].y, h1_, ah_, false); \
            ah_ = __builtin_amdgcn_sdot8((int)buf[i_].z, h2_, ah_, false); ah_ = __builtin_amdgcn_sdot8((int)buf[i_].w, h3_, ah_, false); \
            p_[i_] = reduce8i(al_ + (ah_ << 4)); } \
        const int lo_ = sel8i(SL, p_[0], p_[1], p_[2], p_[3], p_[4], p_[5], p_[6], p_[7]), hi_ = sel8i(SL, p_[8], p_[9], p_[10], p_[11], p_[12], p_[13], p_[14], p_[15]); \
        PARTA[((size_t)slice * T + (tok)) * 64 + lane] = (int)((((unsigned)(lo_ + 4) >> 3) & 0xffffu) | ((unsigned)((hi_ + 4) >> 3) << 16)); }
#define PU_PROCESS_HG(buf, tok, hav, hbv, ids) { \
        const u32x4 ha_ = (hav), hb_ = (hbv); \
        const int l0_ = (int)__builtin_amdgcn_perm(ha_.y, ha_.x, 0x05040100u), h0_ = (int)__builtin_amdgcn_perm(ha_.y, ha_.x, 0x07060302u); \
        const int l1_ = (int)__builtin_amdgcn_perm(ha_.w, ha_.z, 0x05040100u), h1_ = (int)__builtin_amdgcn_perm(ha_.w, ha_.z, 0x07060302u); \
        const int l2_ = (int)__builtin_amdgcn_perm(hb_.y, hb_.x, 0x05040100u), h2_ = (int)__builtin_amdgcn_perm(hb_.y, hb_.x, 0x07060302u); \
        const int l3_ = (int)__builtin_amdgcn_perm(hb_.w, hb_.z, 0x05040100u), h3_ = (int)__builtin_amdgcn_perm(hb_.w, hb_.z, 0x07060302u); \
        int p_[16]; \
        _Pragma("unroll") for (int i_ = 0; i_ < 16; ++i_) { \
            int al_ = __builtin_amdgcn_sdot8((int)buf[i_].x, l0_, 0, false); al_ = __builtin_amdgcn_sdot8((int)buf[i_].y, l1_, al_, false); \
            al_ = __builtin_amdgcn_sdot8((int)buf[i_].z, l2_, al_, false); al_ = __builtin_amdgcn_sdot8((int)buf[i_].w, l3_, al_, false); \
            int ah_ = __builtin_amdgcn_sdot8((int)buf[i_].x, h0_, 0, false); ah_ = __builtin_amdgcn_sdot8((int)buf[i_].y, h1_, ah_, false); \
            ah_ = __builtin_amdgcn_sdot8((int)buf[i_].z, h2_, ah_, false); ah_ = __builtin_amdgcn_sdot8((int)buf[i_].w, h3_, ah_, false); \
            p_[i_] = reduce8i(al_ + (ah_ << 4)); \
            if ((i_ & 3) == 3) { PU_GATHER4(buf, ids, (i_ >> 2)); } } \
        const int lo_ = sel8i(SL, p_[0], p_[1], p_[2], p_[3], p_[4], p_[5], p_[6], p_[7]), hi_ = sel8i(SL, p_[8], p_[9], p_[10], p_[11], p_[12], p_[13], p_[14], p_[15]); \
        if ((tok) < T) PARTA[((size_t)slice * T + (tok)) * 64 + lane] = (int)((((unsigned)(lo_ + 4) >> 3) & 0xffffu) | ((unsigned)((hi_ + 4) >> 3) << 16)); }
constexpr int NSLU = 8;
#else
#define PU_PROCESS(buf, tok) { \
        const u32x4 hq_ = *(const u32x4*)(H2Q + (size_t)(tok) * D + slice * 128 + c16); \
        int p_[16]; \
        _Pragma("unroll") for (int i_ = 0; i_ < 16; ++i_) { int a_ = __builtin_amdgcn_sdot4((int)buf[i_].x, (int)hq_.x, 0, false); \
            a_ = __builtin_amdgcn_sdot4((int)buf[i_].y, (int)hq_.y, a_, false); a_ = __builtin_amdgcn_sdot4((int)buf[i_].z, (int)hq_.z, a_, false); a_ = __builtin_amdgcn_sdot4((int)buf[i_].w, (int)hq_.w, a_, false); \
            p_[i_] = reduce8i(a_); } \
        const int lo_ = sel8i(SL, p_[0], p_[1], p_[2], p_[3], p_[4], p_[5], p_[6], p_[7]), hi_ = sel8i(SL, p_[8], p_[9], p_[10], p_[11], p_[12], p_[13], p_[14], p_[15]); \
        if (PART16) {   \
            PARTA[((size_t)slice * T + (tok)) * 64 + lane] = (int)((((unsigned)(lo_ + 32) >> 6) & 0xffffu) | ((unsigned)((hi_ + 32) >> 6) << 16)); \
        } else { int* o_ = PARTA + ((size_t)slice * T + (tok)) * 128 + g * 16 + c8; o_[0] = lo_; o_[8] = hi_; } }
constexpr int NSLU = 16;
#endif
__device__ __forceinline__ void step_peer_u(const Ctx& c, const XcdPlace& P) {
    const unsigned char* H2Q = WSP(unsigned char, WS_H2Q); const unsigned char* H2N = WSP(unsigned char, WS_H2N); const unsigned char* U8 = WSP(unsigned char, WS_UB); const int* EP = WSP(int, WS_EXP); int* PARTA = WSP(int, WS_PARTA);
    const unsigned* EP16 = WSP(unsigned, WS_EP16); (void)H2Q; (void)H2N; (void)EP16; (void)EP;
    const int lane = c.lane, g = lane >> 3, c8 = lane & 7, wid = P.rank * NWAVES + c.wave, nw = P.nloc * NWAVES;
    const Sel8 SL{__ballot((c8 & 1) != 0), __ballot((c8 & 2) != 0), __ballot((c8 & 4) != 0)};
    const unsigned c16 = (unsigned)c8 * 16u;
    for (int slice = P.xrank; slice < NSLU; slice += P.nx) {
        const unsigned char* ub = U8 + (size_t)slice * 16384 * 128;
#if U_INT4
#define PU_TOK(x) ((x) < T ? (x) : T - 1)
#define PU_IDS16(ids, tok) { ids[0] = *(const u32x4*)(EP16 + (size_t)(tok) * 64 + g * 8); ids[1] = *(const u32x4*)(EP16 + (size_t)(tok) * 64 + g * 8 + 4); }
#define PU_HLOAD(h0, h1, tok) { h0 = *(const u32x4*)(H2N + (size_t)(tok) * D + slice * 256 + c8 * 32); h1 = *(const u32x4*)(H2N + (size_t)(tok) * D + slice * 256 + c8 * 32 + 16); }
#define PU_ROW(w_, hi_) (*(const u32x4*)(ub + (((hi_) ? ((w_) >> 16) : ((w_) & 0xffffu)) * 128u + c16)))
#define PU_GATHER4(buf, ids, j_) { const unsigned w0_ = ids[(j_) >> 1][(2 * (j_)) & 3], w1_ = ids[(j_) >> 1][(2 * (j_) + 1) & 3]; \
        buf[4 * (j_) + 0] = PU_ROW(w0_, 0); buf[4 * (j_) + 1] = PU_ROW(w0_, 1); buf[4 * (j_) + 2] = PU_ROW(w1_, 0); buf[4 * (j_) + 3] = PU_ROW(w1_, 1); }
#define PU_GATHER16(buf, ids) { _Pragma("unroll") for (int q_ = 0; q_ < 4; ++q_) PU_GATHER4(buf, ids, q_); }
        u32x4 idA[2], idB[2]; u32x4 A[16], B[16]; u32x4 hA0, hA1, hB0, hB1;
        int t = wid;
        if (t < T) {
            PU_IDS16(idA, t); PU_HLOAD(hA0, hA1, t); PU_IDS16(idB, PU_TOK(t + nw)); PU_HLOAD(hB0, hB1, PU_TOK(t + nw));
            PU_GATHER16(A, idA); PU_IDS16(idA, PU_TOK(t + 2 * nw)); PU_GATHER16(B, idB);
            __builtin_amdgcn_s_waitcnt(0x0F70);
            for (; t < T; t += 2 * nw) {
                PU_IDS16(idB, PU_TOK(t + 3 * nw));
                PU_PROCESS_HG(A, t, hA0, hA1, idA);
                PU_IDS16(idA, PU_TOK(t + 4 * nw));
                PU_HLOAD(hA0, hA1, PU_TOK(t + 2 * nw));
                PU_PROCESS_HG(B, t + nw, hB0, hB1, idB);
                PU_HLOAD(hB0, hB1, PU_TOK(t + 3 * nw));
            }
        }
#else
        u32x4 idn[4]; u32x4 A[16], B[16];
        int t = wid;
        if (t < T) { PS_IDS(idn, t); PS_GATHER(A, idn, ub); }
        if (t + nw < T) { PS_IDS(idn, t + nw); PS_GATHER(B, idn, ub); }
        for (; t < T; t += 2 * nw) {
            if (t + 2 * nw < T) PS_IDS(idn, t + 2 * nw);
            PU_PROCESS(A, t);
            if (t + 2 * nw < T) { PS_GATHER(A, idn, ub); }
            if (t + nw < T) {
                if (t + 3 * nw < T) PS_IDS(idn, t + 3 * nw);
                PU_PROCESS(B, t + nw);
                if (t + 3 * nw < T) { PS_GATHER(B, idn, ub); }
            }
        }
#endif
    }
}
#if V_INT8
__device__ __forceinline__ void step_peer_w(const Ctx& c) {
    const int* PARTA = WSP(int, WS_PARTA); const int* EP = WSP(int, WS_EXP); const float* G = WSP(float, WS_GATE); unsigned* W8 = WSP(unsigned, WS_W8);
    const float* SCU = WSP(float, WS_SCU); const float* SCV = WSP(float, WS_SCV); const float* HS = WSP(float, WS_HS); float* WSC = WSP(float, WS_WS);
    const int g = c.lane >> 3, c8 = c.lane & 7, i0 = g * 16 + c8, i1 = i0 + 8;
#if V_INT4 && U_INT4 && PART16
    for (int t = c.gw; t < T; t += 8 * c.ngw) {
        int pq[8][NSLU], e0[8], e1[8]; float g0[8], g1[8], hsv[8];
#pragma unroll
        for (int k = 0; k < 8; ++k) { const int tk = (t + k * c.ngw) < T ? (t + k * c.ngw) : T - 1;
#pragma unroll
            for (int sl = 0; sl < NSLU; ++sl) pq[k][sl] = PARTA[((size_t)sl * T + tk) * 64 + c.lane];
            const size_t base = (size_t)tk * 128; e0[k] = EP[base + i0]; e1[k] = EP[base + i1]; g0[k] = G[base + i0]; g1[k] = G[base + i1]; hsv[k] = HS[tk]; }
        float su0[8], su1[8], sv0[8], sv1[8];
#pragma unroll
        for (int k = 0; k < 8; ++k) { su0[k] = SCU[e0[k]]; su1[k] = SCU[e1[k]]; sv0[k] = SCV[e0[k]]; sv1[k] = SCV[e1[k]]; }
#pragma unroll
        for (int k = 0; k < 8; ++k) { const int tk = t + k * c.ngw;
            int a0 = 0, a1 = 0;
#pragma unroll
            for (int sl = 0; sl < NSLU; ++sl) { const int p = pq[k][sl]; a0 += (int)(short)(p & 0xffff); a1 += p >> 16; }
            const float hs = hsv[k] * 8.f;
            const float w0 = g0[k] * gelu_f((float)a0 * (su0[k] * hs)) * sv0[k], w1 = g1[k] * gelu_f((float)a1 * (su1[k] * hs)) * sv1[k];
            float am = fmaxf(fabsf(w0), fabsf(w1));
            am = DPPMAX(am, 0xB1); am = DPPMAX(am, 0x4E); am = DPPMAX(am, 0x141); am = DPPMAX(am, 0x140);
            const unsigned m0 = __builtin_amdgcn_readlane(__float_as_uint(am), 0), m1 = __builtin_amdgcn_readlane(__float_as_uint(am), 16), m2 = __builtin_amdgcn_readlane(__float_as_uint(am), 32), m3 = __builtin_amdgcn_readlane(__float_as_uint(am), 48);
            const unsigned m01 = m0 > m1 ? m0 : m1, m23 = m2 > m3 ? m2 : m3; am = __uint_as_float(m01 > m23 ? m01 : m23);
            const float inv4 = am > 0.f ? 119.f / am : 0.f;
            const int q0 = (int)__builtin_rintf(w0 * inv4), q1 = (int)__builtin_rintf(w1 * inv4);
            const int sh = 4 * c8;
            const int l0 = reduce8i((q0 & 15) << sh), h0 = reduce8i((((q0 + 8) >> 4) & 15) << sh), l1 = reduce8i((q1 & 15) << sh), h1 = reduce8i((((q1 + 8) >> 4) & 15) << sh);
            if (tk < T) {
                if (c8 == 0) *(u32x4*)(W8 + (size_t)tk * 32 + g * 4) = (u32x4){(unsigned)l0, (unsigned)h0, (unsigned)l1, (unsigned)h1};
                if (c.lane == 0) WSC[tk] = am * (1.f / 119.f);
            }
        }
    }
    return;
#endif
    for (int t = c.gw; t < T; t += c.ngw) {
        int a0 = 0, a1 = 0;
#if PART16
#pragma unroll
        for (int sl = 0; sl < NSLU; ++sl) { const int p = PARTA[((size_t)sl * T + t) * 64 + c.lane]; a0 += (int)(short)(p & 0xffff); a1 += p >> 16; }
        const float descale = U_INT4 ? 8.f : 64.f;
#else
#pragma unroll
        for (int sl = 0; sl < 16; ++sl) { a0 += PARTA[((size_t)sl * T + t) * 128 + i0]; a1 += PARTA[((size_t)sl * T + t) * 128 + i1]; }
        const float descale = 1.f;
#endif
        const size_t base = (size_t)t * 128;
        const int e0 = EP[base + i0], e1 = EP[base + i1]; const float g0 = G[base + i0], g1 = G[base + i1], hs = HS[t] * descale;
        const float w0 = g0 * gelu_f((float)a0 * (SCU[e0] * hs)) * SCV[e0], w1 = g1 * gelu_f((float)a1 * (SCU[e1] * hs)) * SCV[e1];
        float am = fmaxf(fabsf(w0), fabsf(w1));
        am = DPPMAX(am, 0xB1); am = DPPMAX(am, 0x4E); am = DPPMAX(am, 0x141); am = DPPMAX(am, 0x140);
        const unsigned m0 = __builtin_amdgcn_readlane(__float_as_uint(am), 0), m1 = __builtin_amdgcn_readlane(__float_as_uint(am), 16), m2 = __builtin_amdgcn_readlane(__float_as_uint(am), 32), m3 = __builtin_amdgcn_readlane(__float_as_uint(am), 48);
        const unsigned m01 = m0 > m1 ? m0 : m1, m23 = m2 > m3 ? m2 : m3; am = __uint_as_float(m01 > m23 ? m01 : m23);
#if V_INT4 && U_INT4
        {
            const float inv4 = am > 0.f ? 119.f / am : 0.f;
            const int q0 = (int)__builtin_rintf(w0 * inv4), q1 = (int)__builtin_rintf(w1 * inv4);
            const int sh = 4 * c8;
            const int l0 = reduce8i((q0 & 15) << sh), h0 = reduce8i((((q0 + 8) >> 4) & 15) << sh), l1 = reduce8i((q1 & 15) << sh), h1 = reduce8i((((q1 + 8) >> 4) & 15) << sh);
            if (c8 == 0) *(u32x4*)(W8 + (size_t)t * 32 + g * 4) = (u32x4){(unsigned)l0, (unsigned)h0, (unsigned)l1, (unsigned)h1};
            if (c.lane == 0) WSC[t] = am * (1.f / 119.f);
            continue;
        }
#endif
        const float inv = am > 0.f ? 127.f / am : 0.f;
        const int q0 = (int)__builtin_rintf(w0 * inv) & 0xff, q1 = (int)__builtin_rintf(w1 * inv) & 0xff;
        const int pk = q0 | (q1 << 8);
        const int b0 = DPPI(pk, 0x00), b1 = DPPI(pk, 0x55), b2 = DPPI(pk, 0xAA), b3 = DPPI(pk, 0xFF);
        const unsigned dlo = (unsigned)(b0 & 0xff) | ((unsigned)(b1 & 0xff) << 8) | ((unsigned)(b2 & 0xff) << 16) | ((unsigned)(b3 & 0xff) << 24);
        const unsigned dhi = ((unsigned)(b0 >> 8) & 0xff) | (((unsigned)(b1 >> 8) & 0xff) << 8) | (((unsigned)(b2 >> 8) & 0xff) << 16) | (((unsigned)(b3 >> 8) & 0xff) << 24);
        if ((c.lane & 3) == 0) { W8[(size_t)t * 32 + g * 4 + (c8 >> 2)] = dlo; W8[(size_t)t * 32 + g * 4 + 2 + (c8 >> 2)] = dhi; }
        if (c.lane == 0) WSC[t] = am * (1.f / 127.f);
    }
}
#else
__device__ __forceinline__ void step_peer_w(const Ctx& c) {
    const int* PARTA = WSP(int, WS_PARTA); const int* EP = WSP(int, WS_EXP); float* GW = WSP(float, WS_GATE); const float* SCU = WSP(float, WS_SCU); const float* SCV = WSP(float, WS_SCV); const float* HS = WSP(float, WS_HS);
    for (int idx = c.gt; idx < T * 128; idx += c.ngt) {
        int a = 0;
#pragma unroll
        for (int sl = 0; sl < 16; ++sl) a += PARTA[(size_t)sl * T * 128 + idx];
        const int e = EP[idx];
        GW[idx] = GW[idx] * gelu_f((float)a * (SCU[e] * HS[idx >> 7])) * SCV[e];
    }
}
#endif
#if V_INT8
#define PV_PROCESS(buf, tok) { \
        const u32x4 wq_ = *(const u32x4*)(W8 + (size_t)(tok) * 32 + g * 4); const float wsc_ = WSC[tok]; \
        int acc_[16]; _Pragma("unroll") for (int q_ = 0; q_ < 16; ++q_) acc_[q_] = 0; \
        _Pragma("unroll") for (int j_ = 0; j_ < 4; ++j_) { const int w4_ = (int)wq_[j_]; \
            _Pragma("unroll") for (int q_ = 0; q_ < 4; ++q_) { \
                const unsigned a_ = buf[4 * j_][q_], b_ = buf[4 * j_ + 1][q_], c_ = buf[4 * j_ + 2][q_], d_ = buf[4 * j_ + 3][q_]; \
                const unsigned tl_ = __builtin_amdgcn_perm(b_, a_, 0x05010400u), th_ = __builtin_amdgcn_perm(b_, a_, 0x07030602u); \
                const unsigned ul_ = __builtin_amdgcn_perm(d_, c_, 0x05010400u), uh_ = __builtin_amdgcn_perm(d_, c_, 0x07030602u); \
                acc_[4 * q_ + 0] = __builtin_amdgcn_sdot4((int)__builtin_amdgcn_perm(ul_, tl_, 0x05040100u), w4_, acc_[4 * q_ + 0], false); \
                acc_[4 * q_ + 1] = __builtin_amdgcn_sdot4((int)__builtin_amdgcn_perm(ul_, tl_, 0x07060302u), w4_, acc_[4 * q_ + 1], false); \
                acc_[4 * q_ + 2] = __builtin_amdgcn_sdot4((int)__builtin_amdgcn_perm(uh_, th_, 0x05040100u), w4_, acc_[4 * q_ + 2], false); \
                acc_[4 * q_ + 3] = __builtin_amdgcn_sdot4((int)__builtin_amdgcn_perm(uh_, th_, 0x07060302u), w4_, acc_[4 * q_ + 3], false); } } \
        int p_[16]; \
        _Pragma("unroll") for (int q_ = 0; q_ < 16; ++q_) p_[q_] = acc_[q_] + DPPI(acc_[q_], 0x128); \
        int q8_[8]; \
        _Pragma("unroll") for (int k_ = 0; k_ < 8; ++k_) { const auto r_ = __builtin_amdgcn_permlane16_swap((unsigned)p_[k_], (unsigned)p_[k_ + 8], false, false); q8_[k_] = (int)r_[0] + (int)r_[1]; } \
        int r4_[4]; \
        _Pragma("unroll") for (int k_ = 0; k_ < 4; ++k_) { const auto r_ = __builtin_amdgcn_permlane32_swap((unsigned)q8_[k_], (unsigned)q8_[k_ + 4], false, false); r4_[k_] = (int)r_[0] + (int)r_[1]; } \
        if ((lane & 8) == 0) *(u32x2*)(Y + (size_t)(tok) * D + slice * 128 + ocol) = (u32x2){cvtpk((float)r4_[0] * wsc_, (float)r4_[1] * wsc_), cvtpk((float)r4_[2] * wsc_, (float)r4_[3] * wsc_)}; }
#define PV_PROCESS_W(buf, tok, wqv, wsv) { \
        const u32x4 wq_ = (wqv); const float wsc_ = (wsv); \
        int acc_[16]; _Pragma("unroll") for (int q_ = 0; q_ < 16; ++q_) acc_[q_] = 0; \
        _Pragma("unroll") for (int j_ = 0; j_ < 4; ++j_) { const int w4_ = (int)wq_[j_]; \
            _Pragma("unroll") for (int q_ = 0; q_ < 4; ++q_) { \
                const unsigned a_ = buf[4 * j_][q_], b_ = buf[4 * j_ + 1][q_], c_ = buf[4 * j_ + 2][q_], d_ = buf[4 * j_ + 3][q_]; \
                const unsigned tl_ = __builtin_amdgcn_perm(b_, a_, 0x05010400u), th_ = __builtin_amdgcn_perm(b_, a_, 0x07030602u); \
                const unsigned ul_ = __builtin_amdgcn_perm(d_, c_, 0x05010400u), uh_ = __builtin_amdgcn_perm(d_, c_, 0x07030602u); \
                acc_[4 * q_ + 0] = __builtin_amdgcn_sdot4((int)__builtin_amdgcn_perm(ul_, tl_, 0x05040100u), w4_, acc_[4 * q_ + 0], false); \
                acc_[4 * q_ + 1] = __builtin_amdgcn_sdot4((int)__builtin_amdgcn_perm(ul_, tl_, 0x07060302u), w4_, acc_[4 * q_ + 1], false); \
                acc_[4 * q_ + 2] = __builtin_amdgcn_sdot4((int)__builtin_amdgcn_perm(uh_, th_, 0x05040100u), w4_, acc_[4 * q_ + 2], false); \
                acc_[4 * q_ + 3] = __builtin_amdgcn_sdot4((int)__builtin_amdgcn_perm(uh_, th_, 0x07060302u), w4_, acc_[4 * q_ + 3], false); } } \
        int p_[16]; \
        _Pragma("unroll") for (int q_ = 0; q_ < 16; ++q_) p_[q_] = acc_[q_] + DPPI(acc_[q_], 0x128); \
        int q8_[8]; \
        _Pragma("unroll") for (int k_ = 0; k_ < 8; ++k_) { const auto r_ = __builtin_amdgcn_permlane16_swap((unsigned)p_[k_], (unsigned)p_[k_ + 8], false, false); q8_[k_] = (int)r_[0] + (int)r_[1]; } \
        int r4_[4]; \
        _Pragma("unroll") for (int k_ = 0; k_ < 4; ++k_) { const auto r_ = __builtin_amdgcn_permlane32_swap((unsigned)q8_[k_], (unsigned)q8_[k_ + 4], false, false); r4_[k_] = (int)r_[0] + (int)r_[1]; } \
        if ((lane & 8) == 0) *(u32x2*)(Y + (size_t)(tok) * D + slice * 128 + ocol) = (u32x2){cvtpk((float)r4_[0] * wsc_, (float)r4_[1] * wsc_), cvtpk((float)r4_[2] * wsc_, (float)r4_[3] * wsc_)}; }
#define PV_PROCESS_WG(buf, tok, wqv, wsv, NEXT, ids, tabp) { \
        const u32x4 wq_ = (wqv); const float wsc_ = (wsv); \
        int acc_[16]; _Pragma("unroll") for (int q_ = 0; q_ < 16; ++q_) acc_[q_] = 0; \
        _Pragma("unroll") for (int j_ = 0; j_ < 4; ++j_) { const int w4_ = (int)wq_[j_]; \
            _Pragma("unroll") for (int q_ = 0; q_ < 4; ++q_) { \
                const unsigned a_ = buf[4 * j_][q_], b_ = buf[4 * j_ + 1][q_], c_ = buf[4 * j_ + 2][q_], d_ = buf[4 * j_ + 3][q_]; \
                const unsigned tl_ = __builtin_amdgcn_perm(b_, a_, 0x05010400u), th_ = __builtin_amdgcn_perm(b_, a_, 0x07030602u); \
                const unsigned ul_ = __builtin_amdgcn_perm(d_, c_, 0x05010400u), uh_ = __builtin_amdgcn_perm(d_, c_, 0x07030602u); \
                acc_[4 * q_ + 0] = __builtin_amdgcn_sdot4((int)__builtin_amdgcn_perm(ul_, tl_, 0x05040100u), w4_, acc_[4 * q_ + 0], false); \
                acc_[4 * q_ + 1] = __builtin_amdgcn_sdot4((int)__builtin_amdgcn_perm(ul_, tl_, 0x07060302u), w4_, acc_[4 * q_ + 1], false); \
                acc_[4 * q_ + 2] = __builtin_amdgcn_sdot4((int)__builtin_amdgcn_perm(uh_, th_, 0x05040100u), w4_, acc_[4 * q_ + 2], false); \
                acc_[4 * q_ + 3] = __builtin_amdgcn_sdot4((int)__builtin_amdgcn_perm(uh_, th_, 0x07060302u), w4_, acc_[4 * q_ + 3], false); } \
              \
            PV_GATHER4(buf, ids, j_); } \
        int p_[16]; \
        _Pragma("unroll") for (int q_ = 0; q_ < 16; ++q_) p_[q_] = acc_[q_] + DPPI(acc_[q_], 0x128); \
        int q8_[8]; \
        _Pragma("unroll") for (int k_ = 0; k_ < 8; ++k_) { const auto r_ = __builtin_amdgcn_permlane16_swap((unsigned)p_[k_], (unsigned)p_[k_ + 8], false, false); q8_[k_] = (int)r_[0] + (int)r_[1]; } \
        int r4_[4]; \
        _Pragma("unroll") for (int k_ = 0; k_ < 4; ++k_) { const auto r_ = __builtin_amdgcn_permlane32_swap((unsigned)q8_[k_], (unsigned)q8_[k_ + 4], false, false); r4_[k_] = (int)r_[0] + (int)r_[1]; } \
        if ((lane & 8) == 0) *(u32x2*)(Y + (size_t)(tok) * D + slice * 128 + ocol) = (u32x2){cvtpk((float)r4_[0] * wsc_, (float)r4_[1] * wsc_), cvtpk((float)r4_[2] * wsc_, (float)r4_[3] * wsc_)}; }
#else
#define PV_PROCESS(buf, tok) { \
        f32x4 wv_[4]; _Pragma("unroll") for (int q_ = 0; q_ < 4; ++q_) wv_[q_] = *(const f32x4*)(GW + (size_t)(tok) * 128 + g * 16 + q_ * 4); \
        f32x2 acc_[8]; _Pragma("unroll") for (int q_ = 0; q_ < 8; ++q_) acc_[q_] = (f32x2){0.f, 0.f}; \
        _Pragma("unroll") for (int i_ = 0; i_ < 16; ++i_) { const float w1_ = wv_[i_ >> 2][i_ & 3]; const f32x2 ww_ = {w1_, w1_}; \
            _Pragma("unroll") for (int q_ = 0; q_ < 4; ++q_) { const int w_ = (int)buf[i_][q_]; acc_[2 * q_] += __builtin_amdgcn_cvt_pk_f32_fp8(w_, false) * ww_; acc_[2 * q_ + 1] += __builtin_amdgcn_cvt_pk_f32_fp8(w_, true) * ww_; } } \
        float p_[16]; \
        _Pragma("unroll") for (int q_ = 0; q_ < 8; ++q_) { p_[2 * q_] = acc_[q_].x + DPPF(acc_[q_].x, 0x128); p_[2 * q_ + 1] = acc_[q_].y + DPPF(acc_[q_].y, 0x128); } \
        float q8_[8]; \
        _Pragma("unroll") for (int k_ = 0; k_ < 8; ++k_) { const auto r_ = __builtin_amdgcn_permlane16_swap(__float_as_uint(p_[k_]), __float_as_uint(p_[k_ + 8]), false, false); q8_[k_] = __uint_as_float(r_[0]) + __uint_as_float(r_[1]); } \
        float r4_[4]; \
        _Pragma("unroll") for (int k_ = 0; k_ < 4; ++k_) { const auto r_ = __builtin_amdgcn_permlane32_swap(__float_as_uint(q8_[k_]), __float_as_uint(q8_[k_ + 4]), false, false); r4_[k_] = __uint_as_float(r_[0]) + __uint_as_float(r_[1]); } \
        if ((lane & 8) == 0) *(u32x2*)(Y + (size_t)(tok) * D + slice * 128 + ocol) = (u32x2){cvtpk(r4_[0], r4_[1]), cvtpk(r4_[2], r4_[3])}; }
#endif
#if V_INT4 && U_INT4
#define PV4_T8(buf, blk_, q_, col_) { \
        const unsigned r0_ = buf[8 * (blk_) + 0][q_], r1_ = buf[8 * (blk_) + 1][q_], r2_ = buf[8 * (blk_) + 2][q_], r3_ = buf[8 * (blk_) + 3][q_]; \
        const unsigned r4_ = buf[8 * (blk_) + 4][q_], r5_ = buf[8 * (blk_) + 5][q_], r6_ = buf[8 * (blk_) + 6][q_], r7_ = buf[8 * (blk_) + 7][q_]; \
        const unsigned a0_ = __builtin_amdgcn_perm(r4_, r0_, 0x05040100u), a4_ = __builtin_amdgcn_perm(r4_, r0_, 0x07060302u), a1_ = __builtin_amdgcn_perm(r5_, r1_, 0x05040100u), a5_ = __builtin_amdgcn_perm(r5_, r1_, 0x07060302u); \
        const unsigned a2_ = __builtin_amdgcn_perm(r6_, r2_, 0x05040100u), a6_ = __builtin_amdgcn_perm(r6_, r2_, 0x07060302u), a3_ = __builtin_amdgcn_perm(r7_, r3_, 0x05040100u), a7_ = __builtin_amdgcn_perm(r7_, r3_, 0x07060302u); \
        const unsigned b0_ = __builtin_amdgcn_perm(a2_, a0_, 0x06020400u), b2_ = __builtin_amdgcn_perm(a2_, a0_, 0x07030501u), b1_ = __builtin_amdgcn_perm(a3_, a1_, 0x06020400u), b3_ = __builtin_amdgcn_perm(a3_, a1_, 0x07030501u); \
        const unsigned b4_ = __builtin_amdgcn_perm(a6_, a4_, 0x06020400u), b6_ = __builtin_amdgcn_perm(a6_, a4_, 0x07030501u), b5_ = __builtin_amdgcn_perm(a7_, a5_, 0x06020400u), b7_ = __builtin_amdgcn_perm(a7_, a5_, 0x07030501u); \
        const unsigned M_ = 0x0F0F0F0Fu; \
        col_[0] = (b0_ & M_) | ((b1_ << 4) & ~M_); col_[1] = ((b0_ >> 4) & M_) | (b1_ & ~M_); col_[2] = (b2_ & M_) | ((b3_ << 4) & ~M_); col_[3] = ((b2_ >> 4) & M_) | (b3_ & ~M_); \
        col_[4] = (b4_ & M_) | ((b5_ << 4) & ~M_); col_[5] = ((b4_ >> 4) & M_) | (b5_ & ~M_); col_[6] = (b6_ & M_) | ((b7_ << 4) & ~M_); col_[7] = ((b6_ >> 4) & M_) | (b7_ & ~M_); }
#define PV4_PROCESS(buf, tok, wqv, wsv, ids) { const u32x4 wq_ = (wqv); const float wsc_ = (wsv); \
        int S_[32]; \
        _Pragma("unroll") for (int q_ = 0; q_ < 4; ++q_) { unsigned c0_[8], c1_[8]; PV4_T8(buf, 0, q_, c0_); PV4_T8(buf, 1, q_, c1_); \
            _Pragma("unroll") for (int c_ = 0; c_ < 8; ++c_) { \
                int hi_ = __builtin_amdgcn_sdot8((int)c0_[c_], (int)wq_.y, 0, false); hi_ = __builtin_amdgcn_sdot8((int)c1_[c_], (int)wq_.w, hi_, false); \
                int lo_ = __builtin_amdgcn_sdot8((int)c0_[c_], (int)wq_.x, hi_ << 4, false); S_[8 * q_ + c_] = __builtin_amdgcn_sdot8((int)c1_[c_], (int)wq_.z, lo_, false); } } \
        PV_GATHER4(buf, ids, 0); PV_GATHER4(buf, ids, 1); PV_GATHER4(buf, ids, 2); PV_GATHER4(buf, ids, 3); \
          \
        int q16_[16]; _Pragma("unroll") for (int k_ = 0; k_ < 16; ++k_) { const auto r_ = __builtin_amdgcn_permlane16_swap((unsigned)S_[k_], (unsigned)S_[k_ + 16], false, false); q16_[k_] = (int)r_[0] + (int)r_[1]; } \
        int r8_[8]; _Pragma("unroll") for (int k_ = 0; k_ < 8; ++k_) { const auto r_ = __builtin_amdgcn_permlane32_swap((unsigned)q16_[k_], (unsigned)q16_[k_ + 8], false, false); r8_[k_] = (int)r_[0] + (int)r_[1]; } \
        _Pragma("unroll") for (int k_ = 0; k_ < 8; ++k_) r8_[k_] += DPPI(r8_[k_], 0x128); \
        if ((lane & 8) == 0 && (tok) < T) *(u32x4*)(Y + (size_t)(tok) * D + slice * 256 + ocol4) = (u32x4){cvtpk((float)r8_[0] * wsc_, (float)r8_[1] * wsc_), cvtpk((float)r8_[2] * wsc_, (float)r8_[3] * wsc_), \
                cvtpk((float)r8_[4] * wsc_, (float)r8_[5] * wsc_), cvtpk((float)r8_[6] * wsc_, (float)r8_[7] * wsc_)}; }
#endif
__device__ __forceinline__ void step_peer_v(const Ctx& c, const XcdPlace& P) {
    const unsigned char* V8 = WSP(unsigned char, WS_VB); const int* EP = WSP(int, WS_EXP); const float* GW = WSP(float, WS_GATE); bf16_t* Y = WSP(bf16_t, WS_Y);
    const unsigned* W8 = WSP(unsigned, WS_W8); const float* WSC = WSP(float, WS_WS); const unsigned* EP16 = WSP(unsigned, WS_EP16); (void)GW; (void)W8; (void)WSC; (void)EP16; (void)EP;
    const int lane = c.lane, g = lane >> 3, c8 = lane & 7, wid = P.rank * NWAVES + c.wave, nw = P.nloc * NWAVES;
    const int ocol = c8 * 16 + 8 * ((lane >> 4) & 1) + 4 * (lane >> 5);
    const int ocol4 = c8 * 32 + 16 * ((lane >> 4) & 1) + 8 * (lane >> 5); (void)ocol; (void)ocol4;
    constexpr int NSLV = (V_INT4 && U_INT4) ? 8 : 16;
    const unsigned c16 = (unsigned)c8 * 16u;
    for (int slice = P.xrank; slice < NSLV; slice += P.nx) {
        const unsigned char* vb = V8 + (size_t)slice * 16384 * 128;
#if V_INT8
#define PV_IDS16(ids, tok) { ids[0] = *(const u32x4*)(EP16 + (size_t)(tok) * 64 + g * 8); ids[1] = *(const u32x4*)(EP16 + (size_t)(tok) * 64 + g * 8 + 4); }
#define PV_ROW(w_, hi_) (*(const u32x4*)(vb + (((hi_) ? ((w_) >> 16) : ((w_) & 0xffffu)) * 128u + c16)))
#define PV_GATHER4(buf, ids, j_) { const unsigned w0_ = ids[(j_) >> 1][(2 * (j_)) & 3], w1_ = ids[(j_) >> 1][(2 * (j_) + 1) & 3]; \
        buf[4 * (j_) + 0] = PV_ROW(w0_, 0); buf[4 * (j_) + 1] = PV_ROW(w0_, 1); buf[4 * (j_) + 2] = PV_ROW(w1_, 0); buf[4 * (j_) + 3] = PV_ROW(w1_, 1); }
#define PV_GATHER16(buf, ids) { _Pragma("unroll") for (int q_ = 0; q_ < 4; ++q_) PV_GATHER4(buf, ids, q_); }
#define PV_TOK(x) ((x) < T ? (x) : T - 1)
#define PV_WLOAD(wv, sv, tok) { wv = *(const u32x4*)(W8 + (size_t)(tok) * 32 + g * 4); sv = WSC[tok]; }
        u32x4 idA[2], idB[2]; u32x4 A[16], B[16]; u32x4 wA, wB; float sA, sB;
        int t = wid;
        if (t < T) {
            PV_IDS16(idA, t); PV_WLOAD(wA, sA, t); PV_IDS16(idB, PV_TOK(t + nw)); PV_WLOAD(wB, sB, PV_TOK(t + nw));
            PV_GATHER16(A, idA); PV_IDS16(idA, PV_TOK(t + 2 * nw)); PV_GATHER16(B, idB);
            __builtin_amdgcn_s_waitcnt(0x0F70);
            for (; t < T; t += 2 * nw) {
                PV_IDS16(idB, PV_TOK(t + 3 * nw));
#if V_INT4 && U_INT4
                PV4_PROCESS(A, t, wA, sA, idA);
#else
                PV_PROCESS_WG(A, t, wA, sA, true, idA, vb);
#endif
                PV_IDS16(idA, PV_TOK(t + 4 * nw));
                PV_WLOAD(wA, sA, PV_TOK(t + 2 * nw));
#if V_INT4 && U_INT4
                PV4_PROCESS(B, t + nw, wB, sB, idB);
#else
                if (t + nw < T) { PV_PROCESS_WG(B, t + nw, wB, sB, true, idB, vb); }
#endif
                PV_WLOAD(wB, sB, PV_TOK(t + 3 * nw));
            }
        }
#else
        u32x4 idn[4]; u32x4 A[16], B[16];
        int t = wid;
        if (t < T) { PS_IDS(idn, t); PS_GATHER(A, idn, vb); }
        if (t + nw < T) { PS_IDS(idn, t + nw); PS_GATHER(B, idn, vb); }
        for (; t < T; t += 2 * nw) {
            if (t + 2 * nw < T) PS_IDS(idn, t + 2 * nw);
            PV_PROCESS(A, t);
            if (t + 2 * nw < T) { PS_GATHER(A, idn, vb); }
            if (t + nw < T) {
                if (t + 3 * nw < T) PS_IDS(idn, t + 3 * nw);
                PV_PROCESS(B, t + nw);
                if (t + 3 * nw < T) { PS_GATHER(B, idn, vb); }
            }
        }
#endif
    }
}
__device__ __forceinline__ void step_ln2(const Ctx& c) {
    const float* MOD = WSP(float, WS_MOD); const bf16_t* Y = WSP(bf16_t, WS_Y); const bf16_t* X1B = WSP(bf16_t, WS_X1B);
    LAS float* Lg = (LAS float*)c.lds;
    for (int i = c.tid; i < 512; i += NTHR) { ((LAS f32x4*)Lg)[i] = ((const f32x4*)IN_LN2G)[i]; ((LAS f32x4*)Lg)[512 + i] = ((const f32x4*)IN_LN2B)[i]; }
    for (int i = c.tid; i < 4 * 512; i += NTHR) { const int bq = i >> 9, r = i & 511; ((LAS f32x4*)Lg)[1024 + i] = ((const f32x4*)(MOD + bq * NMOD + 5 * D))[r]; }
    __syncthreads();
    u32x2 xc[8], xn[8], yc[8], yn[8];
    int t = c.gw;
#define LN2_LOAD(xa, ya, tok) { _Pragma("unroll") for (int j_ = 0; j_ < 8; ++j_) { xa[j_] = *(const u32x2*)(X1B + (size_t)(tok) * D + j_ * 256 + c.lane * 4); ya[j_] = *(const u32x2*)(Y + (size_t)(tok) * D + j_ * 256 + c.lane * 4); } }
    if (t < T) LN2_LOAD(xc, yc, t);
    for (; t < T; t += c.ngw) {
        const int tn = t + c.ngw;
        if (tn < T) LN2_LOAD(xn, yn, tn);
        const int b = t >> 12; float* row = c.out + (size_t)t * D; const LAS float* g2 = Lg + 4096 + b * 2048;
        f32x4 v[8]; float s = 0.f;
#pragma unroll
        for (int j = 0; j < 8; ++j) { const int col = j * 256 + c.lane * 4; const f32x4 gv = *(const LAS f32x4*)(g2 + col); const u32x2 xw = xc[j], yw = yc[j];
            v[j] = (f32x4){ALPHA * bflo(xw.x) + gv.x * bflo(yw.x), ALPHA * bfhi(xw.x) + gv.y * bfhi(yw.x), ALPHA * bflo(xw.y) + gv.z * bflo(yw.y), ALPHA * bfhi(xw.y) + gv.w * bfhi(yw.y)};
            s += (v[j].x + v[j].y) + (v[j].z + v[j].w); }
        const float mean = wave_sum_all(s) * (1.f / D); float s2 = 0.f;
#pragma unroll
        for (int j = 0; j < 8; ++j) { v[j] = v[j] - mean; s2 += (v[j].x * v[j].x + v[j].y * v[j].y) + (v[j].z * v[j].z + v[j].w * v[j].w); }
        const float rstd = rsqrtf(wave_sum_all(s2) * (1.f / D) + EPS);
#pragma unroll
        for (int j = 0; j < 8; ++j) { const int col = j * 256 + c.lane * 4; const f32x4 gg = *(const LAS f32x4*)(Lg + col), bb = *(const LAS f32x4*)(Lg + 2048 + col);
            *(f32x4*)(row + col) = v[j] * rstd * gg + bb; }
#pragma unroll
        for (int j = 0; j < 8; ++j) { xc[j] = xn[j]; yc[j] = yn[j]; }
    }
#undef LN2_LOAD
}

__device__ __forceinline__ void step_requant(const Ctx& c) {
    const bf16_t* YCAT = WSP(bf16_t, WS_ACT); const float* SSP = WSP(float, WS_SSP); unsigned char* A8 = WSP(unsigned char, WS_A8); float* SA2 = WSP(float, WS_SA2);
    for (int t = c.gw; t < T; t += c.ngw) {
        float s1 = 0.f, s2 = 0.f;
#pragma unroll
        for (int j = 0; j < 4; ++j) { const f32x4 a = *(const f32x4*)(SSP + (size_t)t * 32 + 4 * j), b = *(const f32x4*)(SSP + (size_t)t * 32 + 16 + 4 * j); s1 += (a.x + a.y) + (a.z + a.w); s2 += (b.x + b.y) + (b.z + b.w); }
        const float r1 = rsqrtf(s1 * (1.f / 1024.f) + EPS), r2 = rsqrtf(s2 * (1.f / 1024.f) + EPS);
        f32x4 v[8]; float am = 0.f;
#pragma unroll
        for (int j = 0; j < 8; ++j) { const u32x2 w = *(const u32x2*)(YCAT + (size_t)t * D + j * 256 + c.lane * 4); const float r = j < 4 ? r1 : r2;
            v[j] = (f32x4){bflo(w.x), bfhi(w.x), bflo(w.y), bfhi(w.y)} * r; am = fmaxf(am, fmaxf(fmaxf(fabsf(v[j].x), fabsf(v[j].y)), fmaxf(fabsf(v[j].z), fabsf(v[j].w)))); }
        am = DPPMAX(am, 0xB1); am = DPPMAX(am, 0x4E); am = DPPMAX(am, 0x141); am = DPPMAX(am, 0x140);
        const unsigned a0 = __builtin_amdgcn_readlane(__float_as_uint(am), 0), a1 = __builtin_amdgcn_readlane(__float_as_uint(am), 16), a2 = __builtin_amdgcn_readlane(__float_as_uint(am), 32), a3 = __builtin_amdgcn_readlane(__float_as_uint(am), 48);
        const unsigned m01 = a0 > a1 ? a0 : a1, m23 = a2 > a3 ? a2 : a3; am = __uint_as_float(m01 > m23 ? m01 : m23);
        const float inv = am > 0.f ? 127.f / am : 0.f;
#pragma unroll
        for (int j = 0; j < 8; ++j) *(unsigned*)(A8 + (size_t)t * D + j * 256 + c.lane * 4) = pack_i8x4(v[j] * inv);
        if (c.lane == 0) SA2[t] = am * (1.f / 127.f);
    }
}
__device__ __forceinline__ void step_wq8(const Ctx& c) {
    LAS float* scr = (LAS float*)(c.lds + c.wave * 16384);
    if (I8_GEMM3 && FAST_GEMM) { for (int it = c.gw; it < (D / 64) * (D / 32); it += c.ngw) transpose_item_i8<false>(IN_WQ, D, D, D, WSP(unsigned char, WS_WQ), WSP(unsigned, WS_CTL) + CW_AMXQ, WSP(float, WS_SWQ), scr, it, c.lane); }
    if (I8_GEMM2 && FAST_GEMM) { for (int it = c.gw; it < (D / 64) * (D / 32); it += c.ngw) transpose_item_i8<false, true>(IN_WOUT, D, D, D, WSP(unsigned char, WS_WOUT), WSP(unsigned, WS_CTL) + CW_AMXOUT, WSP(float, WS_SWOUT), scr, it, c.lane, IN_SSMG, IN_ATTG); }
    if (I8_GEMM1 && FAST_GEMM) { for (int it = c.gw; it < (D / 64) * (DINP / 32); it += c.ngw) transpose_item_i8<true>(IN_WIN, D, 3856, DINP, WSP(unsigned char, WS_WIN), WSP(unsigned, WS_CTL) + CW_AMXIN, WSP(float, WS_SWIN), scr, it, c.lane); }
}

#if TAB_PROBE
__device__ __forceinline__ void tabp_load_coal(f32x4 (&v)[8], const float* src, int lane) {
#pragma unroll
    for (int i = 0; i < 8; ++i) v[i] = *(const f32x4*)(src + i * 256 + lane * 4);
}
template <int ROWMAJOR>
__device__ __forceinline__ void tabp_finish_coal(const f32x4 (&v)[8], unsigned char* tab, int row, float* scale, int lane) {
    float am = 0.f;
#pragma unroll
    for (int i = 0; i < 8; ++i) am = fmaxf(am, fmaxf(fmaxf(fabsf(v[i].x), fabsf(v[i].y)), fmaxf(fabsf(v[i].z), fabsf(v[i].w))));
    am = DPPMAX(am, 0xB1); am = DPPMAX(am, 0x4E); am = DPPMAX(am, 0x141); am = DPPMAX(am, 0x140);
    { const unsigned a0 = __builtin_amdgcn_readlane(__float_as_uint(am), 0), a1 = __builtin_amdgcn_readlane(__float_as_uint(am), 16);
      const unsigned a2 = __builtin_amdgcn_readlane(__float_as_uint(am), 32), a3 = __builtin_amdgcn_readlane(__float_as_uint(am), 48);
      const unsigned m01 = a0 > a1 ? a0 : a1, m23 = a2 > a3 ? a2 : a3; am = __uint_as_float(m01 > m23 ? m01 : m23); }
    const float inv = am > 0.f ? 127.f / am : 0.f;
#pragma unroll
    for (int i = 0; i < 8; ++i) {
        const unsigned o = pack_i8x4(v[i] * inv);
        if (ROWMAJOR) *(unsigned*)(tab + (size_t)row * D + i * 256 + lane * 4) = o;
        else *(unsigned*)(tab + ((size_t)(2 * i) * 16384 + row) * 128 + ((unsigned)(lane >> 5) * (16384u * 128u) + (unsigned)(lane & 31) * 4u)) = o;
    }
    if (lane == 0) *scale = am / 127.f;
}
__device__ __forceinline__ void step_tab_probe(const Ctx& c) {
#define TABP_SRC(r_) ((r_) < 16384 ? IN_U + (size_t)(r_) * D : IN_V + (size_t)((r_) - 16384) * D)
    f32x4 cur[8], nxt[8];
    int r = c.gw;
#if TAB_PROBE == 1
    if (r < 2 * 16384) fp8_row_load(cur, TABP_SRC(r), c.lane);
    for (; r < 2 * 16384; r += c.ngw) {
        const int rn = r + c.ngw;
        if (rn < 2 * 16384) fp8_row_load(nxt, TABP_SRC(rn), c.lane);
        if (r < 16384) fp8_row_finish<true>(cur, WSP(unsigned char, WS_UB), r, WSP(float, WS_SCU) + r, c.lane);
        else fp8_row_finish<true>(cur, WSP(unsigned char, WS_VB), r - 16384, WSP(float, WS_SCV) + (r - 16384), c.lane);
#pragma unroll
        for (int i = 0; i < 8; ++i) cur[i] = nxt[i];
    }
#elif TAB_PROBE == 2 || TAB_PROBE == 3
    if (r < 2 * 16384) tabp_load_coal(cur, TABP_SRC(r), c.lane);
    for (; r < 2 * 16384; r += c.ngw) {
        const int rn = r + c.ngw;
        if (rn < 2 * 16384) tabp_load_coal(nxt, TABP_SRC(rn), c.lane);
        if (r < 16384) tabp_finish_coal<TAB_PROBE == 3>(cur, WSP(unsigned char, WS_UB), r, WSP(float, WS_SCU) + r, c.lane);
        else tabp_finish_coal<TAB_PROBE == 3>(cur, WSP(unsigned char, WS_VB), r - 16384, WSP(float, WS_SCV) + (r - 16384), c.lane);
#pragma unroll
        for (int i = 0; i < 8; ++i) cur[i] = nxt[i];
    }
#elif TAB_PROBE == 4
    float acc_ = 0.f;
    for (; r < 2 * 16384; r += c.ngw) { tabp_load_coal(cur, TABP_SRC(r), c.lane);
#pragma unroll
        for (int i = 0; i < 8; ++i) acc_ += (cur[i].x + cur[i].y) + (cur[i].z + cur[i].w); }
    if (acc_ == 1.2345e-30f) WSP(float, WS_SCU)[0] = acc_;
#endif
#undef TABP_SRC
}
#endif

constexpr int NSTEPS = 18;
__global__ void __launch_bounds__(NTHR, 2) fwd_kernel(Args a) {
    extern __shared__ __attribute__((aligned(16))) unsigned char lds_raw[];
    Ctx c;
#pragma unroll
    for (int i = 0; i < 22; ++i) c.in[i] = a.in[i];
    c.out = a.out; c.ws = a.ws; c.lds = (LAS unsigned char*)lds_raw;
    c.tid = threadIdx.x; c.lane = c.tid & 63; c.wave = __builtin_amdgcn_readfirstlane(c.tid >> 6);
    c.gw = blockIdx.x * NWAVES + c.wave; c.ngw = gridDim.x * NWAVES; c.gt = blockIdx.x * NTHR + c.tid; c.ngt = gridDim.x * NTHR;
    for (int u = c.tid; u < (LDS_BYTES - LDSCTL_OFF) / 4; u += NTHR) ((LAS unsigned*)(c.lds + LDSCTL_OFF))[u] = 0u;
    __syncthreads();
    const bool multi = (a.hi - a.lo) > 1;
    XcdBarrier bar; bar.bar = (unsigned*)(c.ws + WS_CTL); bar.x = 0; bar.st = (volatile LAS unsigned*)(c.lds + MISC_OFF);
    if (multi) bar = xcd_barrier_post((unsigned*)(c.ws + WS_CTL), (volatile LAS unsigned*)(c.lds + MISC_OFF));
#define STEP_IDS() { int tid_ = (int)threadIdx.x; asm volatile("" : "+v"(tid_)); c.tid = tid_; c.lane = tid_ & 63; c.gt = (int)blockIdx.x * NTHR + tid_; }
#define STEP(i, ...) if (a.lo <= (i) && (i) < a.hi) { STEP_IDS(); __VA_ARGS__; if ((REPEAT_MASK >> (i)) & 1) { xcd_barrier(bar); __VA_ARGS__; } if ((i) + 1 < a.hi) xcd_barrier(bar); }
    STEP(0, step_pro(c));
#if WQ_ONEPASS && I8_GEMM1 && I8_GEMM2 && I8_GEMM3 && FAST_GEMM
    STEP(1, step_h1(c));
#else
    STEP(1, { step_h1(c); step_wq8(c); });
#endif
#if FAST_GEMM
#define RUN_GEMM(EPI, MIDK, Aoff, Boff, N_, ...) { pg8::Gemm g{WSP(bf16_t, Aoff), WSP(bf16_t, Boff), T, N_, D}; pg8::StaticOrder S; S.init(T, N_, (int)gridDim.x, (int)blockIdx.x); \
        pg8::EpiA<EPI> E{EPI{__VA_ARGS__}}; pg8::gemm_phase<pg8::EpiA<EPI>, pg8::StaticOrder, false, true, MIDK>(c.lds, g, S, E); }
#else
#define RUN_GEMM(EPI, MIDK, Aoff, Boff, N_, ...) { EPI e{__VA_ARGS__}; gemm_simple<EPI, MIDK>(c, WSP(bf16_t, Aoff), WSP(bf16_t, Boff), T, N_, D, e); }
#endif
#if I8_GEMM1 && FAST_GEMM
    STEP(2, { pg8::Gemm g{WSP(bf16_t, WS_ACT), WSP(bf16_t, WS_WIN), T, DINP, D / 2}; pg8::StaticOrder S; S.init(T, DINP, (int)gridDim.x, (int)blockIdx.x);
        pg8::EpiA<Epi1Q, true> E{Epi1Q{WSP(bf16_t, WS_PROJ), WSP(float, WS_DTRAW), WSP(float, WS_SA1), WSP(float, WS_SWIN)}}; pg8::gemm_phase<pg8::EpiA<Epi1Q, true>, pg8::StaticOrder, false, true, false, true>(c.lds, g, S, E); });
#else
    STEP(2, RUN_GEMM(Epi1, false, WS_ACT, WS_WIN, DINP, WSP(bf16_t, WS_PROJ), WSP(float, WS_DTRAW)));
#endif
#if (FAST_MIX & 5) == 5
    STEP(3, { step_att_fast(c); step_conv_only(c); step_dta(c); });
#elif FAST_MIX & 1
    STEP(3, { step_conv_only(c); step_dta(c); });
#else
    STEP(3, step_conv(c));
#endif
#if FAST_MIX & 2
    STEP(4, step_ssd1_fast(c));
#else
    STEP(4, step_ssd1_simple(c));
#endif
#if (FAST_MIX & 5) == 5
#elif FAST_MIX & 4
    STEP(5, step_att_fast(c));
#else
    STEP(5, step_att_simple(c));
#endif
    STEP(6, step_scan(c));
#if FAST_MIX & 8
    STEP(8, step_ssd2_fast<0>(c));
#else
    STEP(7, step_cb_simple(c));
    STEP(8, step_ssd2_simple(c));
#endif
#if I8_GEMM2 && FAST_GEMM
    STEP(9, step_requant(c));
    STEP(10, { pg8::Gemm g{WSP(bf16_t, WS_A8), WSP(bf16_t, WS_WOUT), T, D, D / 2}; pg8::StaticOrder S; S.init(T, D, (int)gridDim.x, (int)blockIdx.x);
        pg8::EpiA<Epi2Q, true> E{Epi2Q{WSP(float, WS_MOD), WSP(float, WS_SA2), WSP(float, WS_SWOUT), WSP(bf16_t, WS_R1B)}}; pg8::gemm_phase<pg8::EpiA<Epi2Q, true>, pg8::StaticOrder, false, true, false, true>(c.lds, g, S, E); });
#else
    STEP(10, RUN_GEMM(Epi2, true, WS_ACT, WS_WOUT, D, IN_X, WSP(float, WS_MOD), WSP(float, WS_SSP), WSP(bf16_t, WS_R1B)));
#endif
    STEP(11, step_ln1(c));
#if I8_GEMM3 && FAST_GEMM && FUSE_TOPK && FAST_TOPK
    STEP(12, { pg8::Gemm g{WSP(bf16_t, WS_H2Q), WSP(bf16_t, WS_WQ), T, D, D / 2}; pg8::StaticOrder S; S.init(T, D, (int)gridDim.x, (int)blockIdx.x);
        pg8::EpiA<Epi3Q, true> E{Epi3Q{WSP(bf16_t, WS_PROJ), WSP(float, WS_HS), WSP(float, WS_SWQ)}}; pg8::gemm_phase<pg8::EpiA<Epi3Q, true>, pg8::StaticOrder, false, true, false, true>(c.lds, g, S, E);
        asm volatile("s_waitcnt vmcnt(0)" ::: "memory"); __syncthreads();
        pg8::Unit u; for (int i = 0; S.next(i, u); ++i) topk_groups(c, u.pn, u.pm * 8 + c.wave, u.pm * 8 + c.wave + 1, 1); });
#else
#if I8_GEMM3 && FAST_GEMM
    STEP(12, { pg8::Gemm g{WSP(bf16_t, WS_H2Q), WSP(bf16_t, WS_WQ), T, D, D / 2}; pg8::StaticOrder S; S.init(T, D, (int)gridDim.x, (int)blockIdx.x);
        pg8::EpiA<Epi3Q, true> E{Epi3Q{WSP(bf16_t, WS_PROJ), WSP(float, WS_HS), WSP(float, WS_SWQ)}}; pg8::gemm_phase<pg8::EpiA<Epi3Q, true>, pg8::StaticOrder, false, true, false, true>(c.lds, g, S, E); });
#else
    STEP(12, RUN_GEMM(Epi3, false, WS_ACT, WS_WQ, D, WSP(bf16_t, WS_PROJ)));
#endif
#if FAST_TOPK
    STEP(13, step_topk_fast(c));
#else
    STEP(13, step_topk_simple(c));
#endif
#endif
#if SLICED_PEER
    XcdPlace P; P.nloc = (int)gridDim.x; P.nx = 1; P.xrank = 0; P.rank = (int)blockIdx.x;
    if (multi && a.lo <= 14 && 14 < a.hi) {
        unsigned* bw = (unsigned*)(c.ws + WS_CTL); const unsigned myx = xb_xcc_id();
        LAS unsigned* pl = (LAS unsigned*)(c.lds + LDSCTL_OFF + 16);
        if (c.tid == 0) pl[0] = xb_add(bw + 16384 + 64 * myx, 1u);
        __syncthreads();
        int nx = 0, xr = 0, nl = 0;
#pragma unroll
        for (int j = 0; j < 16; ++j) { const int cj = (int)xb_ld(&bw[XB_XCNT(j)]); if (cj > 0) { if (j < (int)myx) ++xr; ++nx; } if (j == (int)myx) nl = cj; }
        if (nl > 0 && nx > 0) { P.nloc = nl; P.nx = nx; P.xrank = xr; P.rank = (int)pl[0]; }
    }
    STEP(14, step_peer_u(c, P));
    STEP(15, step_peer_w(c));
    STEP(16, step_peer_v(c, P));
#if SSD2_PROBE
    STEP(17, { step_ln2(c); xcd_barrier(bar); step_ssd2_fast<SSD2_PROBE>(c); });
#elif TAB_PROBE
    STEP(17, { step_ln2(c); xcd_barrier(bar); step_tab_probe(c); });
#else
    STEP(17, step_ln2(c));
#endif
#else
    STEP(14, step_peer(c));
#endif
#undef STEP
}
}

extern "C" void kernel_launch(void* const* d_in, const int* in_sizes, int n_in, void* d_out, int out_size, void* d_ws, size_t ws_size, hipStream_t stream) {
    static int grid = 0;
    if (grid == 0) {
        if (n_in != 22 || in_sizes[0] != T * D || out_size != T * D || ws_size < WS_END) {
            fprintf(stderr, "kernel_launch: unexpected problem (n_in %d, in0 %d, out %d, ws %zu < %zu); nothing launched\n", n_in, n_in > 0 ? in_sizes[0] : -1, out_size, ws_size, (size_t)WS_END);
            grid = -1; return;
        }
        int dev = 0, cus = 0;
        if (hipGetDevice(&dev) != hipSuccess || hipDeviceGetAttribute(&cus, hipDeviceAttributeMultiprocessorCount, dev) != hipSuccess) { grid = -1; return; }
        if (hipFuncSetAttribute((const void*)fwd_kernel, hipFuncAttributeMaxDynamicSharedMemorySize, LDS_BYTES) != hipSuccess) { fprintf(stderr, "kernel_launch: hipFuncSetAttribute failed\n"); grid = -1; return; }
        int per_cu = 0;
        if (hipOccupancyMaxActiveBlocksPerMultiprocessor(&per_cu, (const void*)fwd_kernel, NTHR, LDS_BYTES) != hipSuccess || per_cu < 1) fprintf(stderr, "kernel_launch: occupancy query reports %d blocks per CU\n", per_cu);
        (void)hipGetLastError();
        grid = cus > 0 ? cus : 256;
    }
    if (grid < 0) return;
    (void)hipMemsetAsync((char*)d_ws + WS_CTL, 0, CTL_ZERO_BYTES, stream);
    Args a{};
    for (int i = 0; i < 22; ++i) a.in[i] = (const float*)d_in[i];
    a.out = (float*)d_out; a.ws = (unsigned char*)d_ws;
#if ONE_LAUNCH
    a.lo = 0; a.hi = NSTEPS;
    hipLaunchKernelGGL(fwd_kernel, dim3(grid), dim3(NTHR), LDS_BYTES, stream, a);
#else
    for (int i = 0; i < NSTEPS; ++i) { a.lo = i; a.hi = i + 1; hipLaunchKernelGGL(fwd_kernel, dim3(grid), dim3(NTHR), LDS_BYTES, stream, a); }
#endif
}
```
